# Optimizing an MI355X kernel written in HIP

```python
import math
import jax, jax.numpy as jnp
from jax import lax
import numpy as np

D_MODEL = 1024
BATCH = 2
SEQ = 8192
DEPTH = 4

GRID_W = 64
CTX_LEN = 256
Q_BLOCK = 128
EPS = 1e-6
ROPE_THETA = 10000.0

A_HEADS = 6
A_KV_HEADS = 2
A_GROUP = A_HEADS // A_KV_HEADS
A_HEAD_DIM = 128
A_Q_WIDTH = A_HEADS * A_HEAD_DIM
A_KV_WIDTH = A_KV_HEADS * A_HEAD_DIM
B_GROUPS = 4
B_GROUP_DIM = 64
B_WIDTH = B_GROUPS * B_GROUP_DIM
EVEN_IN = A_Q_WIDTH + 2 * A_KV_WIDTH + B_WIDTH
EVEN_OUT = A_Q_WIDTH + B_WIDTH
EVEN_SPLIT = (A_Q_WIDTH, A_Q_WIDTH + A_KV_WIDTH, A_Q_WIDTH + 2 * A_KV_WIDTH)
C_HEADS = 8
C_QK_DIM = 64
C_V_DIM = 128
C_QK_WIDTH = C_HEADS * 2 * C_QK_DIM
C_V_WIDTH = C_HEADS * C_V_DIM
ODD_IN = 2 * C_QK_WIDTH + C_V_WIDTH
ODD_OUT = C_V_WIDTH
N_GROUPS = 4
EXPERTS_PER_GROUP = 4
N_EXPERTS = N_GROUPS * EXPERTS_PER_GROUP
TOP_K = 2
D_EXPERT = 512

kernel_name = "hybrid_gqa_fnet_diffattn_hmoe_dit"


def rms_norm(x, gain=None):
    xf = x.astype(jnp.float32)
    y = xf * lax.rsqrt(jnp.mean(xf * xf, axis=-1, keepdims=True) + EPS)
    if gain is not None:
        y = y * gain.astype(jnp.float32)
    return y.astype(x.dtype)


def axial_rope_tables(n_tokens, dim):
    rows = n_tokens // GRID_W
    row = jnp.broadcast_to(jnp.arange(rows, dtype=jnp.float32)[:, None], (rows, GRID_W)).reshape(-1)
    col = jnp.broadcast_to(jnp.arange(GRID_W, dtype=jnp.float32)[None, :], (rows, GRID_W)).reshape(-1)
    half = dim // 2
    inv_freq = ROPE_THETA ** (-jnp.arange(0, half, 2, dtype=jnp.float32) / half)
    ang_r = row[:, None] * inv_freq
    ang_c = col[:, None] * inv_freq
    return (jnp.cos(ang_r), jnp.sin(ang_r), jnp.cos(ang_c), jnp.sin(ang_c))


def _rotate(x, cos, sin):
    x1, x2 = jnp.split(x, 2, axis=-1)
    c = cos[:, None, :].astype(x.dtype)
    s = sin[:, None, :].astype(x.dtype)
    return jnp.concatenate([x1 * c - x2 * s, x1 * s + x2 * c], axis=-1)


def apply_axial_rope(x, tables):
    cr, sr, cc, sc = tables
    xr, xc = jnp.split(x, 2, axis=-1)
    return jnp.concatenate([_rotate(xr, cr, sr), _rotate(xc, cc, sc)], axis=-1)


def gqa_blocked(q, k, v):
    b, n = q.shape[:2]
    nb = n // Q_BLOCK
    qb = q.reshape(b, nb, Q_BLOCK, A_KV_HEADS, A_GROUP, A_HEAD_DIM).swapaxes(0, 1)
    scale = A_HEAD_DIM ** -0.5

    def block(qi):
        s = jnp.einsum('bqhgd,bkhd->bhgqk', qi, k).astype(jnp.float32) * scale
        p = jax.nn.softmax(s, axis=-1).astype(v.dtype)
        return jnp.einsum('bhgqk,bkhd->bqhgd', p, v)

    o = lax.map(block, qb)
    return o.swapaxes(0, 1).reshape(b, n, A_Q_WIDTH)


def diff_blocked(q, k, v, lam):
    b, n = q.shape[:2]
    nb = n // Q_BLOCK
    qb = q.reshape(b, nb, Q_BLOCK, C_HEADS, 2, C_QK_DIM).swapaxes(0, 1)
    scale = C_QK_DIM ** -0.5

    def block(qi):
        s = jnp.einsum('bqhmd,bkhmd->bmhqk', qi, k).astype(jnp.float32) * scale
        p = jax.nn.softmax(s, axis=-1)
        diff = (p[:, 0] - lam * p[:, 1]).astype(v.dtype)
        return jnp.einsum('bhqk,bkhd->bqhd', diff, v)

    o = lax.map(block, qb)
    return o.swapaxes(0, 1).reshape(b, n, C_HEADS, C_V_DIM)


def fourier_mix(f, gain):
    b, n, _ = f.shape
    g = rms_norm(f.reshape(b, n, B_GROUPS, B_GROUP_DIM), gain)
    spec = jnp.fft.fft2(g.astype(jnp.float32), axes=(1, 3), norm='ortho')
    return jnp.real(spec).astype(f.dtype).reshape(b, n, B_WIDTH)


def even_mixer(h_lat, h_ctx, w_in, w_out, q_gain, k_gain, f_gain, rope, need_ctx_out):
    def project(h):
        p = h @ w_in
        b, n, _ = p.shape
        q, k, v, f = jnp.split(p, EVEN_SPLIT, axis=-1)
        q = rms_norm(q.reshape(b, n, A_HEADS, A_HEAD_DIM), q_gain)
        k = rms_norm(k.reshape(b, n, A_KV_HEADS, A_HEAD_DIM), k_gain)
        v = v.reshape(b, n, A_KV_HEADS, A_HEAD_DIM)
        return q, k, v, f

    q_l, k_l, v_l, f_l = project(h_lat)
    q_c, k_c, v_c, f_c = project(h_ctx)
    q_l = apply_axial_rope(q_l, rope)
    k_l = apply_axial_rope(k_l, rope)
    k_all = jnp.concatenate([k_c, k_l], axis=1)
    v_all = jnp.concatenate([v_c, v_l], axis=1)
    y_lat = jnp.concatenate([gqa_blocked(q_l, k_all, v_all), fourier_mix(f_l, f_gain)], axis=-1) @ w_out
    if not need_ctx_out:
        return y_lat, None
    y_ctx = jnp.concatenate([gqa_blocked(q_c, k_c, v_c), fourier_mix(f_c, f_gain)], axis=-1) @ w_out
    return y_lat, y_ctx


def odd_mixer(h_lat, h_ctx, w_in, w_out, lq1, lk1, lq2, lk2, head_gain, lam_init, rope, need_ctx_out):
    f32 = jnp.float32
    lam = (jnp.exp(jnp.sum(lq1.astype(f32) * lk1.astype(f32)))
           - jnp.exp(jnp.sum(lq2.astype(f32) * lk2.astype(f32))) + lam_init)

    def project(h):
        p = h @ w_in
        b, n, _ = p.shape
        q, k, v = jnp.split(p, (C_QK_WIDTH, 2 * C_QK_WIDTH), axis=-1)
        return (q.reshape(b, n, 2 * C_HEADS, C_QK_DIM), k.reshape(b, n, 2 * C_HEADS, C_QK_DIM),
                v.reshape(b, n, C_HEADS, C_V_DIM))

    def to_maps(t):
        b, n = t.shape[:2]
        return t.reshape(b, n, C_HEADS, 2, C_QK_DIM)

    def finish(o):
        b, n = o.shape[:2]
        o = rms_norm(o, head_gain) * (1.0 - lam_init)
        return o.reshape(b, n, C_V_WIDTH) @ w_out

    q_l, k_l, v_l = project(h_lat)
    q_c, k_c, v_c = project(h_ctx)
    q_l = to_maps(apply_axial_rope(q_l, rope))
    k_l = to_maps(apply_axial_rope(k_l, rope))
    q_c, k_c = to_maps(q_c), to_maps(k_c)
    k_all = jnp.concatenate([k_c, k_l], axis=1)
    v_all = jnp.concatenate([v_c, v_l], axis=1)
    y_lat = finish(diff_blocked(q_l, k_all, v_all, lam))
    if not need_ctx_out:
        return y_lat, None
    return y_lat, finish(diff_blocked(q_c, k_c, v_c, lam))


def hierarchical_moe(h, w_group, b_group, w_router, b_router, w_gate, w_up, w_down):
    shape = h.shape
    tok = h.reshape(-1, shape[-1])
    g_logits = (tok @ w_group + b_group).astype(jnp.float32)
    g_prob = jax.nn.softmax(g_logits, axis=-1)
    g_idx = jnp.argmax(g_logits, axis=-1)
    g_gate = jnp.take_along_axis(g_prob, g_idx[:, None], axis=-1)
    e_logits = (tok @ w_router + b_router).astype(jnp.float32).reshape(-1, N_GROUPS, EXPERTS_PER_GROUP)
    e_sel = jnp.take_along_axis(e_logits, g_idx[:, None, None], axis=1)[:, 0]
    top_p, top_i = lax.top_k(jax.nn.softmax(e_sel, axis=-1), TOP_K)
    weights = g_gate * top_p / jnp.sum(top_p, axis=-1, keepdims=True)
    expert_id = g_idx[:, None] * EXPERTS_PER_GROUP + top_i
    dense_gate = jnp.einsum('nk,nke->en', weights, jax.nn.one_hot(expert_id, N_EXPERTS, dtype=jnp.float32))

    def expert_step(acc, params):
        wg, wu, wd, gate = params
        y = (jax.nn.silu(tok @ wg) * (tok @ wu)) @ wd
        return acc + gate[:, None].astype(y.dtype) * y, None

    out, _ = lax.scan(expert_step, jnp.zeros_like(tok), (w_gate, w_up, w_down, dense_gate))
    return out.reshape(shape)


def setup_inputs(seed: int = 0) -> dict:
    key = jax.random.key(seed)
    ks = jax.random.split(key, 26)
    n_even = (DEPTH + 1) // 2
    n_odd = DEPTH // 2

    def nrm(k, shape, s):
        return jax.random.normal(k, shape, jnp.float32) * s

    def gain(k, shape):
        return 1.0 + 0.02 * jax.random.normal(k, shape, jnp.float32)

    return {
        "x": nrm(ks[0], (BATCH, SEQ, D_MODEL), 1.0),
        "c": nrm(ks[1], (BATCH, D_MODEL), 1.0),
        "ctx": nrm(ks[2], (BATCH, CTX_LEN, D_MODEL), 1.0),
        "c_ctx": nrm(ks[3], (D_MODEL,), 1.0),
        "w_ada": nrm(ks[4], (DEPTH, D_MODEL, 6 * D_MODEL), 0.5 * D_MODEL ** -0.5),
        "b_ada": nrm(ks[5], (DEPTH, 6 * D_MODEL), 0.01),
        "w_in_even": nrm(ks[6], (n_even, D_MODEL, EVEN_IN), D_MODEL ** -0.5),
        "w_out_even": nrm(ks[7], (n_even, EVEN_OUT, D_MODEL), EVEN_OUT ** -0.5),
        "a_q_gain": gain(ks[8], (n_even, A_HEAD_DIM)),
        "a_k_gain": gain(ks[9], (n_even, A_HEAD_DIM)),
        "b_gain": gain(ks[10], (n_even, B_GROUPS, B_GROUP_DIM)),
        "w_in_odd": nrm(ks[11], (n_odd, D_MODEL, ODD_IN), D_MODEL ** -0.5),
        "w_out_odd": nrm(ks[12], (n_odd, ODD_OUT, D_MODEL), ODD_OUT ** -0.5),
        "c_lambda_q1": nrm(ks[13], (n_odd, C_QK_DIM), 0.1),
        "c_lambda_k1": nrm(ks[14], (n_odd, C_QK_DIM), 0.1),
        "c_lambda_q2": nrm(ks[15], (n_odd, C_QK_DIM), 0.1),
        "c_lambda_k2": nrm(ks[16], (n_odd, C_QK_DIM), 0.1),
        "c_head_gain": gain(ks[17], (n_odd, C_V_DIM)),
        "w_group": nrm(ks[18], (DEPTH, D_MODEL, N_GROUPS), D_MODEL ** -0.5),
        "b_group": nrm(ks[19], (DEPTH, N_GROUPS), 0.01),
        "w_router": nrm(ks[20], (DEPTH, D_MODEL, N_EXPERTS), D_MODEL ** -0.5),
        "b_router": nrm(ks[21], (DEPTH, N_EXPERTS), 0.01),
        "w_gate": nrm(ks[22], (DEPTH, N_EXPERTS, D_MODEL, D_EXPERT), D_MODEL ** -0.5),
        "w_up": nrm(ks[23], (DEPTH, N_EXPERTS, D_MODEL, D_EXPERT), D_MODEL ** -0.5),
        "w_down": nrm(ks[24], (DEPTH, N_EXPERTS, D_EXPERT, D_MODEL), D_EXPERT ** -0.5),
        "final_gain": gain(ks[25], (D_MODEL,)),
    }


def reference(x, c, ctx, c_ctx, w_ada, b_ada, w_in_even, w_out_even, a_q_gain, a_k_gain, b_gain,
              w_in_odd, w_out_odd, c_lambda_q1, c_lambda_k1, c_lambda_q2, c_lambda_k2, c_head_gain,
              w_group, b_group, w_router, b_router, w_gate, w_up, w_down, final_gain):
    n_lat = x.shape[1]
    rope_a = axial_rope_tables(n_lat, A_HEAD_DIM)
    rope_c = axial_rope_tables(n_lat, C_QK_DIM)
    silu_c = jax.nn.silu(c)
    silu_cc = jax.nn.silu(c_ctx)
    for l in range(DEPTH):
        last = l == DEPTH - 1
        i = l // 2
        mod = silu_c @ w_ada[l] + b_ada[l]
        mod_c = silu_cc @ w_ada[l] + b_ada[l]
        sh1, sc1, g1, sh2, sc2, g2 = jnp.split(mod[:, None, :], 6, axis=-1)
        csh1, csc1, cg1, csh2, csc2, cg2 = jnp.split(mod_c, 6, axis=-1)
        h_lat = rms_norm(x) * (1 + sc1) + sh1
        h_ctx = rms_norm(ctx) * (1 + csc1) + csh1
        if l % 2 == 0:
            y_lat, y_ctx = even_mixer(h_lat, h_ctx, w_in_even[i], w_out_even[i], a_q_gain[i], a_k_gain[i],
                                      b_gain[i], rope_a, not last)
        else:
            lam_init = 0.8 - 0.6 * math.exp(-0.3 * l)
            y_lat, y_ctx = odd_mixer(h_lat, h_ctx, w_in_odd[i], w_out_odd[i], c_lambda_q1[i], c_lambda_k1[i],
                                     c_lambda_q2[i], c_lambda_k2[i], c_head_gain[i], lam_init, rope_c, not last)
        x = x + g1 * y_lat
        x = x + g2 * hierarchical_moe(rms_norm(x) * (1 + sc2) + sh2, w_group[l], b_group[l], w_router[l],
                                      b_router[l], w_gate[l], w_up[l], w_down[l])
        if not last:
            ctx = ctx + cg1 * y_ctx
            ctx = ctx + cg2 * hierarchical_moe(rms_norm(ctx) * (1 + csc2) + csh2, w_group[l], b_group[l],
                                               w_router[l], b_router[l], w_gate[l], w_up[l], w_down[l])
    return rms_norm(x, final_gain)
```

```cpp
#include <hip/hip_runtime.h>
#include <cstdio>
#include <cstdint>

#ifndef MK_ONE_LAUNCH
#define MK_ONE_LAUNCH 1
#endif

#define GAS __attribute__((address_space(1)))
#define LAS __attribute__((address_space(3)))
typedef unsigned short bf16;
typedef float f32x4 __attribute__((ext_vector_type(4)));
typedef unsigned u32x4 __attribute__((ext_vector_type(4)));
typedef unsigned u32x2 __attribute__((ext_vector_type(2)));
typedef int i32x4 __attribute__((ext_vector_type(4)));
typedef int i32x2 __attribute__((ext_vector_type(2)));
typedef float f32x2 __attribute__((ext_vector_type(2)));

constexpr int NB = 2, SEQ = 8192, CTX = 256, TPB = SEQ + CTX, NTOK = NB * TPB, DM = 1024, DEPTH = 4;
constexpr int EIN = 1536, OIN = 3072, OAE = 1280, OAO = 1024, OTW = 2048;
constexpr int NEXP = 16, DEXP = 512;
constexpr int XS_TILES = 2 * NTOK / 256 + NEXP, XS_ROWS = XS_TILES * 256;
constexpr float EPS = 1e-6f;
constexpr int NTHREADS = 512, NWAVES = 8;

constexpr size_t MiB = 1u << 20;
constexpr size_t WS_CTL = 0, CTL_ZERO_BYTES = MiB;
constexpr size_t WS_MODV = 1 * MiB;
constexpr size_t WS_TABA = 1 * MiB + 512 * 1024;
constexpr size_t WS_TABC = WS_TABA + 32 * 1024;
constexpr size_t WS_LAM = WS_TABC + 16 * 1024;
constexpr size_t WS_SELA = 2 * MiB;
constexpr size_t WS_SELW = 2 * MiB + 512 * 1024;
constexpr size_t WS_RPOS = 2 * MiB + 768 * 1024;
constexpr size_t WS_WINE = 3 * MiB;
constexpr size_t WS_WOUTE = 9 * MiB;
constexpr size_t WS_WINO = 14 * MiB;
constexpr size_t WS_WOUTO = 26 * MiB;
constexpr size_t WS_WGU = 30 * MiB;
constexpr size_t WS_WD = 158 * MiB;
constexpr size_t WS_X = 222 * MiB;
constexpr size_t WS_HA = 288 * MiB;
constexpr size_t WS_YB = 321 * MiB;
constexpr size_t WS_PBUF = 337 * MiB;
constexpr size_t WS_OT = 436 * MiB;
constexpr size_t WS_OA = 502 * MiB;
constexpr size_t WS_XS = 337 * MiB;
constexpr size_t WS_HID = 411 * MiB;
constexpr size_t WS_Y2S = 448 * MiB;
constexpr size_t WS_END = 544 * MiB;
static_assert(WS_XS + (size_t)XS_ROWS * 1024 * 2 <= WS_HID && WS_HID + (size_t)XS_ROWS * 512 * 2 <= WS_Y2S && WS_Y2S + (size_t)XS_ROWS * 1024 * 2 <= WS_END, "moe overlay");
static_assert(WS_OA + (size_t)NTOK * OAE * 2 <= WS_END && WS_PBUF + (size_t)NTOK * OIN * 2 <= WS_OT && WS_OT + (size_t)NTOK * OTW * 2 <= WS_OA, "ws map");
constexpr int CW_BAR = 4096;
constexpr int CW_CNT = 16384;

constexpr int LDS_BYTES = 147456;
constexpr int MISC_OFF = 131072 + 320;

constexpr int PH_PRO_A = 0, PH_PRO_B = 1, PH_L0 = 2, PPL = 11;
constexpr int PL_INPROJ = 0, PL_QKFIX = 1, PL_FFT1 = 2, PL_ATTN = 3, PL_FINISH = 4, PL_OUTPROJ = 5, PL_ROUTER = 6, PL_GATHER = 7, PL_GU = 8, PL_DOWN = 9, PL_COMBINE = 10;
constexpr int N_PHASES = PH_L0 + DEPTH * PPL;

struct Args { const float* in[26]; float* out; unsigned char* ws; int ph_lo, ph_hi; };

__device__ __forceinline__ unsigned f2bf(float f) { unsigned u = __builtin_bit_cast(unsigned, f); return (u + 0x7fffu + ((u >> 16) & 1u)) >> 16; }
__device__ __forceinline__ unsigned pk2(float lo, float hi) { return f2bf(lo) | (f2bf(hi) << 16); }
__device__ __forceinline__ float bf2f(bf16 b) { return __builtin_bit_cast(float, (unsigned)b << 16); }
__device__ __forceinline__ float bflo(unsigned w) { return __builtin_bit_cast(float, w << 16); }
__device__ __forceinline__ float bfhi(unsigned w) { return __builtin_bit_cast(float, w & 0xffff0000u); }
__device__ __forceinline__ float wave_sum(float v) {
#pragma unroll
    for (int o = 1; o < 64; o <<= 1) v += __shfl_xor(v, o);
    return v;
}
__device__ __forceinline__ float silu_f(float x) { return x / (1.f + expf(-x)); }
#define LDS_WAIT() asm volatile("s_waitcnt lgkmcnt(0)" ::: "memory")

#define XB_TMO      128
#define XB_XCNT(j)  (256  + 64 * (j))
#define XB_XSUB(j)  (1280 + 64 * (j))
#define XB_XGEN(j)  (2304 + 64 * (j))
#define XB_TOP      3328
#define XB_TOPGEN   3392
#define XCD_BAR_WORDS 3456
#define XB_SPIN_CAP (1u << 24)
__device__ __forceinline__ unsigned xb_ld(unsigned* p)              { return __hip_atomic_load(p, __ATOMIC_RELAXED, __HIP_MEMORY_SCOPE_AGENT); }
__device__ __forceinline__ unsigned xb_add(unsigned* p, unsigned v) { return __hip_atomic_fetch_add(p, v, __ATOMIC_RELAXED, __HIP_MEMORY_SCOPE_AGENT); }
__device__ __forceinline__ unsigned xb_xcc_id() { return (unsigned)__builtin_amdgcn_s_getreg((3 << 11) | 20) & 0xFu; }
#define XB_SPIN(cond, bar) do { unsigned _sp = 0; while (cond) { __builtin_amdgcn_s_sleep(1); \
    if ((++_sp & 255u) == 0u) { if (xb_ld(&(bar)[XB_TMO])) break; if (_sp > XB_SPIN_CAP) { atomicAdd(&(bar)[XB_TMO], 1u); break; } } } } while (0)
struct XcdBarrier { unsigned* bar; unsigned x; volatile LAS unsigned* st; };
__device__ __forceinline__ XcdBarrier xcd_barrier_post(unsigned* bar, volatile LAS unsigned* st) {
    XcdBarrier b; b.bar = bar; b.x = xb_xcc_id(); b.st = st;
    if (threadIdx.x == 0) (void)xb_add(&bar[XB_XCNT(b.x)], 1u);
    return b;
}
__device__ __forceinline__ void xcd_barrier_complete(unsigned* bar, unsigned x, unsigned& nloc, unsigned& nx) {
    const unsigned G = gridDim.x * gridDim.y * gridDim.z;
    unsigned sum, cnt, mine, sp = 0u;
    for (;;) {
        sum = 0u; cnt = 0u; mine = 0u;
#pragma unroll
        for (unsigned j = 0; j < 16; ++j) { const unsigned c = xb_ld(&bar[XB_XCNT(j)]); sum += c; cnt += (c > 0u) ? 1u : 0u; mine = (j == x) ? c : mine; }
        if (sum == G) break;
        __builtin_amdgcn_s_sleep(1);
        if ((++sp & 255u) == 0u) { if (xb_ld(&bar[XB_TMO])) break; if (sp > XB_SPIN_CAP) { atomicAdd(&bar[XB_TMO], 1u); break; } }
    }
    nloc = mine > 0u ? mine : 1u; nx = cnt > 0u ? cnt : 1u;
}
__device__ __forceinline__ void xcd_barrier(const XcdBarrier& b) {
    asm volatile("s_waitcnt vmcnt(0)" ::: "memory");
    __syncthreads();
    if (threadIdx.x == 0) {
        unsigned* bar = b.bar;
        __builtin_amdgcn_s_waitcnt(0);
        unsigned nloc = b.st[0], nx = b.st[1];
        if (nloc == 0u) { xcd_barrier_complete(bar, b.x, nloc, nx); b.st[0] = nloc; b.st[1] = nx; }
        const unsigned old = xb_add(&bar[XB_XSUB(b.x)], 1u);
        const unsigned gen = old / nloc;
        if (old + 1u == (gen + 1u) * nloc) {
            __builtin_amdgcn_fence(__ATOMIC_RELEASE, "agent");
            asm volatile("s_waitcnt vmcnt(0)" ::: "memory");
            const unsigned og = xb_add(&bar[XB_TOP], 1u);
            const unsigned tg = og / nx;
            if (og + 1u == (tg + 1u) * nx) xb_add(&bar[XB_TOPGEN], 1u);
            else XB_SPIN(xb_ld(&bar[XB_TOPGEN]) == tg, bar);
            __builtin_amdgcn_fence(__ATOMIC_ACQUIRE, "agent");
            xb_add(&bar[XB_XGEN(b.x)], 1u);
            asm volatile("s_waitcnt vmcnt(0)" ::: "memory");
        } else {
            XB_SPIN(xb_ld(&bar[XB_XGEN(b.x)]) == gen, bar);
            __builtin_amdgcn_fence(__ATOMIC_ACQUIRE, "agent");
            asm volatile("s_waitcnt vmcnt(0)" ::: "memory");
        }
    }
    __syncthreads();
}

struct Frame {
    LAS unsigned char* lds;
    unsigned char* ws;
    int tid, lane, wave, bid, G;
};
template <class T> __device__ __forceinline__ T* opq(T* p) { asm volatile("" : "+s"(p)); return p; }
__device__ __forceinline__ Frame fresh(const Frame& F) { Frame G = F; asm volatile("" : "+s"(G.ws), "+s"(G.bid), "+s"(G.wave), "+v"(G.tid), "+v"(G.lane)); return G; }
#define AIN(k) opq(A.in[k])
__device__ __forceinline__ const float* modv(const Frame& F, int l, int type, int chunk) { return (const float*)(F.ws + WS_MODV) + ((size_t)(l * 3 + type) * 6 + chunk) * DM; }
__device__ __forceinline__ int row_type(int r) { const int b = r / TPB, j = r - b * TPB; return j < CTX ? 2 : b; }

__device__ __forceinline__ void load_row_f32(const float* p, int lane, f32x4 (&v)[4]) {
    const GAS f32x4* q = (const GAS f32x4*)p + lane;
#pragma unroll
    for (int j = 0; j < 4; ++j) v[j] = q[64 * j];
}
__device__ __forceinline__ void store_row_f32(float* p, int lane, const f32x4 (&v)[4]) {
    GAS f32x4* q = (GAS f32x4*)p + lane;
#pragma unroll
    for (int j = 0; j < 4; ++j) q[64 * j] = v[j];
}
__device__ __forceinline__ void load_row_bf16(const bf16* p, int lane, f32x4 (&v)[4]) {
    const GAS u32x2* q = (const GAS u32x2*)p + lane;
#pragma unroll
    for (int j = 0; j < 4; ++j) { const u32x2 w = q[64 * j]; v[j] = (f32x4){bflo(w.x), bfhi(w.x), bflo(w.y), bfhi(w.y)}; }
}
__device__ __forceinline__ void store_row_bf16(bf16* p, int lane, const f32x4 (&v)[4]) {
    GAS u32x2* q = (GAS u32x2*)p + lane;
#pragma unroll
    for (int j = 0; j < 4; ++j) { u32x2 w; w.x = pk2(v[j].x, v[j].y); w.y = pk2(v[j].z, v[j].w); q[64 * j] = w; }
}
__device__ __forceinline__ float row_rstd(const f32x4 (&v)[4]) {
    float s = 0.f;
#pragma unroll
    for (int j = 0; j < 4; ++j) s += (v[j].x * v[j].x + v[j].y * v[j].y) + (v[j].z * v[j].z + v[j].w * v[j].w);
    return rsqrtf(wave_sum(s) * (1.f / DM) + EPS);
}
__device__ __forceinline__ void modnorm_store(const f32x4 (&v)[4], const float* sc, const float* sh, bf16* dst, int lane) {
    const float rstd = row_rstd(v);
    f32x4 s[4], h[4], o[4]; load_row_f32(sc, lane, s); load_row_f32(sh, lane, h);
#pragma unroll
    for (int j = 0; j < 4; ++j) o[j] = v[j] * rstd * (s[j] + 1.f) + h[j];
    store_row_bf16(dst, lane, o);
}

constexpr int SG_AS = 132, SG_BS = 68;
template <class FA, class FB>
__device__ __forceinline__ void sg_tile(LAS float* As, LAS float* Bs, int K, FA fa, FB fb, float (&acc)[4][4], int tid) {
    const int ty = tid >> 4, tx = tid & 15;
#pragma unroll
    for (int i = 0; i < 4; ++i)
#pragma unroll
        for (int j = 0; j < 4; ++j) acc[i][j] = 0.f;
    for (int k0 = 0; k0 < K; k0 += 16) {
#pragma unroll
        for (int i = 0; i < 4; ++i) { const int idx = tid + 512 * i, m = idx >> 4, kk = idx & 15; As[kk * SG_AS + m] = fa(m, k0 + kk); }
#pragma unroll
        for (int i = 0; i < 2; ++i) { const int idx = tid + 512 * i, n = idx >> 4, kk = idx & 15; Bs[kk * SG_BS + n] = fb(k0 + kk, n); }
        __syncthreads();
#pragma unroll
        for (int kk = 0; kk < 16; ++kk) {
            const f32x4 a = *(const LAS f32x4*)(As + kk * SG_AS + 4 * ty), b = *(const LAS f32x4*)(Bs + kk * SG_BS + 4 * tx);
#pragma unroll
            for (int i = 0; i < 4; ++i)
#pragma unroll
                for (int j = 0; j < 4; ++j) acc[i][j] += a[i] * b[j];
        }
        __syncthreads();
    }
}

template <int DQK>
__device__ __forceinline__ void sattn_unit(LAS float* sm, const bf16* Q, int ldq, const bf16* Kp, int ldk, const bf16* Vp, int ldv, bf16* O, int ldo, int nkeys, float scale, int tid) {
    constexpr int QS = DQK + 1;
    LAS float* Qs = sm; LAS float* Ks = Qs + 32 * QS; LAS float* Vs = Ks + 64 * QS; LAS float* Ss = Vs + 64 * 128;
    const int qi = tid >> 4, sub = tid & 15;
    __syncthreads();
    for (int idx = tid; idx < 32 * DQK; idx += 512) { const int r = idx / DQK, d = idx % DQK; Qs[r * QS + d] = bf2f(Q[(size_t)r * ldq + d]) * scale; }
    float m = -1e30f, l = 0.f, acc[8];
#pragma unroll
    for (int e = 0; e < 8; ++e) acc[e] = 0.f;
    for (int k0 = 0; k0 < nkeys; k0 += 64) {
        __syncthreads();
        for (int idx = tid; idx < 64 * DQK; idx += 512) { const int r = idx / DQK, d = idx % DQK; Ks[r * QS + d] = bf2f(Kp[(size_t)(k0 + r) * ldk + d]); }
        for (int idx = tid; idx < 64 * 128; idx += 512) { const int r = idx >> 7, d = idx & 127; Vs[r * 128 + d] = bf2f(Vp[(size_t)(k0 + r) * ldv + d]); }
        __syncthreads();
        float s[4];
#pragma unroll
        for (int c = 0; c < 4; ++c) { const int kj = sub + 16 * c; float a = 0.f;
            for (int d = 0; d < DQK; ++d) a += Qs[qi * QS + d] * Ks[kj * QS + d];
            s[c] = a; }
        float tmax = fmaxf(fmaxf(s[0], s[1]), fmaxf(s[2], s[3]));
#pragma unroll
        for (int o = 1; o < 16; o <<= 1) tmax = fmaxf(tmax, __shfl_xor(tmax, o));
        const float mnew = fmaxf(m, tmax), alpha = expf(m - mnew);
        float ps = 0.f;
#pragma unroll
        for (int c = 0; c < 4; ++c) { const float p = expf(s[c] - mnew); ps += p; Ss[qi * 65 + sub + 16 * c] = p; }
#pragma unroll
        for (int o = 1; o < 16; o <<= 1) ps += __shfl_xor(ps, o);
        l = l * alpha + ps; m = mnew;
        __syncthreads();
#pragma unroll
        for (int e = 0; e < 8; ++e) acc[e] *= alpha;
        for (int k = 0; k < 64; ++k) { const float p = Ss[qi * 65 + k];
#pragma unroll
            for (int e = 0; e < 8; ++e) acc[e] += p * Vs[k * 128 + sub * 8 + e]; }
    }
    const float rl = 1.f / l;
    u32x4 w; w.x = pk2(acc[0] * rl, acc[1] * rl); w.y = pk2(acc[2] * rl, acc[3] * rl); w.z = pk2(acc[4] * rl, acc[5] * rl); w.w = pk2(acc[6] * rl, acc[7] * rl);
    *(GAS u32x4*)(O + (size_t)qi * ldo + sub * 8) = w;
}

template <class RM>
__device__ __forceinline__ void transpose_item(const float* W, int K, int N, bf16* WT, int ldt, RM rowmap, LAS float* scr, int item, int lane) {
    const int nblk = N / 32, kb = item / nblk, nb = item % nblk, k0 = 64 * kb, n0 = 32 * nb;
#pragma unroll 8
    for (int i = 0; i < 32; ++i) { const int kk = 2 * i + (lane >> 5); scr[kk * 33 + (lane & 31)] = W[(size_t)(k0 + kk) * N + n0 + (lane & 31)]; }
    LDS_WAIT(); asm volatile("" ::: "memory");
    const int c = lane & 7;
#pragma unroll
    for (int j = 0; j < 4; ++j) { const int n = (lane >> 3) + 8 * j; const LAS float* s = scr + (8 * c) * 33 + n;
        u32x4 o; o.x = pk2(s[0 * 33], s[1 * 33]); o.y = pk2(s[2 * 33], s[3 * 33]); o.z = pk2(s[4 * 33], s[5 * 33]); o.w = pk2(s[6 * 33], s[7 * 33]);
        *(GAS u32x4*)(WT + (size_t)rowmap(n0 + n) * ldt + k0 + 8 * c) = o; }
    LDS_WAIT(); asm volatile("" ::: "memory");
}

__device__ __forceinline__ void phase_pro_a(const Frame& F_, const Args& A) { const Frame F = fresh(F_);
    const int gw = F.bid * NWAVES + F.wave, NGW = F.G * NWAVES, gt = F.bid * NTHREADS + F.tid, NGT = F.G * NTHREADS;
    {
        LAS float* sv = (LAS float*)F.lds;
        LAS float* red = sv + 3 * DM;
        for (int i = F.tid; i < 3 * DM; i += NTHREADS) { const int t = i / DM, k = i % DM; const float x = (t < 2) ? AIN(1)[t * DM + k] : AIN(3)[k]; sv[i] = silu_f(x); }
        __syncthreads();
        for (int item = F.bid; item < DEPTH * 96; item += F.G) {
            const int l = item / 96, n0 = (item % 96) * 64, n = F.tid & 63, kp = F.tid >> 6;
            const float* w = AIN(4) + (size_t)l * DM * 6144 + n0 + n;
            float a0 = 0.f, a1 = 0.f, a2 = 0.f;
            for (int k = kp * 128; k < kp * 128 + 128; ++k) { const float wv = w[(size_t)k * 6144]; a0 += sv[k] * wv; a1 += sv[DM + k] * wv; a2 += sv[2 * DM + k] * wv; }
            red[(kp * 3 + 0) * 64 + n] = a0; red[(kp * 3 + 1) * 64 + n] = a1; red[(kp * 3 + 2) * 64 + n] = a2;
            __syncthreads();
            if (F.tid < 192) { const int t = F.tid >> 6, nn = F.tid & 63; float s = AIN(5)[l * 6144 + n0 + nn];
                for (int q = 0; q < 8; ++q) s += red[(q * 3 + t) * 64 + nn];
                ((float*)(F.ws + WS_MODV))[(size_t)(l * 3 + t) * 6144 + n0 + nn] = s; }
            __syncthreads();
        }
    }
    for (int i = gt; i < 128 * 32 + 128 * 16; i += NGT) {
        if (i < 128 * 32) { const int p = i >> 5, f = i & 31; const float inv = powf(10000.f, -(float)(2 * f) / 64.f), ang = (float)p * inv;
            ((float*)(F.ws + WS_TABA))[2 * i] = cosf(ang); ((float*)(F.ws + WS_TABA))[2 * i + 1] = sinf(ang); }
        else { const int ii = i - 128 * 32, p = ii >> 4, f = ii & 15; const float inv = powf(10000.f, -(float)(2 * f) / 32.f), ang = (float)p * inv;
            ((float*)(F.ws + WS_TABC))[2 * ii] = cosf(ang); ((float*)(F.ws + WS_TABC))[2 * ii + 1] = sinf(ang); }
    }
    if (F.bid == 0 && F.wave < 2) { const int i = F.wave; const float a = AIN(13)[i * 64 + F.lane] * AIN(14)[i * 64 + F.lane], b = AIN(15)[i * 64 + F.lane] * AIN(16)[i * 64 + F.lane];
        const float sa = wave_sum(a), sb = wave_sum(b); const int l = 2 * i + 1; const float lam_init = 0.8f - 0.6f * expf(-0.3f * (float)l);
        if (F.lane == 0) { ((float*)(F.ws + WS_LAM))[2 * i] = expf(sa) - expf(sb) + lam_init; ((float*)(F.ws + WS_LAM))[2 * i + 1] = lam_init; } }
    {
        LAS float* scr = (LAS float*)(F.lds + 16384) + F.wave * (64 * 33);
        constexpr int I_INE = (DM / 64) * (EIN / 32), I_OUT = (DM / 64) * (DM / 32), I_INO = (DM / 64) * (OIN / 32), I_G = (DM / 64) * (DEXP / 32), I_D = (DEXP / 64) * (DM / 32);
        constexpr int T_INE = 2 * I_INE, T_OUTE = 2 * I_OUT, T_INO = 2 * I_INO, T_OUTO = 2 * I_OUT, T_G = 64 * I_G, T_U = 64 * I_G, T_D = 64 * I_D;
        constexpr int NITEMS = T_INE + T_OUTE + T_INO + T_OUTO + T_G + T_U + T_D;
        for (int it = gw; it < NITEMS; it += NGW) {
            int r = it;
            if (r < T_INE) { const int i = r / I_INE; transpose_item(AIN(6) + (size_t)i * DM * EIN, DM, EIN, (bf16*)(F.ws + WS_WINE) + (size_t)i * EIN * DM, DM, [](int n) { return n; }, scr, r % I_INE, F.lane); continue; } r -= T_INE;
            if (r < T_OUTE) { const int i = r / I_OUT, item = r % I_OUT;
                if (item / (DM / 32) < 12) transpose_item(AIN(7) + (size_t)i * DM * DM, DM, DM, (bf16*)(F.ws + WS_WOUTE) + (size_t)i * DM * OAE, OAE, [](int n) { return n; }, scr, item, F.lane);
                continue; } r -= T_OUTE;
            if (r < T_INO) { const int i = r / I_INO; transpose_item(AIN(11) + (size_t)i * DM * OIN, DM, OIN, (bf16*)(F.ws + WS_WINO) + (size_t)i * OIN * DM, DM, [](int n) { return n; }, scr, r % I_INO, F.lane); continue; } r -= T_INO;
            if (r < T_OUTO) { const int i = r / I_OUT; transpose_item(AIN(12) + (size_t)i * DM * DM, DM, DM, (bf16*)(F.ws + WS_WOUTO) + (size_t)i * DM * DM, DM, [](int n) { return n; }, scr, r % I_OUT, F.lane); continue; } r -= T_OUTO;
            if (r < T_G) { const int le = r / I_G; transpose_item(AIN(22) + (size_t)le * DM * DEXP, DM, DEXP, (bf16*)(F.ws + WS_WGU) + (size_t)le * DM * DM, DM, [](int n) { return (n >> 7) * 256 + (n & 127); }, scr, r % I_G, F.lane); continue; } r -= T_G;
            if (r < T_U) { const int le = r / I_G; transpose_item(AIN(23) + (size_t)le * DM * DEXP, DM, DEXP, (bf16*)(F.ws + WS_WGU) + (size_t)le * DM * DM, DM, [](int n) { return (n >> 7) * 256 + 128 + (n & 127); }, scr, r % I_G, F.lane); continue; } r -= T_U;
            { const int le = r / I_D; transpose_item(AIN(24) + (size_t)le * DEXP * DM, DEXP, DM, (bf16*)(F.ws + WS_WD) + (size_t)le * DM * DEXP, DEXP, [](int n) { return n; }, scr, r % I_D, F.lane); }
        }
    }
    for (int o = gt; o < 2 * 2 * 256 * DM; o += NGT) {
        const int n = o & 1023, gc = (o >> 10) & 255, ri = (o >> 18) & 1, i = o >> 19, g = gc >> 6, c = gc & 63;
        const float* w = AIN(7) + (size_t)i * DM * DM + (size_t)(768 + 64 * g) * DM + n;
        float a = 0.f;
        for (int m = 0; m < 64; ++m) { const float fr = (float)((m * c) & 63) * (1.f / 64.f); const float t = ri ? __builtin_amdgcn_sinf(fr) : __builtin_amdgcn_cosf(fr); a += t * w[(size_t)m * DM]; }
        ((bf16*)(F.ws + WS_WOUTE))[(size_t)i * DM * OAE + (size_t)n * OAE + 768 + ri * 256 + gc] = (bf16)f2bf(a);
    }
}

__device__ __forceinline__ void phase_pro_b(const Frame& F_, const Args& A) { const Frame F = fresh(F_);
    const int gw = F.bid * NWAVES + F.wave, NGW = F.G * NWAVES;
    for (int r = gw; r < NTOK; r += NGW) {
        const int b = r / TPB, j = r - b * TPB, type = j < CTX ? 2 : b;
        const float* src = j < CTX ? AIN(2) + (size_t)(b * CTX + j) * DM : AIN(0) + (size_t)(b * SEQ + (j - CTX)) * DM;
        f32x4 v[4]; load_row_f32(src, F.lane, v);
        store_row_f32((float*)(F.ws + WS_X) + (size_t)r * DM, F.lane, v);
        modnorm_store(v, modv(F, 0, type, 1), modv(F, 0, type, 0), (bf16*)(F.ws + WS_HA) + (size_t)r * DM, F.lane);
    }
}

__device__ __forceinline__ void unpack8(const u32x4 w, float (&v)[8]) { v[0] = bflo(w.x); v[1] = bfhi(w.x); v[2] = bflo(w.y); v[3] = bfhi(w.y); v[4] = bflo(w.z); v[5] = bfhi(w.z); v[6] = bflo(w.w); v[7] = bfhi(w.w); }
__device__ __forceinline__ u32x4 pack8(const float (&v)[8]) { u32x4 w; w.x = pk2(v[0], v[1]); w.y = pk2(v[2], v[3]); w.z = pk2(v[4], v[5]); w.w = pk2(v[6], v[7]); return w; }

__device__ __forceinline__ void phase_qkfix_e(const Frame& F_, const Args& A, int i) { const Frame F = fresh(F_);
    const int gw = F.bid * NWAVES + F.wave, NGW = F.G * NWAVES, lane = F.lane;
    const float* qg = AIN(8) + i * 128; const float* kg = AIN(9) + i * 128; const float* bg = AIN(10) + i * 256;
    const float* tab = (const float*)(F.ws + WS_TABA);
    for (int r = gw; r < NTOK; r += NGW) {
        const int b = r / TPB, j = r - b * TPB; const bool lat = j >= CTX; const int t = j - CTX, prow = t >> 6, pcol = t & 63;
        bf16* P = (bf16*)(F.ws + WS_PBUF) + (size_t)r * EIN;
#pragma unroll
        for (int it = 0; it < 2; ++it) {
            GAS u32x4* p = (GAS u32x4*)(P + 512 * it) + lane;
            float v[8], y[8], o[8]; unpack8(*p, v);
            float ss = 0.f;
#pragma unroll
            for (int e = 0; e < 8; ++e) ss += v[e] * v[e];
            ss += __shfl_xor(ss, 1); ss += __shfl_xor(ss, 2); ss += __shfl_xor(ss, 4); ss += __shfl_xor(ss, 8);
            const float rstd = rsqrtf(ss * (1.f / 128.f) + EPS);
            const bool isk = (it == 1) && (lane >= 32);
            const int d0 = 8 * (lane & 15);
            const float* gp = (isk ? kg : qg) + d0;
#pragma unroll
            for (int e = 0; e < 8; ++e) y[e] = v[e] * rstd * gp[e];
            const int quarter = (lane & 15) >> 2, fi = 8 * (lane & 3);
            const int pos = quarter < 2 ? prow : pcol;
#pragma unroll
            for (int e = 0; e < 8; ++e) {
                const float pv = __shfl_xor(y[e], 4);
                const float c = lat ? tab[2 * (pos * 32 + fi + e)] : 1.f, s = lat ? tab[2 * (pos * 32 + fi + e) + 1] : 0.f;
                o[e] = (quarter & 1) ? (pv * s + y[e] * c) : (y[e] * c - pv * s);
            }
            *p = pack8(o);
        }
        {
            GAS u32x4* p = (GAS u32x4*)(P + 1024) + lane;
            float v[8], o[8]; unpack8(*p, v);
            float ss = 0.f;
#pragma unroll
            for (int e = 0; e < 8; ++e) ss += v[e] * v[e];
            ss += __shfl_xor(ss, 1); ss += __shfl_xor(ss, 2); ss += __shfl_xor(ss, 4);
            const float rstd = rsqrtf(ss * (1.f / 64.f) + EPS);
            const float* gp = bg + 8 * (lane & 31);
#pragma unroll
            for (int e = 0; e < 8; ++e) o[e] = v[e] * rstd * gp[e];
            if (lane >= 32) *p = pack8(o);
        }
    }
}
__device__ __forceinline__ void phase_qkfix_o(const Frame& F_) { const Frame F = fresh(F_);
    const int gw = F.bid * NWAVES + F.wave, NGW = F.G * NWAVES, lane = F.lane;
    const float* tab = (const float*)(F.ws + WS_TABC);
    for (int r = gw; r < NTOK; r += NGW) {
        const int b = r / TPB, j = r - b * TPB; if (j < CTX) continue;
        const int t = j - CTX, prow = t >> 6, pcol = t & 63;
        bf16* P = (bf16*)(F.ws + WS_PBUF) + (size_t)r * OIN;
#pragma unroll
        for (int it = 0; it < 4; ++it) {
            GAS u32x4* p = (GAS u32x4*)(P + 512 * it) + lane;
            float y[8], o[8]; unpack8(*p, y);
            const int quarter = (lane & 7) >> 1, fi = 8 * (lane & 1);
            const int pos = quarter < 2 ? prow : pcol;
#pragma unroll
            for (int e = 0; e < 8; ++e) {
                const float pv = __shfl_xor(y[e], 2);
                const float c = tab[2 * (pos * 16 + fi + e)], s = tab[2 * (pos * 16 + fi + e) + 1];
                o[e] = (quarter & 1) ? (pv * s + y[e] * c) : (y[e] * c - pv * s);
            }
            *p = pack8(o);
        }
    }
}
__device__ __forceinline__ void phase_finish_o(const Frame& F_, const Args& A, int i) { const Frame F = fresh(F_);
    const int gw = F.bid * NWAVES + F.wave, NGW = F.G * NWAVES, lane = F.lane;
    const float lam = ((const float*)(F.ws + WS_LAM))[2 * i], post = 1.f - ((const float*)(F.ws + WS_LAM))[2 * i + 1];
    const float* hg = AIN(17) + i * 128 + 8 * (lane & 15);
    for (int r = gw; r < NTOK; r += NGW) {
        const bf16* T = (const bf16*)(F.ws + WS_OT) + (size_t)r * OTW; bf16* O = (bf16*)(F.ws + WS_OA) + (size_t)r * OAO;
#pragma unroll
        for (int it = 0; it < 4; ++it) {
            float v[8], o[8]; unpack8(*((const GAS u32x4*)(T + 512 * it) + lane), v);
            float ss = 0.f;
#pragma unroll
            for (int e = 0; e < 8; ++e) { const float pv = __shfl_xor(v[e], 16); o[e] = v[e] - lam * pv; ss += o[e] * o[e]; }
            ss += __shfl_xor(ss, 1); ss += __shfl_xor(ss, 2); ss += __shfl_xor(ss, 4); ss += __shfl_xor(ss, 8);
            const float rstd = rsqrtf(ss * (1.f / 128.f) + EPS) * post;
#pragma unroll
            for (int e = 0; e < 8; ++e) o[e] = o[e] * rstd * hg[e];
            if (((lane >> 4) & 1) == 0) *(GAS u32x4*)(O + (2 * it + (lane >> 5)) * 128 + 8 * (lane & 15)) = pack8(o);
        }
    }
}

__device__ __forceinline__ void phase_router(const Frame& F_, const Args& A, int l) { const Frame F = fresh(F_);
    LAS float* wc = (LAS float*)F.lds;
    LAS int* lcnt = (LAS int*)(F.lds + 81920);
    LAS int* gb = lcnt + 16;
    LAS int* rec = gb + 16;
    LAS float* recw = (LAS float*)(rec + 72 * 4);
    const int lane = F.lane;
    __syncthreads();
    for (int i = F.tid; i < DM * 20; i += NTHREADS) { const int k = i / 20, c = i % 20; wc[i] = c < 4 ? AIN(18)[(size_t)l * DM * 4 + k * 4 + c] : AIN(20)[(size_t)l * DM * 16 + k * 16 + (c - 4)]; }
    if (F.tid < 16) lcnt[F.tid] = 0;
    __syncthreads();
    const int nmine = (NTOK - F.bid + F.G - 1) / F.G;
    for (int it = F.wave; it < nmine; it += NWAVES) {
        const int r = F.bid + it * F.G, type = row_type(r);
        f32x4 v[4]; load_row_f32((const float*)(F.ws + WS_X) + (size_t)r * DM, lane, v);
        const float rstd = row_rstd(v);
        f32x4 s[4], h[4]; load_row_f32(modv(F, l, type, 4), lane, s); load_row_f32(modv(F, l, type, 3), lane, h);
#pragma unroll
        for (int j = 0; j < 4; ++j) v[j] = v[j] * rstd * (s[j] + 1.f) + h[j];
        store_row_bf16((bf16*)(F.ws + WS_HA) + (size_t)r * DM, lane, v);
        float lg[20];
#pragma unroll
        for (int c = 0; c < 20; ++c) lg[c] = 0.f;
#pragma unroll
        for (int j = 0; j < 4; ++j)
#pragma unroll
            for (int e = 0; e < 4; ++e) { const LAS float* wr = wc + (4 * lane + 256 * j + e) * 20; const float xv = v[j][e];
#pragma unroll
                for (int c = 0; c < 20; ++c) lg[c] += xv * wr[c]; }
#pragma unroll
        for (int c = 0; c < 20; ++c) lg[c] = wave_sum(lg[c]);
        if (lane == 0) {
            float gl[4]; int gi = 0;
#pragma unroll
            for (int g = 0; g < 4; ++g) gl[g] = lg[g] + AIN(19)[l * 4 + g];
#pragma unroll
            for (int g = 1; g < 4; ++g) if (gl[g] > gl[gi]) gi = g;
            float gs = 0.f;
#pragma unroll
            for (int g = 0; g < 4; ++g) gs += expf(gl[g] - gl[gi]);
            const float ggate = 1.f / gs;
            float el[4];
#pragma unroll
            for (int e = 0; e < 4; ++e) { float x = 0.f;
#pragma unroll
                for (int g = 0; g < 4; ++g) x = (g == gi) ? lg[4 + 4 * g + e] + AIN(21)[l * 16 + 4 * g + e] : x;
                el[e] = x; }
            int i0 = 0;
#pragma unroll
            for (int e = 1; e < 4; ++e) if (el[e] > el[i0]) i0 = e;
            int i1 = (i0 == 0) ? 1 : 0;
#pragma unroll
            for (int e = 0; e < 4; ++e) if (e != i0 && el[e] > el[i1]) i1 = e;
            const float p1 = expf(el[i1] - el[i0]);
            const float w0 = ggate / (1.f + p1), w1 = ggate * p1 / (1.f + p1);
            const int e0 = gi * 4 + i0, e1 = gi * 4 + i1;
            const int lp0 = __hip_atomic_fetch_add(lcnt + e0, 1, __ATOMIC_RELAXED, __HIP_MEMORY_SCOPE_WORKGROUP);
            const int lp1 = __hip_atomic_fetch_add(lcnt + e1, 1, __ATOMIC_RELAXED, __HIP_MEMORY_SCOPE_WORKGROUP);
            rec[it * 4 + 0] = e0; rec[it * 4 + 1] = lp0; rec[it * 4 + 2] = e1; rec[it * 4 + 3] = lp1; recw[it * 2] = w0; recw[it * 2 + 1] = w1;
        }
    }
    __syncthreads();
    if (F.tid < 16) gb[F.tid] = (int)__hip_atomic_fetch_add((unsigned*)(F.ws + WS_CTL) + CW_CNT + 64 * l + F.tid, (unsigned)lcnt[F.tid], __ATOMIC_RELAXED, __HIP_MEMORY_SCOPE_AGENT);
    __syncthreads();
    if (F.tid < nmine) { const int it = F.tid, r = F.bid + it * F.G; const int e0 = rec[it * 4], e1 = rec[it * 4 + 2];
        ((GAS i32x4*)(F.ws + WS_SELA))[r] = (i32x4){e0, gb[e0] + rec[it * 4 + 1], e1, gb[e1] + rec[it * 4 + 3]};
        ((GAS f32x2*)(F.ws + WS_SELW))[r] = (f32x2){recw[it * 2], recw[it * 2 + 1]}; }
    __syncthreads();
}
__device__ __forceinline__ void moe_bases(const Frame& F, int l, int (&base)[17]) {
    const unsigned* cnt = (const unsigned*)(F.ws + WS_CTL) + CW_CNT + 64 * l;
    int acc = 0;
#pragma unroll
    for (int e = 0; e < 16; ++e) { base[e] = acc; const int c = (int)__hip_atomic_load(cnt + e, __ATOMIC_RELAXED, __HIP_MEMORY_SCOPE_AGENT); acc += ((c + 255) >> 8) << 8; }
    base[16] = acc;
}
__device__ __forceinline__ void phase_gather(const Frame& F_, int l) { const Frame F = fresh(F_);
    const int gw = F.bid * NWAVES + F.wave, NGW = F.G * NWAVES, lane = F.lane;
    int base[17]; moe_bases(F, l, base);
    for (int r = gw; r < NTOK; r += NGW) {
        const i32x4 s = ((const GAS i32x4*)(F.ws + WS_SELA))[r];
        int b0 = 0, b1 = 0;
#pragma unroll
        for (int e = 0; e < 16; ++e) { b0 = (s.x == e) ? base[e] : b0; b1 = (s.z == e) ? base[e] : b1; }
        const int r0 = b0 + s.y, r1 = b1 + s.w;
        const GAS u32x4* src = (const GAS u32x4*)((const bf16*)(F.ws + WS_HA) + (size_t)r * DM) + lane;
        const u32x4 a = src[0], c = src[64];
        GAS u32x4* d0 = (GAS u32x4*)((bf16*)(F.ws + WS_XS) + (size_t)r0 * DM) + lane; d0[0] = a; d0[64] = c;
        GAS u32x4* d1 = (GAS u32x4*)((bf16*)(F.ws + WS_XS) + (size_t)r1 * DM) + lane; d1[0] = a; d1[64] = c;
        if (lane == 0) ((GAS i32x2*)(F.ws + WS_RPOS))[r] = (i32x2){r0, r1};
    }
}
__device__ __forceinline__ void phase_combine(const Frame& F_, const Args& A, int l) { const Frame F = fresh(F_);
    const int gw = F.bid * NWAVES + F.wave, NGW = F.G * NWAVES, lane = F.lane;
    for (int r = gw; r < NTOK; r += NGW) {
        const int b = r / TPB, j = r - b * TPB, type = j < CTX ? 2 : b;
        if (l == DEPTH - 1 && j < CTX) continue;
        const i32x2 rp = ((const GAS i32x2*)(F.ws + WS_RPOS))[r]; const f32x2 w = ((const GAS f32x2*)(F.ws + WS_SELW))[r];
        f32x4 x[4], y0[4], y1[4], g[4];
        float* xp = (float*)(F.ws + WS_X) + (size_t)r * DM;
        load_row_f32(xp, lane, x); load_row_bf16((const bf16*)(F.ws + WS_Y2S) + (size_t)rp.x * DM, lane, y0); load_row_bf16((const bf16*)(F.ws + WS_Y2S) + (size_t)rp.y * DM, lane, y1);
        load_row_f32(modv(F, l, type, 5), lane, g);
#pragma unroll
        for (int q = 0; q < 4; ++q) x[q] = x[q] + g[q] * (y0[q] * w.x + y1[q] * w.y);
        if (l < DEPTH - 1) {
            store_row_f32(xp, lane, x);
            modnorm_store(x, modv(F, l + 1, type, 1), modv(F, l + 1, type, 0), (bf16*)(F.ws + WS_HA) + (size_t)r * DM, lane);
        } else {
            const float rstd = row_rstd(x);
            f32x4 fg[4]; load_row_f32(AIN(25), lane, fg);
#pragma unroll
            for (int q = 0; q < 4; ++q) x[q] = x[q] * rstd * fg[q];
            store_row_f32(A.out + (size_t)(b * SEQ + (j - CTX)) * DM, lane, x);
        }
    }
}

__device__ __forceinline__ void sphase_gemm_bf16(const Frame& F_, const bf16* Am, int lda, const bf16* Bt, int ldb, bf16* C, int ldc, int M, int N, int K) { const Frame F = fresh(F_);
    LAS float* As = (LAS float*)F.lds; LAS float* Bs = As + 16 * SG_AS;
    const int nm = M / 128, nn = N / 64, ty = F.tid >> 4, tx = F.tid & 15;
    for (int t = F.bid; t < nm * nn; t += F.G) {
        const int tm = t / nn, tn = t % nn; const bf16* a0 = Am + (size_t)tm * 128 * lda; const bf16* b0 = Bt + (size_t)tn * 64 * ldb;
        float acc[4][4];
        sg_tile(As, Bs, K, [&](int m, int k) { return bf2f(a0[(size_t)m * lda + k]); }, [&](int k, int n) { return bf2f(b0[(size_t)n * ldb + k]); }, acc, F.tid);
#pragma unroll
        for (int i = 0; i < 4; ++i) { u32x2 w; w.x = pk2(acc[i][0], acc[i][1]); w.y = pk2(acc[i][2], acc[i][3]);
            *(GAS u32x2*)(C + (size_t)(tm * 128 + 4 * ty + i) * ldc + tn * 64 + 4 * tx) = w; }
    }
}
__device__ __forceinline__ void sphase_outproj(const Frame& F_, const bf16* Am, int lda, const bf16* Bt, int K, int l) { const Frame F = fresh(F_);
    LAS float* As = (LAS float*)F.lds; LAS float* Bs = As + 16 * SG_AS;
    const int nm = NTOK / 128, nn = DM / 64, ty = F.tid >> 4, tx = F.tid & 15;
    for (int t = F.bid; t < nm * nn; t += F.G) {
        const int tm = t / nn, tn = t % nn; const bf16* a0 = Am + (size_t)tm * 128 * lda; const bf16* b0 = Bt + (size_t)tn * 64 * K;
        float acc[4][4];
        sg_tile(As, Bs, K, [&](int m, int k) { return bf2f(a0[(size_t)m * lda + k]); }, [&](int k, int n) { return bf2f(b0[(size_t)n * K + k]); }, acc, F.tid);
#pragma unroll
        for (int i = 0; i < 4; ++i) { const int r = tm * 128 + 4 * ty + i, c = tn * 64 + 4 * tx;
            const f32x4 g = *(const GAS f32x4*)(modv(F, l, row_type(r), 2) + c);
            GAS f32x4* xp = (GAS f32x4*)((float*)(F.ws + WS_X) + (size_t)r * DM + c); f32x4 x = *xp;
            x.x += g.x * acc[i][0]; x.y += g.y * acc[i][1]; x.z += g.z * acc[i][2]; x.w += g.w * acc[i][3]; *xp = x; }
    }
}
__device__ __forceinline__ int moe_expert_of_row(const int (&base)[17], int row) { int e = 0;
#pragma unroll
    for (int q = 1; q < 16; ++q) e = (row >= base[q]) ? q : e;
    return e; }
__device__ __forceinline__ void sphase_moe_gu(const Frame& F_, int l) { const Frame F = fresh(F_);
    LAS float* As = (LAS float*)F.lds; LAS float* Bs = As + 16 * SG_AS;
    int base[17]; moe_bases(F, l, base);
    const int nm = base[16] / 128, nn = DEXP / 64, ty = F.tid >> 4, tx = F.tid & 15;
    for (int t = F.bid; t < nm * nn; t += F.G) {
        const int tm = t / nn, tn = t % nn, e = moe_expert_of_row(base, tm * 128);
        const bf16* a0 = (const bf16*)(F.ws + WS_XS) + (size_t)tm * 128 * DM;
        const bf16* w = (const bf16*)(F.ws + WS_WGU) + (size_t)(l * 16 + e) * DM * DM;
        const int hc0 = tn * 64;
        const bf16* bg0 = w + (size_t)((hc0 >> 7) * 256 + (hc0 & 127)) * DM; const bf16* bu0 = bg0 + (size_t)128 * DM;
        float ag[4][4], au[4][4];
        sg_tile(As, Bs, DM, [&](int m, int k) { return bf2f(a0[(size_t)m * DM + k]); }, [&](int k, int n) { return bf2f(bg0[(size_t)n * DM + k]); }, ag, F.tid);
        sg_tile(As, Bs, DM, [&](int m, int k) { return bf2f(a0[(size_t)m * DM + k]); }, [&](int k, int n) { return bf2f(bu0[(size_t)n * DM + k]); }, au, F.tid);
#pragma unroll
        for (int i = 0; i < 4; ++i) { float h[4];
#pragma unroll
            for (int j = 0; j < 4; ++j) h[j] = silu_f(ag[i][j]) * au[i][j];
            u32x2 wv; wv.x = pk2(h[0], h[1]); wv.y = pk2(h[2], h[3]);
            *(GAS u32x2*)((bf16*)(F.ws + WS_HID) + (size_t)(tm * 128 + 4 * ty + i) * DEXP + hc0 + 4 * tx) = wv; }
    }
}
__device__ __forceinline__ void sphase_moe_down(const Frame& F_, int l) { const Frame F = fresh(F_);
    LAS float* As = (LAS float*)F.lds; LAS float* Bs = As + 16 * SG_AS;
    int base[17]; moe_bases(F, l, base);
    const int nm = base[16] / 128, nn = DM / 64, ty = F.tid >> 4, tx = F.tid & 15;
    for (int t = F.bid; t < nm * nn; t += F.G) {
        const int tm = t / nn, tn = t % nn, e = moe_expert_of_row(base, tm * 128);
        const bf16* a0 = (const bf16*)(F.ws + WS_HID) + (size_t)tm * 128 * DEXP;
        const bf16* b0 = (const bf16*)(F.ws + WS_WD) + (size_t)(l * 16 + e) * DM * DEXP + (size_t)tn * 64 * DEXP;
        float acc[4][4];
        sg_tile(As, Bs, DEXP, [&](int m, int k) { return bf2f(a0[(size_t)m * DEXP + k]); }, [&](int k, int n) { return bf2f(b0[(size_t)n * DEXP + k]); }, acc, F.tid);
#pragma unroll
        for (int i = 0; i < 4; ++i) { u32x2 w; w.x = pk2(acc[i][0], acc[i][1]); w.y = pk2(acc[i][2], acc[i][3]);
            *(GAS u32x2*)((bf16*)(F.ws + WS_Y2S) + (size_t)(tm * 128 + 4 * ty + i) * DM + tn * 64 + 4 * tx) = w; }
    }
}

__device__ __forceinline__ void sphase_fft1(const Frame& F_) { const Frame F = fresh(F_);
    const int gt = F.bid * NTHREADS + F.tid, NGT = F.G * NTHREADS;
    for (int o = gt; o < NB * 128 * 2 * 64 * 256; o += NGT) {
        const int col = o & 255, t2 = (o >> 8) & 63, ri = (o >> 14) & 1, k1 = (o >> 15) & 127, b = o >> 22;
        const bf16* f = (const bf16*)(F.ws + WS_PBUF) + (size_t)(b * TPB + CTX + t2) * EIN + 1280 + col;
        float a = 0.f;
        for (int t1 = 0; t1 < 128; ++t1) { const int t = 64 * t1 + t2; const float fr = (float)((k1 * t) & 8191) * (1.f / 8192.f);
            const float c = ri ? -__builtin_amdgcn_sinf(fr) : __builtin_amdgcn_cosf(fr); a += c * bf2f(f[(size_t)(64 * t1) * EIN]); }
        ((bf16*)(F.ws + WS_YB))[o] = (bf16)f2bf(a);
    }
}
__device__ __forceinline__ void sphase_fft2(const Frame& F_) { const Frame F = fresh(F_);
    const int gt = F.bid * NTHREADS + F.tid, NGT = F.G * NTHREADS;
    const float norm = 1.f / sqrtf(8192.f * 64.f);
    for (int o = gt; o < NB * SEQ * 2 * 256; o += NGT) {
        const int col = o & 255, ri = (o >> 8) & 1, k = (o >> 9) & 8191, b = o >> 22, k1 = k & 127, k2 = k >> 7;
        const bf16* yr = (const bf16*)(F.ws + WS_YB) + ((size_t)((b * 128 + k1) * 2 + 0) * 64) * 256 + col; const bf16* yi = yr + 64 * 256;
        float a = 0.f;
        for (int t2 = 0; t2 < 64; ++t2) { const float fr = (float)((k2 * t2) & 63) * (1.f / 64.f), c = __builtin_amdgcn_cosf(fr), s = __builtin_amdgcn_sinf(fr);
            const float vr = bf2f(yr[t2 * 256]), vi = bf2f(yi[t2 * 256]);
            a += ri ? (c * vi - s * vr) : (c * vr + s * vi); }
        ((bf16*)(F.ws + WS_OA))[(size_t)(b * TPB + CTX + k) * OAE + 768 + ri * 256 + col] = (bf16)f2bf(a * norm);
    }
}
__device__ __forceinline__ void sphase_fftc(const Frame& F_) { const Frame F = fresh(F_);
    const int gt = F.bid * NTHREADS + F.tid, NGT = F.G * NTHREADS;
    const float norm = 1.f / sqrtf(256.f * 64.f);
    for (int o = gt; o < NB * CTX * 2 * 256; o += NGT) {
        const int col = o & 255, ri = (o >> 8) & 1, k = (o >> 9) & 255, b = o >> 17;
        const bf16* f = (const bf16*)(F.ws + WS_PBUF) + (size_t)(b * TPB) * EIN + 1280 + col;
        float a = 0.f;
        for (int t = 0; t < CTX; ++t) { const float fr = (float)((k * t) & 255) * (1.f / 256.f); const float c = ri ? -__builtin_amdgcn_sinf(fr) : __builtin_amdgcn_cosf(fr); a += c * bf2f(f[(size_t)t * EIN]); }
        ((bf16*)(F.ws + WS_OA))[(size_t)(b * TPB + k) * OAE + 768 + ri * 256 + col] = (bf16)f2bf(a * norm);
    }
}

__device__ __forceinline__ void sphase_attn_e(const Frame& F_) { const Frame F = fresh(F_);
    const bf16* P = (const bf16*)(F.ws + WS_PBUF); bf16* OA = (bf16*)(F.ws + WS_OA);
    const int NL = NB * 6 * (SEQ / 32), NC = NB * 6 * (CTX / 32);
    for (int u = F.bid; u < NL + NC; u += F.G) {
        int b, h, q0, nk;
        if (u < NL) { b = u / (6 * 256); h = (u / 256) % 6; q0 = CTX + 32 * (u % 256); nk = TPB; }
        else { const int v = u - NL; b = v / (6 * 8); h = (v / 8) % 6; q0 = 32 * (v % 8); nk = CTX; }
        const size_t rq = (size_t)(b * TPB + q0), rk = (size_t)b * TPB;
        sattn_unit<128>((LAS float*)F.lds, P + rq * EIN + h * 128, EIN, P + rk * EIN + 768 + (h / 3) * 128, EIN, P + rk * EIN + 1024 + (h / 3) * 128, EIN,
                        OA + rq * OAE + h * 128, OAE, nk, 0.08838834764831845f, F.tid);
    }
}
__device__ __forceinline__ void sphase_attn_o(const Frame& F_) { const Frame F = fresh(F_);
    const bf16* P = (const bf16*)(F.ws + WS_PBUF); bf16* OT = (bf16*)(F.ws + WS_OT);
    const int NL = NB * 16 * (SEQ / 32), NC = NB * 16 * (CTX / 32);
    for (int u = F.bid; u < NL + NC; u += F.G) {
        int b, g, q0, nk;
        if (u < NL) { b = u / (16 * 256); g = (u / 256) % 16; q0 = CTX + 32 * (u % 256); nk = TPB; }
        else { const int v = u - NL; b = v / (16 * 8); g = (v / 8) % 16; q0 = 32 * (v % 8); nk = CTX; }
        const size_t rq = (size_t)(b * TPB + q0), rk = (size_t)b * TPB;
        sattn_unit<64>((LAS float*)F.lds, P + rq * OIN + g * 64, OIN, P + rk * OIN + 1024 + g * 64, OIN, P + rk * OIN + 2048 + (g / 2) * 128, OIN,
                       OT + rq * OTW + g * 128, OTW, nk, 0.125f, F.tid);
    }
}

__global__ void __launch_bounds__(NTHREADS, 2) fwd_kernel(Args args) {
    extern __shared__ __attribute__((aligned(16))) unsigned char lds_raw[];
    Frame F;
    F.lds = (LAS unsigned char*)lds_raw; F.ws = args.ws;
    F.tid = threadIdx.x; F.lane = F.tid & 63; F.wave = __builtin_amdgcn_readfirstlane(F.tid >> 6); F.bid = blockIdx.x; F.G = gridDim.x;
    volatile LAS unsigned* MISC = (volatile LAS unsigned*)(F.lds + MISC_OFF);
    if (F.tid < 32) MISC[F.tid] = 0u;
    __syncthreads();
    const int lo = args.ph_lo, hi = args.ph_hi;
    const bool multi = (hi - lo) > 1;
    XcdBarrier bar; bar.bar = (unsigned*)(F.ws + WS_CTL) + CW_BAR; bar.x = 0; bar.st = MISC + 8;
    if (multi) bar = xcd_barrier_post((unsigned*)(F.ws + WS_CTL) + CW_BAR, MISC + 8);
#define IN(k) (lo <= (k) && (k) < hi)
#define SEAM(k) do { if (IN(k) && IN((k) + 1)) xcd_barrier(bar); } while (0)
    if (IN(PH_PRO_A)) { phase_pro_a(F, args); } SEAM(PH_PRO_A);
    if (IN(PH_PRO_B)) { phase_pro_b(F, args); } SEAM(PH_PRO_B);
    for (int l = 0; l < DEPTH; ++l) {
        const int p0 = PH_L0 + l * PPL, i = l >> 1; const bool even = (l & 1) == 0;
        if (IN(p0 + PL_INPROJ)) {
            if (even) sphase_gemm_bf16(F, (const bf16*)(F.ws + WS_HA), DM, (const bf16*)(F.ws + WS_WINE) + (size_t)i * EIN * DM, DM, (bf16*)(F.ws + WS_PBUF), EIN, NTOK, EIN, DM);
            else sphase_gemm_bf16(F, (const bf16*)(F.ws + WS_HA), DM, (const bf16*)(F.ws + WS_WINO) + (size_t)i * OIN * DM, DM, (bf16*)(F.ws + WS_PBUF), OIN, NTOK, OIN, DM);
        } SEAM(p0 + PL_INPROJ);
        if (IN(p0 + PL_QKFIX)) { if (even) phase_qkfix_e(F, args, i); else phase_qkfix_o(F); } SEAM(p0 + PL_QKFIX);
        if (IN(p0 + PL_FFT1)) { if (even) sphase_fft1(F); } SEAM(p0 + PL_FFT1);
        if (IN(p0 + PL_ATTN)) { if (even) { sphase_attn_e(F); sphase_fft2(F); sphase_fftc(F); } else sphase_attn_o(F); } SEAM(p0 + PL_ATTN);
        if (IN(p0 + PL_FINISH)) { if (!even) phase_finish_o(F, args, i); } SEAM(p0 + PL_FINISH);
        if (IN(p0 + PL_OUTPROJ)) {
            if (even) sphase_outproj(F, (const bf16*)(F.ws + WS_OA), OAE, (const bf16*)(F.ws + WS_WOUTE) + (size_t)i * DM * OAE, OAE, l);
            else sphase_outproj(F, (const bf16*)(F.ws + WS_OA), OAO, (const bf16*)(F.ws + WS_WOUTO) + (size_t)i * DM * DM, DM, l);
        } SEAM(p0 + PL_OUTPROJ);
        if (IN(p0 + PL_ROUTER)) { phase_router(F, args, l); } SEAM(p0 + PL_ROUTER);
        if (IN(p0 + PL_GATHER)) { phase_gather(F, l); } SEAM(p0 + PL_GATHER);
        if (IN(p0 + PL_GU)) { sphase_moe_gu(F, l); } SEAM(p0 + PL_GU);
        if (IN(p0 + PL_DOWN)) { sphase_moe_down(F, l); } SEAM(p0 + PL_DOWN);
        if (IN(p0 + PL_COMBINE)) { phase_combine(F, args, l); } SEAM(p0 + PL_COMBINE);
    }
#undef IN
#undef SEAM
}

extern "C" void kernel_launch(void* const* d_in, const int* in_sizes, int n_in, void* d_out, int out_size, void* d_ws, size_t ws_size, hipStream_t stream) {
    static int grid = 0;
    if (grid == 0) {
        if (n_in != 26 || in_sizes[0] != NB * SEQ * DM || out_size != NB * SEQ * DM || ws_size < WS_END) {
            fprintf(stderr, "kernel_launch: shape/workspace mismatch (n_in %d, in0 %d, out %d, ws %zu, need %zu); nothing launched\n", n_in, n_in > 0 ? in_sizes[0] : -1, out_size, ws_size, (size_t)WS_END); grid = -1; return; }
        int dev = 0, cus = 0;
        if (hipGetDevice(&dev) != hipSuccess || hipDeviceGetAttribute(&cus, hipDeviceAttributeMultiprocessorCount, dev) != hipSuccess) { grid = -1; return; }
        if (hipFuncSetAttribute((const void*)fwd_kernel, hipFuncAttributeMaxDynamicSharedMemorySize, LDS_BYTES) != hipSuccess) { fprintf(stderr, "kernel_launch: hipFuncSetAttribute failed\n"); grid = -1; return; }
        int per_cu = 0;
        if (hipOccupancyMaxActiveBlocksPerMultiprocessor(&per_cu, (const void*)fwd_kernel, NTHREADS, LDS_BYTES) != hipSuccess || per_cu < 1) { fprintf(stderr, "kernel_launch: occupancy query says %d\n", per_cu); }
        (void)hipGetLastError();
        grid = cus;
    }
    if (grid < 0) return;
    (void)hipMemsetAsync((char*)d_ws + WS_CTL, 0, CTL_ZERO_BYTES, stream);
    Args a{};
    for (int i = 0; i < 26; ++i) a.in[i] = (const float*)d_in[i];
    a.out = (float*)d_out; a.ws = (unsigned char*)d_ws;
#if MK_ONE_LAUNCH
    a.ph_lo = 0; a.ph_hi = N_PHASES;
    hipLaunchKernelGGL(fwd_kernel, dim3(grid), dim3(NTHREADS), LDS_BYTES, stream, a);
#else
    for (int p = 0; p < N_PHASES; ++p) {
        if (p >= PH_L0) { const int l = (p - PH_L0) / PPL, k = (p - PH_L0) % PPL; const bool even = (l & 1) == 0;
            if ((k == PL_FFT1 && !even) || (k == PL_FINISH && even)) continue; }
        a.ph_lo = p; a.ph_hi = p + 1;
        hipLaunchKernelGGL(fwd_kernel, dim3(grid), dim3(NTHREADS), LDS_BYTES, stream, a);
    }
#endif
}
```

```cpp
#include <hip/hip_runtime.h>
#include <cstdio>
#include <cstdint>

#ifndef PROBE_PARITY
#define PROBE_PARITY (-1)
#endif
#ifndef PROBE_MULT
#define PROBE_MULT 4
#endif
#ifndef MK_ONE_LAUNCH
#define MK_ONE_LAUNCH 1
#endif

#define GAS __attribute__((address_space(1)))
#define LAS __attribute__((address_space(3)))
typedef unsigned short bf16;
typedef float f32x4 __attribute__((ext_vector_type(4)));
typedef unsigned u32x4 __attribute__((ext_vector_type(4)));
typedef unsigned u32x2 __attribute__((ext_vector_type(2)));
typedef int i32x4 __attribute__((ext_vector_type(4)));
typedef int i32x2 __attribute__((ext_vector_type(2)));
typedef float f32x2 __attribute__((ext_vector_type(2)));

constexpr int NB = 2, SEQ = 8192, CTX = 256, TPB = SEQ + CTX, NTOK = NB * TPB, DM = 1024, DEPTH = 4;
constexpr int EIN = 1536, OIN = 3072, OAE = 1280, OAO = 1024, OTW = 2048;
constexpr int NEXP = 16, DEXP = 512;
constexpr int XS_TILES = 2 * NTOK / 256 + NEXP, XS_ROWS = XS_TILES * 256;
constexpr float EPS = 1e-6f;
constexpr int NTHREADS = 512, NWAVES = 8;

constexpr size_t MiB = 1u << 20;
constexpr size_t WS_CTL = 0, CTL_ZERO_BYTES = MiB;
constexpr size_t WS_MODV = 1 * MiB;
constexpr size_t WS_TABA = 1 * MiB + 512 * 1024;
constexpr size_t WS_TABC = WS_TABA + 32 * 1024;
constexpr size_t WS_LAM = WS_TABC + 16 * 1024;
constexpr size_t WS_SELA = 2 * MiB;
constexpr size_t WS_SELW = 2 * MiB + 512 * 1024;
constexpr size_t WS_RPOS = 2 * MiB + 768 * 1024;
constexpr size_t WS_WINE = 3 * MiB;
constexpr size_t WS_WOUTE = 9 * MiB;
constexpr size_t WS_WINO = 14 * MiB;
constexpr size_t WS_WOUTO = 26 * MiB;
constexpr size_t WS_WGU = 30 * MiB;
constexpr size_t WS_WD = 158 * MiB;
constexpr size_t WS_X = 222 * MiB;
constexpr size_t WS_HA = 288 * MiB;
constexpr size_t WS_YB = 321 * MiB;
constexpr size_t WS_PBUF = 337 * MiB;
constexpr size_t WS_OT = 436 * MiB;
constexpr size_t WS_OA = 502 * MiB;
constexpr size_t WS_XS = 337 * MiB;
constexpr size_t WS_HID = 411 * MiB;
constexpr size_t WS_Y2S = 448 * MiB;
constexpr size_t WS_END = 544 * MiB;
static_assert(WS_XS + (size_t)XS_ROWS * 1024 * 2 <= WS_HID && WS_HID + (size_t)XS_ROWS * 512 * 2 <= WS_Y2S && WS_Y2S + (size_t)XS_ROWS * 1024 * 2 <= WS_END, "moe overlay");
static_assert(WS_OA + (size_t)NTOK * OAE * 2 <= WS_END && WS_PBUF + (size_t)NTOK * OIN * 2 <= WS_OT && WS_OT + (size_t)NTOK * OTW * 2 <= WS_OA, "ws map");
constexpr int CW_BAR = 4096;
constexpr int CW_CNT = 16384;

constexpr int LDS_BYTES = 147456;
constexpr int MISC_OFF = 131072 + 320;
constexpr int TB_OFF = 131072 + 1024;

constexpr int PH_PRO_A = 0, PH_PRO_B = 1, PH_L0 = 2, PPL = 11;
constexpr int PL_INPROJ = 0, PL_QKFIX = 1, PL_FFT1 = 2, PL_ATTN = 3, PL_FINISH = 4, PL_OUTPROJ = 5, PL_ROUTER = 6, PL_GATHER = 7, PL_GU = 8, PL_DOWN = 9, PL_COMBINE = 10;
constexpr int N_PHASES = PH_L0 + DEPTH * PPL;

struct Args { const float* in[26]; float* out; unsigned char* ws; int ph_lo, ph_hi; };

__device__ __forceinline__ unsigned f2bf(float f) { unsigned u = __builtin_bit_cast(unsigned, f); return (u + 0x7fffu + ((u >> 16) & 1u)) >> 16; }
__device__ __forceinline__ unsigned pk2(float lo, float hi) { return f2bf(lo) | (f2bf(hi) << 16); }
__device__ __forceinline__ float bf2f(bf16 b) { return __builtin_bit_cast(float, (unsigned)b << 16); }
__device__ __forceinline__ float bflo(unsigned w) { return __builtin_bit_cast(float, w << 16); }
__device__ __forceinline__ float bfhi(unsigned w) { return __builtin_bit_cast(float, w & 0xffff0000u); }
__device__ __forceinline__ float wave_sum(float v) {
#pragma unroll
    for (int o = 1; o < 64; o <<= 1) v += __shfl_xor(v, o);
    return v;
}
__device__ __forceinline__ float silu_f(float x) { return x / (1.f + expf(-x)); }
#define LDS_WAIT() asm volatile("s_waitcnt lgkmcnt(0)" ::: "memory")

#define XB_TMO      128
#define XB_XCNT(j)  (256  + 64 * (j))
#define XB_XSUB(j)  (1280 + 64 * (j))
#define XB_XGEN(j)  (2304 + 64 * (j))
#define XB_TOP      3328
#define XB_TOPGEN   3392
#define XCD_BAR_WORDS 3456
#define XB_SPIN_CAP (1u << 24)
__device__ __forceinline__ unsigned xb_ld(unsigned* p)              { return __hip_atomic_load(p, __ATOMIC_RELAXED, __HIP_MEMORY_SCOPE_AGENT); }
__device__ __forceinline__ unsigned xb_add(unsigned* p, unsigned v) { return __hip_atomic_fetch_add(p, v, __ATOMIC_RELAXED, __HIP_MEMORY_SCOPE_AGENT); }
__device__ __forceinline__ unsigned xb_xcc_id() { return (unsigned)__builtin_amdgcn_s_getreg((3 << 11) | 20) & 0xFu; }
#define XB_SPIN(cond, bar) do { unsigned _sp = 0; while (cond) { __builtin_amdgcn_s_sleep(1); \
    if ((++_sp & 255u) == 0u) { if (xb_ld(&(bar)[XB_TMO])) break; if (_sp > XB_SPIN_CAP) { atomicAdd(&(bar)[XB_TMO], 1u); break; } } } } while (0)
struct XcdBarrier { unsigned* bar; unsigned x; volatile LAS unsigned* st; };
__device__ __forceinline__ XcdBarrier xcd_barrier_post(unsigned* bar, volatile LAS unsigned* st) {
    XcdBarrier b; b.bar = bar; b.x = xb_xcc_id(); b.st = st;
    if (threadIdx.x == 0) (void)xb_add(&bar[XB_XCNT(b.x)], 1u);
    return b;
}
__device__ __forceinline__ void xcd_barrier_complete(unsigned* bar, unsigned x, unsigned& nloc, unsigned& nx) {
    const unsigned G = gridDim.x * gridDim.y * gridDim.z;
    unsigned sum, cnt, mine, sp = 0u;
    for (;;) {
        sum = 0u; cnt = 0u; mine = 0u;
#pragma unroll
        for (unsigned j = 0; j < 16; ++j) { const unsigned c = xb_ld(&bar[XB_XCNT(j)]); sum += c; cnt += (c > 0u) ? 1u : 0u; mine = (j == x) ? c : mine; }
        if (sum == G) break;
        __builtin_amdgcn_s_sleep(1);
        if ((++sp & 255u) == 0u) { if (xb_ld(&bar[XB_TMO])) break; if (sp > XB_SPIN_CAP) { atomicAdd(&bar[XB_TMO], 1u); break; } }
    }
    nloc = mine > 0u ? mine : 1u; nx = cnt > 0u ? cnt : 1u;
}
__device__ __forceinline__ void xcd_barrier(const XcdBarrier& b) {
    asm volatile("s_waitcnt vmcnt(0)" ::: "memory");
    __syncthreads();
    if (threadIdx.x == 0) {
        unsigned* bar = b.bar; unsigned bx_ = b.x; asm volatile("" : "+s"(bar), "+s"(bx_));
        __builtin_amdgcn_s_waitcnt(0);
        unsigned nloc = b.st[0], nx = b.st[1];
        if (nloc == 0u) { xcd_barrier_complete(bar, bx_, nloc, nx); b.st[0] = nloc; b.st[1] = nx; }
        const unsigned old = xb_add(&bar[XB_XSUB(bx_)], 1u);
        const unsigned gen = old / nloc;
        if (old + 1u == (gen + 1u) * nloc) {
            __builtin_amdgcn_fence(__ATOMIC_RELEASE, "agent");
            asm volatile("s_waitcnt vmcnt(0)" ::: "memory");
            const unsigned og = xb_add(&bar[XB_TOP], 1u);
            const unsigned tg = og / nx;
            if (og + 1u == (tg + 1u) * nx) xb_add(&bar[XB_TOPGEN], 1u);
            else XB_SPIN(xb_ld(&bar[XB_TOPGEN]) == tg, bar);
            __builtin_amdgcn_fence(__ATOMIC_ACQUIRE, "agent");
            xb_add(&bar[XB_XGEN(bx_)], 1u);
            asm volatile("s_waitcnt vmcnt(0)" ::: "memory");
        } else {
            XB_SPIN(xb_ld(&bar[XB_XGEN(bx_)]) == gen, bar);
            __builtin_amdgcn_fence(__ATOMIC_ACQUIRE, "agent");
            asm volatile("s_waitcnt vmcnt(0)" ::: "memory");
        }
    }
    __syncthreads();
}

struct Frame {
    LAS unsigned char* lds;
    unsigned char* ws;
    int tid, lane, wave, bid, G;
};
template <class T> __device__ __forceinline__ T* opq(T* p) { asm volatile("" : "+s"(p)); return p; }
__device__ __forceinline__ Frame fresh(const Frame& F) { Frame G = F; asm volatile("" : "+s"(G.ws), "+s"(G.bid), "+s"(G.wave), "+s"(G.G), "+v"(G.tid), "+v"(G.lane)); return G; }
#define AIN(k) opq(A.in[k])
template <class T> __device__ __forceinline__ T* uptr(T* p) {
    const unsigned long long v = (unsigned long long)p; const unsigned lo = __builtin_amdgcn_readfirstlane((unsigned)v), hi = __builtin_amdgcn_readfirstlane((unsigned)(v >> 32));
    return (T*)(((unsigned long long)hi << 32) | lo); }
__device__ __forceinline__ const float* modv(const Frame& F, int l, int type, int chunk) { return (const float*)(F.ws + WS_MODV) + ((size_t)(l * 3 + type) * 6 + chunk) * DM; }
__device__ __forceinline__ int row_type(int r) { const int b = r / TPB, j = r - b * TPB; return j < CTX ? 2 : b; }

__device__ __forceinline__ void load_row_f32(const float* p, int lane, f32x4 (&v)[4]) {
    const GAS f32x4* q = (const GAS f32x4*)p + lane;
#pragma unroll
    for (int j = 0; j < 4; ++j) v[j] = q[64 * j];
}
__device__ __forceinline__ void store_row_f32(float* p, int lane, const f32x4 (&v)[4]) {
    GAS f32x4* q = (GAS f32x4*)p + lane;
#pragma unroll
    for (int j = 0; j < 4; ++j) q[64 * j] = v[j];
}
__device__ __forceinline__ void load_row_bf16(const bf16* p, int lane, f32x4 (&v)[4]) {
    const GAS u32x2* q = (const GAS u32x2*)p + lane;
#pragma unroll
    for (int j = 0; j < 4; ++j) { const u32x2 w = q[64 * j]; v[j] = (f32x4){bflo(w.x), bfhi(w.x), bflo(w.y), bfhi(w.y)}; }
}
__device__ __forceinline__ void store_row_bf16(bf16* p, int lane, const f32x4 (&v)[4]) {
    GAS u32x2* q = (GAS u32x2*)p + lane;
#pragma unroll
    for (int j = 0; j < 4; ++j) { u32x2 w; w.x = pk2(v[j].x, v[j].y); w.y = pk2(v[j].z, v[j].w); q[64 * j] = w; }
}
__device__ __forceinline__ float row_rstd(const f32x4 (&v)[4]) {
    float s = 0.f;
#pragma unroll
    for (int j = 0; j < 4; ++j) s += (v[j].x * v[j].x + v[j].y * v[j].y) + (v[j].z * v[j].z + v[j].w * v[j].w);
    return rsqrtf(wave_sum(s) * (1.f / DM) + EPS);
}
__device__ __forceinline__ void modnorm_store(const f32x4 (&v)[4], const float* sc, const float* sh, bf16* dst, int lane) {
    const float rstd = row_rstd(v);
    f32x4 s[4], h[4], o[4]; load_row_f32(sc, lane, s); load_row_f32(sh, lane, h);
#pragma unroll
    for (int j = 0; j < 4; ++j) o[j] = v[j] * rstd * (s[j] + 1.f) + h[j];
    store_row_bf16(dst, lane, o);
}

namespace pg8 {
#define PG8_LAS __attribute__((address_space(3)))
typedef unsigned short bf16_t;
typedef short bf16x8 __attribute__((ext_vector_type(8)));
typedef float f32x4 __attribute__((ext_vector_type(4)));
typedef unsigned u32x4 __attribute__((ext_vector_type(4)));
constexpr int BM = 256, BK = 64, HALF = 128, HTB = HALF * BK * 2  , STAGE_BYTES = 8 * HTB, NXCD = 8, WGM = 8;

__host__ __device__ __forceinline__ int lds_byte(int r, int c) { const int st = (r >> 4) * 2 + (c >> 5), rr = r & 15, cc = c & 31, ob = rr * 64 + cc * 2; return st * 1024 + (ob ^ (((ob >> 9) & 1) << 5)); }
__host__ __device__ __forceinline__ void stage_rc(int b, int& R, int& C) { const int st = b / 1024, sb = b % 1024, swz = sb ^ (((sb >> 9) & 1) << 5); R = (st >> 1) * 16 + swz / 64; C = (st & 1) * 32 + (swz % 64) / 2; }
__host__ __device__ __forceinline__ int perm32(int rho) { const int n = rho >> 4, i = rho & 15; return 8 * (i >> 2) + 4 * n + (i & 3); }

struct Unit { int pm, pn, e; };
struct Gemm { const bf16_t* A; const bf16_t* Bt; int M, N, K; size_t estride; };

struct StaticOrder {
    int nM, nN, nwg, G, c;
    __host__ __device__ void init(int M, int N, int G_, int c_) { nM = M / BM; nN = N / BM; nwg = nM * nN; G = G_; c = c_; }
    __host__ __device__ bool next(int i, Unit& u) const {
        const long L = (long)i * G + c; if (L >= nwg) return false;
        int wgid = (int)L; { const int q = nwg / NXCD, r = nwg % NXCD, xcd = wgid % NXCD, off = wgid / NXCD; wgid = (xcd < r ? xcd * (q + 1) : r * (q + 1) + (xcd - r) * q) + off; }
        const int nig = WGM * nN, gid = wgid / nig, fm = gid * WGM, gsz = (nM - fm) < WGM ? (nM - fm) : WGM;
        u.pm = fm + ((wgid % nig) % gsz); u.pn = (wgid % nig) / gsz; u.e = 0; return true;
    }
    __device__ __forceinline__ void a_ready(const Unit&) const {}
    __device__ __forceinline__ void done(const Unit&) const {}
};

__device__ __forceinline__ unsigned cvt_pk_bf16(float lo, float hi) { unsigned r; asm volatile("v_cvt_pk_bf16_f32 %0, %1, %2" : "=v"(r) : "v"(lo), "v"(hi)); return r; }
typedef float f32x2 __attribute__((ext_vector_type(2)));
__device__ __forceinline__ f32x2 gelu_pk(f32x2 v) {
    const f32x2 av = __builtin_elementwise_abs(v), d = av * 0.2316418882f + 1.0f;
    f32x2 t; t.x = __builtin_amdgcn_rcpf(d.x); t.y = __builtin_amdgcn_rcpf(d.y);
    f32x2 q = t * 0.5307027145f + (-0.7265760135f); q = q * t + 0.7107068705f; q = q * t + (-0.142248368f); q = q * t + 0.127414796f; q = q * t;
    const f32x2 s = (v * v) * (-0.72134752044f);
    f32x2 e; e.x = __builtin_amdgcn_exp2f(s.x); e.y = __builtin_amdgcn_exp2f(s.y);
    const f32x2 m = v * (q * e), r = v - m;
    f32x2 o; o.x = v.x < 0.f ? m.x : r.x; o.y = v.y < 0.f ? m.y : r.y; return o;
}

template <int ACT  > struct EpiBf16 {
    static constexpr bool PERM = true, AFTER_DRAIN = false; static_assert(ACT == 0 || ACT == 1, "EpiBf16: ACT is 0 (none) or 1 (gelu_pk)");
    bf16_t* O; int ldc; const float* bias; int split_cols; size_t split_stride; float scale0;
    __device__ __forceinline__ void operator()(const f32x4 (&acc)[2][2][4][2], const Unit& u, int wr, int wc, int fr, int fq) const {
        const int row0 = u.pm * BM + wr * 64 + fr; int colt = u.pn * BM; bf16_t* base = O;
        float sc = 1.f; if (split_cols) { const int t = colt / split_cols; base += (size_t)t * split_stride; colt -= t * split_cols; if (t == 0) sc = scale0; }
        const int col0 = colt + wc * 32 + 8 * fq, bcol0 = u.pn * BM + wc * 32 + 8 * fq;
        f32x4 bv[2][2];
#pragma unroll
        for (int bj = 0; bj < 2; ++bj)
#pragma unroll
            for (int n = 0; n < 2; ++n) bv[bj][n] = bias ? *(const f32x4*)(bias + bcol0 + bj * HALF + 4 * n) : (f32x4){0.f, 0.f, 0.f, 0.f};
#pragma unroll
        for (int ai = 0; ai < 2; ++ai)
#pragma unroll
            for (int m = 0; m < 4; ++m) { bf16_t* rowp = base + (size_t)(row0 + ai * HALF + m * 16) * ldc + col0;
#pragma unroll
                for (int bj = 0; bj < 2; ++bj) { f32x4 v0 = acc[ai][bj][m][0] + bv[bj][0], v1 = acc[ai][bj][m][1] + bv[bj][1];
                    if (ACT == 1) { f32x2 a = gelu_pk((f32x2){v0[0], v0[1]}), b = gelu_pk((f32x2){v0[2], v0[3]}), c = gelu_pk((f32x2){v1[0], v1[1]}), d = gelu_pk((f32x2){v1[2], v1[3]});
                        v0 = (f32x4){a.x, a.y, b.x, b.y}; v1 = (f32x4){c.x, c.y, d.x, d.y}; }
                    v0 = v0 * sc; v1 = v1 * sc; u32x4 w; w.x = cvt_pk_bf16(v0[0], v0[1]); w.y = cvt_pk_bf16(v0[2], v0[3]); w.z = cvt_pk_bf16(v1[0], v1[1]); w.w = cvt_pk_bf16(v1[2], v1[3]);
                    *(GAS u32x4*)(rowp + bj * HALF) = w; } }
    }
};

__device__ __forceinline__ float silu_fast(float x) { return x * __builtin_amdgcn_rcpf(1.f + __expf(-x)); }
struct EpiSwiGLU {
    static constexpr bool PERM = true, AFTER_DRAIN = false;
    bf16_t* O;
    __device__ __forceinline__ void operator()(const f32x4 (&acc)[2][2][4][2], const Unit& u, int wr, int wc, int fr, int fq) const {
        const int row0 = u.pm * BM + wr * 64 + fr, col0 = u.pn * HALF + wc * 32 + 8 * fq;
#pragma unroll
        for (int ai = 0; ai < 2; ++ai)
#pragma unroll
            for (int m = 0; m < 4; ++m) { bf16_t* rowp = O + (size_t)(row0 + ai * HALF + m * 16) * 512 + col0;
                const f32x4 g0 = acc[ai][0][m][0], g1 = acc[ai][0][m][1], u0 = acc[ai][1][m][0], u1 = acc[ai][1][m][1];
                u32x4 w; w.x = cvt_pk_bf16(silu_fast(g0[0]) * u0[0], silu_fast(g0[1]) * u0[1]); w.y = cvt_pk_bf16(silu_fast(g0[2]) * u0[2], silu_fast(g0[3]) * u0[3]);
                w.z = cvt_pk_bf16(silu_fast(g1[0]) * u1[0], silu_fast(g1[1]) * u1[1]); w.w = cvt_pk_bf16(silu_fast(g1[2]) * u1[2], silu_fast(g1[3]) * u1[3]);
                *(GAS u32x4*)rowp = w; }
    }
};
struct EpiResGate {
    static constexpr bool PERM = false, AFTER_DRAIN = false;
    float* X; const float* gate3;
    __device__ __forceinline__ void operator()(const f32x4 (&acc)[2][2][4][2], const Unit& u, int wr, int wc, int fr, int fq) const {
        const int type = (u.pm % 33 == 0) ? 2 : u.pm / 33;
        const int col0 = u.pn * BM + wc * 32 + 4 * fq; const float* gp = gate3 + (size_t)type * 6144 + col0;
        f32x4 gv[2][2];
#pragma unroll
        for (int bj = 0; bj < 2; ++bj)
#pragma unroll
            for (int n = 0; n < 2; ++n) gv[bj][n] = *(const GAS f32x4*)(gp + bj * HALF + n * 16);
#pragma unroll
        for (int ai = 0; ai < 2; ++ai)
#pragma unroll
            for (int m = 0; m < 4; ++m) { float* rowp = X + (size_t)(u.pm * BM + ai * HALF + wr * 64 + m * 16 + fr) * 1024 + col0;
#pragma unroll
                for (int bj = 0; bj < 2; ++bj)
#pragma unroll
                    for (int n = 0; n < 2; ++n) { GAS f32x4* xp = (GAS f32x4*)(rowp + bj * HALF + n * 16); *xp = *xp + gv[bj][n] * acc[ai][bj][m][n]; } }
    }
};
struct MoeOrder {
    const PG8_LAS int* tb; int nN, nwg, G, c;
    __device__ __forceinline__ bool next(int i, Unit& u) const {
        const int L = i * G + c; if (L >= nwg) return false;
        u.pm = L / nN; u.pn = L - u.pm * nN; int e = 0;
#pragma unroll
        for (int q = 1; q < 16; ++q) e = (u.pm >= tb[q]) ? q : e;
        u.e = __builtin_amdgcn_readfirstlane(e); return true;
    }
    __device__ __forceinline__ void a_ready(const Unit&) const {}
    __device__ __forceinline__ void done(const Unit&) const {}
};

template <class Epi, class Sched, bool ALIGN_EPI = false, bool SP2 = false>
__device__ __forceinline__ void gemm_phase(PG8_LAS unsigned char* lds, const Gemm g, const Sched& S, const Epi& E, const int tid_) {
    const int tid = tid_, wid = __builtin_amdgcn_readfirstlane(tid >> 6), lane = tid & 63, wr = wid >> 2, wc = wid & 3, fr = lane & 15, fq = lane >> 4;
    const int K = g.K, nt = K / BK;
    unsigned voffA[2], voffB[2];
#pragma unroll
    for (int i = 0; i < 2; ++i) { int R, C; stage_rc(tid * 16 + i * 8192, R, C); const int Rb = Epi::PERM ? ((R & ~31) + perm32(R & 31)) : R;
        voffA[i] = (unsigned)(R * K + C) * 2u; voffB[i] = (unsigned)(Rb * K + C) * 2u; }
    const size_t kstep = (size_t)(BK * 2);
    const size_t hstep = (size_t)HALF * K * 2;
    const size_t tstep = 2 * hstep;
    const unsigned ldsw = (unsigned)wid * 1024u;
    const int aoff = lds_byte(wr * 64 + fr, fq * 8), boff = lds_byte(wc * 32 + fr, fq * 8);
#define PG8_SA(b, h) (((b) * 2 + (h)) * HTB)
#define PG8_SB(b, h) ((4 + (b) * 2 + (h)) * HTB)
#define PG8_STAGE(bufoff, gbase, voff) do { _Pragma("unroll") for (int _i = 0; _i < 2; ++_i) \
        __builtin_amdgcn_global_load_lds((const unsigned*)((const char*)(gbase) + (voff)[_i]), (PG8_LAS unsigned*)(lds + (bufoff) + ldsw + _i * 8192), 16, 0, 0); } while (0)
#define PG8_LDA(dst, b, h) do { _Pragma("unroll") for (int m = 0; m < 4; ++m) _Pragma("unroll") for (int k = 0; k < 2; ++k) dst[m][k] = *(const PG8_LAS bf16x8*)(lds + PG8_SA(b, h) + aoff + m * 2048 + k * 1024); } while (0)
#define PG8_LDB(dst, b, h) do { _Pragma("unroll") for (int n = 0; n < 2; ++n) _Pragma("unroll") for (int k = 0; k < 2; ++k) dst[n][k] = *(const PG8_LAS bf16x8*)(lds + PG8_SB(b, h) + boff + n * 2048 + k * 1024); } while (0)
#define PG8_MMA(ai, bj, At, Bt) do { __builtin_amdgcn_s_setprio(1); _Pragma("unroll") for (int m = 0; m < 4; ++m) _Pragma("unroll") for (int n = 0; n < 2; ++n) _Pragma("unroll") for (int k = 0; k < 2; ++k) \
        acc[ai][bj][m][n] = __builtin_amdgcn_mfma_f32_16x16x32_bf16(Bt[n][k], At[m][k], acc[ai][bj][m][n], 0, 0, 0); __builtin_amdgcn_s_setprio(0); } while (0)
#define PG8_WAIT_V(n) asm volatile("s_waitcnt vmcnt(" #n ")" ::: "memory")
#define PG8_WAIT_L(n) asm volatile("s_waitcnt lgkmcnt(" #n ")" ::: "memory")
#define PG8_BAR __builtin_amdgcn_s_barrier()
#define PG8_SCHED __builtin_amdgcn_sched_barrier(0)
    Unit cur, nxt; int ui = 0;
    if (!S.next(0, cur)) return;
    f32x4 acc[2][2][4][2];
#pragma unroll
    for (int a = 0; a < 2; ++a)
#pragma unroll
        for (int b = 0; b < 2; ++b)
#pragma unroll
            for (int m = 0; m < 4; ++m)
#pragma unroll
                for (int n = 0; n < 2; ++n) acc[a][b][m][n] = (f32x4){0.f, 0.f, 0.f, 0.f};
    bf16x8 At[4][2], B0[2][2], B1[2][2];
    const char* cA = (const char*)g.A + (size_t)cur.pm * tstep; const char* cB = (const char*)g.Bt + (size_t)cur.e * g.estride + (size_t)cur.pn * tstep;
    S.a_ready(cur);
    if constexpr (SP2) {
        PG8_STAGE(PG8_SB(0, 0), cB, voffB); PG8_STAGE(PG8_SB(0, 1), cB + hstep, voffB); PG8_STAGE(PG8_SA(0, 0), cA, voffA); PG8_STAGE(PG8_SA(0, 1), cA + hstep, voffA);
        if (wr == 1) PG8_BAR;
        PG8_WAIT_V(2); PG8_BAR;
        PG8_STAGE(PG8_SB(1, 0), cB + kstep, voffB); PG8_STAGE(PG8_SA(1, 0), cA + kstep, voffA); PG8_STAGE(PG8_SB(1, 1), cB + hstep + kstep, voffB);
        PG8_WAIT_V(6); PG8_BAR;
    } else {
        PG8_STAGE(PG8_SB(0, 0), cB, voffB); PG8_STAGE(PG8_SA(0, 0), cA, voffA); PG8_STAGE(PG8_SB(0, 1), cB + hstep, voffB); PG8_STAGE(PG8_SA(0, 1), cA + hstep, voffA);
        if (wr == 1) PG8_BAR;
        PG8_WAIT_V(4); PG8_BAR;
        PG8_STAGE(PG8_SB(1, 0), cB + kstep, voffB); PG8_STAGE(PG8_SA(1, 0), cA + kstep, voffA); PG8_STAGE(PG8_SB(1, 1), cB + hstep + kstep, voffB);
        PG8_WAIT_V(6); PG8_BAR;
    }
    for (;;) {
        const bool has_next = S.next(ui + 1, nxt);
        const char* nA = has_next ? (const char*)g.A + (size_t)nxt.pm * tstep : cA; const char* nB = has_next ? (const char*)g.Bt + (size_t)nxt.e * g.estride + (size_t)nxt.pn * tstep : cB;
        for (int t = 0; t < nt; t += 2) {
            const bool last = (t == nt - 2);
            const char* a1 = cA + (size_t)(t + 1) * kstep;
            const char* a2 = last ? nA : cA + (size_t)(t + 2) * kstep; const char* b2 = last ? nB : cB + (size_t)(t + 2) * kstep;
            const char* a3 = a2 + kstep; const char* b3 = b2 + kstep;
            if (last && has_next) S.a_ready(nxt);
            if constexpr (SP2) {
            PG8_LDB(B0, 0, 0); PG8_LDB(B1, 0, 1); PG8_SCHED; PG8_LDA(At, 0, 0); PG8_STAGE(PG8_SA(1, 1), a1 + hstep, voffA);
            PG8_WAIT_V(8); PG8_WAIT_L(0); PG8_BAR; PG8_MMA(0, 0, At, B0); PG8_MMA(0, 1, At, B1); PG8_BAR; PG8_SCHED;
            PG8_LDA(At, 0, 1); PG8_STAGE(PG8_SB(0, 0), b2, voffB); PG8_STAGE(PG8_SB(0, 1), b2 + hstep, voffB); PG8_STAGE(PG8_SA(0, 0), a2, voffA);
            PG8_WAIT_V(8); PG8_WAIT_L(0); PG8_BAR; PG8_MMA(1, 0, At, B0); PG8_MMA(1, 1, At, B1); PG8_BAR; PG8_SCHED;
            PG8_LDB(B0, 1, 0); PG8_LDB(B1, 1, 1); PG8_SCHED; PG8_LDA(At, 1, 0); PG8_STAGE(PG8_SA(0, 1), a2 + hstep, voffA);
            PG8_WAIT_V(8); PG8_WAIT_L(0); PG8_BAR; PG8_MMA(0, 0, At, B0); PG8_MMA(0, 1, At, B1); PG8_BAR; PG8_SCHED;
            PG8_LDA(At, 1, 1); PG8_STAGE(PG8_SB(1, 0), b3, voffB); PG8_STAGE(PG8_SB(1, 1), b3 + hstep, voffB); PG8_STAGE(PG8_SA(1, 0), a3, voffA);
            PG8_WAIT_V(8); PG8_WAIT_L(0); PG8_BAR; PG8_MMA(1, 0, At, B0); PG8_MMA(1, 1, At, B1); PG8_BAR; PG8_SCHED;
            } else {
            PG8_LDB(B0, 0, 0); PG8_SCHED; PG8_LDA(At, 0, 0); PG8_STAGE(PG8_SA(1, 1), a1 + hstep, voffA);
            PG8_WAIT_L(8); PG8_BAR; PG8_WAIT_L(0); PG8_MMA(0, 0, At, B0); PG8_BAR; PG8_SCHED;
            PG8_LDB(B1, 0, 1); PG8_STAGE(PG8_SB(0, 0), b2, voffB);
            PG8_BAR; PG8_WAIT_L(0); PG8_MMA(0, 1, At, B1); PG8_BAR;
            PG8_LDA(At, 0, 1); PG8_STAGE(PG8_SA(0, 0), a2, voffA);
            PG8_BAR; PG8_WAIT_L(0); PG8_MMA(1, 0, At, B0); PG8_BAR; PG8_SCHED;
            PG8_STAGE(PG8_SB(0, 1), b2 + hstep, voffB);
            PG8_WAIT_V(6); PG8_BAR; PG8_MMA(1, 1, At, B1); PG8_BAR;
            PG8_LDB(B0, 1, 0); PG8_SCHED; PG8_LDA(At, 1, 0); PG8_STAGE(PG8_SA(0, 1), a2 + hstep, voffA);
            PG8_WAIT_L(8); PG8_BAR; PG8_WAIT_L(0); PG8_MMA(0, 0, At, B0); PG8_BAR; PG8_SCHED;
            PG8_LDB(B1, 1, 1); PG8_STAGE(PG8_SB(1, 0), b3, voffB);
            PG8_BAR; PG8_WAIT_L(0); PG8_MMA(0, 1, At, B1); PG8_BAR;
            PG8_LDA(At, 1, 1); PG8_STAGE(PG8_SA(1, 0), a3, voffA);
            PG8_BAR; PG8_WAIT_L(0); PG8_MMA(1, 0, At, B0); PG8_BAR; PG8_SCHED;
            PG8_STAGE(PG8_SB(1, 1), b3 + hstep, voffB);
            PG8_WAIT_V(6); PG8_BAR; PG8_MMA(1, 1, At, B1); PG8_BAR;
            }
        }
        if constexpr (ALIGN_EPI) { if (wr == 0) PG8_BAR; }
        if constexpr (!Epi::AFTER_DRAIN) { E(acc, cur, wr, wc, fr, fq); S.done(cur); }
        if (!has_next) break;
#pragma unroll
        for (int a = 0; a < 2; ++a)
#pragma unroll
            for (int b = 0; b < 2; ++b)
#pragma unroll
                for (int m = 0; m < 4; ++m)
#pragma unroll
                    for (int n = 0; n < 2; ++n) acc[a][b][m][n] = (f32x4){0.f, 0.f, 0.f, 0.f};
        cur = nxt; cA = nA; cB = nB; ++ui;
        if constexpr (ALIGN_EPI) { if (wr == 1) PG8_BAR; }
    }
    PG8_WAIT_V(0);
    if constexpr (!ALIGN_EPI) { if (wr == 0) PG8_BAR; }
    PG8_BAR;
    if constexpr (Epi::AFTER_DRAIN) { E.fused(acc, cur, wr, wc, fr, fq, lds, wid, lane); S.done(cur); }
#undef PG8_SA
#undef PG8_SB
#undef PG8_STAGE
#undef PG8_LDA
#undef PG8_LDB
#undef PG8_MMA
#undef PG8_WAIT_V
#undef PG8_WAIT_L
#undef PG8_BAR
#undef PG8_SCHED
}
}

constexpr int SG_AS = 132, SG_BS = 68;
template <class FA, class FB>
__device__ __forceinline__ void sg_tile(LAS float* As, LAS float* Bs, int K, FA fa, FB fb, float (&acc)[4][4], int tid) {
    const int ty = tid >> 4, tx = tid & 15;
#pragma unroll
    for (int i = 0; i < 4; ++i)
#pragma unroll
        for (int j = 0; j < 4; ++j) acc[i][j] = 0.f;
    for (int k0 = 0; k0 < K; k0 += 16) {
#pragma unroll
        for (int i = 0; i < 4; ++i) { const int idx = tid + 512 * i, m = idx >> 4, kk = idx & 15; As[kk * SG_AS + m] = fa(m, k0 + kk); }
#pragma unroll
        for (int i = 0; i < 2; ++i) { const int idx = tid + 512 * i, n = idx >> 4, kk = idx & 15; Bs[kk * SG_BS + n] = fb(k0 + kk, n); }
        __syncthreads();
#pragma unroll
        for (int kk = 0; kk < 16; ++kk) {
            const f32x4 a = *(const LAS f32x4*)(As + kk * SG_AS + 4 * ty), b = *(const LAS f32x4*)(Bs + kk * SG_BS + 4 * tx);
#pragma unroll
            for (int i = 0; i < 4; ++i)
#pragma unroll
                for (int j = 0; j < 4; ++j) acc[i][j] += a[i] * b[j];
        }
        __syncthreads();
    }
}

template <int DQK>
__device__ __forceinline__ void sattn_unit(LAS float* sm, const bf16* Q, int ldq, const bf16* Kp, int ldk, const bf16* Vp, int ldv, bf16* O, int ldo, int nkeys, float scale, int tid) {
    constexpr int QS = DQK + 1;
    LAS float* Qs = sm; LAS float* Ks = Qs + 32 * QS; LAS float* Vs = Ks + 64 * QS; LAS float* Ss = Vs + 64 * 128;
    const int qi = tid >> 4, sub = tid & 15;
    __syncthreads();
    for (int idx = tid; idx < 32 * DQK; idx += 512) { const int r = idx / DQK, d = idx % DQK; Qs[r * QS + d] = bf2f(Q[(size_t)r * ldq + d]) * scale; }
    float m = -1e30f, l = 0.f, acc[8];
#pragma unroll
    for (int e = 0; e < 8; ++e) acc[e] = 0.f;
    for (int k0 = 0; k0 < nkeys; k0 += 64) {
        __syncthreads();
        for (int idx = tid; idx < 64 * DQK; idx += 512) { const int r = idx / DQK, d = idx % DQK; Ks[r * QS + d] = bf2f(Kp[(size_t)(k0 + r) * ldk + d]); }
        for (int idx = tid; idx < 64 * 128; idx += 512) { const int r = idx >> 7, d = idx & 127; Vs[r * 128 + d] = bf2f(Vp[(size_t)(k0 + r) * ldv + d]); }
        __syncthreads();
        float s[4];
#pragma unroll
        for (int c = 0; c < 4; ++c) { const int kj = sub + 16 * c; float a = 0.f;
            for (int d = 0; d < DQK; ++d) a += Qs[qi * QS + d] * Ks[kj * QS + d];
            s[c] = a; }
        float tmax = fmaxf(fmaxf(s[0], s[1]), fmaxf(s[2], s[3]));
#pragma unroll
        for (int o = 1; o < 16; o <<= 1) tmax = fmaxf(tmax, __shfl_xor(tmax, o));
        const float mnew = fmaxf(m, tmax), alpha = expf(m - mnew);
        float ps = 0.f;
#pragma unroll
        for (int c = 0; c < 4; ++c) { const float p = expf(s[c] - mnew); ps += p; Ss[qi * 65 + sub + 16 * c] = p; }
#pragma unroll
        for (int o = 1; o < 16; o <<= 1) ps += __shfl_xor(ps, o);
        l = l * alpha + ps; m = mnew;
        __syncthreads();
#pragma unroll
        for (int e = 0; e < 8; ++e) acc[e] *= alpha;
        for (int k = 0; k < 64; ++k) { const float p = Ss[qi * 65 + k];
#pragma unroll
            for (int e = 0; e < 8; ++e) acc[e] += p * Vs[k * 128 + sub * 8 + e]; }
    }
    const float rl = 1.f / l;
    u32x4 w; w.x = pk2(acc[0] * rl, acc[1] * rl); w.y = pk2(acc[2] * rl, acc[3] * rl); w.z = pk2(acc[4] * rl, acc[5] * rl); w.w = pk2(acc[6] * rl, acc[7] * rl);
    *(GAS u32x4*)(O + (size_t)qi * ldo + sub * 8) = w;
}

template <class RM>
__device__ __forceinline__ void transpose_item(const float* W, int K, int N, bf16* WT, int ldt, RM rowmap, LAS float* scr, int item, int lane) {
    const int nblk = N / 32, kb = item / nblk, nb = item % nblk, k0 = 64 * kb, n0 = 32 * nb;
#pragma unroll 8
    for (int i = 0; i < 32; ++i) { const int kk = 2 * i + (lane >> 5); scr[kk * 33 + (lane & 31)] = W[(size_t)(k0 + kk) * N + n0 + (lane & 31)]; }
    LDS_WAIT(); asm volatile("" ::: "memory");
    const int c = lane & 7;
#pragma unroll
    for (int j = 0; j < 4; ++j) { const int n = (lane >> 3) + 8 * j; const LAS float* s = scr + (8 * c) * 33 + n;
        u32x4 o; o.x = pk2(s[0 * 33], s[1 * 33]); o.y = pk2(s[2 * 33], s[3 * 33]); o.z = pk2(s[4 * 33], s[5 * 33]); o.w = pk2(s[6 * 33], s[7 * 33]);
        *(GAS u32x4*)(WT + (size_t)rowmap(n0 + n) * ldt + k0 + 8 * c) = o; }
    LDS_WAIT(); asm volatile("" ::: "memory");
}

__device__ __forceinline__ void phase_pro_a(const Frame& F_, const Args& A) { const Frame F = fresh(F_);
    const int gw = F.bid * NWAVES + F.wave, NGW = F.G * NWAVES, gt = F.bid * NTHREADS + F.tid, NGT = F.G * NTHREADS;
    {
        LAS float* sv = (LAS float*)F.lds;
        LAS float* red = sv + 3 * DM;
        for (int i = F.tid; i < 3 * DM; i += NTHREADS) { const int t = i / DM, k = i % DM; const float x = (t < 2) ? AIN(1)[t * DM + k] : AIN(3)[k]; sv[i] = silu_f(x); }
        __syncthreads();
        for (int item = F.bid; item < DEPTH * 96; item += F.G) {
            const int l = item / 96, n0 = (item % 96) * 64, n = F.tid & 63, kp = F.tid >> 6;
            const float* w = AIN(4) + (size_t)l * DM * 6144 + n0 + n;
            float a0 = 0.f, a1 = 0.f, a2 = 0.f;
            for (int k = kp * 128; k < kp * 128 + 128; ++k) { const float wv = w[(size_t)k * 6144]; a0 += sv[k] * wv; a1 += sv[DM + k] * wv; a2 += sv[2 * DM + k] * wv; }
            red[(kp * 3 + 0) * 64 + n] = a0; red[(kp * 3 + 1) * 64 + n] = a1; red[(kp * 3 + 2) * 64 + n] = a2;
            __syncthreads();
            if (F.tid < 192) { const int t = F.tid >> 6, nn = F.tid & 63; float s = AIN(5)[l * 6144 + n0 + nn];
                for (int q = 0; q < 8; ++q) s += red[(q * 3 + t) * 64 + nn];
                ((float*)(F.ws + WS_MODV))[(size_t)(l * 3 + t) * 6144 + n0 + nn] = s; }
            __syncthreads();
        }
    }
    for (int i = gt; i < 128 * 32 + 128 * 16; i += NGT) {
        if (i < 128 * 32) { const int p = i >> 5, f = i & 31; const float inv = powf(10000.f, -(float)(2 * f) / 64.f), ang = (float)p * inv;
            ((float*)(F.ws + WS_TABA))[2 * i] = cosf(ang); ((float*)(F.ws + WS_TABA))[2 * i + 1] = sinf(ang); }
        else { const int ii = i - 128 * 32, p = ii >> 4, f = ii & 15; const float inv = powf(10000.f, -(float)(2 * f) / 32.f), ang = (float)p * inv;
            ((float*)(F.ws + WS_TABC))[2 * ii] = cosf(ang); ((float*)(F.ws + WS_TABC))[2 * ii + 1] = sinf(ang); }
    }
    if (F.bid == 0 && F.wave < 2) { const int i = F.wave; const float a = AIN(13)[i * 64 + F.lane] * AIN(14)[i * 64 + F.lane], b = AIN(15)[i * 64 + F.lane] * AIN(16)[i * 64 + F.lane];
        const float sa = wave_sum(a), sb = wave_sum(b); const int l = 2 * i + 1; const float lam_init = 0.8f - 0.6f * expf(-0.3f * (float)l);
        if (F.lane == 0) { ((float*)(F.ws + WS_LAM))[2 * i] = expf(sa) - expf(sb) + lam_init; ((float*)(F.ws + WS_LAM))[2 * i + 1] = lam_init; } }
    {
        LAS float* scr = (LAS float*)(F.lds + 16384) + F.wave * (64 * 33);
        constexpr int I_INE = (DM / 64) * (EIN / 32), I_OUT = (DM / 64) * (DM / 32), I_INO = (DM / 64) * (OIN / 32), I_G = (DM / 64) * (DEXP / 32), I_D = (DEXP / 64) * (DM / 32);
        constexpr int T_INE = 2 * I_INE, T_OUTE = 2 * I_OUT, T_INO = 2 * I_INO, T_OUTO = 2 * I_OUT, T_G = 64 * I_G, T_U = 64 * I_G, T_D = 64 * I_D;
        constexpr int NITEMS = T_INE + T_OUTE + T_INO + T_OUTO + T_G + T_U + T_D;
        for (int it = gw; it < NITEMS; it += NGW) {
            int r = it;
            if (r < T_INE) { const int i = r / I_INE; transpose_item(AIN(6) + (size_t)i * DM * EIN, DM, EIN, (bf16*)(F.ws + WS_WINE) + (size_t)i * EIN * DM, DM, [](int n) { return n; }, scr, r % I_INE, F.lane); continue; } r -= T_INE;
            if (r < T_OUTE) { const int i = r / I_OUT, item = r % I_OUT;
                if (item / (DM / 32) < 12) transpose_item(AIN(7) + (size_t)i * DM * DM, DM, DM, (bf16*)(F.ws + WS_WOUTE) + (size_t)i * DM * OAE, OAE, [](int n) { return n; }, scr, item, F.lane);
                continue; } r -= T_OUTE;
            if (r < T_INO) { const int i = r / I_INO; transpose_item(AIN(11) + (size_t)i * DM * OIN, DM, OIN, (bf16*)(F.ws + WS_WINO) + (size_t)i * OIN * DM, DM, [](int n) { return n; }, scr, r % I_INO, F.lane); continue; } r -= T_INO;
            if (r < T_OUTO) { const int i = r / I_OUT; transpose_item(AIN(12) + (size_t)i * DM * DM, DM, DM, (bf16*)(F.ws + WS_WOUTO) + (size_t)i * DM * DM, DM, [](int n) { return n; }, scr, r % I_OUT, F.lane); continue; } r -= T_OUTO;
            if (r < T_G) { const int le = r / I_G; transpose_item(AIN(22) + (size_t)le * DM * DEXP, DM, DEXP, (bf16*)(F.ws + WS_WGU) + (size_t)le * DM * DM, DM, [](int n) { return (n >> 7) * 256 + (n & 127); }, scr, r % I_G, F.lane); continue; } r -= T_G;
            if (r < T_U) { const int le = r / I_G; transpose_item(AIN(23) + (size_t)le * DM * DEXP, DM, DEXP, (bf16*)(F.ws + WS_WGU) + (size_t)le * DM * DM, DM, [](int n) { return (n >> 7) * 256 + 128 + (n & 127); }, scr, r % I_G, F.lane); continue; } r -= T_U;
            { const int le = r / I_D; transpose_item(AIN(24) + (size_t)le * DEXP * DM, DEXP, DM, (bf16*)(F.ws + WS_WD) + (size_t)le * DM * DEXP, DEXP, [](int n) { return n; }, scr, r % I_D, F.lane); }
        }
    }
    for (int o = gt; o < 2 * 2 * 256 * DM; o += NGT) {
        const int n = o & 1023, gc = (o >> 10) & 255, ri = (o >> 18) & 1, i = o >> 19, g = gc >> 6, c = gc & 63;
        const float* w = AIN(7) + (size_t)i * DM * DM + (size_t)(768 + 64 * g) * DM + n;
        float a = 0.f;
        for (int m = 0; m < 64; ++m) { const float fr = (float)((m * c) & 63) * (1.f / 64.f); const float t = ri ? __builtin_amdgcn_sinf(fr) : __builtin_amdgcn_cosf(fr); a += t * w[(size_t)m * DM]; }
        ((bf16*)(F.ws + WS_WOUTE))[(size_t)i * DM * OAE + (size_t)n * OAE + 768 + ri * 256 + gc] = (bf16)f2bf(a);
    }
}

__device__ __forceinline__ void phase_pro_b(const Frame& F_, const Args& A) { const Frame F = fresh(F_);
    const int gw = F.bid * NWAVES + F.wave, NGW = F.G * NWAVES;
    for (int r = gw; r < NTOK; r += NGW) {
        const int b = r / TPB, j = r - b * TPB, type = j < CTX ? 2 : b;
        const float* src = j < CTX ? AIN(2) + (size_t)(b * CTX + j) * DM : AIN(0) + (size_t)(b * SEQ + (j - CTX)) * DM;
        f32x4 v[4]; load_row_f32(src, F.lane, v);
        store_row_f32((float*)(F.ws + WS_X) + (size_t)r * DM, F.lane, v);
        modnorm_store(v, modv(F, 0, type, 1), modv(F, 0, type, 0), (bf16*)(F.ws + WS_HA) + (size_t)r * DM, F.lane);
    }
}

__device__ __forceinline__ void unpack8(const u32x4 w, float (&v)[8]) { v[0] = bflo(w.x); v[1] = bfhi(w.x); v[2] = bflo(w.y); v[3] = bfhi(w.y); v[4] = bflo(w.z); v[5] = bfhi(w.z); v[6] = bflo(w.w); v[7] = bfhi(w.w); }
__device__ __forceinline__ u32x4 pack8(const float (&v)[8]) { u32x4 w; w.x = pk2(v[0], v[1]); w.y = pk2(v[2], v[3]); w.z = pk2(v[4], v[5]); w.w = pk2(v[6], v[7]); return w; }

__device__ __forceinline__ void phase_qkfix_e(const Frame& F_, const Args& A, int i) { const Frame F = fresh(F_);
    const int gw = F.bid * NWAVES + F.wave, NGW = F.G * NWAVES, lane = F.lane;
    const float* qg = AIN(8) + i * 128; const float* kg = AIN(9) + i * 128; const float* bg = AIN(10) + i * 256;
    const float* tab = (const float*)(F.ws + WS_TABA);
    for (int r = gw; r < NTOK; r += NGW) {
        const int b = r / TPB, j = r - b * TPB; const bool lat = j >= CTX; const int t = j - CTX, prow = t >> 6, pcol = t & 63;
        bf16* P = (bf16*)(F.ws + WS_PBUF) + (size_t)r * EIN;
#pragma unroll
        for (int it = 0; it < 2; ++it) {
            GAS u32x4* p = (GAS u32x4*)(P + 512 * it) + lane;
            float v[8], y[8], o[8]; unpack8(*p, v);
            float ss = 0.f;
#pragma unroll
            for (int e = 0; e < 8; ++e) ss += v[e] * v[e];
            ss += __shfl_xor(ss, 1); ss += __shfl_xor(ss, 2); ss += __shfl_xor(ss, 4); ss += __shfl_xor(ss, 8);
            const float rstd = rsqrtf(ss * (1.f / 128.f) + EPS);
            const bool isk = (it == 1) && (lane >= 32);
            const int d0 = 8 * (lane & 15);
            const float* gp = (isk ? kg : qg) + d0;
#pragma unroll
            for (int e = 0; e < 8; ++e) y[e] = v[e] * rstd * gp[e];
            const int quarter = (lane & 15) >> 2, fi = 8 * (lane & 3);
            const int pos = quarter < 2 ? prow : pcol;
#pragma unroll
            for (int e = 0; e < 8; ++e) {
                const float pv = __shfl_xor(y[e], 4);
                const float c = lat ? tab[2 * (pos * 32 + fi + e)] : 1.f, s = lat ? tab[2 * (pos * 32 + fi + e) + 1] : 0.f;
                o[e] = (quarter & 1) ? (pv * s + y[e] * c) : (y[e] * c - pv * s);
            }
            *p = pack8(o);
        }
        {
            GAS u32x4* p = (GAS u32x4*)(P + 1024) + lane;
            float v[8], o[8]; unpack8(*p, v);
            float ss = 0.f;
#pragma unroll
            for (int e = 0; e < 8; ++e) ss += v[e] * v[e];
            ss += __shfl_xor(ss, 1); ss += __shfl_xor(ss, 2); ss += __shfl_xor(ss, 4);
            const float rstd = rsqrtf(ss * (1.f / 64.f) + EPS);
            const float* gp = bg + 8 * (lane & 31);
#pragma unroll
            for (int e = 0; e < 8; ++e) o[e] = v[e] * rstd * gp[e];
            if (lane >= 32) *p = pack8(o);
        }
    }
}
__device__ __forceinline__ void phase_qkfix_o(const Frame& F_) { const Frame F = fresh(F_);
    const int gw = F.bid * NWAVES + F.wave, NGW = F.G * NWAVES, lane = F.lane;
    const float* tab = (const float*)(F.ws + WS_TABC);
    for (int r = gw; r < NTOK; r += NGW) {
        const int b = r / TPB, j = r - b * TPB; if (j < CTX) continue;
        const int t = j - CTX, prow = t >> 6, pcol = t & 63;
        bf16* P = (bf16*)(F.ws + WS_PBUF) + (size_t)r * OIN;
#pragma unroll
        for (int it = 0; it < 4; ++it) {
            GAS u32x4* p = (GAS u32x4*)(P + 512 * it) + lane;
            float y[8], o[8]; unpack8(*p, y);
            const int quarter = (lane & 7) >> 1, fi = 8 * (lane & 1);
            const int pos = quarter < 2 ? prow : pcol;
#pragma unroll
            for (int e = 0; e < 8; ++e) {
                const float pv = __shfl_xor(y[e], 2);
                const float c = tab[2 * (pos * 16 + fi + e)], s = tab[2 * (pos * 16 + fi + e) + 1];
                o[e] = (quarter & 1) ? (pv * s + y[e] * c) : (y[e] * c - pv * s);
            }
            *p = pack8(o);
        }
    }
}
__device__ __forceinline__ void phase_finish_o(const Frame& F_, const Args& A, int i) { const Frame F = fresh(F_);
    const int gw = F.bid * NWAVES + F.wave, NGW = F.G * NWAVES, lane = F.lane;
    const float lam = ((const float*)(F.ws + WS_LAM))[2 * i], post = 1.f - ((const float*)(F.ws + WS_LAM))[2 * i + 1];
    const float* hg = AIN(17) + i * 128 + 8 * (lane & 15);
    for (int r = gw; r < NTOK; r += NGW) {
        const bf16* T = (const bf16*)(F.ws + WS_OT) + (size_t)r * OTW; bf16* O = (bf16*)(F.ws + WS_OA) + (size_t)r * OAO;
#pragma unroll
        for (int it = 0; it < 4; ++it) {
            float v[8], o[8]; unpack8(*((const GAS u32x4*)(T + 512 * it) + lane), v);
            float ss = 0.f;
#pragma unroll
            for (int e = 0; e < 8; ++e) { const float pv = __shfl_xor(v[e], 16); o[e] = v[e] - lam * pv; ss += o[e] * o[e]; }
            ss += __shfl_xor(ss, 1); ss += __shfl_xor(ss, 2); ss += __shfl_xor(ss, 4); ss += __shfl_xor(ss, 8);
            const float rstd = rsqrtf(ss * (1.f / 128.f) + EPS) * post;
#pragma unroll
            for (int e = 0; e < 8; ++e) o[e] = o[e] * rstd * hg[e];
            if (((lane >> 4) & 1) == 0) *(GAS u32x4*)(O + (2 * it + (lane >> 5)) * 128 + 8 * (lane & 15)) = pack8(o);
        }
    }
}

__device__ __forceinline__ void phase_router(const Frame& F_, const Args& A, int l) { const Frame F = fresh(F_);
    LAS float* wc = (LAS float*)F.lds;
    LAS int* lcnt = (LAS int*)(F.lds + 81920);
    LAS int* gb = lcnt + 16;
    LAS int* rec = gb + 16;
    LAS float* recw = (LAS float*)(rec + 72 * 4);
    const int lane = F.lane;
    __syncthreads();
    for (int i = F.tid; i < DM * 20; i += NTHREADS) { const int k = i / 20, c = i % 20; wc[i] = c < 4 ? AIN(18)[(size_t)l * DM * 4 + k * 4 + c] : AIN(20)[(size_t)l * DM * 16 + k * 16 + (c - 4)]; }
    if (F.tid < 16) lcnt[F.tid] = 0;
    __syncthreads();
    const int nmine = (NTOK - F.bid + F.G - 1) / F.G;
    for (int it = F.wave; it < nmine; it += NWAVES) {
        const int r = F.bid + it * F.G, type = row_type(r);
        f32x4 v[4]; load_row_f32((const float*)(F.ws + WS_X) + (size_t)r * DM, lane, v);
        const float rstd = row_rstd(v);
        f32x4 s[4], h[4]; load_row_f32(modv(F, l, type, 4), lane, s); load_row_f32(modv(F, l, type, 3), lane, h);
#pragma unroll
        for (int j = 0; j < 4; ++j) v[j] = v[j] * rstd * (s[j] + 1.f) + h[j];
        store_row_bf16((bf16*)(F.ws + WS_HA) + (size_t)r * DM, lane, v);
        float lg[20];
#pragma unroll
        for (int c = 0; c < 20; ++c) lg[c] = 0.f;
#pragma unroll
        for (int j = 0; j < 4; ++j)
#pragma unroll
            for (int e = 0; e < 4; ++e) { const LAS float* wr = wc + (4 * lane + 256 * j + e) * 20; const float xv = v[j][e];
#pragma unroll
                for (int c = 0; c < 20; ++c) lg[c] += xv * wr[c]; }
#pragma unroll
        for (int c = 0; c < 20; ++c) lg[c] = wave_sum(lg[c]);
        if (lane == 0) {
            float gl[4]; int gi = 0;
#pragma unroll
            for (int g = 0; g < 4; ++g) gl[g] = lg[g] + AIN(19)[l * 4 + g];
#pragma unroll
            for (int g = 1; g < 4; ++g) if (gl[g] > gl[gi]) gi = g;
            float gs = 0.f;
#pragma unroll
            for (int g = 0; g < 4; ++g) gs += expf(gl[g] - gl[gi]);
            const float ggate = 1.f / gs;
            float el[4];
#pragma unroll
            for (int e = 0; e < 4; ++e) { float x = 0.f;
#pragma unroll
                for (int g = 0; g < 4; ++g) x = (g == gi) ? lg[4 + 4 * g + e] + AIN(21)[l * 16 + 4 * g + e] : x;
                el[e] = x; }
            int i0 = 0;
#pragma unroll
            for (int e = 1; e < 4; ++e) if (el[e] > el[i0]) i0 = e;
            int i1 = (i0 == 0) ? 1 : 0;
#pragma unroll
            for (int e = 0; e < 4; ++e) if (e != i0 && el[e] > el[i1]) i1 = e;
            const float p1 = expf(el[i1] - el[i0]);
            const float w0 = ggate / (1.f + p1), w1 = ggate * p1 / (1.f + p1);
            const int e0 = gi * 4 + i0, e1 = gi * 4 + i1;
            const int lp0 = __hip_atomic_fetch_add(lcnt + e0, 1, __ATOMIC_RELAXED, __HIP_MEMORY_SCOPE_WORKGROUP);
            const int lp1 = __hip_atomic_fetch_add(lcnt + e1, 1, __ATOMIC_RELAXED, __HIP_MEMORY_SCOPE_WORKGROUP);
            rec[it * 4 + 0] = e0; rec[it * 4 + 1] = lp0; rec[it * 4 + 2] = e1; rec[it * 4 + 3] = lp1; recw[it * 2] = w0; recw[it * 2 + 1] = w1;
        }
    }
    __syncthreads();
    if (F.tid < 16) gb[F.tid] = (int)__hip_atomic_fetch_add((unsigned*)(F.ws + WS_CTL) + CW_CNT + 64 * l + F.tid, (unsigned)lcnt[F.tid], __ATOMIC_RELAXED, __HIP_MEMORY_SCOPE_AGENT);
    __syncthreads();
    if (F.tid < nmine) { const int it = F.tid, r = F.bid + it * F.G; const int e0 = rec[it * 4], e1 = rec[it * 4 + 2];
        ((GAS i32x4*)(F.ws + WS_SELA))[r] = (i32x4){e0, gb[e0] + rec[it * 4 + 1], e1, gb[e1] + rec[it * 4 + 3]};
        ((GAS f32x2*)(F.ws + WS_SELW))[r] = (f32x2){recw[it * 2], recw[it * 2 + 1]}; }
    __syncthreads();
}
__device__ __forceinline__ void moe_bases(const Frame& F, int l, int (&base)[17]) {
    const unsigned* cnt = (const unsigned*)(F.ws + WS_CTL) + CW_CNT + 64 * l;
    int acc = 0;
#pragma unroll
    for (int e = 0; e < 16; ++e) { base[e] = acc; const int c = __builtin_amdgcn_readfirstlane((int)__hip_atomic_load(cnt + e, __ATOMIC_RELAXED, __HIP_MEMORY_SCOPE_AGENT)); acc += ((c + 255) >> 8) << 8; }
    base[16] = acc;
}
__device__ __forceinline__ void phase_gather(const Frame& F_, int l) { const Frame F = fresh(F_);
    const int gw = F.bid * NWAVES + F.wave, NGW = F.G * NWAVES, lane = F.lane;
    int base[17]; moe_bases(F, l, base);
    for (int r = gw; r < NTOK; r += NGW) {
        const i32x4 s = ((const GAS i32x4*)(F.ws + WS_SELA))[r];
        int b0 = 0, b1 = 0;
#pragma unroll
        for (int e = 0; e < 16; ++e) { b0 = (s.x == e) ? base[e] : b0; b1 = (s.z == e) ? base[e] : b1; }
        const int r0 = b0 + s.y, r1 = b1 + s.w;
        const GAS u32x4* src = (const GAS u32x4*)((const bf16*)(F.ws + WS_HA) + (size_t)r * DM) + lane;
        const u32x4 a = src[0], c = src[64];
        GAS u32x4* d0 = (GAS u32x4*)((bf16*)(F.ws + WS_XS) + (size_t)r0 * DM) + lane; d0[0] = a; d0[64] = c;
        GAS u32x4* d1 = (GAS u32x4*)((bf16*)(F.ws + WS_XS) + (size_t)r1 * DM) + lane; d1[0] = a; d1[64] = c;
        if (lane == 0) ((GAS i32x2*)(F.ws + WS_RPOS))[r] = (i32x2){r0, r1};
    }
}
__device__ __forceinline__ void phase_combine(const Frame& F_, const Args& A, int l) { const Frame F = fresh(F_);
    const int gw = F.bid * NWAVES + F.wave, NGW = F.G * NWAVES, lane = F.lane;
    for (int r = gw; r < NTOK; r += NGW) {
        const int b = r / TPB, j = r - b * TPB, type = j < CTX ? 2 : b;
        if (l == DEPTH - 1 && j < CTX) continue;
        const i32x2 rp = ((const GAS i32x2*)(F.ws + WS_RPOS))[r]; const f32x2 w = ((const GAS f32x2*)(F.ws + WS_SELW))[r];
        f32x4 x[4], y0[4], y1[4], g[4];
        float* xp = (float*)(F.ws + WS_X) + (size_t)r * DM;
        load_row_f32(xp, lane, x); load_row_bf16((const bf16*)(F.ws + WS_Y2S) + (size_t)rp.x * DM, lane, y0); load_row_bf16((const bf16*)(F.ws + WS_Y2S) + (size_t)rp.y * DM, lane, y1);
        load_row_f32(modv(F, l, type, 5), lane, g);
#pragma unroll
        for (int q = 0; q < 4; ++q) x[q] = x[q] + g[q] * (y0[q] * w.x + y1[q] * w.y);
        if (l < DEPTH - 1) {
            store_row_f32(xp, lane, x);
            modnorm_store(x, modv(F, l + 1, type, 1), modv(F, l + 1, type, 0), (bf16*)(F.ws + WS_HA) + (size_t)r * DM, lane);
        } else {
            const float rstd = row_rstd(x);
            f32x4 fg[4]; load_row_f32(AIN(25), lane, fg);
#pragma unroll
            for (int q = 0; q < 4; ++q) x[q] = x[q] * rstd * fg[q];
            store_row_f32(A.out + (size_t)(b * SEQ + (j - CTX)) * DM, lane, x);
        }
    }
}

__device__ __forceinline__ void sphase_gemm_bf16(const Frame& F_, const bf16* Am, int lda, const bf16* Bt, int ldb, bf16* C, int ldc, int M, int N, int K) { const Frame F = fresh(F_);
    LAS float* As = (LAS float*)F.lds; LAS float* Bs = As + 16 * SG_AS;
    const int nm = M / 128, nn = N / 64, ty = F.tid >> 4, tx = F.tid & 15;
    for (int t = F.bid; t < nm * nn; t += F.G) {
        const int tm = t / nn, tn = t % nn; const bf16* a0 = Am + (size_t)tm * 128 * lda; const bf16* b0 = Bt + (size_t)tn * 64 * ldb;
        float acc[4][4];
        sg_tile(As, Bs, K, [&](int m, int k) { return bf2f(a0[(size_t)m * lda + k]); }, [&](int k, int n) { return bf2f(b0[(size_t)n * ldb + k]); }, acc, F.tid);
#pragma unroll
        for (int i = 0; i < 4; ++i) { u32x2 w; w.x = pk2(acc[i][0], acc[i][1]); w.y = pk2(acc[i][2], acc[i][3]);
            *(GAS u32x2*)(C + (size_t)(tm * 128 + 4 * ty + i) * ldc + tn * 64 + 4 * tx) = w; }
    }
}
__device__ __forceinline__ void sphase_outproj(const Frame& F_, const bf16* Am, int lda, const bf16* Bt, int K, int l) { const Frame F = fresh(F_);
    LAS float* As = (LAS float*)F.lds; LAS float* Bs = As + 16 * SG_AS;
    const int nm = NTOK / 128, nn = DM / 64, ty = F.tid >> 4, tx = F.tid & 15;
    for (int t = F.bid; t < nm * nn; t += F.G) {
        const int tm = t / nn, tn = t % nn; const bf16* a0 = Am + (size_t)tm * 128 * lda; const bf16* b0 = Bt + (size_t)tn * 64 * K;
        float acc[4][4];
        sg_tile(As, Bs, K, [&](int m, int k) { return bf2f(a0[(size_t)m * lda + k]); }, [&](int k, int n) { return bf2f(b0[(size_t)n * K + k]); }, acc, F.tid);
#pragma unroll
        for (int i = 0; i < 4; ++i) { const int r = tm * 128 + 4 * ty + i, c = tn * 64 + 4 * tx;
            const f32x4 g = *(const GAS f32x4*)(modv(F, l, row_type(r), 2) + c);
            GAS f32x4* xp = (GAS f32x4*)((float*)(F.ws + WS_X) + (size_t)r * DM + c); f32x4 x = *xp;
            x.x += g.x * acc[i][0]; x.y += g.y * acc[i][1]; x.z += g.z * acc[i][2]; x.w += g.w * acc[i][3]; *xp = x; }
    }
}
__device__ __forceinline__ int moe_expert_of_row(const int (&base)[17], int row) { int e = 0;
#pragma unroll
    for (int q = 1; q < 16; ++q) e = (row >= base[q]) ? q : e;
    return e; }
__device__ __forceinline__ void sphase_moe_gu(const Frame& F_, int l) { const Frame F = fresh(F_);
    LAS float* As = (LAS float*)F.lds; LAS float* Bs = As + 16 * SG_AS;
    int base[17]; moe_bases(F, l, base);
    const int nm = base[16] / 128, nn = DEXP / 64, ty = F.tid >> 4, tx = F.tid & 15;
    for (int t = F.bid; t < nm * nn; t += F.G) {
        const int tm = t / nn, tn = t % nn, e = moe_expert_of_row(base, tm * 128);
        const bf16* a0 = (const bf16*)(F.ws + WS_XS) + (size_t)tm * 128 * DM;
        const bf16* w = (const bf16*)(F.ws + WS_WGU) + (size_t)(l * 16 + e) * DM * DM;
        const int hc0 = tn * 64;
        const bf16* bg0 = w + (size_t)((hc0 >> 7) * 256 + (hc0 & 127)) * DM; const bf16* bu0 = bg0 + (size_t)128 * DM;
        float ag[4][4], au[4][4];
        sg_tile(As, Bs, DM, [&](int m, int k) { return bf2f(a0[(size_t)m * DM + k]); }, [&](int k, int n) { return bf2f(bg0[(size_t)n * DM + k]); }, ag, F.tid);
        sg_tile(As, Bs, DM, [&](int m, int k) { return bf2f(a0[(size_t)m * DM + k]); }, [&](int k, int n) { return bf2f(bu0[(size_t)n * DM + k]); }, au, F.tid);
#pragma unroll
        for (int i = 0; i < 4; ++i) { float h[4];
#pragma unroll
            for (int j = 0; j < 4; ++j) h[j] = silu_f(ag[i][j]) * au[i][j];
            u32x2 wv; wv.x = pk2(h[0], h[1]); wv.y = pk2(h[2], h[3]);
            *(GAS u32x2*)((bf16*)(F.ws + WS_HID) + (size_t)(tm * 128 + 4 * ty + i) * DEXP + hc0 + 4 * tx) = wv; }
    }
}
__device__ __forceinline__ void sphase_moe_down(const Frame& F_, int l) { const Frame F = fresh(F_);
    LAS float* As = (LAS float*)F.lds; LAS float* Bs = As + 16 * SG_AS;
    int base[17]; moe_bases(F, l, base);
    const int nm = base[16] / 128, nn = DM / 64, ty = F.tid >> 4, tx = F.tid & 15;
    for (int t = F.bid; t < nm * nn; t += F.G) {
        const int tm = t / nn, tn = t % nn, e = moe_expert_of_row(base, tm * 128);
        const bf16* a0 = (const bf16*)(F.ws + WS_HID) + (size_t)tm * 128 * DEXP;
        const bf16* b0 = (const bf16*)(F.ws + WS_WD) + (size_t)(l * 16 + e) * DM * DEXP + (size_t)tn * 64 * DEXP;
        float acc[4][4];
        sg_tile(As, Bs, DEXP, [&](int m, int k) { return bf2f(a0[(size_t)m * DEXP + k]); }, [&](int k, int n) { return bf2f(b0[(size_t)n * DEXP + k]); }, acc, F.tid);
#pragma unroll
        for (int i = 0; i < 4; ++i) { u32x2 w; w.x = pk2(acc[i][0], acc[i][1]); w.y = pk2(acc[i][2], acc[i][3]);
            *(GAS u32x2*)((bf16*)(F.ws + WS_Y2S) + (size_t)(tm * 128 + 4 * ty + i) * DM + tn * 64 + 4 * tx) = w; }
    }
}


#ifndef FAST_GEMM
#define FAST_GEMM 1
#endif
__device__ __forceinline__ void fphase_inproj(const Frame& F_, bool even, int i) { const Frame F = fresh(F_);
    const int N = even ? EIN : OIN;
    const bf16* Bt = even ? (const bf16*)(F.ws + WS_WINE) + (size_t)i * EIN * DM : (const bf16*)(F.ws + WS_WINO) + (size_t)i * OIN * DM;
    pg8::Gemm g{(const bf16*)(F.ws + WS_HA), Bt, NTOK, N, DM, 0};
    pg8::StaticOrder S; S.init(NTOK, N, F.G, F.bid);
    pg8::EpiBf16<0> E{(bf16*)(F.ws + WS_PBUF), N, nullptr, 0, 0, 1.f};
    pg8::gemm_phase<pg8::EpiBf16<0>, pg8::StaticOrder, true, true>(F.lds, g, S, E, F.tid);
}
__device__ __forceinline__ void fphase_outproj(const Frame& F_, bool even, int i, int l) { const Frame F = fresh(F_);
    const int K = even ? OAE : OAO;
    const bf16* Bt = even ? (const bf16*)(F.ws + WS_WOUTE) + (size_t)i * DM * OAE : (const bf16*)(F.ws + WS_WOUTO) + (size_t)i * DM * DM;
    pg8::Gemm g{(const bf16*)(F.ws + WS_OA), Bt, NTOK, DM, K, 0};
    pg8::StaticOrder S; S.init(NTOK, DM, F.G, F.bid);
    pg8::EpiResGate E{(float*)(F.ws + WS_X), modv(F, l, 0, 2)};
    pg8::gemm_phase<pg8::EpiResGate, pg8::StaticOrder, true, true>(F.lds, g, S, E, F.tid);
}
__device__ __forceinline__ void fphase_moe_gu(const Frame& F_, int l) { const Frame F = fresh(F_);
    int base[17]; moe_bases(F, l, base);
    LAS int* tbl = (LAS int*)(F.lds + TB_OFF);
    __syncthreads();
#pragma unroll
    for (int e = 0; e < 17; ++e) if (F.tid == e) tbl[e] = base[e] >> 8;
    __syncthreads();
    pg8::MoeOrder S; S.tb = tbl; S.nN = 4; S.nwg = (base[16] >> 8) * 4; S.G = F.G; S.c = F.bid;
    pg8::Gemm g{(const bf16*)(F.ws + WS_XS), (const bf16*)(F.ws + WS_WGU) + (size_t)l * 16 * DM * DM, base[16], DM, DM, (size_t)DM * DM * 2};
    pg8::EpiSwiGLU E{(bf16*)(F.ws + WS_HID)};
    pg8::gemm_phase<pg8::EpiSwiGLU, pg8::MoeOrder, true, true>(F.lds, g, S, E, F.tid);
}
__device__ __forceinline__ void fphase_moe_down(const Frame& F_, int l) { const Frame F = fresh(F_);
    int base[17]; moe_bases(F, l, base);
    LAS int* tbl = (LAS int*)(F.lds + TB_OFF);
    __syncthreads();
#pragma unroll
    for (int e = 0; e < 17; ++e) if (F.tid == e) tbl[e] = base[e] >> 8;
    __syncthreads();
    pg8::MoeOrder S; S.tb = tbl; S.nN = 4; S.nwg = (base[16] >> 8) * 4; S.G = F.G; S.c = F.bid;
    pg8::Gemm g{(const bf16*)(F.ws + WS_HID), (const bf16*)(F.ws + WS_WD) + (size_t)l * 16 * DM * DEXP, base[16], DM, DEXP, (size_t)DM * DEXP * 2};
    pg8::EpiBf16<0> E{(bf16*)(F.ws + WS_Y2S), DM, nullptr, 0, 0, 1.f};
    pg8::gemm_phase<pg8::EpiBf16<0>, pg8::MoeOrder, true, true>(F.lds, g, S, E, F.tid);
}

__device__ __forceinline__ void sphase_fft1(const Frame& F_) { const Frame F = fresh(F_);
    const int gt = F.bid * NTHREADS + F.tid, NGT = F.G * NTHREADS;
    for (int o = gt; o < NB * 128 * 2 * 64 * 256; o += NGT) {
        const int col = o & 255, t2 = (o >> 8) & 63, ri = (o >> 14) & 1, k1 = (o >> 15) & 127, b = o >> 22;
        const bf16* f = (const bf16*)(F.ws + WS_PBUF) + (size_t)(b * TPB + CTX + t2) * EIN + 1280 + col;
        float a = 0.f;
        for (int t1 = 0; t1 < 128; ++t1) { const int t = 64 * t1 + t2; const float fr = (float)((k1 * t) & 8191) * (1.f / 8192.f);
            const float c = ri ? -__builtin_amdgcn_sinf(fr) : __builtin_amdgcn_cosf(fr); a += c * bf2f(f[(size_t)(64 * t1) * EIN]); }
        ((bf16*)(F.ws + WS_YB))[o] = (bf16)f2bf(a);
    }
}
__device__ __forceinline__ void sphase_fft2(const Frame& F_) { const Frame F = fresh(F_);
    const int gt = F.bid * NTHREADS + F.tid, NGT = F.G * NTHREADS;
    const float norm = 1.f / sqrtf(8192.f * 64.f);
    for (int o = gt; o < NB * SEQ * 2 * 256; o += NGT) {
        const int col = o & 255, ri = (o >> 8) & 1, k = (o >> 9) & 8191, b = o >> 22, k1 = k & 127, k2 = k >> 7;
        const bf16* yr = (const bf16*)(F.ws + WS_YB) + ((size_t)((b * 128 + k1) * 2 + 0) * 64) * 256 + col; const bf16* yi = yr + 64 * 256;
        float a = 0.f;
        for (int t2 = 0; t2 < 64; ++t2) { const float fr = (float)((k2 * t2) & 63) * (1.f / 64.f), c = __builtin_amdgcn_cosf(fr), s = __builtin_amdgcn_sinf(fr);
            const float vr = bf2f(yr[t2 * 256]), vi = bf2f(yi[t2 * 256]);
            a += ri ? (c * vi - s * vr) : (c * vr + s * vi); }
        ((bf16*)(F.ws + WS_OA))[(size_t)(b * TPB + CTX + k) * OAE + 768 + ri * 256 + col] = (bf16)f2bf(a * norm);
    }
}
__device__ __forceinline__ void sphase_fftc(const Frame& F_) { const Frame F = fresh(F_);
    const int gt = F.bid * NTHREADS + F.tid, NGT = F.G * NTHREADS;
    const float norm = 1.f / sqrtf(256.f * 64.f);
    for (int o = gt; o < NB * CTX * 2 * 256; o += NGT) {
        const int col = o & 255, ri = (o >> 8) & 1, k = (o >> 9) & 255, b = o >> 17;
        const bf16* f = (const bf16*)(F.ws + WS_PBUF) + (size_t)(b * TPB) * EIN + 1280 + col;
        float a = 0.f;
        for (int t = 0; t < CTX; ++t) { const float fr = (float)((k * t) & 255) * (1.f / 256.f); const float c = ri ? -__builtin_amdgcn_sinf(fr) : __builtin_amdgcn_cosf(fr); a += c * bf2f(f[(size_t)t * EIN]); }
        ((bf16*)(F.ws + WS_OA))[(size_t)(b * TPB + k) * OAE + 768 + ri * 256 + col] = (bf16)f2bf(a * norm);
    }
}


namespace fa {
using bf16x8 = __attribute__((ext_vector_type(8))) short;
using s16x4  = __attribute__((ext_vector_type(4))) short;
using f32x16 = __attribute__((ext_vector_type(16))) float;
constexpr int NW = 8, QBLK = 32, KVBLK = 64, DV = 128;
constexpr float THR = 8.f;
constexpr int SHM_V = KVBLK * DV * 2;
template <int DQK> struct Cfg { static constexpr float SCALE = DQK == 128 ? 0.088388347648318440f : 0.125f; static constexpr int RB = DQK * 2, SHM_K = KVBLK * DQK * 2, ND0 = DQK / 16; };
#define FA_KSWZ(row, colB, RB) ((row) * (RB) + ((colB) ^ (((row) & 7) << 4)))
#define FA_SBAR() __builtin_amdgcn_sched_barrier(0)
__device__ __forceinline__ int crow(int r, int hi) { return (r & 3) + 8 * (r >> 2) + 4 * hi; }
__device__ __forceinline__ unsigned cvtpk(float lo, float hi) { unsigned r; asm volatile("v_cvt_pk_bf16_f32 %0, %1, %2" : "=v"(r) : "v"(lo), "v"(hi)); return r; }
template <int DQK>
__device__ __forceinline__ void partialSM(f32x16& p0, f32x16& p1, float& m_reg, float& mn, float& alpha) {
  constexpr float SCALE = Cfg<DQK>::SCALE, C = SCALE * 1.4426950408889634f;
  float pmax = p0[0];
#pragma unroll
  for (int r = 1; r < 16; ++r) pmax = fmaxf(pmax, p0[r]);
#pragma unroll
  for (int r = 0; r < 16; ++r) pmax = fmaxf(pmax, p1[r]);
  { auto rr = __builtin_amdgcn_permlane32_swap(__float_as_uint(pmax), __float_as_uint(pmax), false, false);
    pmax = fmaxf(__uint_as_float(rr[0]), __uint_as_float(rr[1])); }
  if (__builtin_expect(__all(pmax - m_reg <= THR / SCALE), 1)) { mn = m_reg; alpha = 1.f; }
  else { mn = fmaxf(m_reg, pmax); alpha = __builtin_amdgcn_exp2f((m_reg - mn) * C); m_reg = mn; }
  const float mnC = -mn * C;
#pragma unroll
  for (int r = 0; r < 16; ++r) p0[r] = fmaf(p0[r], C, mnC);
#pragma unroll
  for (int r = 0; r < 16; ++r) p1[r] = fmaf(p1[r], C, mnC);
#pragma unroll
  for (int r = 0; r < 16; ++r) p0[r] = __builtin_amdgcn_exp2f(p0[r]);
}
__device__ __forceinline__ void finishSM(f32x16& p0, f32x16& p1, float alpha, float& l_reg, bf16x8& pa0, bf16x8& pa1, bf16x8& pa2, bf16x8& pa3) {
#pragma unroll
  for (int r = 0; r < 16; ++r) p1[r] = __builtin_amdgcn_exp2f(p1[r]);
  float ps = 0;
#pragma unroll
  for (int r = 0; r < 16; ++r) ps += p0[r];
#pragma unroll
  for (int r = 0; r < 16; ++r) ps += p1[r];
  { auto rr = __builtin_amdgcn_permlane32_swap(__float_as_uint(ps), __float_as_uint(ps), false, false);
    ps = __uint_as_float(rr[0]) + __uint_as_float(rr[1]); }
  l_reg = l_reg * alpha + ps;
#define FA_PK4(P, BASE, OUT) do { unsigned a0 = cvtpk(P[BASE + 0], P[BASE + 1]), a1 = cvtpk(P[BASE + 2], P[BASE + 3]);   \
    unsigned b0 = cvtpk(P[BASE + 4], P[BASE + 5]), b1 = cvtpk(P[BASE + 6], P[BASE + 7]);                              \
    auto r0 = __builtin_amdgcn_permlane32_swap(a0, b0, false, false); auto r1 = __builtin_amdgcn_permlane32_swap(a1, b1, false, false); \
    u32x4 w = {r0[0], r1[0], r0[1], r1[1]}; OUT = *reinterpret_cast<bf16x8*>(&w); } while (0)
  FA_PK4(p0, 0, pa0); FA_PK4(p0, 8, pa1); FA_PK4(p1, 0, pa2); FA_PK4(p1, 8, pa3);
#undef FA_PK4
}
template <int DQK>
__device__ __forceinline__ void qkt(f32x16& p0, f32x16& p1, const LAS char* Ks, const bf16x8* qr, int r32, int hi) {
  constexpr int RB = Cfg<DQK>::RB;
  p0 = f32x16{}; p1 = f32x16{};
#pragma unroll
  for (int d0 = 0; d0 < Cfg<DQK>::ND0; ++d0) { const int cb = (d0 * 16 + hi * 8) * 2;
    bf16x8 b0 = *reinterpret_cast<const LAS bf16x8*>(Ks + FA_KSWZ(r32, cb, RB));
    bf16x8 b1 = *reinterpret_cast<const LAS bf16x8*>(Ks + FA_KSWZ(32 + r32, cb, RB));
    p0 = __builtin_amdgcn_mfma_f32_32x32x16_bf16(b0, qr[d0], p0, 0, 0, 0);
    p1 = __builtin_amdgcn_mfma_f32_32x32x16_bf16(b1, qr[d0], p1, 0, 0, 0); }
}
__device__ __forceinline__ int v_st(int k, int c) { const int kk = (k & ~0xC) | ((k & 4) << 1) | ((k & 8) >> 1); return ((kk >> 3) * 4 + (c >> 5)) * 512 + ((kk & 7) * 32 + (c & 31)) * 2; }
__device__ __forceinline__ int v_rd_base(int lane) { return ((lane & 3) << 3) | (((lane >> 2) & 3) << 6) | (((lane >> 4) & 1) << 5) | (((lane >> 5) & 1) << 8); }
constexpr int v_rd_off(int d0, int ks, int half) { return d0 * 512 + ks * 4096 + half * 2048; }
template <int OFF> __device__ __forceinline__ s16x4 tr_read(int vb) {
  s16x4 r; asm volatile("ds_read_b64_tr_b16 %0, %1 offset:%2" : "=&v"(r) : "v"(vb), "i"(OFF) : "memory"); return r;
}
template <int D0> __device__ __forceinline__ void pv_one(f32x16& od, int vb, bf16x8 pa0, bf16x8 pa1, bf16x8 pa2, bf16x8 pa3) {
  const s16x4 l0 = tr_read<v_rd_off(D0, 0, 0)>(vb), h0 = tr_read<v_rd_off(D0, 0, 1)>(vb), l1 = tr_read<v_rd_off(D0, 1, 0)>(vb), h1 = tr_read<v_rd_off(D0, 1, 1)>(vb);
  const s16x4 l2 = tr_read<v_rd_off(D0, 2, 0)>(vb), h2 = tr_read<v_rd_off(D0, 2, 1)>(vb), l3 = tr_read<v_rd_off(D0, 3, 0)>(vb), h3 = tr_read<v_rd_off(D0, 3, 1)>(vb);
  asm volatile("s_waitcnt lgkmcnt(0)" ::: "memory"); FA_SBAR();
#define FA_PK(L, H) (bf16x8){L[0], L[1], L[2], L[3], H[0], H[1], H[2], H[3]}
  od = __builtin_amdgcn_mfma_f32_32x32x16_bf16(pa0, FA_PK(l0, h0), od, 0, 0, 0);
  od = __builtin_amdgcn_mfma_f32_32x32x16_bf16(pa1, FA_PK(l1, h1), od, 0, 0, 0);
  od = __builtin_amdgcn_mfma_f32_32x32x16_bf16(pa2, FA_PK(l2, h2), od, 0, 0, 0);
  od = __builtin_amdgcn_mfma_f32_32x32x16_bf16(pa3, FA_PK(l3, h3), od, 0, 0, 0);
#undef FA_PK
}
__device__ __forceinline__ void pv_d0(f32x16* o, int vb, bf16x8 pa0, bf16x8 pa1, bf16x8 pa2, bf16x8 pa3) {
  pv_one<0>(o[0], vb, pa0, pa1, pa2, pa3); pv_one<1>(o[1], vb, pa0, pa1, pa2, pa3); pv_one<2>(o[2], vb, pa0, pa1, pa2, pa3); pv_one<3>(o[3], vb, pa0, pa1, pa2, pa3);
}
template <int DQK, int LDI, int LDO, int SDEPTH>
__device__ __forceinline__ void attn_unit(const bf16* __restrict__ Qb, const bf16* __restrict__ Kh, const bf16* __restrict__ Vh, bf16* __restrict__ Ob, int seq, LAS char* lds, int tid) {
  constexpr int ldq = LDI, ldk = LDI, ldv = LDI, ldo = LDO;
  constexpr int RB = Cfg<DQK>::RB, SHM_K = Cfg<DQK>::SHM_K, ND0 = Cfg<DQK>::ND0;
  const int wid = tid >> 6, lane = tid & 63, r32 = lane & 31, hi = lane >> 5;
  LAS char* V_lds = lds; LAS char* K_lds = lds + 2 * SHM_V;
  LAS float* ws = (LAS float*)(lds + 2 * SHM_V + 2 * SHM_K) + wid * 64; LAS float* li_l = ws; LAS float* al_l = ws + 32;
  float m_reg = -1e30f, l_reg = 0; f32x16 o[4] = {}; bf16x8 qr[ND0];
  __syncthreads();
  const GAS bf16* Qw = (const GAS bf16*)Qb + (size_t)(wid * QBLK + r32) * ldq + hi * 8;
#pragma unroll
  for (int d0 = 0; d0 < ND0; ++d0) qr[d0] = *reinterpret_cast<const GAS bf16x8*>(Qw + d0 * 16);
  const int sr = tid >> 4, sc = (tid & 15) * 8, vst0 = v_st(sr, sc), vst1 = v_st(32 + sr, sc);
  const int kr = DQK == 128 ? sr : (tid >> 3), kc = DQK == 128 ? sc : (tid & 7) * 8;
  const int vb0 = (int)(unsigned)(size_t)V_lds + v_rd_base(lane);
  struct { bf16x8 vs0, vs1, ks0, ks1; } sr_[SDEPTH];
const unsigned vo0 = (unsigned)(sr * ldv + sc), vo1 = (unsigned)((32 + sr) * ldv + sc), ko0 = (unsigned)(kr * ldk + kc), ko1 = (unsigned)((32 + kr) * ldk + kc);
#define FA_SLOAD(i, k0) do { const GAS bf16* Vt_ = (const GAS bf16*)Vh + (size_t)(k0) * ldv; const GAS bf16* Kt_ = (const GAS bf16*)Kh + (size_t)(k0) * ldk; \
    sr_[i].vs0 = *reinterpret_cast<const GAS bf16x8*>(Vt_ + vo0); sr_[i].vs1 = *reinterpret_cast<const GAS bf16x8*>(Vt_ + vo1); \
    sr_[i].ks0 = *reinterpret_cast<const GAS bf16x8*>(Kt_ + ko0); if constexpr (DQK == 128) sr_[i].ks1 = *reinterpret_cast<const GAS bf16x8*>(Kt_ + ko1); } while (0)
#define FA_SWRITE(b, i) do { *(LAS bf16x8*)(V_lds + (b) * SHM_V + vst0) = sr_[i].vs0; *(LAS bf16x8*)(V_lds + (b) * SHM_V + vst1) = sr_[i].vs1; \
    *(LAS bf16x8*)(K_lds + (b) * SHM_K + FA_KSWZ(kr, kc * 2, RB)) = sr_[i].ks0; if constexpr (DQK == 128) *(LAS bf16x8*)(K_lds + (b) * SHM_K + FA_KSWZ(32 + kr, kc * 2, RB)) = sr_[i].ks1; } while (0)
#define FA_SWAIT() do { if constexpr (SDEPTH == 1) asm volatile("s_waitcnt vmcnt(0)" ::: "memory"); else if constexpr (DQK == 128) asm volatile("s_waitcnt vmcnt(4)" ::: "memory"); else asm volatile("s_waitcnt vmcnt(3)" ::: "memory"); } while (0)
#define FA_RESC(a) do { if (__any((a) < 1.f)) { if (hi == 0) al_l[r32] = (a); asm volatile("s_waitcnt lgkmcnt(0)" ::: "memory"); \
    _Pragma("unroll") for (int d = 0; d < 4; ++d) _Pragma("unroll") for (int r = 0; r < 16; ++r) o[d][r] *= al_l[crow(r, hi)]; } } while (0)
  f32x16 pA0, pA1, pB0, pB1; float mnA, mnB, alA, alB; bf16x8 pa0, pa1, pa2, pa3; const int NT = seq / KVBLK;
  constexpr int SE = 0, SO = SDEPTH - 1;
  FA_SLOAD(SE, 0); asm volatile("s_waitcnt vmcnt(0)" ::: "memory"); FA_SWRITE(0, SE); __syncthreads();
  qkt<DQK>(pA0, pA1, K_lds, qr, r32, hi); partialSM<DQK>(pA0, pA1, m_reg, mnA, alA);
  FA_SLOAD(SO, KVBLK); if constexpr (SDEPTH == 2) { if (2 < NT) FA_SLOAD(SE, 2 * KVBLK); }
  FA_SWAIT(); FA_SWRITE(1, SO); __syncthreads();
  for (int j = 1; j + 1 < NT; j += 2) {
    FA_SBAR(); qkt<DQK>(pB0, pB1, K_lds + SHM_K, qr, r32, hi);
    finishSM(pA0, pA1, alA, l_reg, pa0, pa1, pa2, pa3); FA_SBAR();
    FA_SLOAD(SO, (j + SDEPTH) * KVBLK); FA_SBAR();
    pv_d0(o, vb0, pa0, pa1, pa2, pa3); partialSM<DQK>(pB0, pB1, m_reg, mnB, alB);
    __syncthreads(); FA_SWAIT(); FA_SWRITE(0, SE);
    FA_RESC(alB); __syncthreads();
    FA_SBAR(); qkt<DQK>(pA0, pA1, K_lds, qr, r32, hi);
    finishSM(pB0, pB1, alB, l_reg, pa0, pa1, pa2, pa3); FA_SBAR();
    if (SDEPTH == 1 || j + 3 < NT) FA_SLOAD(SE, (j + 1 + SDEPTH) * KVBLK); FA_SBAR();
    pv_d0(o, vb0 + SHM_V, pa0, pa1, pa2, pa3); partialSM<DQK>(pA0, pA1, m_reg, mnA, alA);
    __syncthreads(); FA_SWAIT(); FA_SWRITE(1, SO);
    FA_RESC(alA); __syncthreads();
  }
  FA_SBAR(); qkt<DQK>(pB0, pB1, K_lds + SHM_K, qr, r32, hi);
  finishSM(pA0, pA1, alA, l_reg, pa0, pa1, pa2, pa3); FA_SBAR();
  pv_d0(o, vb0, pa0, pa1, pa2, pa3); partialSM<DQK>(pB0, pB1, m_reg, mnB, alB);
  __syncthreads(); FA_RESC(alB);
  finishSM(pB0, pB1, alB, l_reg, pa0, pa1, pa2, pa3); FA_SBAR();
  pv_d0(o, vb0 + SHM_V, pa0, pa1, pa2, pa3);
  if (hi == 0) li_l[r32] = l_reg; asm volatile("s_waitcnt lgkmcnt(0)" ::: "memory");
  int r32e = r32, hie = hi; asm volatile("" : "+v"(r32e), "+v"(hie));
  float rli[16];
#pragma unroll
  for (int r = 0; r < 16; ++r) rli[r] = __builtin_amdgcn_rcpf(li_l[crow(r, hie)]);
  GAS bf16* Ow = (GAS bf16*)Ob + (size_t)(wid * QBLK) * ldo;
  const unsigned oo = (unsigned)(4 * hie * ldo + r32e);
#pragma unroll
  for (int r = 0; r < 16; ++r) { const unsigned orow = (unsigned)((r & 3) + 8 * (r >> 2));
#pragma unroll
    for (int d0 = 0; d0 < 4; ++d0) Ow[oo + orow * ldo + d0 * 32] = (bf16)f2bf(o[d0][r] * rli[r]); }
#undef FA_SLOAD
#undef FA_SWRITE
#undef FA_SWAIT
#undef FA_RESC
}
}

#ifndef FAST_ATTN
#define FAST_ATTN 1
#endif
__device__ __forceinline__ void fphase_attn_e(const Frame& F_) { const Frame F = fresh(F_);
    const bf16* P = (const bf16*)(F.ws + WS_PBUF); bf16* OA = (bf16*)(F.ws + WS_OA);
    constexpr int NL = NB * 6 * (SEQ / 256), NC = NB * 6;
    for (int u = F.bid; u < NL + NC; u += F.G) {
        int b, h, q0, nk;
        if (u < NL) { b = u / (6 * 32); h = (u / 32) % 6; q0 = CTX + 256 * (u % 32); nk = TPB; }
        else { const int v = u - NL; b = v / 6; h = v % 6; q0 = 0; nk = CTX; }
        const size_t rq = (size_t)(b * TPB + q0), rk = (size_t)b * TPB;
        fa::attn_unit<128, EIN, OAE, 1>(P + rq * EIN + h * 128, P + rk * EIN + 768 + (h / 3) * 128, P + rk * EIN + 1024 + (h / 3) * 128, OA + rq * OAE + h * 128, nk, (LAS char*)F.lds, F.tid);
    }
}
__device__ __forceinline__ void fphase_attn_o(const Frame& F_) { const Frame F = fresh(F_);
    const bf16* P = (const bf16*)(F.ws + WS_PBUF); bf16* OT = (bf16*)(F.ws + WS_OT);
    constexpr int NL = NB * 16 * (SEQ / 256), NC = NB * 16;
    for (int u = F.bid; u < NL + NC; u += F.G) {
        int b, g, q0, nk;
        if (u < NL) { b = u / (16 * 32); g = (u / 32) % 16; q0 = CTX + 256 * (u % 32); nk = TPB; }
        else { const int v = u - NL; b = v / 16; g = v % 16; q0 = 0; nk = CTX; }
        const size_t rq = (size_t)(b * TPB + q0), rk = (size_t)b * TPB;
        fa::attn_unit<64, OIN, OTW, 2>(P + rq * OIN + g * 64, P + rk * OIN + 1024 + g * 64, P + rk * OIN + 2048 + (g / 2) * 128, OT + rq * OTW + g * 128, nk, (LAS char*)F.lds, F.tid);
    }
}


#ifndef FAST_FFT
#define FAST_FFT 1
#endif
template <int NTILE, class Gen, class Out>
__device__ __forceinline__ void dft_unit(LAS char* lds, const bf16* data, unsigned ldv, int nch, int rowbase, int vsel, Gen gen, GAS bf16* obase, float oscale, Out out_off, int tid) {
    const int lane = tid & 63, r32 = lane & 31, hi = lane >> 5;
    const int sr = tid >> 4, sc = (tid & 15) * 8, vst0 = fa::v_st(sr, sc), vst1 = fa::v_st(32 + sr, sc);
    const int vb = (int)(unsigned)(size_t)lds + vsel * fa::SHM_V + fa::v_rd_base(lane);
    fa::f32x16 o[4] = {};
    for (int ch = 0; ch < nch; ++ch) {
        __syncthreads();
#pragma unroll
        for (int t = 0; t < NTILE; ++t) {
            const GAS bf16* dt = (const GAS bf16*)data + (size_t)(64 * ch) * ldv + 128 * t;
            const fa::bf16x8 a = *reinterpret_cast<const GAS fa::bf16x8*>(dt + (unsigned)sr * ldv + sc), c = *reinterpret_cast<const GAS fa::bf16x8*>(dt + (unsigned)(32 + sr) * ldv + sc);
            *(LAS fa::bf16x8*)(lds + t * fa::SHM_V + vst0) = a; *(LAS fa::bf16x8*)(lds + t * fa::SHM_V + vst1) = c;
        }
        fa::bf16x8 pa[4];
#pragma unroll
        for (int ks = 0; ks < 4; ++ks) { const int k0 = 64 * ch + 16 * ks + 8 * hi; u32x4 w;
            w.x = fa::cvtpk(gen(rowbase + r32, k0 + 0), gen(rowbase + r32, k0 + 1)); w.y = fa::cvtpk(gen(rowbase + r32, k0 + 2), gen(rowbase + r32, k0 + 3));
            w.z = fa::cvtpk(gen(rowbase + r32, k0 + 4), gen(rowbase + r32, k0 + 5)); w.w = fa::cvtpk(gen(rowbase + r32, k0 + 6), gen(rowbase + r32, k0 + 7));
            pa[ks] = *reinterpret_cast<fa::bf16x8*>(&w); }
        __syncthreads();
        fa::pv_d0(o, vb, pa[0], pa[1], pa[2], pa[3]);
    }
    int r32e = r32, hie = hi; asm volatile("" : "+v"(r32e), "+v"(hie));
#pragma unroll
    for (int r = 0; r < 16; ++r)
#pragma unroll
        for (int d0 = 0; d0 < 4; ++d0) obase[out_off(rowbase + (r & 3) + 8 * (r >> 2) + 4 * hie, 32 * d0 + r32e)] = (bf16)f2bf(o[d0][r] * oscale);
}
__device__ __forceinline__ void fphase_fft1(const Frame& F_) { const Frame F = fresh(F_);
    for (int u = F.bid; u < NB * 64 * 2; u += F.G) {
        const int ch2 = u & 1, t2 = (u >> 1) & 63, b = u >> 7;
        const bf16* data = uptr((const bf16*)(F.ws + WS_PBUF) + (size_t)(b * TPB + CTX + t2) * EIN + 1280 + 128 * ch2);
        GAS bf16* yb = (GAS bf16*)uptr((bf16*)(F.ws + WS_YB) + ((size_t)b * 128 * 2 * 64 + t2) * 256 + 128 * ch2);
        dft_unit<1>((LAS char*)F.lds, data, 64u * EIN, 2, 32 * F.wave, 0,
            [&](int rho, int kap) { const int k1 = rho & 127, t = 64 * kap + t2; const float fr = (float)((k1 * t) & 8191) * (1.f / 8192.f); return (rho >> 7) ? -__builtin_amdgcn_sinf(fr) : __builtin_amdgcn_cosf(fr); },
            yb, 1.f, [&](int rho, int col) { return (unsigned)((((rho & 127) * 2 + (rho >> 7)) * 64) * 256 + col); }, F.tid);
    }
}
__device__ __forceinline__ void fphase_fft2(const Frame& F_) { const Frame F = fresh(F_);
    const float norm = 0.0013810679320049757f, normc = 0.0078125f;
    constexpr int BUSY = 140;
    const int nfree = F.G > BUSY ? F.G - BUSY : F.G, vb0 = F.G > BUSY ? F.bid - BUSY : F.bid;
    if (vb0 < 0) return;
    for (int u = vb0; u < NB * 128; u += nfree) {
        const int k1 = u & 127, b = u >> 7;
        const bf16* data = uptr((const bf16*)(F.ws + WS_YB) + (size_t)(b * 128 + k1) * 2 * 64 * 256);
        bf16* oa_ = uptr((bf16*)(F.ws + WS_OA) + (size_t)(b * TPB + CTX + k1) * OAE + 768 + 128 * (F.wave >> 2));
        dft_unit<2>((LAS char*)F.lds, data, 256u, 2, 32 * (F.wave & 3), F.wave >> 2,
            [&](int rho, int kap) { const int k2 = rho & 63, ro = rho >> 6, t2 = kap & 63, si = kap >> 6; const float fr = (float)((k2 * t2) & 63) * (1.f / 64.f);
                return (ro == si) ? __builtin_amdgcn_cosf(fr) : (ro ? -__builtin_amdgcn_sinf(fr) : __builtin_amdgcn_sinf(fr)); },
            (GAS bf16*)oa_, norm, [&](int rho, int col) { return (unsigned)((128 * (rho & 63)) * OAE + (rho >> 6) * 256 + col); }, F.tid);
    }
    for (int u = vb0; u < 8; u += nfree) {
        const int rb = u & 1, ch2 = (u >> 1) & 1, b = u >> 2;
        const bf16* data = uptr((const bf16*)(F.ws + WS_PBUF) + (size_t)(b * TPB) * EIN + 1280 + 128 * ch2);
        bf16* oa_ = uptr((bf16*)(F.ws + WS_OA) + (size_t)(b * TPB) * OAE + 768 + 128 * ch2);
        dft_unit<1>((LAS char*)F.lds, data, (unsigned)EIN, 4, 256 * rb + 32 * F.wave, 0,
            [&](int rho, int kap) { const int k = rho & 255; const float fr = (float)((k * kap) & 255) * (1.f / 256.f); return (rho >> 8) ? -__builtin_amdgcn_sinf(fr) : __builtin_amdgcn_cosf(fr); },
            (GAS bf16*)oa_, normc, [&](int rho, int col) { return (unsigned)((rho & 255) * OAE + (rho >> 8) * 256 + col); }, F.tid);
    }
}

__device__ __forceinline__ void sphase_attn_e(const Frame& F_) { const Frame F = fresh(F_);
    const bf16* P = (const bf16*)(F.ws + WS_PBUF); bf16* OA = (bf16*)(F.ws + WS_OA);
    const int NL = NB * 6 * (SEQ / 32), NC = NB * 6 * (CTX / 32);
    for (int u = F.bid; u < NL + NC; u += F.G) {
        int b, h, q0, nk;
        if (u < NL) { b = u / (6 * 256); h = (u / 256) % 6; q0 = CTX + 32 * (u % 256); nk = TPB; }
        else { const int v = u - NL; b = v / (6 * 8); h = (v / 8) % 6; q0 = 32 * (v % 8); nk = CTX; }
        const size_t rq = (size_t)(b * TPB + q0), rk = (size_t)b * TPB;
        sattn_unit<128>((LAS float*)F.lds, P + rq * EIN + h * 128, EIN, P + rk * EIN + 768 + (h / 3) * 128, EIN, P + rk * EIN + 1024 + (h / 3) * 128, EIN,
                        OA + rq * OAE + h * 128, OAE, nk, 0.08838834764831845f, F.tid);
    }
}
__device__ __forceinline__ void sphase_attn_o(const Frame& F_) { const Frame F = fresh(F_);
    const bf16* P = (const bf16*)(F.ws + WS_PBUF); bf16* OT = (bf16*)(F.ws + WS_OT);
    const int NL = NB * 16 * (SEQ / 32), NC = NB * 16 * (CTX / 32);
    for (int u = F.bid; u < NL + NC; u += F.G) {
        int b, g, q0, nk;
        if (u < NL) { b = u / (16 * 256); g = (u / 256) % 16; q0 = CTX + 32 * (u % 256); nk = TPB; }
        else { const int v = u - NL; b = v / (16 * 8); g = (v / 8) % 16; q0 = 32 * (v % 8); nk = CTX; }
        const size_t rq = (size_t)(b * TPB + q0), rk = (size_t)b * TPB;
        sattn_unit<64>((LAS float*)F.lds, P + rq * OIN + g * 64, OIN, P + rk * OIN + 1024 + g * 64, OIN, P + rk * OIN + 2048 + (g / 2) * 128, OIN,
                       OT + rq * OTW + g * 128, OTW, nk, 0.125f, F.tid);
    }
}

__global__ void __launch_bounds__(NTHREADS, 2) fwd_kernel(Args args) {
    extern __shared__ __attribute__((aligned(16))) unsigned char lds_raw[];
    Frame F;
    F.lds = (LAS unsigned char*)lds_raw; F.ws = args.ws;
    F.tid = threadIdx.x; F.lane = F.tid & 63; F.wave = __builtin_amdgcn_readfirstlane(F.tid >> 6); F.bid = blockIdx.x; F.G = gridDim.x;
    volatile LAS unsigned* MISC = (volatile LAS unsigned*)(F.lds + MISC_OFF);
    if (F.tid < 32) MISC[F.tid] = 0u;
    __syncthreads();
    const int lo = args.ph_lo, hi = args.ph_hi;
    const bool multi = (hi - lo) > 1;
    XcdBarrier bar; bar.bar = (unsigned*)(F.ws + WS_CTL) + CW_BAR; bar.x = 0; bar.st = MISC + 8;
    if (multi) bar = xcd_barrier_post((unsigned*)(F.ws + WS_CTL) + CW_BAR, MISC + 8);
#define IN(k) (lo <= (k) && (k) < hi)
#ifdef PROBE_KIND
    unsigned long long probe_acc = 0, probe_t0 = 0;
#define PROBE_BEGIN(kind) do { if ((kind) == PROBE_KIND) probe_t0 = __builtin_amdgcn_s_memrealtime(); } while (0)
#define PROBE_END(kind) do { if ((kind) == PROBE_KIND) probe_acc += __builtin_amdgcn_s_memrealtime() - probe_t0; } while (0)
#else
#define PROBE_BEGIN(kind) do {} while (0)
#define PROBE_END(kind) do {} while (0)
#endif
#define SEAM(k) do { if (IN(k) && IN((k) + 1)) xcd_barrier(bar); } while (0)
    PROBE_BEGIN(100); if (IN(PH_PRO_A)) { phase_pro_a(F, args); } SEAM(PH_PRO_A); PROBE_END(100);
    PROBE_BEGIN(101); if (IN(PH_PRO_B)) { phase_pro_b(F, args); } SEAM(PH_PRO_B); PROBE_END(101);
    for (int l = 0; l < DEPTH; ++l) {
        const int p0 = PH_L0 + l * PPL, i = l >> 1; const bool even = (l & 1) == 0;
        PROBE_BEGIN(PL_INPROJ + (PROBE_PARITY < 0 ? 0 : ((l & 1) == PROBE_PARITY ? 0 : 1000))); if (IN(p0 + PL_INPROJ)) {
#if FAST_GEMM
            fphase_inproj(F, even, i);
#else
            if (even) sphase_gemm_bf16(F, (const bf16*)(F.ws + WS_HA), DM, (const bf16*)(F.ws + WS_WINE) + (size_t)i * EIN * DM, DM, (bf16*)(F.ws + WS_PBUF), EIN, NTOK, EIN, DM);
            else sphase_gemm_bf16(F, (const bf16*)(F.ws + WS_HA), DM, (const bf16*)(F.ws + WS_WINO) + (size_t)i * OIN * DM, DM, (bf16*)(F.ws + WS_PBUF), OIN, NTOK, OIN, DM);
#endif
        } SEAM(p0 + PL_INPROJ); PROBE_END(PL_INPROJ + (PROBE_PARITY < 0 ? 0 : ((l & 1) == PROBE_PARITY ? 0 : 1000)));
        PROBE_BEGIN(PL_QKFIX + (PROBE_PARITY < 0 ? 0 : ((l & 1) == PROBE_PARITY ? 0 : 1000))); if (IN(p0 + PL_QKFIX)) { if (even) phase_qkfix_e(F, args, i); else phase_qkfix_o(F); } SEAM(p0 + PL_QKFIX); PROBE_END(PL_QKFIX + (PROBE_PARITY < 0 ? 0 : ((l & 1) == PROBE_PARITY ? 0 : 1000)));
        PROBE_BEGIN(PL_FFT1 + (PROBE_PARITY < 0 ? 0 : ((l & 1) == PROBE_PARITY ? 0 : 1000))); if (IN(p0 + PL_FFT1)) { if (even) { if (FAST_FFT) fphase_fft1(F); else sphase_fft1(F); } } SEAM(p0 + PL_FFT1); PROBE_END(PL_FFT1 + (PROBE_PARITY < 0 ? 0 : ((l & 1) == PROBE_PARITY ? 0 : 1000)));
        PROBE_BEGIN(PL_ATTN + (PROBE_PARITY < 0 ? 0 : ((l & 1) == PROBE_PARITY ? 0 : 1000))); if (IN(p0 + PL_ATTN)) { if (even) { if (FAST_ATTN) fphase_attn_e(F); else sphase_attn_e(F); if (FAST_FFT) fphase_fft2(F); else { sphase_fft2(F); sphase_fftc(F); } } else { if (FAST_ATTN) fphase_attn_o(F); else sphase_attn_o(F); } } SEAM(p0 + PL_ATTN); PROBE_END(PL_ATTN + (PROBE_PARITY < 0 ? 0 : ((l & 1) == PROBE_PARITY ? 0 : 1000)));
        PROBE_BEGIN(PL_FINISH + (PROBE_PARITY < 0 ? 0 : ((l & 1) == PROBE_PARITY ? 0 : 1000))); if (IN(p0 + PL_FINISH)) { if (!even) phase_finish_o(F, args, i); } SEAM(p0 + PL_FINISH); PROBE_END(PL_FINISH + (PROBE_PARITY < 0 ? 0 : ((l & 1) == PROBE_PARITY ? 0 : 1000)));
        PROBE_BEGIN(PL_OUTPROJ + (PROBE_PARITY < 0 ? 0 : ((l & 1) == PROBE_PARITY ? 0 : 1000))); if (IN(p0 + PL_OUTPROJ)) {
#if FAST_GEMM
            fphase_outproj(F, even, i, l);
#else
            if (even) sphase_outproj(F, (const bf16*)(F.ws + WS_OA), OAE, (const bf16*)(F.ws + WS_WOUTE) + (size_t)i * DM * OAE, OAE, l);
            else sphase_outproj(F, (const bf16*)(F.ws + WS_OA), OAO, (const bf16*)(F.ws + WS_WOUTO) + (size_t)i * DM * DM, DM, l);
#endif
        } SEAM(p0 + PL_OUTPROJ); PROBE_END(PL_OUTPROJ + (PROBE_PARITY < 0 ? 0 : ((l & 1) == PROBE_PARITY ? 0 : 1000)));
        PROBE_BEGIN(PL_ROUTER + (PROBE_PARITY < 0 ? 0 : ((l & 1) == PROBE_PARITY ? 0 : 1000))); if (IN(p0 + PL_ROUTER)) { phase_router(F, args, l); } SEAM(p0 + PL_ROUTER); PROBE_END(PL_ROUTER + (PROBE_PARITY < 0 ? 0 : ((l & 1) == PROBE_PARITY ? 0 : 1000)));
        PROBE_BEGIN(PL_GATHER + (PROBE_PARITY < 0 ? 0 : ((l & 1) == PROBE_PARITY ? 0 : 1000))); if (IN(p0 + PL_GATHER)) { phase_gather(F, l); } SEAM(p0 + PL_GATHER); PROBE_END(PL_GATHER + (PROBE_PARITY < 0 ? 0 : ((l & 1) == PROBE_PARITY ? 0 : 1000)));
        PROBE_BEGIN(PL_GU + (PROBE_PARITY < 0 ? 0 : ((l & 1) == PROBE_PARITY ? 0 : 1000))); if (IN(p0 + PL_GU)) { if (FAST_GEMM) fphase_moe_gu(F, l); else sphase_moe_gu(F, l); } SEAM(p0 + PL_GU); PROBE_END(PL_GU + (PROBE_PARITY < 0 ? 0 : ((l & 1) == PROBE_PARITY ? 0 : 1000)));
        PROBE_BEGIN(PL_DOWN + (PROBE_PARITY < 0 ? 0 : ((l & 1) == PROBE_PARITY ? 0 : 1000))); if (IN(p0 + PL_DOWN)) { if (FAST_GEMM) fphase_moe_down(F, l); else sphase_moe_down(F, l); } SEAM(p0 + PL_DOWN); PROBE_END(PL_DOWN + (PROBE_PARITY < 0 ? 0 : ((l & 1) == PROBE_PARITY ? 0 : 1000)));
        PROBE_BEGIN(PL_COMBINE + (PROBE_PARITY < 0 ? 0 : ((l & 1) == PROBE_PARITY ? 0 : 1000))); if (IN(p0 + PL_COMBINE)) { phase_combine(F, args, l); } SEAM(p0 + PL_COMBINE); PROBE_END(PL_COMBINE + (PROBE_PARITY < 0 ? 0 : ((l & 1) == PROBE_PARITY ? 0 : 1000)));
    }
#undef IN
#undef SEAM
#ifdef PROBE_KIND
    if (F.bid == 0 && F.tid == 0) { const unsigned long long t1 = __builtin_amdgcn_s_memrealtime(), want = probe_acc * PROBE_MULT; while (__builtin_amdgcn_s_memrealtime() - t1 < want) __builtin_amdgcn_s_sleep(8); }
#endif
}

extern "C" void kernel_launch(void* const* d_in, const int* in_sizes, int n_in, void* d_out, int out_size, void* d_ws, size_t ws_size, hipStream_t stream) {
    static int grid = 0;
    if (grid == 0) {
        if (n_in != 26 || in_sizes[0] != NB * SEQ * DM || out_size != NB * SEQ * DM || ws_size < WS_END) {
            fprintf(stderr, "kernel_launch: shape/workspace mismatch (n_in %d, in0 %d, out %d, ws %zu, need %zu); nothing launched\n", n_in, n_in > 0 ? in_sizes[0] : -1, out_size, ws_size, (size_t)WS_END); grid = -1; return; }
        int dev = 0, cus = 0;
        if (hipGetDevice(&dev) != hipSuccess || hipDeviceGetAttribute(&cus, hipDeviceAttributeMultiprocessorCount, dev) != hipSuccess) { grid = -1; return; }
        if (hipFuncSetAttribute((const void*)fwd_kernel, hipFuncAttributeMaxDynamicSharedMemorySize, LDS_BYTES) != hipSuccess) { fprintf(stderr, "kernel_launch: hipFuncSetAttribute failed\n"); grid = -1; return; }
        int per_cu = 0;
        if (hipOccupancyMaxActiveBlocksPerMultiprocessor(&per_cu, (const void*)fwd_kernel, NTHREADS, LDS_BYTES) != hipSuccess || per_cu < 1) { fprintf(stderr, "kernel_launch: occupancy query says %d\n", per_cu); }
        (void)hipGetLastError();
        grid = cus;
    }
    if (grid < 0) return;
    (void)hipMemsetAsync((char*)d_ws + WS_CTL, 0, CTL_ZERO_BYTES, stream);
    Args a{};
    for (int i = 0; i < 26; ++i) a.in[i] = (const float*)d_in[i];
    a.out = (float*)d_out; a.ws = (unsigned char*)d_ws;
#if MK_ONE_LAUNCH
    a.ph_lo = 0; a.ph_hi = N_PHASES;
    hipLaunchKernelGGL(fwd_kernel, dim3(grid), dim3(NTHREADS), LDS_BYTES, stream, a);
#else
    for (int p = 0; p < N_PHASES; ++p) {
        if (p >= PH_L0) { const int l = (p - PH_L0) / PPL, k = (p - PH_L0) % PPL; const bool even = (l & 1) == 0;
            if ((k == PL_FFT1 && !even) || (k == PL_FINISH && even)) continue; }
        a.ph_lo = p; a.ph_hi = p + 1;
        hipLaunchKernelGGL(fwd_kernel, dim3(grid), dim3(NTHREADS), LDS_BYTES, stream, a);
    }
#endif
}
```

```cpp
#include <hip/hip_runtime.h>
#include <cstdio>
#include <cstdint>

#ifndef PROBE_PARITY
#define PROBE_PARITY (-1)
#endif
#ifndef PROBE_MULT
#define PROBE_MULT 4
#endif
#ifndef MK_ONE_LAUNCH
#define MK_ONE_LAUNCH 1
#endif

#define GAS __attribute__((address_space(1)))
#define LAS __attribute__((address_space(3)))
typedef unsigned short bf16;
typedef float f32x4 __attribute__((ext_vector_type(4)));
typedef unsigned u32x4 __attribute__((ext_vector_type(4)));
typedef unsigned u32x2 __attribute__((ext_vector_type(2)));
typedef int i32x4 __attribute__((ext_vector_type(4)));
typedef int i32x2 __attribute__((ext_vector_type(2)));
typedef float f32x2 __attribute__((ext_vector_type(2)));

constexpr int NB = 2, SEQ = 8192, CTX = 256, TPB = SEQ + CTX, NTOK = NB * TPB, DM = 1024, DEPTH = 4;
constexpr int EIN = 1536, OIN = 3072, OAE = 1280, OAO = 1024, OTW = 2048;
constexpr int NEXP = 16, DEXP = 512;
constexpr int XS_TILES = 2 * NTOK / 256 + NEXP, XS_ROWS = XS_TILES * 256;
constexpr float EPS = 1e-6f;
constexpr int NTHREADS = 512, NWAVES = 8;

constexpr size_t MiB = 1u << 20;
constexpr size_t WS_CTL = 0, CTL_ZERO_BYTES = MiB;
constexpr size_t WS_MODV = 1 * MiB;
constexpr size_t WS_TABA = 1 * MiB + 512 * 1024;
constexpr size_t WS_TABC = WS_TABA + 32 * 1024;
constexpr size_t WS_LAM = WS_TABC + 16 * 1024;
constexpr size_t WS_SELA = 2 * MiB;
constexpr size_t WS_SELW = 2 * MiB + 512 * 1024;
constexpr size_t WS_RPOS = 2 * MiB + 768 * 1024;
constexpr size_t WS_WINE = 3 * MiB;
constexpr size_t WS_WOUTE = 9 * MiB;
constexpr size_t WS_WINO = 14 * MiB;
constexpr size_t WS_WOUTO = 26 * MiB;
constexpr size_t WS_WGU = 30 * MiB;
constexpr size_t WS_WD = 158 * MiB;
constexpr size_t WS_X = 222 * MiB;
constexpr size_t WS_HA = 288 * MiB;
constexpr size_t WS_YB = 321 * MiB;
constexpr size_t WS_PBUF = 337 * MiB;
constexpr size_t WS_OT = 436 * MiB;
constexpr size_t WS_OA = 502 * MiB;
constexpr size_t WS_OPART = 436 * MiB;
constexpr size_t WS_OSTAT = 470 * MiB;
constexpr size_t WS_ROWTOK = 321 * MiB;
constexpr size_t WS_XS = 337 * MiB;
constexpr size_t WS_HID = 411 * MiB;
constexpr size_t WS_Y2S = 448 * MiB;
constexpr size_t WS_END = 544 * MiB;
static_assert(WS_XS + (size_t)XS_ROWS * 1024 * 2 <= WS_HID && WS_HID + (size_t)XS_ROWS * 512 * 2 <= WS_Y2S && WS_Y2S + (size_t)XS_ROWS * 1024 * 2 <= WS_END, "moe overlay");
static_assert(WS_OA + (size_t)NTOK * OAE * 2 <= WS_END && WS_PBUF + (size_t)NTOK * OIN * 2 <= WS_OT && WS_OT + (size_t)NTOK * OTW * 2 <= WS_OA, "ws map");
constexpr int CW_BAR = 4096;
constexpr int CW_CNT = 16384;

constexpr int LDS_BYTES = 147456;
constexpr int MISC_OFF = 147456 - 1024;
constexpr int TB_OFF = 147456 - 512;

constexpr int PH_PRO_A = 0, PH_PRO_B = 1, PH_L0 = 2, PPL = 11;
constexpr int PL_INPROJ = 0, PL_QKFIX = 1, PL_FFT1 = 2, PL_ATTN = 3, PL_FINISH = 4, PL_OUTPROJ = 5, PL_ROUTER = 6, PL_GATHER = 7, PL_GU = 8, PL_DOWN = 9, PL_COMBINE = 10;
constexpr int N_PHASES = PH_L0 + DEPTH * PPL;

struct Args { const float* in[26]; float* out; unsigned char* ws; int ph_lo, ph_hi; };

__device__ __forceinline__ unsigned f2bf(float f) { unsigned u = __builtin_bit_cast(unsigned, f); return (u + 0x7fffu + ((u >> 16) & 1u)) >> 16; }
__device__ __forceinline__ unsigned pk2(float lo, float hi) { return f2bf(lo) | (f2bf(hi) << 16); }
__device__ __forceinline__ float bf2f(bf16 b) { return __builtin_bit_cast(float, (unsigned)b << 16); }
__device__ __forceinline__ float bflo(unsigned w) { return __builtin_bit_cast(float, w << 16); }
__device__ __forceinline__ float bfhi(unsigned w) { return __builtin_bit_cast(float, w & 0xffff0000u); }
__device__ __forceinline__ float wave_sum(float v) {
#pragma unroll
    for (int o = 1; o < 64; o <<= 1) v += __shfl_xor(v, o);
    return v;
}
__device__ __forceinline__ float silu_f(float x) { return x / (1.f + expf(-x)); }
#define LDS_WAIT() asm volatile("s_waitcnt lgkmcnt(0)" ::: "memory")

#define XB_TMO      128
#define XB_XCNT(j)  (256  + 64 * (j))
#define XB_XSUB(j)  (1280 + 64 * (j))
#define XB_XGEN(j)  (2304 + 64 * (j))
#define XB_TOP      3328
#define XB_TOPGEN   3392
#define XCD_BAR_WORDS 3456
#define XB_SPIN_CAP (1u << 24)
__device__ __forceinline__ unsigned xb_ld(unsigned* p)              { return __hip_atomic_load(p, __ATOMIC_RELAXED, __HIP_MEMORY_SCOPE_AGENT); }
__device__ __forceinline__ unsigned xb_add(unsigned* p, unsigned v) { return __hip_atomic_fetch_add(p, v, __ATOMIC_RELAXED, __HIP_MEMORY_SCOPE_AGENT); }
__device__ __forceinline__ unsigned xb_xcc_id() { return (unsigned)__builtin_amdgcn_s_getreg((3 << 11) | 20) & 0xFu; }
#define XB_SPIN(cond, bar) do { unsigned _sp = 0; while (cond) { __builtin_amdgcn_s_sleep(1); \
    if ((++_sp & 255u) == 0u) { if (xb_ld(&(bar)[XB_TMO])) break; if (_sp > XB_SPIN_CAP) { atomicAdd(&(bar)[XB_TMO], 1u); break; } } } } while (0)
struct XcdBarrier { unsigned* bar; unsigned x; volatile LAS unsigned* st; };
__device__ __forceinline__ XcdBarrier xcd_barrier_post(unsigned* bar, volatile LAS unsigned* st) {
    XcdBarrier b; b.bar = bar; b.x = xb_xcc_id(); b.st = st;
    if (threadIdx.x == 0) (void)xb_add(&bar[XB_XCNT(b.x)], 1u);
    return b;
}
__device__ __forceinline__ void xcd_barrier_complete(unsigned* bar, unsigned x, unsigned& nloc, unsigned& nx) {
    const unsigned G = gridDim.x * gridDim.y * gridDim.z;
    unsigned sum, cnt, mine, sp = 0u;
    for (;;) {
        sum = 0u; cnt = 0u; mine = 0u;
#pragma unroll
        for (unsigned j = 0; j < 16; ++j) { const unsigned c = xb_ld(&bar[XB_XCNT(j)]); sum += c; cnt += (c > 0u) ? 1u : 0u; mine = (j == x) ? c : mine; }
        if (sum == G) break;
        __builtin_amdgcn_s_sleep(1);
        if ((++sp & 255u) == 0u) { if (xb_ld(&bar[XB_TMO])) break; if (sp > XB_SPIN_CAP) { atomicAdd(&bar[XB_TMO], 1u); break; } }
    }
    nloc = mine > 0u ? mine : 1u; nx = cnt > 0u ? cnt : 1u;
}
__device__ __forceinline__ void xcd_barrier(const XcdBarrier& b) {
    asm volatile("s_waitcnt vmcnt(0)" ::: "memory");
    __syncthreads();
    if (threadIdx.x == 0) {
        unsigned* bar = b.bar; unsigned bx_ = b.x; asm volatile("" : "+s"(bar), "+s"(bx_));
        __builtin_amdgcn_s_waitcnt(0);
        unsigned nloc = b.st[0], nx = b.st[1];
        if (nloc == 0u) { xcd_barrier_complete(bar, bx_, nloc, nx); b.st[0] = nloc; b.st[1] = nx; }
        const unsigned old = xb_add(&bar[XB_XSUB(bx_)], 1u);
        const unsigned gen = old / nloc;
        if (old + 1u == (gen + 1u) * nloc) {
            __builtin_amdgcn_fence(__ATOMIC_RELEASE, "agent");
            asm volatile("s_waitcnt vmcnt(0)" ::: "memory");
            const unsigned og = xb_add(&bar[XB_TOP], 1u);
            const unsigned tg = og / nx;
            if (og + 1u == (tg + 1u) * nx) xb_add(&bar[XB_TOPGEN], 1u);
            else XB_SPIN(xb_ld(&bar[XB_TOPGEN]) == tg, bar);
            __builtin_amdgcn_fence(__ATOMIC_ACQUIRE, "agent");
            xb_add(&bar[XB_XGEN(bx_)], 1u);
            asm volatile("s_waitcnt vmcnt(0)" ::: "memory");
        } else {
            XB_SPIN(xb_ld(&bar[XB_XGEN(bx_)]) == gen, bar);
            __builtin_amdgcn_fence(__ATOMIC_ACQUIRE, "agent");
            asm volatile("s_waitcnt vmcnt(0)" ::: "memory");
        }
    }
    __syncthreads();
}

struct Frame {
    LAS unsigned char* lds;
    unsigned char* ws;
    int tid, lane, wave, bid, G;
};
template <class T> __device__ __forceinline__ T* opq(T* p) { asm volatile("" : "+s"(p)); return p; }
__device__ __forceinline__ Frame fresh(const Frame& F) { Frame G = F; asm volatile("" : "+s"(G.ws), "+s"(G.bid), "+s"(G.wave), "+s"(G.G), "+v"(G.tid), "+v"(G.lane)); return G; }
#define AIN(k) opq(A.in[k])
template <class T> __device__ __forceinline__ T* uptr(T* p) {
    const unsigned long long v = (unsigned long long)p; const unsigned lo = __builtin_amdgcn_readfirstlane((unsigned)v), hi = __builtin_amdgcn_readfirstlane((unsigned)(v >> 32));
    return (T*)(((unsigned long long)hi << 32) | lo); }
__device__ __forceinline__ const float* modv(const Frame& F, int l, int type, int chunk) { return (const float*)(F.ws + WS_MODV) + ((size_t)(l * 3 + type) * 6 + chunk) * DM; }
__device__ __forceinline__ int row_type(int r) { const int b = r / TPB, j = r - b * TPB; return j < CTX ? 2 : b; }

__device__ __forceinline__ void load_row_f32(const float* p, int lane, f32x4 (&v)[4]) {
    const GAS f32x4* q = (const GAS f32x4*)p + lane;
#pragma unroll
    for (int j = 0; j < 4; ++j) v[j] = q[64 * j];
}
__device__ __forceinline__ void store_row_f32(float* p, int lane, const f32x4 (&v)[4]) {
    GAS f32x4* q = (GAS f32x4*)p + lane;
#pragma unroll
    for (int j = 0; j < 4; ++j) q[64 * j] = v[j];
}
__device__ __forceinline__ void load_row_bf16(const bf16* p, int lane, f32x4 (&v)[4]) {
    const GAS u32x2* q = (const GAS u32x2*)p + lane;
#pragma unroll
    for (int j = 0; j < 4; ++j) { const u32x2 w = q[64 * j]; v[j] = (f32x4){bflo(w.x), bfhi(w.x), bflo(w.y), bfhi(w.y)}; }
}
__device__ __forceinline__ void store_row_bf16(bf16* p, int lane, const f32x4 (&v)[4]) {
    GAS u32x2* q = (GAS u32x2*)p + lane;
#pragma unroll
    for (int j = 0; j < 4; ++j) { u32x2 w; w.x = pk2(v[j].x, v[j].y); w.y = pk2(v[j].z, v[j].w); q[64 * j] = w; }
}
__device__ __forceinline__ float row_rstd(const f32x4 (&v)[4]) {
    float s = 0.f;
#pragma unroll
    for (int j = 0; j < 4; ++j) s += (v[j].x * v[j].x + v[j].y * v[j].y) + (v[j].z * v[j].z + v[j].w * v[j].w);
    return rsqrtf(wave_sum(s) * (1.f / DM) + EPS);
}
__device__ __forceinline__ void modnorm_store(const f32x4 (&v)[4], const float* sc, const float* sh, bf16* dst, int lane) {
    const float rstd = row_rstd(v);
    f32x4 s[4], h[4], o[4]; load_row_f32(sc, lane, s); load_row_f32(sh, lane, h);
#pragma unroll
    for (int j = 0; j < 4; ++j) o[j] = v[j] * rstd * (s[j] + 1.f) + h[j];
    store_row_bf16(dst, lane, o);
}

namespace pg8 {
#define PG8_LAS __attribute__((address_space(3)))
typedef unsigned short bf16_t;
typedef short bf16x8 __attribute__((ext_vector_type(8)));
typedef float f32x4 __attribute__((ext_vector_type(4)));
typedef unsigned u32x4 __attribute__((ext_vector_type(4)));
constexpr int BM = 256, BK = 64, HALF = 128, HTB = HALF * BK * 2  , STAGE_BYTES = 8 * HTB, NXCD = 8, WGM = 8;

__host__ __device__ __forceinline__ int lds_byte(int r, int c) { const int st = (r >> 4) * 2 + (c >> 5), rr = r & 15, cc = c & 31, ob = rr * 64 + cc * 2; return st * 1024 + (ob ^ (((ob >> 9) & 1) << 5)); }
__host__ __device__ __forceinline__ void stage_rc(int b, int& R, int& C) { const int st = b / 1024, sb = b % 1024, swz = sb ^ (((sb >> 9) & 1) << 5); R = (st >> 1) * 16 + swz / 64; C = (st & 1) * 32 + (swz % 64) / 2; }
__host__ __device__ __forceinline__ int perm32(int rho) { const int n = rho >> 4, i = rho & 15; return 8 * (i >> 2) + 4 * n + (i & 3); }

struct Unit { int pm, pn, e, lt; };
struct Gemm { const bf16_t* A; const bf16_t* Bt; int M, N, K; size_t estride; const int* rowtok; int ntok; };

struct StaticOrder {
    int nM, nN, nwg, G, c;
    __host__ __device__ void init(int M, int N, int G_, int c_) { nM = M / BM; nN = N / BM; nwg = nM * nN; G = G_; c = c_; }
    __host__ __device__ bool next(int i, Unit& u) const {
        const long L = (long)i * G + c; if (L >= nwg) return false;
        int wgid = (int)L; { const int q = nwg / NXCD, r = nwg % NXCD, xcd = wgid % NXCD, off = wgid / NXCD; wgid = (xcd < r ? xcd * (q + 1) : r * (q + 1) + (xcd - r) * q) + off; }
        const int nig = WGM * nN, gid = wgid / nig, fm = gid * WGM, gsz = (nM - fm) < WGM ? (nM - fm) : WGM;
        u.pm = fm + ((wgid % nig) % gsz); u.pn = (wgid % nig) / gsz; u.e = 0; u.lt = 0; return true;
    }
    __device__ __forceinline__ void a_ready(const Unit&) const {}
    __device__ __forceinline__ void done(const Unit&) const {}
};

__device__ __forceinline__ unsigned cvt_pk_bf16(float lo, float hi) { unsigned r; asm volatile("v_cvt_pk_bf16_f32 %0, %1, %2" : "=v"(r) : "v"(lo), "v"(hi)); return r; }
typedef float f32x2 __attribute__((ext_vector_type(2)));
__device__ __forceinline__ f32x2 gelu_pk(f32x2 v) {
    const f32x2 av = __builtin_elementwise_abs(v), d = av * 0.2316418882f + 1.0f;
    f32x2 t; t.x = __builtin_amdgcn_rcpf(d.x); t.y = __builtin_amdgcn_rcpf(d.y);
    f32x2 q = t * 0.5307027145f + (-0.7265760135f); q = q * t + 0.7107068705f; q = q * t + (-0.142248368f); q = q * t + 0.127414796f; q = q * t;
    const f32x2 s = (v * v) * (-0.72134752044f);
    f32x2 e; e.x = __builtin_amdgcn_exp2f(s.x); e.y = __builtin_amdgcn_exp2f(s.y);
    const f32x2 m = v * (q * e), r = v - m;
    f32x2 o; o.x = v.x < 0.f ? m.x : r.x; o.y = v.y < 0.f ? m.y : r.y; return o;
}

template <int ACT  > struct EpiBf16 {
    static constexpr bool PERM = true, AFTER_DRAIN = false; static_assert(ACT == 0 || ACT == 1, "EpiBf16: ACT is 0 (none) or 1 (gelu_pk)");
    bf16_t* O; int ldc; const float* bias; int split_cols; size_t split_stride; float scale0;
    __device__ __forceinline__ void operator()(const f32x4 (&acc)[2][2][4][2], const Unit& u, int wr, int wc, int fr, int fq) const {
        const int row0 = u.pm * BM + wr * 64 + fr; int colt = u.pn * BM; bf16_t* base = O;
        float sc = 1.f; if (split_cols) { const int t = colt / split_cols; base += (size_t)t * split_stride; colt -= t * split_cols; if (t == 0) sc = scale0; }
        const int col0 = colt + wc * 32 + 8 * fq, bcol0 = u.pn * BM + wc * 32 + 8 * fq;
        f32x4 bv[2][2];
#pragma unroll
        for (int bj = 0; bj < 2; ++bj)
#pragma unroll
            for (int n = 0; n < 2; ++n) bv[bj][n] = bias ? *(const f32x4*)(bias + bcol0 + bj * HALF + 4 * n) : (f32x4){0.f, 0.f, 0.f, 0.f};
#pragma unroll
        for (int ai = 0; ai < 2; ++ai)
#pragma unroll
            for (int m = 0; m < 4; ++m) { bf16_t* rowp = base + (size_t)(row0 + ai * HALF + m * 16) * ldc + col0;
#pragma unroll
                for (int bj = 0; bj < 2; ++bj) { f32x4 v0 = acc[ai][bj][m][0] + bv[bj][0], v1 = acc[ai][bj][m][1] + bv[bj][1];
                    if (ACT == 1) { f32x2 a = gelu_pk((f32x2){v0[0], v0[1]}), b = gelu_pk((f32x2){v0[2], v0[3]}), c = gelu_pk((f32x2){v1[0], v1[1]}), d = gelu_pk((f32x2){v1[2], v1[3]});
                        v0 = (f32x4){a.x, a.y, b.x, b.y}; v1 = (f32x4){c.x, c.y, d.x, d.y}; }
                    v0 = v0 * sc; v1 = v1 * sc; u32x4 w; w.x = cvt_pk_bf16(v0[0], v0[1]); w.y = cvt_pk_bf16(v0[2], v0[3]); w.z = cvt_pk_bf16(v1[0], v1[1]); w.w = cvt_pk_bf16(v1[2], v1[3]);
                    *(GAS u32x4*)(rowp + bj * HALF) = w; } }
    }
};

__device__ __forceinline__ float silu_fast(float x) { return x * __builtin_amdgcn_rcpf(1.f + __expf(-x)); }
struct EpiSwiGLU {
    static constexpr bool PERM = true, AFTER_DRAIN = false;
    bf16_t* O;
    __device__ __forceinline__ void operator()(const f32x4 (&acc)[2][2][4][2], const Unit& u, int wr, int wc, int fr, int fq) const {
        const int row0 = u.pm * BM + wr * 64 + fr, col0 = u.pn * HALF + wc * 32 + 8 * fq;
#pragma unroll
        for (int ai = 0; ai < 2; ++ai)
#pragma unroll
            for (int m = 0; m < 4; ++m) { bf16_t* rowp = O + (size_t)(row0 + ai * HALF + m * 16) * 512 + col0;
                const f32x4 g0 = acc[ai][0][m][0], g1 = acc[ai][0][m][1], u0 = acc[ai][1][m][0], u1 = acc[ai][1][m][1];
                u32x4 w; w.x = cvt_pk_bf16(silu_fast(g0[0]) * u0[0], silu_fast(g0[1]) * u0[1]); w.y = cvt_pk_bf16(silu_fast(g0[2]) * u0[2], silu_fast(g0[3]) * u0[3]);
                w.z = cvt_pk_bf16(silu_fast(g1[0]) * u1[0], silu_fast(g1[1]) * u1[1]); w.w = cvt_pk_bf16(silu_fast(g1[2]) * u1[2], silu_fast(g1[3]) * u1[3]);
                *(GAS u32x4*)rowp = w; }
    }
};
struct EpiResGate {
    static constexpr bool PERM = false, AFTER_DRAIN = false;
    float* X; const float* gate3;
    __device__ __forceinline__ void operator()(const f32x4 (&acc)[2][2][4][2], const Unit& u, int wr, int wc, int fr, int fq) const {
        const int type = (u.pm % 33 == 0) ? 2 : u.pm / 33;
        const int col0 = u.pn * BM + wc * 32 + 4 * fq; const float* gp = gate3 + (size_t)type * 6144 + col0;
        f32x4 gv[2][2];
#pragma unroll
        for (int bj = 0; bj < 2; ++bj)
#pragma unroll
            for (int n = 0; n < 2; ++n) gv[bj][n] = *(const GAS f32x4*)(gp + bj * HALF + n * 16);
#pragma unroll
        for (int ai = 0; ai < 2; ++ai)
#pragma unroll
            for (int m = 0; m < 4; ++m) { float* rowp = X + (size_t)(u.pm * BM + ai * HALF + wr * 64 + m * 16 + fr) * 1024 + col0;
#pragma unroll
                for (int bj = 0; bj < 2; ++bj)
#pragma unroll
                    for (int n = 0; n < 2; ++n) { GAS f32x4* xp = (GAS f32x4*)(rowp + bj * HALF + n * 16); *xp = *xp + gv[bj][n] * acc[ai][bj][m][n]; } }
    }
};

struct EpiRopeO {
    static constexpr bool PERM = true, AFTER_DRAIN = false;
    bf16_t* O; int ldc; const float* tab; int nrope_tiles;
    __device__ __forceinline__ void operator()(const f32x4 (&acc)[2][2][4][2], const Unit& u, int wr, int wc, int fr, int fq) const {
        const int row0 = u.pm * BM + wr * 64 + fr, col0 = u.pn * BM + wc * 32 + 8 * fq;
        const bool rope = (u.pn < nrope_tiles) && (u.pm % 33 != 0);
        const int t0 = row0 - (u.pm / 33) * 8448 - 256;
        const bool x2 = (fq >> 1) != 0;
#pragma unroll
        for (int ai = 0; ai < 2; ++ai)
#pragma unroll
            for (int m = 0; m < 4; ++m) { const int t = t0 + ai * HALF + m * 16; bf16_t* rowp = O + (size_t)(row0 + ai * HALF + m * 16) * ldc + col0;
                f32x4 cs[4];
                if (rope) { const int pos = (wc & 1) ? (t & 63) : (t >> 6); const float* tp = tab + (size_t)(pos * 16 + 8 * (fq & 1)) * 2;
#pragma unroll
                    for (int q = 0; q < 4; ++q) cs[q] = *(const GAS f32x4*)(tp + 4 * q); }
#pragma unroll
                for (int bj = 0; bj < 2; ++bj) { f32x4 v0 = acc[ai][bj][m][0], v1 = acc[ai][bj][m][1];
                    if (rope) { f32x4 p0, p1;
#pragma unroll
                        for (int e = 0; e < 4; ++e) { p0[e] = __shfl_xor(v0[e], 32); p1[e] = __shfl_xor(v1[e], 32); }
                        const f32x4 c0 = {cs[0][0], cs[0][2], cs[1][0], cs[1][2]}, s0 = {cs[0][1], cs[0][3], cs[1][1], cs[1][3]};
                        const f32x4 c1 = {cs[2][0], cs[2][2], cs[3][0], cs[3][2]}, s1 = {cs[2][1], cs[2][3], cs[3][1], cs[3][3]};
                        v0 = x2 ? (p0 * s0 + v0 * c0) : (v0 * c0 - p0 * s0); v1 = x2 ? (p1 * s1 + v1 * c1) : (v1 * c1 - p1 * s1); }
                    u32x4 w; w.x = cvt_pk_bf16(v0[0], v0[1]); w.y = cvt_pk_bf16(v0[2], v0[3]); w.z = cvt_pk_bf16(v1[0], v1[1]); w.w = cvt_pk_bf16(v1[2], v1[3]);
                    *(GAS u32x4*)(rowp + bj * HALF) = w; } }
    }
};
struct MoeOrder {
    const PG8_LAS int* tb; int nN, nwg, G, c;
    __device__ __forceinline__ bool next(int i, Unit& u) const {
        const int L = i * G + c; if (L >= nwg) return false;
        u.pm = L / nN; u.pn = L - u.pm * nN; int e = 0;
        int t0 = 0;
#pragma unroll
        for (int q = 1; q < 16; ++q) { const int tq = tb[q]; const bool ge = u.pm >= tq; e = ge ? q : e; t0 = ge ? tq : t0; }
        u.e = __builtin_amdgcn_readfirstlane(e); u.lt = u.pm - __builtin_amdgcn_readfirstlane(t0); return true;
    }
    __device__ __forceinline__ void a_ready(const Unit&) const {}
    __device__ __forceinline__ void done(const Unit&) const {}
};

template <class Epi, class Sched, bool ALIGN_EPI = false, bool SP2 = false, bool GATHER = false>
__device__ __forceinline__ void gemm_phase(PG8_LAS unsigned char* lds, const Gemm g, const Sched& S, const Epi& E, const int tid_) {
    const int tid = tid_, wid = __builtin_amdgcn_readfirstlane(tid >> 6), lane = tid & 63, wr = wid >> 2, wc = wid & 3, fr = lane & 15, fq = lane >> 4;
    const int K = g.K, nt = K / BK;
    unsigned voffA[2], voffB[2];
#pragma unroll
    for (int i = 0; i < 2; ++i) { int R, C; stage_rc(tid * 16 + i * 8192, R, C); const int Rb = Epi::PERM ? ((R & ~31) + perm32(R & 31)) : R;
        voffA[i] = (unsigned)(R * K + C) * 2u; voffB[i] = (unsigned)(Rb * K + C) * 2u; }
    static_assert(!GATHER || SP2, "GATHER is implemented on the SP2 loop only");
    int gR[2], gC[2];
#pragma unroll
    for (int i = 0; i < 2; ++i) stage_rc(tid * 16 + i * 8192, gR[i], gC[i]);
    unsigned vAc[2][2], vAn[2][2];
#define PG8_LOADIDX(u, v) do { _Pragma("unroll") for (int h_ = 0; h_ < 2; ++h_) _Pragma("unroll") for (int i_ = 0; i_ < 2; ++i_) { \
        int tok_ = g.rowtok[(size_t)(u).e * g.ntok + (u).lt * 256 + h_ * HALF + gR[i_]]; tok_ = ((unsigned)tok_ < (unsigned)g.ntok) ? tok_ : 0; (v)[h_][i_] = (unsigned)(tok_ * K + gC[i_]) * 2u; } } while (0)
#define PG8_STAGE_A(bufoff, gbase, h, set) do { if constexpr (GATHER) { PG8_STAGE(bufoff, gbase, (set)[h]); } else { PG8_STAGE(bufoff, (gbase) + (h) * hstep, voffA); } } while (0)
    const size_t kstep = (size_t)(BK * 2);
    const size_t hstep = (size_t)HALF * K * 2;
    const size_t tstep = 2 * hstep;
    const unsigned ldsw = (unsigned)wid * 1024u;
    const int aoff = lds_byte(wr * 64 + fr, fq * 8), boff = lds_byte(wc * 32 + fr, fq * 8);
#define PG8_SA(b, h) (((b) * 2 + (h)) * HTB)
#define PG8_SB(b, h) ((4 + (b) * 2 + (h)) * HTB)
#define PG8_STAGE(bufoff, gbase, voff) do { _Pragma("unroll") for (int _i = 0; _i < 2; ++_i) \
        __builtin_amdgcn_global_load_lds((const unsigned*)((const char*)(gbase) + (voff)[_i]), (PG8_LAS unsigned*)(lds + (bufoff) + ldsw + _i * 8192), 16, 0, 0); } while (0)
#define PG8_LDA(dst, b, h) do { _Pragma("unroll") for (int m = 0; m < 4; ++m) _Pragma("unroll") for (int k = 0; k < 2; ++k) dst[m][k] = *(const PG8_LAS bf16x8*)(lds + PG8_SA(b, h) + aoff + m * 2048 + k * 1024); } while (0)
#define PG8_LDB(dst, b, h) do { _Pragma("unroll") for (int n = 0; n < 2; ++n) _Pragma("unroll") for (int k = 0; k < 2; ++k) dst[n][k] = *(const PG8_LAS bf16x8*)(lds + PG8_SB(b, h) + boff + n * 2048 + k * 1024); } while (0)
#define PG8_MMA(ai, bj, At, Bt) do { __builtin_amdgcn_s_setprio(1); _Pragma("unroll") for (int m = 0; m < 4; ++m) _Pragma("unroll") for (int n = 0; n < 2; ++n) _Pragma("unroll") for (int k = 0; k < 2; ++k) \
        acc[ai][bj][m][n] = __builtin_amdgcn_mfma_f32_16x16x32_bf16(Bt[n][k], At[m][k], acc[ai][bj][m][n], 0, 0, 0); __builtin_amdgcn_s_setprio(0); } while (0)
#define PG8_WAIT_V(n) asm volatile("s_waitcnt vmcnt(" #n ")" ::: "memory")
#define PG8_WAIT_L(n) asm volatile("s_waitcnt lgkmcnt(" #n ")" ::: "memory")
#define PG8_BAR __builtin_amdgcn_s_barrier()
#define PG8_SCHED __builtin_amdgcn_sched_barrier(0)
    Unit cur, nxt; int ui = 0;
    if (!S.next(0, cur)) return;
    f32x4 acc[2][2][4][2];
#pragma unroll
    for (int a = 0; a < 2; ++a)
#pragma unroll
        for (int b = 0; b < 2; ++b)
#pragma unroll
            for (int m = 0; m < 4; ++m)
#pragma unroll
                for (int n = 0; n < 2; ++n) acc[a][b][m][n] = (f32x4){0.f, 0.f, 0.f, 0.f};
    bf16x8 At[4][2], B0[2][2], B1[2][2];
    const char* cA = GATHER ? (const char*)g.A : (const char*)g.A + (size_t)cur.pm * tstep; const char* cB = (const char*)g.Bt + (size_t)cur.e * g.estride + (size_t)cur.pn * tstep;
    if constexpr (GATHER) { PG8_LOADIDX(cur, vAc); }
    S.a_ready(cur);
    if constexpr (SP2) {
        PG8_STAGE(PG8_SB(0, 0), cB, voffB); PG8_STAGE(PG8_SB(0, 1), cB + hstep, voffB); PG8_STAGE_A(PG8_SA(0, 0), cA, 0, vAc); PG8_STAGE_A(PG8_SA(0, 1), cA, 1, vAc);
        if (wr == 1) PG8_BAR;
        PG8_WAIT_V(2); PG8_BAR;
        PG8_STAGE(PG8_SB(1, 0), cB + kstep, voffB); PG8_STAGE_A(PG8_SA(1, 0), cA + kstep, 0, vAc); PG8_STAGE(PG8_SB(1, 1), cB + hstep + kstep, voffB);
        PG8_WAIT_V(6); PG8_BAR;
    } else {
        PG8_STAGE(PG8_SB(0, 0), cB, voffB); PG8_STAGE(PG8_SA(0, 0), cA, voffA); PG8_STAGE(PG8_SB(0, 1), cB + hstep, voffB); PG8_STAGE(PG8_SA(0, 1), cA + hstep, voffA);
        if (wr == 1) PG8_BAR;
        PG8_WAIT_V(4); PG8_BAR;
        PG8_STAGE(PG8_SB(1, 0), cB + kstep, voffB); PG8_STAGE(PG8_SA(1, 0), cA + kstep, voffA); PG8_STAGE(PG8_SB(1, 1), cB + hstep + kstep, voffB);
        PG8_WAIT_V(6); PG8_BAR;
    }
    for (;;) {
        const bool has_next = S.next(ui + 1, nxt);
        const char* nA = GATHER ? cA : (has_next ? (const char*)g.A + (size_t)nxt.pm * tstep : cA); const char* nB = has_next ? (const char*)g.Bt + (size_t)nxt.e * g.estride + (size_t)nxt.pn * tstep : cB;
        if constexpr (GATHER) { if (has_next) { PG8_LOADIDX(nxt, vAn); } else {
#pragma unroll
            for (int h_ = 0; h_ < 2; ++h_) { vAn[h_][0] = vAc[h_][0]; vAn[h_][1] = vAc[h_][1]; } } }
        for (int t = 0; t < nt; t += 2) {
            const bool last = (t == nt - 2);
            const char* a1 = cA + (size_t)(t + 1) * kstep;
            const char* a2 = last ? nA : cA + (size_t)(t + 2) * kstep; const char* b2 = last ? nB : cB + (size_t)(t + 2) * kstep;
            const char* a3 = a2 + kstep; const char* b3 = b2 + kstep;
            if (last && has_next) S.a_ready(nxt);
            if constexpr (SP2) {
            unsigned vA2[2][2];
#pragma unroll
            for (int h_ = 0; h_ < 2; ++h_) { vA2[h_][0] = last ? vAn[h_][0] : vAc[h_][0]; vA2[h_][1] = last ? vAn[h_][1] : vAc[h_][1]; }
            PG8_LDB(B0, 0, 0); PG8_LDB(B1, 0, 1); PG8_SCHED; PG8_LDA(At, 0, 0); PG8_STAGE_A(PG8_SA(1, 1), a1, 1, vAc);
            PG8_WAIT_V(8); PG8_WAIT_L(0); PG8_BAR; PG8_MMA(0, 0, At, B0); PG8_MMA(0, 1, At, B1); PG8_BAR; PG8_SCHED;
            PG8_LDA(At, 0, 1); PG8_STAGE(PG8_SB(0, 0), b2, voffB); PG8_STAGE(PG8_SB(0, 1), b2 + hstep, voffB); PG8_STAGE_A(PG8_SA(0, 0), a2, 0, vA2);
            PG8_WAIT_V(8); PG8_WAIT_L(0); PG8_BAR; PG8_MMA(1, 0, At, B0); PG8_MMA(1, 1, At, B1); PG8_BAR; PG8_SCHED;
            PG8_LDB(B0, 1, 0); PG8_LDB(B1, 1, 1); PG8_SCHED; PG8_LDA(At, 1, 0); PG8_STAGE_A(PG8_SA(0, 1), a2, 1, vA2);
            PG8_WAIT_V(8); PG8_WAIT_L(0); PG8_BAR; PG8_MMA(0, 0, At, B0); PG8_MMA(0, 1, At, B1); PG8_BAR; PG8_SCHED;
            PG8_LDA(At, 1, 1); PG8_STAGE(PG8_SB(1, 0), b3, voffB); PG8_STAGE(PG8_SB(1, 1), b3 + hstep, voffB); PG8_STAGE_A(PG8_SA(1, 0), a3, 0, vA2);
            PG8_WAIT_V(8); PG8_WAIT_L(0); PG8_BAR; PG8_MMA(1, 0, At, B0); PG8_MMA(1, 1, At, B1); PG8_BAR; PG8_SCHED;
            } else {
            PG8_LDB(B0, 0, 0); PG8_SCHED; PG8_LDA(At, 0, 0); PG8_STAGE(PG8_SA(1, 1), a1 + hstep, voffA);
            PG8_WAIT_L(8); PG8_BAR; PG8_WAIT_L(0); PG8_MMA(0, 0, At, B0); PG8_BAR; PG8_SCHED;
            PG8_LDB(B1, 0, 1); PG8_STAGE(PG8_SB(0, 0), b2, voffB);
            PG8_BAR; PG8_WAIT_L(0); PG8_MMA(0, 1, At, B1); PG8_BAR;
            PG8_LDA(At, 0, 1); PG8_STAGE(PG8_SA(0, 0), a2, voffA);
            PG8_BAR; PG8_WAIT_L(0); PG8_MMA(1, 0, At, B0); PG8_BAR; PG8_SCHED;
            PG8_STAGE(PG8_SB(0, 1), b2 + hstep, voffB);
            PG8_WAIT_V(6); PG8_BAR; PG8_MMA(1, 1, At, B1); PG8_BAR;
            PG8_LDB(B0, 1, 0); PG8_SCHED; PG8_LDA(At, 1, 0); PG8_STAGE(PG8_SA(0, 1), a2 + hstep, voffA);
            PG8_WAIT_L(8); PG8_BAR; PG8_WAIT_L(0); PG8_MMA(0, 0, At, B0); PG8_BAR; PG8_SCHED;
            PG8_LDB(B1, 1, 1); PG8_STAGE(PG8_SB(1, 0), b3, voffB);
            PG8_BAR; PG8_WAIT_L(0); PG8_MMA(0, 1, At, B1); PG8_BAR;
            PG8_LDA(At, 1, 1); PG8_STAGE(PG8_SA(1, 0), a3, voffA);
            PG8_BAR; PG8_WAIT_L(0); PG8_MMA(1, 0, At, B0); PG8_BAR; PG8_SCHED;
            PG8_STAGE(PG8_SB(1, 1), b3 + hstep, voffB);
            PG8_WAIT_V(6); PG8_BAR; PG8_MMA(1, 1, At, B1); PG8_BAR;
            }
        }
        if constexpr (ALIGN_EPI) { if (wr == 0) PG8_BAR; }
        if constexpr (!Epi::AFTER_DRAIN) { E(acc, cur, wr, wc, fr, fq); S.done(cur); }
        if (!has_next) break;
#pragma unroll
        for (int a = 0; a < 2; ++a)
#pragma unroll
            for (int b = 0; b < 2; ++b)
#pragma unroll
                for (int m = 0; m < 4; ++m)
#pragma unroll
                    for (int n = 0; n < 2; ++n) acc[a][b][m][n] = (f32x4){0.f, 0.f, 0.f, 0.f};
        cur = nxt; cA = nA; cB = nB; ++ui;
        if constexpr (GATHER) {
#pragma unroll
            for (int h_ = 0; h_ < 2; ++h_) { vAc[h_][0] = vAn[h_][0]; vAc[h_][1] = vAn[h_][1]; } }
        if constexpr (ALIGN_EPI) { if (wr == 1) PG8_BAR; }
    }
    PG8_WAIT_V(0);
    if constexpr (!ALIGN_EPI) { if (wr == 0) PG8_BAR; }
    PG8_BAR;
    if constexpr (Epi::AFTER_DRAIN) { E.fused(acc, cur, wr, wc, fr, fq, lds, wid, lane); S.done(cur); }
#undef PG8_SA
#undef PG8_LOADIDX
#undef PG8_STAGE_A
#undef PG8_SB
#undef PG8_STAGE
#undef PG8_LDA
#undef PG8_LDB
#undef PG8_MMA
#undef PG8_WAIT_V
#undef PG8_WAIT_L
#undef PG8_BAR
#undef PG8_SCHED
}
}

constexpr int SG_AS = 132, SG_BS = 68;
template <class FA, class FB>
__device__ __forceinline__ void sg_tile(LAS float* As, LAS float* Bs, int K, FA fa, FB fb, float (&acc)[4][4], int tid) {
    const int ty = tid >> 4, tx = tid & 15;
#pragma unroll
    for (int i = 0; i < 4; ++i)
#pragma unroll
        for (int j = 0; j < 4; ++j) acc[i][j] = 0.f;
    for (int k0 = 0; k0 < K; k0 += 16) {
#pragma unroll
        for (int i = 0; i < 4; ++i) { const int idx = tid + 512 * i, m = idx >> 4, kk = idx & 15; As[kk * SG_AS + m] = fa(m, k0 + kk); }
#pragma unroll
        for (int i = 0; i < 2; ++i) { const int idx = tid + 512 * i, n = idx >> 4, kk = idx & 15; Bs[kk * SG_BS + n] = fb(k0 + kk, n); }
        __syncthreads();
#pragma unroll
        for (int kk = 0; kk < 16; ++kk) {
            const f32x4 a = *(const LAS f32x4*)(As + kk * SG_AS + 4 * ty), b = *(const LAS f32x4*)(Bs + kk * SG_BS + 4 * tx);
#pragma unroll
            for (int i = 0; i < 4; ++i)
#pragma unroll
                for (int j = 0; j < 4; ++j) acc[i][j] += a[i] * b[j];
        }
        __syncthreads();
    }
}

template <int DQK>
__device__ __forceinline__ void sattn_unit(LAS float* sm, const bf16* Q, int ldq, const bf16* Kp, int ldk, const bf16* Vp, int ldv, bf16* O, int ldo, int nkeys, float scale, int tid) {
    constexpr int QS = DQK + 1;
    LAS float* Qs = sm; LAS float* Ks = Qs + 32 * QS; LAS float* Vs = Ks + 64 * QS; LAS float* Ss = Vs + 64 * 128;
    const int qi = tid >> 4, sub = tid & 15;
    __syncthreads();
    for (int idx = tid; idx < 32 * DQK; idx += 512) { const int r = idx / DQK, d = idx % DQK; Qs[r * QS + d] = bf2f(Q[(size_t)r * ldq + d]) * scale; }
    float m = -1e30f, l = 0.f, acc[8];
#pragma unroll
    for (int e = 0; e < 8; ++e) acc[e] = 0.f;
    for (int k0 = 0; k0 < nkeys; k0 += 64) {
        __syncthreads();
        for (int idx = tid; idx < 64 * DQK; idx += 512) { const int r = idx / DQK, d = idx % DQK; Ks[r * QS + d] = bf2f(Kp[(size_t)(k0 + r) * ldk + d]); }
        for (int idx = tid; idx < 64 * 128; idx += 512) { const int r = idx >> 7, d = idx & 127; Vs[r * 128 + d] = bf2f(Vp[(size_t)(k0 + r) * ldv + d]); }
        __syncthreads();
        float s[4];
#pragma unroll
        for (int c = 0; c < 4; ++c) { const int kj = sub + 16 * c; float a = 0.f;
            for (int d = 0; d < DQK; ++d) a += Qs[qi * QS + d] * Ks[kj * QS + d];
            s[c] = a; }
        float tmax = fmaxf(fmaxf(s[0], s[1]), fmaxf(s[2], s[3]));
#pragma unroll
        for (int o = 1; o < 16; o <<= 1) tmax = fmaxf(tmax, __shfl_xor(tmax, o));
        const float mnew = fmaxf(m, tmax), alpha = expf(m - mnew);
        float ps = 0.f;
#pragma unroll
        for (int c = 0; c < 4; ++c) { const float p = expf(s[c] - mnew); ps += p; Ss[qi * 65 + sub + 16 * c] = p; }
#pragma unroll
        for (int o = 1; o < 16; o <<= 1) ps += __shfl_xor(ps, o);
        l = l * alpha + ps; m = mnew;
        __syncthreads();
#pragma unroll
        for (int e = 0; e < 8; ++e) acc[e] *= alpha;
        for (int k = 0; k < 64; ++k) { const float p = Ss[qi * 65 + k];
#pragma unroll
            for (int e = 0; e < 8; ++e) acc[e] += p * Vs[k * 128 + sub * 8 + e]; }
    }
    const float rl = 1.f / l;
    u32x4 w; w.x = pk2(acc[0] * rl, acc[1] * rl); w.y = pk2(acc[2] * rl, acc[3] * rl); w.z = pk2(acc[4] * rl, acc[5] * rl); w.w = pk2(acc[6] * rl, acc[7] * rl);
    *(GAS u32x4*)(O + (size_t)qi * ldo + sub * 8) = w;
}

template <class RM>
__device__ __forceinline__ void transpose_item(const float* W, int K, int N, bf16* WT, int ldt, RM rowmap, LAS float* scr, int item, int lane) {
    const int nblk = N / 64, kb = item / nblk, nb = item % nblk, k0 = 64 * kb, n0 = 64 * nb;
    const int rsub = lane >> 4, c4 = (lane & 15) * 4;
    const GAS float* src = (const GAS float*)W + (size_t)(k0 + rsub) * N + n0 + c4;
    f32x4 v[16];
#pragma unroll
    for (int i = 0; i < 16; ++i) v[i] = *(const GAS f32x4*)(src + (size_t)(4 * i) * N);
#pragma unroll
    for (int i = 0; i < 16; ++i) { LAS float* d = scr + (4 * i + rsub) * 65 + c4; d[0] = v[i].x; d[1] = v[i].y; d[2] = v[i].z; d[3] = v[i].w; }
    LDS_WAIT(); asm volatile("" ::: "memory");
    const int kc = (lane & 7) * 8;
#pragma unroll
    for (int j = 0; j < 8; ++j) { const int n = (lane >> 3) + 8 * j; const LAS float* t = scr + kc * 65 + n;
        u32x4 o; o.x = pk2(t[0 * 65], t[1 * 65]); o.y = pk2(t[2 * 65], t[3 * 65]); o.z = pk2(t[4 * 65], t[5 * 65]); o.w = pk2(t[6 * 65], t[7 * 65]);
        *(GAS u32x4*)(WT + (size_t)rowmap(n0 + n) * ldt + k0 + kc) = o; }
    LDS_WAIT(); asm volatile("" ::: "memory");
}

__device__ __forceinline__ void phase_pro_a(const Frame& F_, const Args& A) { const Frame F = fresh(F_);
    const int gw = F.bid * NWAVES + F.wave, NGW = F.G * NWAVES, gt = F.bid * NTHREADS + F.tid, NGT = F.G * NTHREADS;
    {
        LAS float* sv = (LAS float*)F.lds;
        LAS float* red = sv + 3 * DM;
        for (int i = F.tid; i < 3 * DM; i += NTHREADS) { const int t = i / DM, k = i % DM; const float x = (t < 2) ? AIN(1)[t * DM + k] : AIN(3)[k]; sv[i] = silu_f(x); }
        __syncthreads();
        for (int item = F.bid; item < DEPTH * 24; item += F.G) {
            const int l = item / 24, n0 = (item % 24) * 256, kp = F.wave;
            const GAS float* w = (const GAS float*)AIN(4) + (size_t)l * DM * 6144 + (size_t)(kp * 128) * 6144 + n0 + 4 * F.lane;
            f32x4 a0 = {0.f, 0.f, 0.f, 0.f}, a1 = a0, a2 = a0;
#pragma unroll 8
            for (int k = 0; k < 128; ++k) { const f32x4 wv = *(const GAS f32x4*)(w + (size_t)k * 6144); const int kk = kp * 128 + k; a0 += wv * sv[kk]; a1 += wv * sv[DM + kk]; a2 += wv * sv[2 * DM + kk]; }
            *(LAS f32x4*)(red + (kp * 3 + 0) * 256 + 4 * F.lane) = a0; *(LAS f32x4*)(red + (kp * 3 + 1) * 256 + 4 * F.lane) = a1; *(LAS f32x4*)(red + (kp * 3 + 2) * 256 + 4 * F.lane) = a2;
            __syncthreads();
            for (int o = F.tid; o < 3 * 256; o += NTHREADS) { const int t = o >> 8, nn = o & 255; float sacc = AIN(5)[l * 6144 + n0 + nn];
                for (int q = 0; q < 8; ++q) sacc += red[(q * 3 + t) * 256 + nn];
                ((float*)(F.ws + WS_MODV))[(size_t)(l * 3 + t) * 6144 + n0 + nn] = sacc; }
            __syncthreads();
        }
    }
    for (int i = gt; i < 128 * 32 + 128 * 16; i += NGT) {
        if (i < 128 * 32) { const int p = i >> 5, f = i & 31; const float inv = powf(10000.f, -(float)(2 * f) / 64.f), ang = (float)p * inv;
            ((float*)(F.ws + WS_TABA))[2 * i] = cosf(ang); ((float*)(F.ws + WS_TABA))[2 * i + 1] = sinf(ang); }
        else { const int ii = i - 128 * 32, p = ii >> 4, f = ii & 15; const float inv = powf(10000.f, -(float)(2 * f) / 32.f), ang = (float)p * inv;
            ((float*)(F.ws + WS_TABC))[2 * ii] = cosf(ang); ((float*)(F.ws + WS_TABC))[2 * ii + 1] = sinf(ang); }
    }
    if (F.bid == 0 && F.wave < 2) { const int i = F.wave; const float a = AIN(13)[i * 64 + F.lane] * AIN(14)[i * 64 + F.lane], b = AIN(15)[i * 64 + F.lane] * AIN(16)[i * 64 + F.lane];
        const float sa = wave_sum(a), sb = wave_sum(b); const int l = 2 * i + 1; const float lam_init = 0.8f - 0.6f * expf(-0.3f * (float)l);
        if (F.lane == 0) { ((float*)(F.ws + WS_LAM))[2 * i] = expf(sa) - expf(sb) + lam_init; ((float*)(F.ws + WS_LAM))[2 * i + 1] = lam_init; } }
    {
        __syncthreads();
        LAS float* scr = (LAS float*)F.lds + F.wave * (64 * 65);
        constexpr int I_INE = (DM / 64) * (EIN / 64), I_OUT = (DM / 64) * (DM / 64), I_INO = (DM / 64) * (OIN / 64), I_G = (DM / 64) * (DEXP / 64), I_D = (DEXP / 64) * (DM / 64);
        constexpr int T_INE = 2 * I_INE, T_OUTE = 2 * I_OUT, T_INO = 2 * I_INO, T_OUTO = 2 * I_OUT, T_G = 64 * I_G, T_U = 64 * I_G, T_D = 64 * I_D;
        constexpr int NITEMS = T_INE + T_OUTE + T_INO + T_OUTO + T_G + T_U + T_D;
        for (int it = gw; it < NITEMS; it += NGW) {
            int r = it;
            if (r < T_INE) { const int i = r / I_INE; transpose_item(AIN(6) + (size_t)i * DM * EIN, DM, EIN, (bf16*)(F.ws + WS_WINE) + (size_t)i * EIN * DM, DM, [](int n) { return n; }, scr, r % I_INE, F.lane); continue; } r -= T_INE;
            if (r < T_OUTE) { const int i = r / I_OUT, item = r % I_OUT;
                if (item / (DM / 64) < 12) transpose_item(AIN(7) + (size_t)i * DM * DM, DM, DM, (bf16*)(F.ws + WS_WOUTE) + (size_t)i * DM * OAE, OAE, [](int n) { return n; }, scr, item, F.lane);
                continue; } r -= T_OUTE;
            if (r < T_INO) { const int i = r / I_INO; transpose_item(AIN(11) + (size_t)i * DM * OIN, DM, OIN, (bf16*)(F.ws + WS_WINO) + (size_t)i * OIN * DM, DM, [](int n) { return n; }, scr, r % I_INO, F.lane); continue; } r -= T_INO;
            if (r < T_OUTO) { const int i = r / I_OUT; transpose_item(AIN(12) + (size_t)i * DM * DM, DM, DM, (bf16*)(F.ws + WS_WOUTO) + (size_t)i * DM * DM, DM, [](int n) { return n; }, scr, r % I_OUT, F.lane); continue; } r -= T_OUTO;
            if (r < T_G) { const int le = r / I_G; transpose_item(AIN(22) + (size_t)le * DM * DEXP, DM, DEXP, (bf16*)(F.ws + WS_WGU) + (size_t)le * DM * DM, DM, [](int n) { return (n >> 7) * 256 + (n & 127); }, scr, r % I_G, F.lane); continue; } r -= T_G;
            if (r < T_U) { const int le = r / I_G; transpose_item(AIN(23) + (size_t)le * DM * DEXP, DM, DEXP, (bf16*)(F.ws + WS_WGU) + (size_t)le * DM * DM, DM, [](int n) { return (n >> 7) * 256 + 128 + (n & 127); }, scr, r % I_G, F.lane); continue; } r -= T_U;
            { const int le = r / I_D; transpose_item(AIN(24) + (size_t)le * DEXP * DM, DEXP, DM, (bf16*)(F.ws + WS_WD) + (size_t)le * DM * DEXP, DEXP, [](int n) { return n; }, scr, r % I_D, F.lane); }
        }
    }
    for (int o = gt; o < 2 * 2 * 256 * DM; o += NGT) {
        const int n = o & 1023, gc = (o >> 10) & 255, ri = (o >> 18) & 1, i = o >> 19, g = gc >> 6, c = gc & 63;
        const float* w = AIN(7) + (size_t)i * DM * DM + (size_t)(768 + 64 * g) * DM + n;
        float a = 0.f;
        for (int m = 0; m < 64; ++m) { const float fr = (float)((m * c) & 63) * (1.f / 64.f); const float t = ri ? __builtin_amdgcn_sinf(fr) : __builtin_amdgcn_cosf(fr); a += t * w[(size_t)m * DM]; }
        ((bf16*)(F.ws + WS_WOUTE))[(size_t)i * DM * OAE + (size_t)n * OAE + 768 + ri * 256 + gc] = (bf16)f2bf(a);
    }
}

__device__ __forceinline__ void phase_pro_b(const Frame& F_, const Args& A) { const Frame F = fresh(F_);
    const int gw = F.bid * NWAVES + F.wave, NGW = F.G * NWAVES;
    for (int r = gw; r < NTOK; r += NGW) {
        const int b = r / TPB, j = r - b * TPB, type = j < CTX ? 2 : b;
        const float* src = j < CTX ? AIN(2) + (size_t)(b * CTX + j) * DM : AIN(0) + (size_t)(b * SEQ + (j - CTX)) * DM;
        f32x4 v[4]; load_row_f32(src, F.lane, v);
        store_row_f32((float*)(F.ws + WS_X) + (size_t)r * DM, F.lane, v);
        modnorm_store(v, modv(F, 0, type, 1), modv(F, 0, type, 0), (bf16*)(F.ws + WS_HA) + (size_t)r * DM, F.lane);
    }
}

__device__ __forceinline__ void unpack8(const u32x4 w, float (&v)[8]) { v[0] = bflo(w.x); v[1] = bfhi(w.x); v[2] = bflo(w.y); v[3] = bfhi(w.y); v[4] = bflo(w.z); v[5] = bfhi(w.z); v[6] = bflo(w.w); v[7] = bfhi(w.w); }
__device__ __forceinline__ u32x4 pack8(const float (&v)[8]) { u32x4 w; w.x = pk2(v[0], v[1]); w.y = pk2(v[2], v[3]); w.z = pk2(v[4], v[5]); w.w = pk2(v[6], v[7]); return w; }

__device__ __forceinline__ void phase_qkfix_e(const Frame& F_, const Args& A, int i) { const Frame F = fresh(F_);
    const int gw = F.bid * NWAVES + F.wave, NGW = F.G * NWAVES, lane = F.lane;
    const float* qg = AIN(8) + i * 128; const float* kg = AIN(9) + i * 128; const float* bg = AIN(10) + i * 256;
    const float* tab = (const float*)(F.ws + WS_TABA);
    for (int r = gw; r < NTOK; r += NGW) {
        const int b = r / TPB, j = r - b * TPB; const bool lat = j >= CTX; const int t = j - CTX, prow = t >> 6, pcol = t & 63;
        bf16* P = (bf16*)(F.ws + WS_PBUF) + (size_t)r * EIN;
#pragma unroll
        for (int it = 0; it < 2; ++it) {
            GAS u32x4* p = (GAS u32x4*)(P + 512 * it) + lane;
            float v[8], y[8], o[8]; unpack8(*p, v);
            float ss = 0.f;
#pragma unroll
            for (int e = 0; e < 8; ++e) ss += v[e] * v[e];
            ss += __shfl_xor(ss, 1); ss += __shfl_xor(ss, 2); ss += __shfl_xor(ss, 4); ss += __shfl_xor(ss, 8);
            const float rstd = rsqrtf(ss * (1.f / 128.f) + EPS);
            const bool isk = (it == 1) && (lane >= 32);
            const int d0 = 8 * (lane & 15);
            const float* gp = (isk ? kg : qg) + d0;
#pragma unroll
            for (int e = 0; e < 8; ++e) y[e] = v[e] * rstd * gp[e];
            const int quarter = (lane & 15) >> 2, fi = 8 * (lane & 3);
            const int pos = quarter < 2 ? prow : pcol;
#pragma unroll
            for (int e = 0; e < 8; ++e) {
                const float pv = __shfl_xor(y[e], 4);
                const float c = lat ? tab[2 * (pos * 32 + fi + e)] : 1.f, s = lat ? tab[2 * (pos * 32 + fi + e) + 1] : 0.f;
                o[e] = (quarter & 1) ? (pv * s + y[e] * c) : (y[e] * c - pv * s);
            }
            *p = pack8(o);
        }
        {
            GAS u32x4* p = (GAS u32x4*)(P + 1024) + lane;
            float v[8], o[8]; unpack8(*p, v);
            float ss = 0.f;
#pragma unroll
            for (int e = 0; e < 8; ++e) ss += v[e] * v[e];
            ss += __shfl_xor(ss, 1); ss += __shfl_xor(ss, 2); ss += __shfl_xor(ss, 4);
            const float rstd = rsqrtf(ss * (1.f / 64.f) + EPS);
            const float* gp = bg + 8 * (lane & 31);
#pragma unroll
            for (int e = 0; e < 8; ++e) o[e] = v[e] * rstd * gp[e];
            if (lane >= 32) *p = pack8(o);
        }
    }
}
__device__ __forceinline__ void phase_qkfix_o(const Frame& F_) { const Frame F = fresh(F_);
    const int gw = F.bid * NWAVES + F.wave, NGW = F.G * NWAVES, lane = F.lane;
    const float* tab = (const float*)(F.ws + WS_TABC);
    for (int r = gw; r < NTOK; r += NGW) {
        const int b = r / TPB, j = r - b * TPB; if (j < CTX) continue;
        const int t = j - CTX, prow = t >> 6, pcol = t & 63;
        bf16* P = (bf16*)(F.ws + WS_PBUF) + (size_t)r * OIN;
#pragma unroll
        for (int it = 0; it < 4; ++it) {
            GAS u32x4* p = (GAS u32x4*)(P + 512 * it) + lane;
            float y[8], o[8]; unpack8(*p, y);
            const int quarter = (lane & 7) >> 1, fi = 8 * (lane & 1);
            const int pos = quarter < 2 ? prow : pcol;
#pragma unroll
            for (int e = 0; e < 8; ++e) {
                const float pv = __shfl_xor(y[e], 2);
                const float c = tab[2 * (pos * 16 + fi + e)], s = tab[2 * (pos * 16 + fi + e) + 1];
                o[e] = (quarter & 1) ? (pv * s + y[e] * c) : (y[e] * c - pv * s);
            }
            *p = pack8(o);
        }
    }
}
__device__ __forceinline__ void phase_finish_o(const Frame& F_, const Args& A, int i) { const Frame F = fresh(F_);
    const int gw = F.bid * NWAVES + F.wave, NGW = F.G * NWAVES, lane = F.lane;
    const float lam = ((const float*)(F.ws + WS_LAM))[2 * i], post = 1.f - ((const float*)(F.ws + WS_LAM))[2 * i + 1];
    const float* hg = AIN(17) + i * 128 + 8 * (lane & 15);
    for (int r = gw; r < NTOK; r += NGW) {
        const bf16* T = (const bf16*)(F.ws + WS_OT) + (size_t)r * OTW; bf16* O = (bf16*)(F.ws + WS_OA) + (size_t)r * OAO;
#pragma unroll
        for (int it = 0; it < 4; ++it) {
            float v[8], o[8]; unpack8(*((const GAS u32x4*)(T + 512 * it) + lane), v);
            float ss = 0.f;
#pragma unroll
            for (int e = 0; e < 8; ++e) { const float pv = __shfl_xor(v[e], 16); o[e] = v[e] - lam * pv; ss += o[e] * o[e]; }
            ss += __shfl_xor(ss, 1); ss += __shfl_xor(ss, 2); ss += __shfl_xor(ss, 4); ss += __shfl_xor(ss, 8);
            const float rstd = rsqrtf(ss * (1.f / 128.f) + EPS) * post;
#pragma unroll
            for (int e = 0; e < 8; ++e) o[e] = o[e] * rstd * hg[e];
            if (((lane >> 4) & 1) == 0) *(GAS u32x4*)(O + (2 * it + (lane >> 5)) * 128 + 8 * (lane & 15)) = pack8(o);
        }
    }
}

__device__ __forceinline__ void phase_router(const Frame& F_, const Args& A, int l) { const Frame F = fresh(F_);
    LAS float* wc = (LAS float*)F.lds;
    LAS int* lcnt = (LAS int*)(F.lds + 81920);
    LAS int* gb = lcnt + 16;
    LAS int* rec = gb + 16;
    LAS float* recw = (LAS float*)(rec + 72 * 4);
    const int lane = F.lane;
    __syncthreads();
    for (int i = F.tid; i < DM * 20; i += NTHREADS) { const int k = i / 20, c = i % 20; wc[i] = c < 4 ? AIN(18)[(size_t)l * DM * 4 + k * 4 + c] : AIN(20)[(size_t)l * DM * 16 + k * 16 + (c - 4)]; }
    if (F.tid < 16) lcnt[F.tid] = 0;
    __syncthreads();
    const int nmine = (NTOK - F.bid + F.G - 1) / F.G;
    for (int it = F.wave; it < nmine; it += NWAVES) {
        const int r = F.bid + it * F.G, type = row_type(r);
        f32x4 v[4]; load_row_f32((const float*)(F.ws + WS_X) + (size_t)r * DM, lane, v);
        const float rstd = row_rstd(v);
        f32x4 s[4], h[4]; load_row_f32(modv(F, l, type, 4), lane, s); load_row_f32(modv(F, l, type, 3), lane, h);
#pragma unroll
        for (int j = 0; j < 4; ++j) v[j] = v[j] * rstd * (s[j] + 1.f) + h[j];
        store_row_bf16((bf16*)(F.ws + WS_HA) + (size_t)r * DM, lane, v);
        float lg[20];
#pragma unroll
        for (int c = 0; c < 20; ++c) lg[c] = 0.f;
#pragma unroll
        for (int j = 0; j < 4; ++j)
#pragma unroll
            for (int e = 0; e < 4; ++e) { const LAS float* wr = wc + (4 * lane + 256 * j + e) * 20; const float xv = v[j][e];
#pragma unroll
                for (int c = 0; c < 20; ++c) lg[c] += xv * wr[c]; }
#pragma unroll
        for (int c = 0; c < 20; ++c) lg[c] = wave_sum(lg[c]);
        if (lane == 0) {
            float gl[4]; int gi = 0;
#pragma unroll
            for (int g = 0; g < 4; ++g) gl[g] = lg[g] + AIN(19)[l * 4 + g];
#pragma unroll
            for (int g = 1; g < 4; ++g) if (gl[g] > gl[gi]) gi = g;
            float gs = 0.f;
#pragma unroll
            for (int g = 0; g < 4; ++g) gs += expf(gl[g] - gl[gi]);
            const float ggate = 1.f / gs;
            float el[4];
#pragma unroll
            for (int e = 0; e < 4; ++e) { float x = 0.f;
#pragma unroll
                for (int g = 0; g < 4; ++g) x = (g == gi) ? lg[4 + 4 * g + e] + AIN(21)[l * 16 + 4 * g + e] : x;
                el[e] = x; }
            int i0 = 0;
#pragma unroll
            for (int e = 1; e < 4; ++e) if (el[e] > el[i0]) i0 = e;
            int i1 = (i0 == 0) ? 1 : 0;
#pragma unroll
            for (int e = 0; e < 4; ++e) if (e != i0 && el[e] > el[i1]) i1 = e;
            const float p1 = expf(el[i1] - el[i0]);
            const float w0 = ggate / (1.f + p1), w1 = ggate * p1 / (1.f + p1);
            const int e0 = gi * 4 + i0, e1 = gi * 4 + i1;
            const int lp0 = __hip_atomic_fetch_add(lcnt + e0, 1, __ATOMIC_RELAXED, __HIP_MEMORY_SCOPE_WORKGROUP);
            const int lp1 = __hip_atomic_fetch_add(lcnt + e1, 1, __ATOMIC_RELAXED, __HIP_MEMORY_SCOPE_WORKGROUP);
            rec[it * 4 + 0] = e0; rec[it * 4 + 1] = lp0; rec[it * 4 + 2] = e1; rec[it * 4 + 3] = lp1; recw[it * 2] = w0; recw[it * 2 + 1] = w1;
        }
    }
    __syncthreads();
    if (F.tid < 16) gb[F.tid] = (int)__hip_atomic_fetch_add((unsigned*)(F.ws + WS_CTL) + CW_CNT + 64 * l + F.tid, (unsigned)lcnt[F.tid], __ATOMIC_RELAXED, __HIP_MEMORY_SCOPE_AGENT);
    __syncthreads();
    if (F.tid < nmine) { const int it = F.tid, r = F.bid + it * F.G; const int e0 = rec[it * 4], e1 = rec[it * 4 + 2];
        const int q0 = gb[e0] + rec[it * 4 + 1], q1 = gb[e1] + rec[it * 4 + 3];
        ((GAS i32x4*)(F.ws + WS_SELA))[r] = (i32x4){e0, q0, e1, q1};
        ((GAS int*)(F.ws + WS_ROWTOK))[(size_t)e0 * NTOK + q0] = r; ((GAS int*)(F.ws + WS_ROWTOK))[(size_t)e1 * NTOK + q1] = r;
        ((GAS f32x2*)(F.ws + WS_SELW))[r] = (f32x2){recw[it * 2], recw[it * 2 + 1]}; }
    __syncthreads();
}
__device__ __forceinline__ void moe_bases(const Frame& F, int l, int (&base)[17]) {
    const unsigned* cnt = (const unsigned*)(F.ws + WS_CTL) + CW_CNT + 64 * l;
    int acc = 0;
#pragma unroll
    for (int e = 0; e < 16; ++e) { base[e] = acc; const int c = __builtin_amdgcn_readfirstlane((int)__hip_atomic_load(cnt + e, __ATOMIC_RELAXED, __HIP_MEMORY_SCOPE_AGENT)); acc += ((c + 255) >> 8) << 8; }
    base[16] = acc;
}
__device__ __forceinline__ void phase_gather(const Frame& F_, int l) { const Frame F = fresh(F_);
    const int gw = F.bid * NWAVES + F.wave, NGW = F.G * NWAVES, lane = F.lane;
    int base[17]; moe_bases(F, l, base);
    for (int r = gw; r < NTOK; r += NGW) {
        const i32x4 s = ((const GAS i32x4*)(F.ws + WS_SELA))[r];
        int b0 = 0, b1 = 0;
#pragma unroll
        for (int e = 0; e < 16; ++e) { b0 = (s.x == e) ? base[e] : b0; b1 = (s.z == e) ? base[e] : b1; }
        const int r0 = b0 + s.y, r1 = b1 + s.w;
        const GAS u32x4* src = (const GAS u32x4*)((const bf16*)(F.ws + WS_HA) + (size_t)r * DM) + lane;
        const u32x4 a = src[0], c = src[64];
        GAS u32x4* d0 = (GAS u32x4*)((bf16*)(F.ws + WS_XS) + (size_t)r0 * DM) + lane; d0[0] = a; d0[64] = c;
        GAS u32x4* d1 = (GAS u32x4*)((bf16*)(F.ws + WS_XS) + (size_t)r1 * DM) + lane; d1[0] = a; d1[64] = c;
        if (lane == 0) ((GAS i32x2*)(F.ws + WS_RPOS))[r] = (i32x2){r0, r1};
    }
}
__device__ __forceinline__ void phase_combine(const Frame& F_, const Args& A, int l) { const Frame F = fresh(F_);
    const int gw = F.bid * NWAVES + F.wave, NGW = F.G * NWAVES, lane = F.lane;
    int base[17]; moe_bases(F, l, base);
    for (int r = gw; r < NTOK; r += NGW) {
        const int b = r / TPB, j = r - b * TPB, type = j < CTX ? 2 : b;
        if (l == DEPTH - 1 && j < CTX) continue;
        const i32x4 sel = ((const GAS i32x4*)(F.ws + WS_SELA))[r]; const f32x2 w = ((const GAS f32x2*)(F.ws + WS_SELW))[r];
        int b0_ = 0, b1_ = 0;
#pragma unroll
        for (int e = 0; e < 16; ++e) { b0_ = (sel.x == e) ? base[e] : b0_; b1_ = (sel.z == e) ? base[e] : b1_; }
        const i32x2 rp = (i32x2){b0_ + sel.y, b1_ + sel.w};
        f32x4 x[4], y0[4], y1[4], g[4];
        float* xp = (float*)(F.ws + WS_X) + (size_t)r * DM;
        load_row_f32(xp, lane, x); load_row_bf16((const bf16*)(F.ws + WS_Y2S) + (size_t)rp.x * DM, lane, y0); load_row_bf16((const bf16*)(F.ws + WS_Y2S) + (size_t)rp.y * DM, lane, y1);
        load_row_f32(modv(F, l, type, 5), lane, g);
#pragma unroll
        for (int q = 0; q < 4; ++q) x[q] = x[q] + g[q] * (y0[q] * w.x + y1[q] * w.y);
        if (l < DEPTH - 1) {
            store_row_f32(xp, lane, x);
            modnorm_store(x, modv(F, l + 1, type, 1), modv(F, l + 1, type, 0), (bf16*)(F.ws + WS_HA) + (size_t)r * DM, lane);
        } else {
            const float rstd = row_rstd(x);
            f32x4 fg[4]; load_row_f32(AIN(25), lane, fg);
#pragma unroll
            for (int q = 0; q < 4; ++q) x[q] = x[q] * rstd * fg[q];
            store_row_f32(A.out + (size_t)(b * SEQ + (j - CTX)) * DM, lane, x);
        }
    }
}

__device__ __forceinline__ void sphase_gemm_bf16(const Frame& F_, const bf16* Am, int lda, const bf16* Bt, int ldb, bf16* C, int ldc, int M, int N, int K) { const Frame F = fresh(F_);
    LAS float* As = (LAS float*)F.lds; LAS float* Bs = As + 16 * SG_AS;
    const int nm = M / 128, nn = N / 64, ty = F.tid >> 4, tx = F.tid & 15;
    for (int t = F.bid; t < nm * nn; t += F.G) {
        const int tm = t / nn, tn = t % nn; const bf16* a0 = Am + (size_t)tm * 128 * lda; const bf16* b0 = Bt + (size_t)tn * 64 * ldb;
        float acc[4][4];
        sg_tile(As, Bs, K, [&](int m, int k) { return bf2f(a0[(size_t)m * lda + k]); }, [&](int k, int n) { return bf2f(b0[(size_t)n * ldb + k]); }, acc, F.tid);
#pragma unroll
        for (int i = 0; i < 4; ++i) { u32x2 w; w.x = pk2(acc[i][0], acc[i][1]); w.y = pk2(acc[i][2], acc[i][3]);
            *(GAS u32x2*)(C + (size_t)(tm * 128 + 4 * ty + i) * ldc + tn * 64 + 4 * tx) = w; }
    }
}
__device__ __forceinline__ void sphase_outproj(const Frame& F_, const bf16* Am, int lda, const bf16* Bt, int K, int l) { const Frame F = fresh(F_);
    LAS float* As = (LAS float*)F.lds; LAS float* Bs = As + 16 * SG_AS;
    const int nm = NTOK / 128, nn = DM / 64, ty = F.tid >> 4, tx = F.tid & 15;
    for (int t = F.bid; t < nm * nn; t += F.G) {
        const int tm = t / nn, tn = t % nn; const bf16* a0 = Am + (size_t)tm * 128 * lda; const bf16* b0 = Bt + (size_t)tn * 64 * K;
        float acc[4][4];
        sg_tile(As, Bs, K, [&](int m, int k) { return bf2f(a0[(size_t)m * lda + k]); }, [&](int k, int n) { return bf2f(b0[(size_t)n * K + k]); }, acc, F.tid);
#pragma unroll
        for (int i = 0; i < 4; ++i) { const int r = tm * 128 + 4 * ty + i, c = tn * 64 + 4 * tx;
            const f32x4 g = *(const GAS f32x4*)(modv(F, l, row_type(r), 2) + c);
            GAS f32x4* xp = (GAS f32x4*)((float*)(F.ws + WS_X) + (size_t)r * DM + c); f32x4 x = *xp;
            x.x += g.x * acc[i][0]; x.y += g.y * acc[i][1]; x.z += g.z * acc[i][2]; x.w += g.w * acc[i][3]; *xp = x; }
    }
}
__device__ __forceinline__ int moe_expert_of_row(const int (&base)[17], int row) { int e = 0;
#pragma unroll
    for (int q = 1; q < 16; ++q) e = (row >= base[q]) ? q : e;
    return e; }
__device__ __forceinline__ void sphase_moe_gu(const Frame& F_, int l) { const Frame F = fresh(F_);
    LAS float* As = (LAS float*)F.lds; LAS float* Bs = As + 16 * SG_AS;
    int base[17]; moe_bases(F, l, base);
    const int nm = base[16] / 128, nn = DEXP / 64, ty = F.tid >> 4, tx = F.tid & 15;
    for (int t = F.bid; t < nm * nn; t += F.G) {
        const int tm = t / nn, tn = t % nn, e = moe_expert_of_row(base, tm * 128);
        const bf16* a0 = (const bf16*)(F.ws + WS_XS) + (size_t)tm * 128 * DM;
        const bf16* w = (const bf16*)(F.ws + WS_WGU) + (size_t)(l * 16 + e) * DM * DM;
        const int hc0 = tn * 64;
        const bf16* bg0 = w + (size_t)((hc0 >> 7) * 256 + (hc0 & 127)) * DM; const bf16* bu0 = bg0 + (size_t)128 * DM;
        float ag[4][4], au[4][4];
        sg_tile(As, Bs, DM, [&](int m, int k) { return bf2f(a0[(size_t)m * DM + k]); }, [&](int k, int n) { return bf2f(bg0[(size_t)n * DM + k]); }, ag, F.tid);
        sg_tile(As, Bs, DM, [&](int m, int k) { return bf2f(a0[(size_t)m * DM + k]); }, [&](int k, int n) { return bf2f(bu0[(size_t)n * DM + k]); }, au, F.tid);
#pragma unroll
        for (int i = 0; i < 4; ++i) { float h[4];
#pragma unroll
            for (int j = 0; j < 4; ++j) h[j] = silu_f(ag[i][j]) * au[i][j];
            u32x2 wv; wv.x = pk2(h[0], h[1]); wv.y = pk2(h[2], h[3]);
            *(GAS u32x2*)((bf16*)(F.ws + WS_HID) + (size_t)(tm * 128 + 4 * ty + i) * DEXP + hc0 + 4 * tx) = wv; }
    }
}
__device__ __forceinline__ void sphase_moe_down(const Frame& F_, int l) { const Frame F = fresh(F_);
    LAS float* As = (LAS float*)F.lds; LAS float* Bs = As + 16 * SG_AS;
    int base[17]; moe_bases(F, l, base);
    const int nm = base[16] / 128, nn = DM / 64, ty = F.tid >> 4, tx = F.tid & 15;
    for (int t = F.bid; t < nm * nn; t += F.G) {
        const int tm = t / nn, tn = t % nn, e = moe_expert_of_row(base, tm * 128);
        const bf16* a0 = (const bf16*)(F.ws + WS_HID) + (size_t)tm * 128 * DEXP;
        const bf16* b0 = (const bf16*)(F.ws + WS_WD) + (size_t)(l * 16 + e) * DM * DEXP + (size_t)tn * 64 * DEXP;
        float acc[4][4];
        sg_tile(As, Bs, DEXP, [&](int m, int k) { return bf2f(a0[(size_t)m * DEXP + k]); }, [&](int k, int n) { return bf2f(b0[(size_t)n * DEXP + k]); }, acc, F.tid);
#pragma unroll
        for (int i = 0; i < 4; ++i) { u32x2 w; w.x = pk2(acc[i][0], acc[i][1]); w.y = pk2(acc[i][2], acc[i][3]);
            *(GAS u32x2*)((bf16*)(F.ws + WS_Y2S) + (size_t)(tm * 128 + 4 * ty + i) * DM + tn * 64 + 4 * tx) = w; }
    }
}


#ifndef FAST_GEMM
#define FAST_GEMM 1
#endif
__device__ __forceinline__ void fphase_inproj(const Frame& F_, bool even, int i) { const Frame F = fresh(F_);
    if (even) {
        pg8::Gemm g{(const bf16*)(F.ws + WS_HA), (const bf16*)(F.ws + WS_WINE) + (size_t)i * EIN * DM, NTOK, EIN, DM, 0};
        pg8::StaticOrder S; S.init(NTOK, EIN, F.G, F.bid);
        pg8::EpiBf16<0> E{(bf16*)(F.ws + WS_PBUF), EIN, nullptr, 0, 0, 1.f};
        pg8::gemm_phase<pg8::EpiBf16<0>, pg8::StaticOrder, true, true>(F.lds, g, S, E, F.tid);
    } else {
        pg8::Gemm g{(const bf16*)(F.ws + WS_HA), (const bf16*)(F.ws + WS_WINO) + (size_t)i * OIN * DM, NTOK, OIN, DM, 0};
        pg8::StaticOrder S; S.init(NTOK, OIN, F.G, F.bid);
        pg8::EpiRopeO E{(bf16*)(F.ws + WS_PBUF), OIN, (const float*)(F.ws + WS_TABC), 8};
        pg8::gemm_phase<pg8::EpiRopeO, pg8::StaticOrder, true, true>(F.lds, g, S, E, F.tid);
    }
}
__device__ __forceinline__ void fphase_outproj(const Frame& F_, bool even, int i, int l) { const Frame F = fresh(F_);
    const int K = even ? OAE : OAO;
    const bf16* Bt = even ? (const bf16*)(F.ws + WS_WOUTE) + (size_t)i * DM * OAE : (const bf16*)(F.ws + WS_WOUTO) + (size_t)i * DM * DM;
    pg8::Gemm g{(const bf16*)(F.ws + WS_OA), Bt, NTOK, DM, K, 0};
    pg8::StaticOrder S; S.init(NTOK, DM, F.G, F.bid);
    pg8::EpiResGate E{(float*)(F.ws + WS_X), modv(F, l, 0, 2)};
    pg8::gemm_phase<pg8::EpiResGate, pg8::StaticOrder, true, true>(F.lds, g, S, E, F.tid);
}
__device__ __forceinline__ void fphase_moe_gu(const Frame& F_, int l) { const Frame F = fresh(F_);
    int base[17]; moe_bases(F, l, base);
    LAS int* tbl = (LAS int*)(F.lds + TB_OFF);
    __syncthreads();
#pragma unroll
    for (int e = 0; e < 17; ++e) if (F.tid == e) tbl[e] = base[e] >> 8;
    __syncthreads();
    pg8::MoeOrder S; S.tb = tbl; S.nN = 4; S.nwg = (base[16] >> 8) * 4; S.G = F.G; S.c = F.bid;
    pg8::Gemm g{(const bf16*)(F.ws + WS_HA), (const bf16*)(F.ws + WS_WGU) + (size_t)l * 16 * DM * DM, base[16], DM, DM, (size_t)DM * DM * 2, (const int*)(F.ws + WS_ROWTOK), NTOK};
    pg8::EpiSwiGLU E{(bf16*)(F.ws + WS_HID)};
    pg8::gemm_phase<pg8::EpiSwiGLU, pg8::MoeOrder, true, true, true>(F.lds, g, S, E, F.tid);
}
__device__ __forceinline__ void fphase_moe_down(const Frame& F_, int l) { const Frame F = fresh(F_);
    int base[17]; moe_bases(F, l, base);
    LAS int* tbl = (LAS int*)(F.lds + TB_OFF);
    __syncthreads();
#pragma unroll
    for (int e = 0; e < 17; ++e) if (F.tid == e) tbl[e] = base[e] >> 8;
    __syncthreads();
    pg8::MoeOrder S; S.tb = tbl; S.nN = 4; S.nwg = (base[16] >> 8) * 4; S.G = F.G; S.c = F.bid;
    pg8::Gemm g{(const bf16*)(F.ws + WS_HID), (const bf16*)(F.ws + WS_WD) + (size_t)l * 16 * DM * DEXP, base[16], DM, DEXP, (size_t)DM * DEXP * 2};
    pg8::EpiBf16<0> E{(bf16*)(F.ws + WS_Y2S), DM, nullptr, 0, 0, 1.f};
    pg8::gemm_phase<pg8::EpiBf16<0>, pg8::MoeOrder, true, true>(F.lds, g, S, E, F.tid);
}

__device__ __forceinline__ void sphase_fft1(const Frame& F_) { const Frame F = fresh(F_);
    const int gt = F.bid * NTHREADS + F.tid, NGT = F.G * NTHREADS;
    for (int o = gt; o < NB * 128 * 2 * 64 * 256; o += NGT) {
        const int col = o & 255, t2 = (o >> 8) & 63, ri = (o >> 14) & 1, k1 = (o >> 15) & 127, b = o >> 22;
        const bf16* f = (const bf16*)(F.ws + WS_PBUF) + (size_t)(b * TPB + CTX + t2) * EIN + 1280 + col;
        float a = 0.f;
        for (int t1 = 0; t1 < 128; ++t1) { const int t = 64 * t1 + t2; const float fr = (float)((k1 * t) & 8191) * (1.f / 8192.f);
            const float c = ri ? -__builtin_amdgcn_sinf(fr) : __builtin_amdgcn_cosf(fr); a += c * bf2f(f[(size_t)(64 * t1) * EIN]); }
        ((bf16*)(F.ws + WS_YB))[o] = (bf16)f2bf(a);
    }
}
__device__ __forceinline__ void sphase_fft2(const Frame& F_) { const Frame F = fresh(F_);
    const int gt = F.bid * NTHREADS + F.tid, NGT = F.G * NTHREADS;
    const float norm = 1.f / sqrtf(8192.f * 64.f);
    for (int o = gt; o < NB * SEQ * 2 * 256; o += NGT) {
        const int col = o & 255, ri = (o >> 8) & 1, k = (o >> 9) & 8191, b = o >> 22, k1 = k & 127, k2 = k >> 7;
        const bf16* yr = (const bf16*)(F.ws + WS_YB) + ((size_t)((b * 128 + k1) * 2 + 0) * 64) * 256 + col; const bf16* yi = yr + 64 * 256;
        float a = 0.f;
        for (int t2 = 0; t2 < 64; ++t2) { const float fr = (float)((k2 * t2) & 63) * (1.f / 64.f), c = __builtin_amdgcn_cosf(fr), s = __builtin_amdgcn_sinf(fr);
            const float vr = bf2f(yr[t2 * 256]), vi = bf2f(yi[t2 * 256]);
            a += ri ? (c * vi - s * vr) : (c * vr + s * vi); }
        ((bf16*)(F.ws + WS_OA))[(size_t)(b * TPB + CTX + k) * OAE + 768 + ri * 256 + col] = (bf16)f2bf(a * norm);
    }
}
__device__ __forceinline__ void sphase_fftc(const Frame& F_) { const Frame F = fresh(F_);
    const int gt = F.bid * NTHREADS + F.tid, NGT = F.G * NTHREADS;
    const float norm = 1.f / sqrtf(256.f * 64.f);
    for (int o = gt; o < NB * CTX * 2 * 256; o += NGT) {
        const int col = o & 255, ri = (o >> 8) & 1, k = (o >> 9) & 255, b = o >> 17;
        const bf16* f = (const bf16*)(F.ws + WS_PBUF) + (size_t)(b * TPB) * EIN + 1280 + col;
        float a = 0.f;
        for (int t = 0; t < CTX; ++t) { const float fr = (float)((k * t) & 255) * (1.f / 256.f); const float c = ri ? -__builtin_amdgcn_sinf(fr) : __builtin_amdgcn_cosf(fr); a += c * bf2f(f[(size_t)t * EIN]); }
        ((bf16*)(F.ws + WS_OA))[(size_t)(b * TPB + k) * OAE + 768 + ri * 256 + col] = (bf16)f2bf(a * norm);
    }
}


namespace fa {
using bf16x8 = __attribute__((ext_vector_type(8))) short;
using s16x4  = __attribute__((ext_vector_type(4))) short;
using f32x16 = __attribute__((ext_vector_type(16))) float;
constexpr int NW = 8, QBLK = 32, KVBLK = 64, DV = 128;
constexpr float THR = 8.f;
constexpr int SHM_V = KVBLK * DV * 2;
template <int DQK> struct Cfg { static constexpr float SCALE = DQK == 128 ? 0.088388347648318440f : 0.125f; static constexpr int RB = DQK * 2, SHM_K = KVBLK * DQK * 2, ND0 = DQK / 16; };
#define FA_KSWZ(row, colB, RB) ((row) * (RB) + ((colB) ^ (((row) & 7) << 4)))
#define FA_SBAR() __builtin_amdgcn_sched_barrier(0)
__device__ __forceinline__ int crow(int r, int hi) { return (r & 3) + 8 * (r >> 2) + 4 * hi; }
__device__ __forceinline__ unsigned cvtpk(float lo, float hi) { unsigned r; asm volatile("v_cvt_pk_bf16_f32 %0, %1, %2" : "=v"(r) : "v"(lo), "v"(hi)); return r; }
template <int DQK>
__device__ __forceinline__ void partialSM(f32x16& p0, f32x16& p1, float& m_reg, float& mn, float& alpha) {
  constexpr float SCALE = Cfg<DQK>::SCALE, C = SCALE * 1.4426950408889634f;
  float pmax = p0[0];
#pragma unroll
  for (int r = 1; r < 16; ++r) pmax = fmaxf(pmax, p0[r]);
#pragma unroll
  for (int r = 0; r < 16; ++r) pmax = fmaxf(pmax, p1[r]);
  { auto rr = __builtin_amdgcn_permlane32_swap(__float_as_uint(pmax), __float_as_uint(pmax), false, false);
    pmax = fmaxf(__uint_as_float(rr[0]), __uint_as_float(rr[1])); }
  if (__builtin_expect(__all(pmax - m_reg <= THR / SCALE), 1)) { mn = m_reg; alpha = 1.f; }
  else { mn = fmaxf(m_reg, pmax); alpha = __builtin_amdgcn_exp2f((m_reg - mn) * C); m_reg = mn; }
  const float mnC = -mn * C;
#pragma unroll
  for (int r = 0; r < 16; ++r) p0[r] = fmaf(p0[r], C, mnC);
#pragma unroll
  for (int r = 0; r < 16; ++r) p1[r] = fmaf(p1[r], C, mnC);
#pragma unroll
  for (int r = 0; r < 16; ++r) p0[r] = __builtin_amdgcn_exp2f(p0[r]);
}
__device__ __forceinline__ void finishSM(f32x16& p0, f32x16& p1, float alpha, float& l_reg, bf16x8& pa0, bf16x8& pa1, bf16x8& pa2, bf16x8& pa3) {
#pragma unroll
  for (int r = 0; r < 16; ++r) p1[r] = __builtin_amdgcn_exp2f(p1[r]);
  float ps = 0;
#pragma unroll
  for (int r = 0; r < 16; ++r) ps += p0[r];
#pragma unroll
  for (int r = 0; r < 16; ++r) ps += p1[r];
  { auto rr = __builtin_amdgcn_permlane32_swap(__float_as_uint(ps), __float_as_uint(ps), false, false);
    ps = __uint_as_float(rr[0]) + __uint_as_float(rr[1]); }
  l_reg = l_reg * alpha + ps;
#define FA_PK4(P, BASE, OUT) do { unsigned a0 = cvtpk(P[BASE + 0], P[BASE + 1]), a1 = cvtpk(P[BASE + 2], P[BASE + 3]);   \
    unsigned b0 = cvtpk(P[BASE + 4], P[BASE + 5]), b1 = cvtpk(P[BASE + 6], P[BASE + 7]);                              \
    auto r0 = __builtin_amdgcn_permlane32_swap(a0, b0, false, false); auto r1 = __builtin_amdgcn_permlane32_swap(a1, b1, false, false); \
    u32x4 w = {r0[0], r1[0], r0[1], r1[1]}; OUT = *reinterpret_cast<bf16x8*>(&w); } while (0)
  FA_PK4(p0, 0, pa0); FA_PK4(p0, 8, pa1); FA_PK4(p1, 0, pa2); FA_PK4(p1, 8, pa3);
#undef FA_PK4
}
template <int DQK>
__device__ __forceinline__ void qkt(f32x16& p0, f32x16& p1, const LAS char* Ks, const bf16x8* qr, int r32, int hi) {
  constexpr int RB = Cfg<DQK>::RB;
  p0 = f32x16{}; p1 = f32x16{};
#pragma unroll
  for (int d0 = 0; d0 < Cfg<DQK>::ND0; ++d0) { const int cb = (d0 * 16 + hi * 8) * 2;
    bf16x8 b0 = *reinterpret_cast<const LAS bf16x8*>(Ks + FA_KSWZ(r32, cb, RB));
    bf16x8 b1 = *reinterpret_cast<const LAS bf16x8*>(Ks + FA_KSWZ(32 + r32, cb, RB));
    p0 = __builtin_amdgcn_mfma_f32_32x32x16_bf16(b0, qr[d0], p0, 0, 0, 0);
    p1 = __builtin_amdgcn_mfma_f32_32x32x16_bf16(b1, qr[d0], p1, 0, 0, 0); }
}
__device__ __forceinline__ int v_st(int k, int c) { const int kk = (k & ~0xC) | ((k & 4) << 1) | ((k & 8) >> 1); return ((kk >> 3) * 4 + (c >> 5)) * 512 + ((kk & 7) * 32 + (c & 31)) * 2; }
__device__ __forceinline__ int v_rd_base(int lane) { return ((lane & 3) << 3) | (((lane >> 2) & 3) << 6) | (((lane >> 4) & 1) << 5) | (((lane >> 5) & 1) << 8); }
constexpr int v_rd_off(int d0, int ks, int half) { return d0 * 512 + ks * 4096 + half * 2048; }
template <int OFF> __device__ __forceinline__ s16x4 tr_read(int vb) {
  s16x4 r; asm volatile("ds_read_b64_tr_b16 %0, %1 offset:%2" : "=&v"(r) : "v"(vb), "i"(OFF) : "memory"); return r;
}
template <int D0> __device__ __forceinline__ void pv_one(f32x16& od, int vb, bf16x8 pa0, bf16x8 pa1, bf16x8 pa2, bf16x8 pa3) {
  const s16x4 l0 = tr_read<v_rd_off(D0, 0, 0)>(vb), h0 = tr_read<v_rd_off(D0, 0, 1)>(vb), l1 = tr_read<v_rd_off(D0, 1, 0)>(vb), h1 = tr_read<v_rd_off(D0, 1, 1)>(vb);
  const s16x4 l2 = tr_read<v_rd_off(D0, 2, 0)>(vb), h2 = tr_read<v_rd_off(D0, 2, 1)>(vb), l3 = tr_read<v_rd_off(D0, 3, 0)>(vb), h3 = tr_read<v_rd_off(D0, 3, 1)>(vb);
  asm volatile("s_waitcnt lgkmcnt(0)" ::: "memory"); FA_SBAR();
#define FA_PK(L, H) (bf16x8){L[0], L[1], L[2], L[3], H[0], H[1], H[2], H[3]}
  od = __builtin_amdgcn_mfma_f32_32x32x16_bf16(pa0, FA_PK(l0, h0), od, 0, 0, 0);
  od = __builtin_amdgcn_mfma_f32_32x32x16_bf16(pa1, FA_PK(l1, h1), od, 0, 0, 0);
  od = __builtin_amdgcn_mfma_f32_32x32x16_bf16(pa2, FA_PK(l2, h2), od, 0, 0, 0);
  od = __builtin_amdgcn_mfma_f32_32x32x16_bf16(pa3, FA_PK(l3, h3), od, 0, 0, 0);
#undef FA_PK
}
__device__ __forceinline__ void pv_d0(f32x16* o, int vb, bf16x8 pa0, bf16x8 pa1, bf16x8 pa2, bf16x8 pa3) {
  pv_one<0>(o[0], vb, pa0, pa1, pa2, pa3); pv_one<1>(o[1], vb, pa0, pa1, pa2, pa3); pv_one<2>(o[2], vb, pa0, pa1, pa2, pa3); pv_one<3>(o[3], vb, pa0, pa1, pa2, pa3);
}
template <int DQK, int LDI, int SDEPTH>
__device__ __forceinline__ void attn_unit(const bf16* __restrict__ Qb, const bf16* __restrict__ Kh, const bf16* __restrict__ Vh, bf16* __restrict__ Ob, const int ldo, float* stats, int seq, LAS char* lds, int tid) {
  constexpr int ldq = LDI, ldk = LDI, ldv = LDI;
  constexpr int RB = Cfg<DQK>::RB, SHM_K = Cfg<DQK>::SHM_K, ND0 = Cfg<DQK>::ND0;
  const int wid = tid >> 6, lane = tid & 63, r32 = lane & 31, hi = lane >> 5;
  LAS char* V_lds = lds; LAS char* K_lds = lds + 2 * SHM_V;
  LAS float* ws = (LAS float*)(lds + 2 * SHM_V + 2 * SHM_K) + wid * 64; LAS float* li_l = ws; LAS float* al_l = ws + 32;
  float m_reg = -1e30f, l_reg = 0; f32x16 o[4] = {}; bf16x8 qr[ND0];
  __syncthreads();
  const GAS bf16* Qw = (const GAS bf16*)Qb + (size_t)(wid * QBLK + r32) * ldq + hi * 8;
#pragma unroll
  for (int d0 = 0; d0 < ND0; ++d0) qr[d0] = *reinterpret_cast<const GAS bf16x8*>(Qw + d0 * 16);
  const int sr = tid >> 4, sc = (tid & 15) * 8, vst0 = v_st(sr, sc), vst1 = v_st(32 + sr, sc);
  const int kr = DQK == 128 ? sr : (tid >> 3), kc = DQK == 128 ? sc : (tid & 7) * 8;
  const int vb0 = (int)(unsigned)(size_t)V_lds + v_rd_base(lane);
  struct { bf16x8 vs0, vs1, ks0, ks1; } sr_[SDEPTH];
const unsigned vo0 = (unsigned)(sr * ldv + sc), vo1 = (unsigned)((32 + sr) * ldv + sc), ko0 = (unsigned)(kr * ldk + kc), ko1 = (unsigned)((32 + kr) * ldk + kc);
#define FA_SLOAD(i, k0) do { const GAS bf16* Vt_ = (const GAS bf16*)Vh + (size_t)(k0) * ldv; const GAS bf16* Kt_ = (const GAS bf16*)Kh + (size_t)(k0) * ldk; \
    sr_[i].vs0 = *reinterpret_cast<const GAS bf16x8*>(Vt_ + vo0); sr_[i].vs1 = *reinterpret_cast<const GAS bf16x8*>(Vt_ + vo1); \
    sr_[i].ks0 = *reinterpret_cast<const GAS bf16x8*>(Kt_ + ko0); if constexpr (DQK == 128) sr_[i].ks1 = *reinterpret_cast<const GAS bf16x8*>(Kt_ + ko1); } while (0)
#define FA_SWRITE(b, i) do { *(LAS bf16x8*)(V_lds + (b) * SHM_V + vst0) = sr_[i].vs0; *(LAS bf16x8*)(V_lds + (b) * SHM_V + vst1) = sr_[i].vs1; \
    *(LAS bf16x8*)(K_lds + (b) * SHM_K + FA_KSWZ(kr, kc * 2, RB)) = sr_[i].ks0; if constexpr (DQK == 128) *(LAS bf16x8*)(K_lds + (b) * SHM_K + FA_KSWZ(32 + kr, kc * 2, RB)) = sr_[i].ks1; } while (0)
#define FA_SWAIT() do { if constexpr (SDEPTH == 1) asm volatile("s_waitcnt vmcnt(0)" ::: "memory"); else if constexpr (DQK == 128) asm volatile("s_waitcnt vmcnt(4)" ::: "memory"); else asm volatile("s_waitcnt vmcnt(3)" ::: "memory"); } while (0)
#define FA_RESC(a) do { if (__any((a) < 1.f)) { if (hi == 0) al_l[r32] = (a); asm volatile("s_waitcnt lgkmcnt(0)" ::: "memory"); \
    _Pragma("unroll") for (int d = 0; d < 4; ++d) _Pragma("unroll") for (int r = 0; r < 16; ++r) o[d][r] *= al_l[crow(r, hi)]; } } while (0)
  f32x16 pA0, pA1, pB0, pB1; float mnA, mnB, alA, alB; bf16x8 pa0, pa1, pa2, pa3; const int NT = seq / KVBLK;
  constexpr int SE = 0, SO = SDEPTH - 1;
  FA_SLOAD(SE, 0); asm volatile("s_waitcnt vmcnt(0)" ::: "memory"); FA_SWRITE(0, SE); __syncthreads();
  qkt<DQK>(pA0, pA1, K_lds, qr, r32, hi); partialSM<DQK>(pA0, pA1, m_reg, mnA, alA);
  FA_SLOAD(SO, KVBLK); if constexpr (SDEPTH == 2) { if (2 < NT) FA_SLOAD(SE, 2 * KVBLK); }
  FA_SWAIT(); FA_SWRITE(1, SO); __syncthreads();
  for (int j = 1; j + 1 < NT; j += 2) {
    FA_SBAR(); qkt<DQK>(pB0, pB1, K_lds + SHM_K, qr, r32, hi);
    finishSM(pA0, pA1, alA, l_reg, pa0, pa1, pa2, pa3); FA_SBAR();
    FA_SLOAD(SO, (j + SDEPTH) * KVBLK); FA_SBAR();
    pv_d0(o, vb0, pa0, pa1, pa2, pa3); partialSM<DQK>(pB0, pB1, m_reg, mnB, alB);
    __syncthreads(); FA_SWAIT(); FA_SWRITE(0, SE);
    FA_RESC(alB); __syncthreads();
    FA_SBAR(); qkt<DQK>(pA0, pA1, K_lds, qr, r32, hi);
    finishSM(pB0, pB1, alB, l_reg, pa0, pa1, pa2, pa3); FA_SBAR();
    if (SDEPTH == 1 || j + 3 < NT) FA_SLOAD(SE, (j + 1 + SDEPTH) * KVBLK); FA_SBAR();
    pv_d0(o, vb0 + SHM_V, pa0, pa1, pa2, pa3); partialSM<DQK>(pA0, pA1, m_reg, mnA, alA);
    __syncthreads(); FA_SWAIT(); FA_SWRITE(1, SO);
    FA_RESC(alA); __syncthreads();
  }
  FA_SBAR(); qkt<DQK>(pB0, pB1, K_lds + SHM_K, qr, r32, hi);
  finishSM(pA0, pA1, alA, l_reg, pa0, pa1, pa2, pa3); FA_SBAR();
  pv_d0(o, vb0, pa0, pa1, pa2, pa3); partialSM<DQK>(pB0, pB1, m_reg, mnB, alB);
  __syncthreads(); FA_RESC(alB);
  finishSM(pB0, pB1, alB, l_reg, pa0, pa1, pa2, pa3); FA_SBAR();
  pv_d0(o, vb0 + SHM_V, pa0, pa1, pa2, pa3);
  if (hi == 0) li_l[r32] = l_reg; asm volatile("s_waitcnt lgkmcnt(0)" ::: "memory");
  if (stats != nullptr && hi == 0) ((GAS f32x2*)stats)[wid * QBLK + r32] = (f32x2){m_reg, l_reg};
  int r32e = r32, hie = hi; asm volatile("" : "+v"(r32e), "+v"(hie));
  float rli[16];
#pragma unroll
  for (int r = 0; r < 16; ++r) rli[r] = __builtin_amdgcn_rcpf(li_l[crow(r, hie)]);
  GAS bf16* Ow = (GAS bf16*)Ob + (size_t)(wid * QBLK) * ldo;
  const unsigned oo = (unsigned)(4 * hie * ldo + r32e);
#pragma unroll
  for (int r = 0; r < 16; ++r) { const unsigned orow = (unsigned)((r & 3) + 8 * (r >> 2));
#pragma unroll
    for (int d0 = 0; d0 < 4; ++d0) Ow[oo + orow * ldo + d0 * 32] = (bf16)f2bf(o[d0][r] * rli[r]); }
#undef FA_SLOAD
#undef FA_SWRITE
#undef FA_SWAIT
#undef FA_RESC
}
}

#ifndef FAST_ATTN
#define FAST_ATTN 1
#endif
constexpr int AE_NL = NB * 6 * (SEQ / 256), AE_FULL = 256, AE_SPLIT = AE_NL - AE_FULL, AE_ITEMS = AE_FULL + 2 * AE_SPLIT + NB * 6;
__device__ __forceinline__ void fphase_attn_e(const Frame& F_) { const Frame F = fresh(F_);
    const bf16* P = (const bf16*)(F.ws + WS_PBUF); bf16* OA = (bf16*)(F.ws + WS_OA);
    for (int w = F.bid; w < AE_ITEMS; w += F.G) {
        int u, part = -1;
        if (w < AE_FULL) u = w; else if (w < AE_FULL + 2 * AE_SPLIT) { u = AE_FULL + ((w - AE_FULL) >> 1); part = (w - AE_FULL) & 1; } else u = AE_NL + (w - AE_FULL - 2 * AE_SPLIT);
        int b, h, q0, nk;
        if (u < AE_NL) { b = u / (6 * 32); h = (u / 32) % 6; q0 = CTX + 256 * (u % 32); nk = TPB; }
        else { const int v = u - AE_NL; b = v / 6; h = v % 6; q0 = 0; nk = CTX; }
        const size_t rq = (size_t)(b * TPB + q0); size_t rk = (size_t)b * TPB;
        bf16* ob = OA + rq * OAE + h * 128; int ldo = OAE; float* st = nullptr;
        if (part >= 0) { nk = TPB / 2; rk += (size_t)part * (TPB / 2); const int su = u - AE_FULL;
            ob = (bf16*)(F.ws + WS_OPART) + ((size_t)(part * AE_SPLIT + su) * 256) * 128; ldo = 128; st = (float*)(F.ws + WS_OSTAT) + ((size_t)(part * AE_SPLIT + su) * 256) * 2; }
        fa::attn_unit<128, EIN, 1>(P + rq * EIN + h * 128, P + rk * EIN + 768 + (h / 3) * 128, P + rk * EIN + 1024 + (h / 3) * 128, ob, ldo, st, nk, (LAS char*)F.lds, F.tid);
    }
}
__device__ __forceinline__ void phase_attn_merge(const Frame& F_) { const Frame F = fresh(F_);
    const int gw = F.bid * NWAVES + F.wave, NGW = F.G * NWAVES, lane = F.lane;
    constexpr float C = 0.088388347648318440f * 1.4426950408889634f;
    for (int it = gw; it < AE_SPLIT * 256; it += NGW) {
        const int su = it >> 8, r = it & 255, u = AE_FULL + su, b = u / (6 * 32), h = (u / 32) % 6, q0 = CTX + 256 * (u % 32);
        const f32x2 sa = ((const GAS f32x2*)(F.ws + WS_OSTAT))[(size_t)su * 256 + r], sb = ((const GAS f32x2*)(F.ws + WS_OSTAT))[(size_t)(AE_SPLIT + su) * 256 + r];
        const float M = fmaxf(sa.x, sb.x), wa = sa.y * __builtin_amdgcn_exp2f((sa.x - M) * C), wb = sb.y * __builtin_amdgcn_exp2f((sb.x - M) * C), rw = 1.f / (wa + wb);
        const unsigned pa = ((const GAS unsigned*)((const bf16*)(F.ws + WS_OPART) + ((size_t)su * 256 + r) * 128))[lane], pb = ((const GAS unsigned*)((const bf16*)(F.ws + WS_OPART) + ((size_t)(AE_SPLIT + su) * 256 + r) * 128))[lane];
        const float o0 = (wa * bflo(pa) + wb * bflo(pb)) * rw, o1 = (wa * bfhi(pa) + wb * bfhi(pb)) * rw;
        ((GAS unsigned*)((bf16*)(F.ws + WS_OA) + (size_t)(b * TPB + q0 + r) * OAE + h * 128))[lane] = pk2(o0, o1);
    }
}
__device__ __forceinline__ void fphase_attn_o(const Frame& F_) { const Frame F = fresh(F_);
    const bf16* P = (const bf16*)(F.ws + WS_PBUF); bf16* OT = (bf16*)(F.ws + WS_OT);
    constexpr int NL = NB * 16 * (SEQ / 256), NC = NB * 16;
    for (int u = F.bid; u < NL + NC; u += F.G) {
        int b, g, q0, nk;
        if (u < NL) { b = u / (16 * 32); g = (u / 32) % 16; q0 = CTX + 256 * (u % 32); nk = TPB; }
        else { const int v = u - NL; b = v / 16; g = v % 16; q0 = 0; nk = CTX; }
        const size_t rq = (size_t)(b * TPB + q0), rk = (size_t)b * TPB;
        fa::attn_unit<64, OIN, 2>(P + rq * OIN + g * 64, P + rk * OIN + 1024 + g * 64, P + rk * OIN + 2048 + (g / 2) * 128, OT + rq * OTW + g * 128, OTW, nullptr, nk, (LAS char*)F.lds, F.tid);
    }
}


#ifndef FAST_FFT
#define FAST_FFT 1
#endif
template <int NTILE, class Gen, class Out>
__device__ __forceinline__ void dft_unit(LAS char* lds, const bf16* data, unsigned ldv, int nch, int rowbase, int vsel, Gen gen, GAS bf16* obase, float oscale, Out out_off, int tid) {
    const int lane = tid & 63, r32 = lane & 31, hi = lane >> 5;
    const int sr = tid >> 4, sc = (tid & 15) * 8, vst0 = fa::v_st(sr, sc), vst1 = fa::v_st(32 + sr, sc);
    const int vb = (int)(unsigned)(size_t)lds + vsel * fa::SHM_V + fa::v_rd_base(lane);
    fa::f32x16 o[4] = {};
    for (int ch = 0; ch < nch; ++ch) {
        __syncthreads();
#pragma unroll
        for (int t = 0; t < NTILE; ++t) {
            const GAS bf16* dt = (const GAS bf16*)data + (size_t)(64 * ch) * ldv + 128 * t;
            const fa::bf16x8 a = *reinterpret_cast<const GAS fa::bf16x8*>(dt + (unsigned)sr * ldv + sc), c = *reinterpret_cast<const GAS fa::bf16x8*>(dt + (unsigned)(32 + sr) * ldv + sc);
            *(LAS fa::bf16x8*)(lds + t * fa::SHM_V + vst0) = a; *(LAS fa::bf16x8*)(lds + t * fa::SHM_V + vst1) = c;
        }
        fa::bf16x8 pa[4];
#pragma unroll
        for (int ks = 0; ks < 4; ++ks) { const int k0 = 64 * ch + 16 * ks + 8 * hi; u32x4 w;
            w.x = fa::cvtpk(gen(rowbase + r32, k0 + 0), gen(rowbase + r32, k0 + 1)); w.y = fa::cvtpk(gen(rowbase + r32, k0 + 2), gen(rowbase + r32, k0 + 3));
            w.z = fa::cvtpk(gen(rowbase + r32, k0 + 4), gen(rowbase + r32, k0 + 5)); w.w = fa::cvtpk(gen(rowbase + r32, k0 + 6), gen(rowbase + r32, k0 + 7));
            pa[ks] = *reinterpret_cast<fa::bf16x8*>(&w); }
        __syncthreads();
        fa::pv_d0(o, vb, pa[0], pa[1], pa[2], pa[3]);
    }
    int r32e = r32, hie = hi; asm volatile("" : "+v"(r32e), "+v"(hie));
#pragma unroll
    for (int r = 0; r < 16; ++r)
#pragma unroll
        for (int d0 = 0; d0 < 4; ++d0) obase[out_off(rowbase + (r & 3) + 8 * (r >> 2) + 4 * hie, 32 * d0 + r32e)] = (bf16)f2bf(o[d0][r] * oscale);
}
__device__ __forceinline__ void fphase_fft1(const Frame& F_) { const Frame F = fresh(F_);
    for (int u = F.bid; u < NB * 64 * 2; u += F.G) {
        const int ch2 = u & 1, t2 = (u >> 1) & 63, b = u >> 7;
        const bf16* data = uptr((const bf16*)(F.ws + WS_PBUF) + (size_t)(b * TPB + CTX + t2) * EIN + 1280 + 128 * ch2);
        GAS bf16* yb = (GAS bf16*)uptr((bf16*)(F.ws + WS_YB) + ((size_t)b * 128 * 2 * 64 + t2) * 256 + 128 * ch2);
        dft_unit<1>((LAS char*)F.lds, data, 64u * EIN, 2, 32 * F.wave, 0,
            [&](int rho, int kap) { const int k1 = rho & 127, t = 64 * kap + t2; const float fr = (float)((k1 * t) & 8191) * (1.f / 8192.f); return (rho >> 7) ? -__builtin_amdgcn_sinf(fr) : __builtin_amdgcn_cosf(fr); },
            yb, 1.f, [&](int rho, int col) { return (unsigned)((((rho & 127) * 2 + (rho >> 7)) * 64) * 256 + col); }, F.tid);
    }
}
__device__ __forceinline__ void fphase_fft2(const Frame& F_) { const Frame F = fresh(F_);
    const float norm = 0.0013810679320049757f, normc = 0.0078125f;
    constexpr int BUSY = 0;
    const int nfree = F.G > BUSY ? F.G - BUSY : F.G, vb0 = F.G > BUSY ? F.bid - BUSY : F.bid;
    if (vb0 < 0) return;
    for (int u = vb0; u < NB * 128; u += nfree) {
        const int k1 = u & 127, b = u >> 7;
        const bf16* data = uptr((const bf16*)(F.ws + WS_YB) + (size_t)(b * 128 + k1) * 2 * 64 * 256);
        bf16* oa_ = uptr((bf16*)(F.ws + WS_OA) + (size_t)(b * TPB + CTX + k1) * OAE + 768 + 128 * (F.wave >> 2));
        dft_unit<2>((LAS char*)F.lds, data, 256u, 2, 32 * (F.wave & 3), F.wave >> 2,
            [&](int rho, int kap) { const int k2 = rho & 63, ro = rho >> 6, t2 = kap & 63, si = kap >> 6; const float fr = (float)((k2 * t2) & 63) * (1.f / 64.f);
                return (ro == si) ? __builtin_amdgcn_cosf(fr) : (ro ? -__builtin_amdgcn_sinf(fr) : __builtin_amdgcn_sinf(fr)); },
            (GAS bf16*)oa_, norm, [&](int rho, int col) { return (unsigned)((128 * (rho & 63)) * OAE + (rho >> 6) * 256 + col); }, F.tid);
    }
    for (int u = vb0; u < 8; u += nfree) {
        const int rb = u & 1, ch2 = (u >> 1) & 1, b = u >> 2;
        const bf16* data = uptr((const bf16*)(F.ws + WS_PBUF) + (size_t)(b * TPB) * EIN + 1280 + 128 * ch2);
        bf16* oa_ = uptr((bf16*)(F.ws + WS_OA) + (size_t)(b * TPB) * OAE + 768 + 128 * ch2);
        dft_unit<1>((LAS char*)F.lds, data, (unsigned)EIN, 4, 256 * rb + 32 * F.wave, 0,
            [&](int rho, int kap) { const int k = rho & 255; const float fr = (float)((k * kap) & 255) * (1.f / 256.f); return (rho >> 8) ? -__builtin_amdgcn_sinf(fr) : __builtin_amdgcn_cosf(fr); },
            (GAS bf16*)oa_, normc, [&](int rho, int col) { return (unsigned)((rho & 255) * OAE + (rho >> 8) * 256 + col); }, F.tid);
    }
}

__device__ __forceinline__ void sphase_attn_e(const Frame& F_) { const Frame F = fresh(F_);
    const bf16* P = (const bf16*)(F.ws + WS_PBUF); bf16* OA = (bf16*)(F.ws + WS_OA);
    const int NL = NB * 6 * (SEQ / 32), NC = NB * 6 * (CTX / 32);
    for (int u = F.bid; u < NL + NC; u += F.G) {
        int b, h, q0, nk;
        if (u < NL) { b = u / (6 * 256); h = (u / 256) % 6; q0 = CTX + 32 * (u % 256); nk = TPB; }
        else { const int v = u - NL; b = v / (6 * 8); h = (v / 8) % 6; q0 = 32 * (v % 8); nk = CTX; }
        const size_t rq = (size_t)(b * TPB + q0), rk = (size_t)b * TPB;
        sattn_unit<128>((LAS float*)F.lds, P + rq * EIN + h * 128, EIN, P + rk * EIN + 768 + (h / 3) * 128, EIN, P + rk * EIN + 1024 + (h / 3) * 128, EIN,
                        OA + rq * OAE + h * 128, OAE, nk, 0.08838834764831845f, F.tid);
    }
}
__device__ __forceinline__ void sphase_attn_o(const Frame& F_) { const Frame F = fresh(F_);
    const bf16* P = (const bf16*)(F.ws + WS_PBUF); bf16* OT = (bf16*)(F.ws + WS_OT);
    const int NL = NB * 16 * (SEQ / 32), NC = NB * 16 * (CTX / 32);
    for (int u = F.bid; u < NL + NC; u += F.G) {
        int b, g, q0, nk;
        if (u < NL) { b = u / (16 * 256); g = (u / 256) % 16; q0 = CTX + 32 * (u % 256); nk = TPB; }
        else { const int v = u - NL; b = v / (16 * 8); g = (v / 8) % 16; q0 = 32 * (v % 8); nk = CTX; }
        const size_t rq = (size_t)(b * TPB + q0), rk = (size_t)b * TPB;
        sattn_unit<64>((LAS float*)F.lds, P + rq * OIN + g * 64, OIN, P + rk * OIN + 1024 + g * 64, OIN, P + rk * OIN + 2048 + (g / 2) * 128, OIN,
                       OT + rq * OTW + g * 128, OTW, nk, 0.125f, F.tid);
    }
}

__global__ void __launch_bounds__(NTHREADS, 2) fwd_kernel(Args args) {
    extern __shared__ __attribute__((aligned(16))) unsigned char lds_raw[];
    Frame F;
    F.lds = (LAS unsigned char*)lds_raw; F.ws = args.ws;
    F.tid = threadIdx.x; F.lane = F.tid & 63; F.wave = __builtin_amdgcn_readfirstlane(F.tid >> 6); F.bid = blockIdx.x; F.G = gridDim.x;
    volatile LAS unsigned* MISC = (volatile LAS unsigned*)(F.lds + MISC_OFF);
    if (F.tid < 32) MISC[F.tid] = 0u;
    __syncthreads();
    const int lo = args.ph_lo, hi = args.ph_hi;
    const bool multi = (hi - lo) > 1;
    XcdBarrier bar; bar.bar = (unsigned*)(F.ws + WS_CTL) + CW_BAR; bar.x = 0; bar.st = MISC + 8;
    if (multi) bar = xcd_barrier_post((unsigned*)(F.ws + WS_CTL) + CW_BAR, MISC + 8);
#define IN(k) (lo <= (k) && (k) < hi)
#ifdef PROBE_KIND
    unsigned long long probe_acc = 0, probe_t0 = 0;
#define PROBE_BEGIN(kind) do { if ((kind) < 32 && ((PROBE_KIND >> (kind)) & 1)) probe_t0 = __builtin_amdgcn_s_memrealtime(); } while (0)
#define PROBE_END(kind) do { if ((kind) < 32 && ((PROBE_KIND >> (kind)) & 1)) probe_acc += __builtin_amdgcn_s_memrealtime() - probe_t0; } while (0)
#else
#define PROBE_BEGIN(kind) do {} while (0)
#define PROBE_END(kind) do {} while (0)
#endif
#define SEAM(k) do { if (IN(k) && IN((k) + 1)) xcd_barrier(bar); } while (0)
#define SEAMC(k, c) do { if ((c) && IN(k) && IN((k) + 1)) xcd_barrier(bar); } while (0)
    PROBE_BEGIN(16); if (IN(PH_PRO_A)) { phase_pro_a(F, args); } SEAM(PH_PRO_A); PROBE_END(16);
    PROBE_BEGIN(17); if (IN(PH_PRO_B)) { phase_pro_b(F, args); } SEAM(PH_PRO_B); PROBE_END(17);
    for (int l = 0; l < DEPTH; ++l) {
        const int p0 = PH_L0 + l * PPL, i = l >> 1; const bool even = (l & 1) == 0;
        PROBE_BEGIN(PL_INPROJ + (PROBE_PARITY < 0 ? 0 : ((l & 1) == PROBE_PARITY ? 0 : 1000))); if (IN(p0 + PL_INPROJ)) {
#if FAST_GEMM
            fphase_inproj(F, even, i);
#else
            if (even) sphase_gemm_bf16(F, (const bf16*)(F.ws + WS_HA), DM, (const bf16*)(F.ws + WS_WINE) + (size_t)i * EIN * DM, DM, (bf16*)(F.ws + WS_PBUF), EIN, NTOK, EIN, DM);
            else sphase_gemm_bf16(F, (const bf16*)(F.ws + WS_HA), DM, (const bf16*)(F.ws + WS_WINO) + (size_t)i * OIN * DM, DM, (bf16*)(F.ws + WS_PBUF), OIN, NTOK, OIN, DM);
#endif
        } SEAM(p0 + PL_INPROJ); PROBE_END(PL_INPROJ + (PROBE_PARITY < 0 ? 0 : ((l & 1) == PROBE_PARITY ? 0 : 1000)));
        PROBE_BEGIN(PL_QKFIX + (PROBE_PARITY < 0 ? 0 : ((l & 1) == PROBE_PARITY ? 0 : 1000))); if (IN(p0 + PL_QKFIX)) { if (even) phase_qkfix_e(F, args, i); else if (!FAST_GEMM) phase_qkfix_o(F); } SEAMC(p0 + PL_QKFIX, even || !FAST_GEMM); PROBE_END(PL_QKFIX + (PROBE_PARITY < 0 ? 0 : ((l & 1) == PROBE_PARITY ? 0 : 1000)));
        PROBE_BEGIN(PL_FFT1 + (PROBE_PARITY < 0 ? 0 : ((l & 1) == PROBE_PARITY ? 0 : 1000))); if (IN(p0 + PL_FFT1)) { if (even) { if (FAST_FFT) fphase_fft1(F); else sphase_fft1(F); } } SEAMC(p0 + PL_FFT1, even); PROBE_END(PL_FFT1 + (PROBE_PARITY < 0 ? 0 : ((l & 1) == PROBE_PARITY ? 0 : 1000)));
        PROBE_BEGIN(PL_ATTN + (PROBE_PARITY < 0 ? 0 : ((l & 1) == PROBE_PARITY ? 0 : 1000))); if (IN(p0 + PL_ATTN)) { if (even) { if (FAST_ATTN) fphase_attn_e(F); else sphase_attn_e(F); if (FAST_FFT) fphase_fft2(F); else { sphase_fft2(F); sphase_fftc(F); } } else { if (FAST_ATTN) fphase_attn_o(F); else sphase_attn_o(F); } } SEAM(p0 + PL_ATTN); PROBE_END(PL_ATTN + (PROBE_PARITY < 0 ? 0 : ((l & 1) == PROBE_PARITY ? 0 : 1000)));
        PROBE_BEGIN(PL_FINISH + (PROBE_PARITY < 0 ? 0 : ((l & 1) == PROBE_PARITY ? 0 : 1000))); if (IN(p0 + PL_FINISH)) { if (!even) phase_finish_o(F, args, i); else if (FAST_ATTN) phase_attn_merge(F); } SEAM(p0 + PL_FINISH); PROBE_END(PL_FINISH + (PROBE_PARITY < 0 ? 0 : ((l & 1) == PROBE_PARITY ? 0 : 1000)));
        PROBE_BEGIN(PL_OUTPROJ + (PROBE_PARITY < 0 ? 0 : ((l & 1) == PROBE_PARITY ? 0 : 1000))); if (IN(p0 + PL_OUTPROJ)) {
#if FAST_GEMM
            fphase_outproj(F, even, i, l);
#else
            if (even) sphase_outproj(F, (const bf16*)(F.ws + WS_OA), OAE, (const bf16*)(F.ws + WS_WOUTE) + (size_t)i * DM * OAE, OAE, l);
            else sphase_outproj(F, (const bf16*)(F.ws + WS_OA), OAO, (const bf16*)(F.ws + WS_WOUTO) + (size_t)i * DM * DM, DM, l);
#endif
        } SEAM(p0 + PL_OUTPROJ); PROBE_END(PL_OUTPROJ + (PROBE_PARITY < 0 ? 0 : ((l & 1) == PROBE_PARITY ? 0 : 1000)));
        PROBE_BEGIN(PL_ROUTER + (PROBE_PARITY < 0 ? 0 : ((l & 1) == PROBE_PARITY ? 0 : 1000))); if (IN(p0 + PL_ROUTER)) { phase_router(F, args, l); } SEAM(p0 + PL_ROUTER); PROBE_END(PL_ROUTER + (PROBE_PARITY < 0 ? 0 : ((l & 1) == PROBE_PARITY ? 0 : 1000)));
        PROBE_BEGIN(PL_GU + (PROBE_PARITY < 0 ? 0 : ((l & 1) == PROBE_PARITY ? 0 : 1000))); if (IN(p0 + PL_GU)) { if (FAST_GEMM) fphase_moe_gu(F, l); else sphase_moe_gu(F, l); } SEAM(p0 + PL_GU); PROBE_END(PL_GU + (PROBE_PARITY < 0 ? 0 : ((l & 1) == PROBE_PARITY ? 0 : 1000)));
        PROBE_BEGIN(PL_DOWN + (PROBE_PARITY < 0 ? 0 : ((l & 1) == PROBE_PARITY ? 0 : 1000))); if (IN(p0 + PL_DOWN)) { if (FAST_GEMM) fphase_moe_down(F, l); else sphase_moe_down(F, l); } SEAM(p0 + PL_DOWN); PROBE_END(PL_DOWN + (PROBE_PARITY < 0 ? 0 : ((l & 1) == PROBE_PARITY ? 0 : 1000)));
        PROBE_BEGIN(PL_COMBINE + (PROBE_PARITY < 0 ? 0 : ((l & 1) == PROBE_PARITY ? 0 : 1000))); if (IN(p0 + PL_COMBINE)) { phase_combine(F, args, l); } SEAM(p0 + PL_COMBINE); PROBE_END(PL_COMBINE + (PROBE_PARITY < 0 ? 0 : ((l & 1) == PROBE_PARITY ? 0 : 1000)));
    }
#undef IN
#undef SEAM
#ifdef PROBE_KIND
    if (F.bid == 0 && F.tid == 0) { const unsigned long long t1 = __builtin_amdgcn_s_memrealtime(), want = probe_acc * PROBE_MULT; while (__builtin_amdgcn_s_memrealtime() - t1 < want) __builtin_amdgcn_s_sleep(8); }
#endif
}

extern "C" void kernel_launch(void* const* d_in, const int* in_sizes, int n_in, void* d_out, int out_size, void* d_ws, size_t ws_size, hipStream_t stream) {
    static int grid = 0;
    if (grid == 0) {
        if (n_in != 26 || in_sizes[0] != NB * SEQ * DM || out_size != NB * SEQ * DM || ws_size < WS_END) {
            fprintf(stderr, "kernel_launch: shape/workspace mismatch (n_in %d, in0 %d, out %d, ws %zu, need %zu); nothing launched\n", n_in, n_in > 0 ? in_sizes[0] : -1, out_size, ws_size, (size_t)WS_END); grid = -1; return; }
        int dev = 0, cus = 0;
        if (hipGetDevice(&dev) != hipSuccess || hipDeviceGetAttribute(&cus, hipDeviceAttributeMultiprocessorCount, dev) != hipSuccess) { grid = -1; return; }
        if (hipFuncSetAttribute((const void*)fwd_kernel, hipFuncAttributeMaxDynamicSharedMemorySize, LDS_BYTES) != hipSuccess) { fprintf(stderr, "kernel_launch: hipFuncSetAttribute failed\n"); grid = -1; return; }
        int per_cu = 0;
        if (hipOccupancyMaxActiveBlocksPerMultiprocessor(&per_cu, (const void*)fwd_kernel, NTHREADS, LDS_BYTES) != hipSuccess || per_cu < 1) { fprintf(stderr, "kernel_launch: occupancy query says %d\n", per_cu); }
        (void)hipGetLastError();
        grid = cus;
    }
    if (grid < 0) return;
    (void)hipMemsetAsync((char*)d_ws + WS_CTL, 0, CTL_ZERO_BYTES, stream);
    Args a{};
    for (int i = 0; i < 26; ++i) a.in[i] = (const float*)d_in[i];
    a.out = (float*)d_out; a.ws = (unsigned char*)d_ws;
#if MK_ONE_LAUNCH
    a.ph_lo = 0; a.ph_hi = N_PHASES;
    hipLaunchKernelGGL(fwd_kernel, dim3(grid), dim3(NTHREADS), LDS_BYTES, stream, a);
#else
    for (int p = 0; p < N_PHASES; ++p) {
        if (p >= PH_L0) { const int l = (p - PH_L0) / PPL, k = (p - PH_L0) % PPL; const bool even = (l & 1) == 0;
            if ((k == PL_FFT1 && !even) || k == PL_GATHER || (k == PL_QKFIX && !even && FAST_GEMM)) continue; }
        a.ph_lo = p; a.ph_hi = p + 1;
        hipLaunchKernelGGL(fwd_kernel, dim3(grid), dim3(NTHREADS), LDS_BYTES, stream, a);
    }
#endif
}
```

```cpp
#include <hip/hip_runtime.h>
#include <cstdio>
#include <cstdint>

#ifndef PROBE_PARITY
#define PROBE_PARITY (-1)
#endif
#ifndef PROBE_MULT
#define PROBE_MULT 4
#endif
#ifndef ATTN_RING3
#define ATTN_RING3 1
#endif
#ifndef ATTN_NEGM
#define ATTN_NEGM 1
#endif
#ifndef MK_ONE_LAUNCH
#define MK_ONE_LAUNCH 1
#endif

#define GAS __attribute__((address_space(1)))
#define LAS __attribute__((address_space(3)))
typedef unsigned short bf16;
typedef float f32x4 __attribute__((ext_vector_type(4)));
typedef unsigned u32x4 __attribute__((ext_vector_type(4)));
typedef unsigned u32x2 __attribute__((ext_vector_type(2)));
typedef int i32x4 __attribute__((ext_vector_type(4)));
typedef int i32x2 __attribute__((ext_vector_type(2)));
typedef float f32x2 __attribute__((ext_vector_type(2)));

constexpr int NB = 2, SEQ = 8192, CTX = 256, TPB = SEQ + CTX, NTOK = NB * TPB, DM = 1024, DEPTH = 4;
constexpr int EIN = 1536, OIN = 3072, OAE = 1280, OAO = 1024, OTW = 2048;
constexpr int NEXP = 16, DEXP = 512;
constexpr int XS_TILES = 2 * NTOK / 256 + NEXP, XS_ROWS = XS_TILES * 256;
constexpr float EPS = 1e-6f;
constexpr int NTHREADS = 512, NWAVES = 8;

constexpr size_t MiB = 1u << 20;
constexpr size_t WS_CTL = 0, CTL_ZERO_BYTES = MiB;
constexpr size_t WS_MODV = 1 * MiB;
constexpr size_t WS_TABA = 1 * MiB + 512 * 1024;
constexpr size_t WS_TABC = WS_TABA + 32 * 1024;
constexpr size_t WS_LAM = WS_TABC + 16 * 1024;
constexpr size_t WS_SELA = 2 * MiB;
constexpr size_t WS_SELW = 2 * MiB + 512 * 1024;
constexpr size_t WS_RPOS = 2 * MiB + 768 * 1024;
constexpr size_t WS_WINE = 3 * MiB;
constexpr size_t WS_WOUTE = 9 * MiB;
constexpr size_t WS_WINO = 14 * MiB;
constexpr size_t WS_WOUTO = 26 * MiB;
constexpr size_t WS_WGU = 30 * MiB;
constexpr size_t WS_WD = 158 * MiB;
constexpr size_t WS_X = 222 * MiB;
constexpr size_t WS_HA = 288 * MiB;
constexpr size_t WS_YB = 321 * MiB;
constexpr size_t WS_PBUF = 337 * MiB;
constexpr size_t WS_OT = 436 * MiB;
constexpr size_t WS_OA = 502 * MiB;
constexpr size_t WS_OPART = 436 * MiB;
constexpr size_t WS_OSTAT = 470 * MiB;
constexpr size_t WS_ROWTOK = 321 * MiB;
constexpr size_t WS_XS = 337 * MiB;
constexpr size_t WS_HID = 411 * MiB;
constexpr size_t WS_Y2S = 448 * MiB;
constexpr size_t WS_END = 544 * MiB;
static_assert(WS_XS + (size_t)XS_ROWS * 1024 * 2 <= WS_HID && WS_HID + (size_t)XS_ROWS * 512 * 2 <= WS_Y2S && WS_Y2S + (size_t)XS_ROWS * 1024 * 2 <= WS_END, "moe overlay");
static_assert(WS_OA + (size_t)NTOK * OAE * 2 <= WS_END && WS_PBUF + (size_t)NTOK * OIN * 2 <= WS_OT && WS_OT + (size_t)NTOK * OTW * 2 <= WS_OA, "ws map");
constexpr int CW_BAR = 4096;
constexpr int CW_CNT = 16384;

constexpr int LDS_BYTES = 147456;
constexpr int MISC_OFF = 147456 - 1024;
constexpr int TB_OFF = 147456 - 512;

constexpr int PH_PRO_A = 0, PH_PRO_B = 1, PH_L0 = 2, PPL = 11;
constexpr int PL_INPROJ = 0, PL_QKFIX = 1, PL_FFT1 = 2, PL_ATTN = 3, PL_FINISH = 4, PL_OUTPROJ = 5, PL_ROUTER = 6, PL_GATHER = 7, PL_GU = 8, PL_DOWN = 9, PL_COMBINE = 10;
constexpr int N_PHASES = PH_L0 + DEPTH * PPL;

struct Args { const float* in[26]; float* out; unsigned char* ws; int ph_lo, ph_hi; };

__device__ __forceinline__ unsigned f2bf(float f) { unsigned u = __builtin_bit_cast(unsigned, f); return (u + 0x7fffu + ((u >> 16) & 1u)) >> 16; }
__device__ __forceinline__ unsigned pk2(float lo, float hi) { return f2bf(lo) | (f2bf(hi) << 16); }
__device__ __forceinline__ float bf2f(bf16 b) { return __builtin_bit_cast(float, (unsigned)b << 16); }
__device__ __forceinline__ float bflo(unsigned w) { return __builtin_bit_cast(float, w << 16); }
__device__ __forceinline__ float bfhi(unsigned w) { return __builtin_bit_cast(float, w & 0xffff0000u); }
template <int M> __device__ __forceinline__ float swz_xor(float v) { static_assert(M >= 1 && M < 32, "swz_xor mask");
    return __builtin_bit_cast(float, __builtin_amdgcn_ds_swizzle(__builtin_bit_cast(int, v), (M << 10) | 0x1f)); }
__device__ __forceinline__ f32x2 swap32(float v) {
    unsigned a = __builtin_bit_cast(unsigned, v), b = a;
    asm volatile("s_nop 1\n\tv_permlane32_swap_b32 %0, %1" : "+v"(a), "+v"(b));
    return (f32x2){__builtin_bit_cast(float, a), __builtin_bit_cast(float, b)}; }
__device__ __forceinline__ float xor32(float v, bool upper) { const f32x2 s2 = swap32(v); return upper ? s2.x : s2.y; }
__device__ __forceinline__ float wave_sum(float v) {
    v += swz_xor<1>(v); v += swz_xor<2>(v); v += swz_xor<4>(v); v += swz_xor<8>(v); v += swz_xor<16>(v);
    const f32x2 s2 = swap32(v); return s2.x + s2.y;
}
__device__ __forceinline__ float silu_f(float x) { return x / (1.f + expf(-x)); }
#define LDS_WAIT() asm volatile("s_waitcnt lgkmcnt(0)" ::: "memory")

#define XB_TMO      128
#define XB_XCNT(j)  (256  + 64 * (j))
#define XB_XSUB(j)  (1280 + 64 * (j))
#define XB_XGEN(j)  (2304 + 64 * (j))
#define XB_TOP      3328
#define XB_TOPGEN   3392
#define XCD_BAR_WORDS 3456
#define XB_SPIN_CAP (1u << 24)
__device__ __forceinline__ unsigned xb_ld(unsigned* p)              { return __hip_atomic_load(p, __ATOMIC_RELAXED, __HIP_MEMORY_SCOPE_AGENT); }
__device__ __forceinline__ unsigned xb_add(unsigned* p, unsigned v) { return __hip_atomic_fetch_add(p, v, __ATOMIC_RELAXED, __HIP_MEMORY_SCOPE_AGENT); }
__device__ __forceinline__ unsigned xb_xcc_id() { return (unsigned)__builtin_amdgcn_s_getreg((3 << 11) | 20) & 0xFu; }
#define XB_SPIN(cond, bar) do { unsigned _sp = 0; while (cond) { __builtin_amdgcn_s_sleep(1); \
    if ((++_sp & 255u) == 0u) { if (xb_ld(&(bar)[XB_TMO])) break; if (_sp > XB_SPIN_CAP) { atomicAdd(&(bar)[XB_TMO], 1u); break; } } } } while (0)
struct XcdBarrier { unsigned* bar; unsigned x; volatile LAS unsigned* st; };
__device__ __forceinline__ XcdBarrier xcd_barrier_post(unsigned* bar, volatile LAS unsigned* st) {
    XcdBarrier b; b.bar = bar; b.x = xb_xcc_id(); b.st = st;
    if (threadIdx.x == 0) (void)xb_add(&bar[XB_XCNT(b.x)], 1u);
    return b;
}
__device__ __forceinline__ void xcd_barrier_complete(unsigned* bar, unsigned x, unsigned& nloc, unsigned& nx) {
    const unsigned G = gridDim.x * gridDim.y * gridDim.z;
    unsigned sum, cnt, mine, sp = 0u;
    for (;;) {
        sum = 0u; cnt = 0u; mine = 0u;
#pragma unroll
        for (unsigned j = 0; j < 16; ++j) { const unsigned c = xb_ld(&bar[XB_XCNT(j)]); sum += c; cnt += (c > 0u) ? 1u : 0u; mine = (j == x) ? c : mine; }
        if (sum == G) break;
        __builtin_amdgcn_s_sleep(1);
        if ((++sp & 255u) == 0u) { if (xb_ld(&bar[XB_TMO])) break; if (sp > XB_SPIN_CAP) { atomicAdd(&bar[XB_TMO], 1u); break; } }
    }
    nloc = mine > 0u ? mine : 1u; nx = cnt > 0u ? cnt : 1u;
}
__device__ __forceinline__ void xcd_barrier(const XcdBarrier& b, const bool leader) {
    asm volatile("s_waitcnt vmcnt(0)" ::: "memory");
    __syncthreads();
    if (leader) {
        unsigned* bar = b.bar; unsigned bx_ = b.x; asm volatile("" : "+s"(bar), "+s"(bx_));
        __builtin_amdgcn_s_waitcnt(0);
        unsigned nloc = b.st[0], nx = b.st[1];
        if (nloc == 0u) { xcd_barrier_complete(bar, bx_, nloc, nx); b.st[0] = nloc; b.st[1] = nx; }
        const unsigned old = xb_add(&bar[XB_XSUB(bx_)], 1u);
        const unsigned gen = old / nloc;
        if (old + 1u == (gen + 1u) * nloc) {
            __builtin_amdgcn_fence(__ATOMIC_RELEASE, "agent");
            asm volatile("s_waitcnt vmcnt(0)" ::: "memory");
            const unsigned og = xb_add(&bar[XB_TOP], 1u);
            const unsigned tg = og / nx;
            if (og + 1u == (tg + 1u) * nx) xb_add(&bar[XB_TOPGEN], 1u);
            else XB_SPIN(xb_ld(&bar[XB_TOPGEN]) == tg, bar);
            __builtin_amdgcn_fence(__ATOMIC_ACQUIRE, "agent");
            xb_add(&bar[XB_XGEN(bx_)], 1u);
            asm volatile("s_waitcnt vmcnt(0)" ::: "memory");
        } else {
            XB_SPIN(xb_ld(&bar[XB_XGEN(bx_)]) == gen, bar);
            __builtin_amdgcn_fence(__ATOMIC_ACQUIRE, "agent");
            asm volatile("s_waitcnt vmcnt(0)" ::: "memory");
        }
    }
    __syncthreads();
}

struct Frame {
    LAS unsigned char* lds;
    unsigned char* ws;
    int tid, lane, wave, bid, G;
};
template <class T> __device__ __forceinline__ T* opq(T* p) { asm volatile("" : "+s"(p)); return p; }
__device__ __forceinline__ Frame fresh(const Frame& F) { Frame G = F;
    asm volatile("" : "+s"(G.ws), "+s"(G.bid), "+s"(G.wave), "+s"(G.G));
    G.lane = (int)__builtin_amdgcn_mbcnt_hi(~0u, __builtin_amdgcn_mbcnt_lo(~0u, 0u)); asm volatile("" : "+v"(G.lane));
    G.tid = G.wave * 64 + G.lane; return G; }
__device__ __forceinline__ const float* ain_ptr(int k) {
    auto kp = __builtin_amdgcn_kernarg_segment_ptr(); asm volatile("" : "+s"(kp));
    typedef const float* cfp;
    return ((const __attribute__((address_space(4))) cfp*)kp)[k]; }
#define AIN(k) ain_ptr(k)
template <class T> __device__ __forceinline__ T* uptr(T* p) {
    const unsigned long long v = (unsigned long long)p; const unsigned lo = __builtin_amdgcn_readfirstlane((unsigned)v), hi = __builtin_amdgcn_readfirstlane((unsigned)(v >> 32));
    return (T*)(((unsigned long long)hi << 32) | lo); }
__device__ __forceinline__ const float* modv(const Frame& F, int l, int type, int chunk) { return (const float*)(F.ws + WS_MODV) + ((size_t)(l * 3 + type) * 6 + chunk) * DM; }
__device__ __forceinline__ int row_type(int r) { const int b = r / TPB, j = r - b * TPB; return j < CTX ? 2 : b; }

__device__ __forceinline__ void load_row_f32(const float* p, int lane, f32x4 (&v)[4]) {
    const GAS f32x4* q = (const GAS f32x4*)p + lane;
#pragma unroll
    for (int j = 0; j < 4; ++j) v[j] = q[64 * j];
}
__device__ __forceinline__ void store_row_f32(float* p, int lane, const f32x4 (&v)[4]) {
    GAS f32x4* q = (GAS f32x4*)p + lane;
#pragma unroll
    for (int j = 0; j < 4; ++j) q[64 * j] = v[j];
}
__device__ __forceinline__ void load_row_bf16(const bf16* p, int lane, f32x4 (&v)[4]) {
    const GAS u32x2* q = (const GAS u32x2*)p + lane;
#pragma unroll
    for (int j = 0; j < 4; ++j) { const u32x2 w = q[64 * j]; v[j] = (f32x4){bflo(w.x), bfhi(w.x), bflo(w.y), bfhi(w.y)}; }
}
__device__ __forceinline__ void store_row_bf16(bf16* p, int lane, const f32x4 (&v)[4]) {
    GAS u32x2* q = (GAS u32x2*)p + lane;
#pragma unroll
    for (int j = 0; j < 4; ++j) { u32x2 w; w.x = pk2(v[j].x, v[j].y); w.y = pk2(v[j].z, v[j].w); q[64 * j] = w; }
}
__device__ __forceinline__ float row_rstd(const f32x4 (&v)[4]) {
    float s = 0.f;
#pragma unroll
    for (int j = 0; j < 4; ++j) s += (v[j].x * v[j].x + v[j].y * v[j].y) + (v[j].z * v[j].z + v[j].w * v[j].w);
    return rsqrtf(wave_sum(s) * (1.f / DM) + EPS);
}
__device__ __forceinline__ void modnorm_store(const f32x4 (&v)[4], const float* sc, const float* sh, bf16* dst, int lane) {
    const float rstd = row_rstd(v);
    f32x4 s[4], h[4], o[4]; load_row_f32(sc, lane, s); load_row_f32(sh, lane, h);
#pragma unroll
    for (int j = 0; j < 4; ++j) o[j] = v[j] * rstd * (s[j] + 1.f) + h[j];
    store_row_bf16(dst, lane, o);
}

namespace pg8 {
#define PG8_LAS __attribute__((address_space(3)))
typedef unsigned short bf16_t;
typedef short bf16x8 __attribute__((ext_vector_type(8)));
typedef float f32x4 __attribute__((ext_vector_type(4)));
typedef unsigned u32x4 __attribute__((ext_vector_type(4)));
constexpr int BM = 256, BK = 64, HALF = 128, HTB = HALF * BK * 2  , STAGE_BYTES = 8 * HTB, NXCD = 8, WGM = 8;

__host__ __device__ __forceinline__ int lds_byte(int r, int c) { const int st = (r >> 4) * 2 + (c >> 5), rr = r & 15, cc = c & 31, ob = rr * 64 + cc * 2; return st * 1024 + (ob ^ (((ob >> 9) & 1) << 5)); }
__host__ __device__ __forceinline__ void stage_rc(int b, int& R, int& C) { const int st = b / 1024, sb = b % 1024, swz = sb ^ (((sb >> 9) & 1) << 5); R = (st >> 1) * 16 + swz / 64; C = (st & 1) * 32 + (swz % 64) / 2; }
__host__ __device__ __forceinline__ int perm32(int rho) { const int n = rho >> 4, i = rho & 15; return 8 * (i >> 2) + 4 * n + (i & 3); }

struct Unit { int pm, pn, e, lt; };
struct Gemm { const bf16_t* A; const bf16_t* Bt; int M, N, K; size_t estride; const int* rowtok; int ntok; };

struct StaticOrder {
    int nM, nN, nwg, G, c;
    __host__ __device__ void init(int M, int N, int G_, int c_) { nM = M / BM; nN = N / BM; nwg = nM * nN; G = G_; c = c_; }
    __host__ __device__ bool next(int i, Unit& u) const {
        const long L = (long)i * G + c; if (L >= nwg) return false;
        int wgid = (int)L; { const int q = nwg / NXCD, r = nwg % NXCD, xcd = wgid % NXCD, off = wgid / NXCD; wgid = (xcd < r ? xcd * (q + 1) : r * (q + 1) + (xcd - r) * q) + off; }
        const int nig = WGM * nN, gid = wgid / nig, fm = gid * WGM, gsz = (nM - fm) < WGM ? (nM - fm) : WGM;
        u.pm = fm + ((wgid % nig) % gsz); u.pn = (wgid % nig) / gsz; u.e = 0; u.lt = 0; return true;
    }
    __device__ __forceinline__ void a_ready(const Unit&) const {}
    __device__ __forceinline__ void done(const Unit&) const {}
};

__device__ __forceinline__ unsigned cvt_pk_bf16(float lo, float hi) { unsigned r; asm volatile("v_cvt_pk_bf16_f32 %0, %1, %2" : "=v"(r) : "v"(lo), "v"(hi)); return r; }
typedef float f32x2 __attribute__((ext_vector_type(2)));
__device__ __forceinline__ f32x2 gelu_pk(f32x2 v) {
    const f32x2 av = __builtin_elementwise_abs(v), d = av * 0.2316418882f + 1.0f;
    f32x2 t; t.x = __builtin_amdgcn_rcpf(d.x); t.y = __builtin_amdgcn_rcpf(d.y);
    f32x2 q = t * 0.5307027145f + (-0.7265760135f); q = q * t + 0.7107068705f; q = q * t + (-0.142248368f); q = q * t + 0.127414796f; q = q * t;
    const f32x2 s = (v * v) * (-0.72134752044f);
    f32x2 e; e.x = __builtin_amdgcn_exp2f(s.x); e.y = __builtin_amdgcn_exp2f(s.y);
    const f32x2 m = v * (q * e), r = v - m;
    f32x2 o; o.x = v.x < 0.f ? m.x : r.x; o.y = v.y < 0.f ? m.y : r.y; return o;
}

template <int ACT  > struct EpiBf16 {
    static constexpr bool PERM = true, AFTER_DRAIN = false; static_assert(ACT == 0 || ACT == 1, "EpiBf16: ACT is 0 (none) or 1 (gelu_pk)");
    bf16_t* O; int ldc; const float* bias; int split_cols; size_t split_stride; float scale0;
    __device__ __forceinline__ void operator()(const f32x4 (&acc)[2][2][4][2], const Unit& u, int wr, int wc, int fr, int fq) const {
        const int row0 = u.pm * BM + wr * 64 + fr; int colt = u.pn * BM; bf16_t* base = O;
        float sc = 1.f; if (split_cols) { const int t = colt / split_cols; base += (size_t)t * split_stride; colt -= t * split_cols; if (t == 0) sc = scale0; }
        const int col0 = colt + wc * 32 + 8 * fq, bcol0 = u.pn * BM + wc * 32 + 8 * fq;
        f32x4 bv[2][2];
#pragma unroll
        for (int bj = 0; bj < 2; ++bj)
#pragma unroll
            for (int n = 0; n < 2; ++n) bv[bj][n] = bias ? *(const f32x4*)(bias + bcol0 + bj * HALF + 4 * n) : (f32x4){0.f, 0.f, 0.f, 0.f};
#pragma unroll
        for (int ai = 0; ai < 2; ++ai)
#pragma unroll
            for (int m = 0; m < 4; ++m) { bf16_t* rowp = base + (size_t)(row0 + ai * HALF + m * 16) * ldc + col0;
#pragma unroll
                for (int bj = 0; bj < 2; ++bj) { f32x4 v0 = acc[ai][bj][m][0] + bv[bj][0], v1 = acc[ai][bj][m][1] + bv[bj][1];
                    if (ACT == 1) { f32x2 a = gelu_pk((f32x2){v0[0], v0[1]}), b = gelu_pk((f32x2){v0[2], v0[3]}), c = gelu_pk((f32x2){v1[0], v1[1]}), d = gelu_pk((f32x2){v1[2], v1[3]});
                        v0 = (f32x4){a.x, a.y, b.x, b.y}; v1 = (f32x4){c.x, c.y, d.x, d.y}; }
                    v0 = v0 * sc; v1 = v1 * sc; u32x4 w; w.x = cvt_pk_bf16(v0[0], v0[1]); w.y = cvt_pk_bf16(v0[2], v0[3]); w.z = cvt_pk_bf16(v1[0], v1[1]); w.w = cvt_pk_bf16(v1[2], v1[3]);
                    *(GAS u32x4*)(rowp + bj * HALF) = w; } }
    }
};

__device__ __forceinline__ float silu_fast(float x) { return x * __builtin_amdgcn_rcpf(1.f + __expf(-x)); }
struct EpiSwiGLU {
    static constexpr bool PERM = true, AFTER_DRAIN = false;
    bf16_t* O;
    __device__ __forceinline__ void operator()(const f32x4 (&acc)[2][2][4][2], const Unit& u, int wr, int wc, int fr, int fq) const {
        const int row0 = u.pm * BM + wr * 64 + fr, col0 = u.pn * HALF + wc * 32 + 8 * fq;
#pragma unroll
        for (int ai = 0; ai < 2; ++ai)
#pragma unroll
            for (int m = 0; m < 4; ++m) { bf16_t* rowp = O + (size_t)(row0 + ai * HALF + m * 16) * 512 + col0;
                const f32x4 g0 = acc[ai][0][m][0], g1 = acc[ai][0][m][1], u0 = acc[ai][1][m][0], u1 = acc[ai][1][m][1];
                u32x4 w; w.x = cvt_pk_bf16(silu_fast(g0[0]) * u0[0], silu_fast(g0[1]) * u0[1]); w.y = cvt_pk_bf16(silu_fast(g0[2]) * u0[2], silu_fast(g0[3]) * u0[3]);
                w.z = cvt_pk_bf16(silu_fast(g1[0]) * u1[0], silu_fast(g1[1]) * u1[1]); w.w = cvt_pk_bf16(silu_fast(g1[2]) * u1[2], silu_fast(g1[3]) * u1[3]);
                *(GAS u32x4*)rowp = w; }
    }
};
struct EpiResGate {
    static constexpr bool PERM = false, AFTER_DRAIN = false;
    float* X; const float* gate3;
    __device__ __forceinline__ void operator()(const f32x4 (&acc)[2][2][4][2], const Unit& u, int wr, int wc, int fr, int fq) const {
        const int type = (u.pm % 33 == 0) ? 2 : u.pm / 33;
        const int col0 = u.pn * BM + wc * 32 + 4 * fq; const float* gp = gate3 + (size_t)type * 6144 + col0;
        f32x4 gv[2][2];
#pragma unroll
        for (int bj = 0; bj < 2; ++bj)
#pragma unroll
            for (int n = 0; n < 2; ++n) gv[bj][n] = *(const GAS f32x4*)(gp + bj * HALF + n * 16);
#pragma unroll
        for (int ai = 0; ai < 2; ++ai)
#pragma unroll
            for (int m = 0; m < 4; ++m) { float* rowp = X + (size_t)(u.pm * BM + ai * HALF + wr * 64 + m * 16 + fr) * 1024 + col0;
#pragma unroll
                for (int bj = 0; bj < 2; ++bj)
#pragma unroll
                    for (int n = 0; n < 2; ++n) { GAS f32x4* xp = (GAS f32x4*)(rowp + bj * HALF + n * 16); *xp = *xp + gv[bj][n] * acc[ai][bj][m][n]; } }
    }
};

struct EpiRopeO {
    static constexpr bool PERM = true, AFTER_DRAIN = false;
    bf16_t* O; int ldc; const float* tab; int nrope_tiles;
    int nq_tiles; float qscale;
    __device__ __forceinline__ void operator()(const f32x4 (&acc)[2][2][4][2], const Unit& u, int wr, int wc, int fr, int fq) const {
        const int row0 = u.pm * BM + wr * 64 + fr, col0 = u.pn * BM + wc * 32 + 8 * fq;
        const bool rope = (u.pn < nrope_tiles) && (u.pm % 33 != 0);
        const int t0 = row0 - (u.pm / 33) * 8448 - 256;
        const bool x2 = (fq >> 1) != 0; const float qs = (u.pn < nq_tiles) ? qscale : 1.f;
#pragma unroll
        for (int ai = 0; ai < 2; ++ai)
#pragma unroll
            for (int m = 0; m < 4; ++m) { const int t = t0 + ai * HALF + m * 16; bf16_t* rowp = O + (size_t)(row0 + ai * HALF + m * 16) * ldc + col0;
                f32x4 cs[4];
                if (rope) { const int pos = (wc & 1) ? (t & 63) : (t >> 6); const float* tp = tab + (size_t)(pos * 16 + 8 * (fq & 1)) * 2;
#pragma unroll
                    for (int q = 0; q < 4; ++q) cs[q] = *(const GAS f32x4*)(tp + 4 * q); }
#pragma unroll
                for (int bj = 0; bj < 2; ++bj) { f32x4 v0 = acc[ai][bj][m][0], v1 = acc[ai][bj][m][1];
                    if (rope) { f32x4 p0, p1;
#pragma unroll
                        for (int e = 0; e < 4; ++e) { p0[e] = xor32(v0[e], x2); p1[e] = xor32(v1[e], x2); }
                        const f32x4 c0 = {cs[0][0], cs[0][2], cs[1][0], cs[1][2]}, s0 = {cs[0][1], cs[0][3], cs[1][1], cs[1][3]};
                        const f32x4 c1 = {cs[2][0], cs[2][2], cs[3][0], cs[3][2]}, s1 = {cs[2][1], cs[2][3], cs[3][1], cs[3][3]};
                        v0 = x2 ? (p0 * s0 + v0 * c0) : (v0 * c0 - p0 * s0); v1 = x2 ? (p1 * s1 + v1 * c1) : (v1 * c1 - p1 * s1); }
                    v0 = v0 * qs; v1 = v1 * qs;
                    u32x4 w; w.x = cvt_pk_bf16(v0[0], v0[1]); w.y = cvt_pk_bf16(v0[2], v0[3]); w.z = cvt_pk_bf16(v1[0], v1[1]); w.w = cvt_pk_bf16(v1[2], v1[3]);
                    *(GAS u32x4*)(rowp + bj * HALF) = w; } }
    }
};
struct MoeOrder {
    const PG8_LAS int* tb; int nN, nwg, G, c;
    __device__ __forceinline__ bool next(int i, Unit& u) const {
        const int L = i * G + c; if (L >= nwg) return false;
        u.pm = L / nN; u.pn = L - u.pm * nN; int e = 0;
        int t0 = 0;
#pragma unroll
        for (int q = 1; q < 16; ++q) { const int tq = tb[q]; const bool ge = u.pm >= tq; e = ge ? q : e; t0 = ge ? tq : t0; }
        u.e = __builtin_amdgcn_readfirstlane(e); u.lt = u.pm - __builtin_amdgcn_readfirstlane(t0); return true;
    }
    __device__ __forceinline__ void a_ready(const Unit&) const {}
    __device__ __forceinline__ void done(const Unit&) const {}
};

template <class Epi, class Sched, bool ALIGN_EPI = false, bool SP2 = false, bool GATHER = false>
__device__ __forceinline__ void gemm_phase(PG8_LAS unsigned char* lds, const Gemm g, const Sched& S, const Epi& E, const int tid_) {
    const int tid = tid_, wid = __builtin_amdgcn_readfirstlane(tid >> 6), lane = tid & 63, wr = wid >> 2, wc = wid & 3, fr = lane & 15, fq = lane >> 4;
    const int K = g.K, nt = K / BK;
    unsigned voffA[2], voffB[2];
#pragma unroll
    for (int i = 0; i < 2; ++i) { int R, C; stage_rc(tid * 16 + i * 8192, R, C); const int Rb = Epi::PERM ? ((R & ~31) + perm32(R & 31)) : R;
        voffA[i] = (unsigned)(R * K + C) * 2u; voffB[i] = (unsigned)(Rb * K + C) * 2u; }
    static_assert(!GATHER || SP2, "GATHER is implemented on the SP2 loop only");
    int gR[2], gC[2];
#pragma unroll
    for (int i = 0; i < 2; ++i) stage_rc(tid * 16 + i * 8192, gR[i], gC[i]);
    unsigned vAc[2][2], vAn[2][2];
#define PG8_LOADIDX(u, v) do { _Pragma("unroll") for (int h_ = 0; h_ < 2; ++h_) _Pragma("unroll") for (int i_ = 0; i_ < 2; ++i_) { \
        int tok_ = g.rowtok[(size_t)(u).e * g.ntok + (u).lt * 256 + h_ * HALF + gR[i_]]; tok_ = ((unsigned)tok_ < (unsigned)g.ntok) ? tok_ : 0; (v)[h_][i_] = (unsigned)(tok_ * K + gC[i_]) * 2u; } } while (0)
#define PG8_STAGE_A(bufoff, gbase, h, set) do { if constexpr (GATHER) { PG8_STAGE(bufoff, gbase, (set)[h]); } else { PG8_STAGE(bufoff, (gbase) + (h) * hstep, voffA); } } while (0)
    const size_t kstep = (size_t)(BK * 2);
    const size_t hstep = (size_t)HALF * K * 2;
    const size_t tstep = 2 * hstep;
    const unsigned ldsw = (unsigned)wid * 1024u;
    const int aoff = lds_byte(wr * 64 + fr, fq * 8), boff = lds_byte(wc * 32 + fr, fq * 8);
#define PG8_SA(b, h) (((b) * 2 + (h)) * HTB)
#define PG8_SB(b, h) ((4 + (b) * 2 + (h)) * HTB)
#define PG8_STAGE(bufoff, gbase, voff) do { _Pragma("unroll") for (int _i = 0; _i < 2; ++_i) \
        __builtin_amdgcn_global_load_lds((const unsigned*)((const char*)(gbase) + (voff)[_i]), (PG8_LAS unsigned*)(lds + (bufoff) + ldsw + _i * 8192), 16, 0, 0); } while (0)
#define PG8_LDA(dst, b, h) do { _Pragma("unroll") for (int m = 0; m < 4; ++m) _Pragma("unroll") for (int k = 0; k < 2; ++k) dst[m][k] = *(const PG8_LAS bf16x8*)(lds + PG8_SA(b, h) + aoff + m * 2048 + k * 1024); } while (0)
#define PG8_LDB(dst, b, h) do { _Pragma("unroll") for (int n = 0; n < 2; ++n) _Pragma("unroll") for (int k = 0; k < 2; ++k) dst[n][k] = *(const PG8_LAS bf16x8*)(lds + PG8_SB(b, h) + boff + n * 2048 + k * 1024); } while (0)
#define PG8_MMA(ai, bj, At, Bt) do { __builtin_amdgcn_s_setprio(1); _Pragma("unroll") for (int m = 0; m < 4; ++m) _Pragma("unroll") for (int n = 0; n < 2; ++n) _Pragma("unroll") for (int k = 0; k < 2; ++k) \
        acc[ai][bj][m][n] = __builtin_amdgcn_mfma_f32_16x16x32_bf16(Bt[n][k], At[m][k], acc[ai][bj][m][n], 0, 0, 0); __builtin_amdgcn_s_setprio(0); } while (0)
#define PG8_WAIT_V(n) asm volatile("s_waitcnt vmcnt(" #n ")" ::: "memory")
#define PG8_WAIT_L(n) asm volatile("s_waitcnt lgkmcnt(" #n ")" ::: "memory")
#define PG8_BAR __builtin_amdgcn_s_barrier()
#define PG8_SCHED __builtin_amdgcn_sched_barrier(0)
    Unit cur, nxt; int ui = 0;
    if (!S.next(0, cur)) return;
    f32x4 acc[2][2][4][2];
#pragma unroll
    for (int a = 0; a < 2; ++a)
#pragma unroll
        for (int b = 0; b < 2; ++b)
#pragma unroll
            for (int m = 0; m < 4; ++m)
#pragma unroll
                for (int n = 0; n < 2; ++n) acc[a][b][m][n] = (f32x4){0.f, 0.f, 0.f, 0.f};
    bf16x8 At[4][2], B0[2][2], B1[2][2];
    const char* cA = GATHER ? (const char*)g.A : (const char*)g.A + (size_t)cur.pm * tstep; const char* cB = (const char*)g.Bt + (size_t)cur.e * g.estride + (size_t)cur.pn * tstep;
    if constexpr (GATHER) { PG8_LOADIDX(cur, vAc); }
    S.a_ready(cur);
    if constexpr (SP2) {
        PG8_STAGE(PG8_SB(0, 0), cB, voffB); PG8_STAGE(PG8_SB(0, 1), cB + hstep, voffB); PG8_STAGE_A(PG8_SA(0, 0), cA, 0, vAc); PG8_STAGE_A(PG8_SA(0, 1), cA, 1, vAc);
        if (wr == 1) PG8_BAR;
        PG8_WAIT_V(2); PG8_BAR;
        PG8_STAGE(PG8_SB(1, 0), cB + kstep, voffB); PG8_STAGE_A(PG8_SA(1, 0), cA + kstep, 0, vAc); PG8_STAGE(PG8_SB(1, 1), cB + hstep + kstep, voffB);
        PG8_WAIT_V(6); PG8_BAR;
    } else {
        PG8_STAGE(PG8_SB(0, 0), cB, voffB); PG8_STAGE(PG8_SA(0, 0), cA, voffA); PG8_STAGE(PG8_SB(0, 1), cB + hstep, voffB); PG8_STAGE(PG8_SA(0, 1), cA + hstep, voffA);
        if (wr == 1) PG8_BAR;
        PG8_WAIT_V(4); PG8_BAR;
        PG8_STAGE(PG8_SB(1, 0), cB + kstep, voffB); PG8_STAGE(PG8_SA(1, 0), cA + kstep, voffA); PG8_STAGE(PG8_SB(1, 1), cB + hstep + kstep, voffB);
        PG8_WAIT_V(6); PG8_BAR;
    }
    for (;;) {
        const bool has_next = S.next(ui + 1, nxt);
        const char* nA = GATHER ? cA : (has_next ? (const char*)g.A + (size_t)nxt.pm * tstep : cA); const char* nB = has_next ? (const char*)g.Bt + (size_t)nxt.e * g.estride + (size_t)nxt.pn * tstep : cB;
        if constexpr (GATHER) { if (has_next) { PG8_LOADIDX(nxt, vAn); } else {
#pragma unroll
            for (int h_ = 0; h_ < 2; ++h_) { vAn[h_][0] = vAc[h_][0]; vAn[h_][1] = vAc[h_][1]; } } }
        for (int t = 0; t < nt; t += 2) {
            const bool last = (t == nt - 2);
            const char* a1 = cA + (size_t)(t + 1) * kstep;
            const char* a2 = last ? nA : cA + (size_t)(t + 2) * kstep; const char* b2 = last ? nB : cB + (size_t)(t + 2) * kstep;
            const char* a3 = a2 + kstep; const char* b3 = b2 + kstep;
            if (last && has_next) S.a_ready(nxt);
            if constexpr (SP2) {
            unsigned vA2[2][2];
#pragma unroll
            for (int h_ = 0; h_ < 2; ++h_) { vA2[h_][0] = last ? vAn[h_][0] : vAc[h_][0]; vA2[h_][1] = last ? vAn[h_][1] : vAc[h_][1]; }
            PG8_LDB(B0, 0, 0); PG8_LDB(B1, 0, 1); PG8_SCHED; PG8_LDA(At, 0, 0); PG8_STAGE_A(PG8_SA(1, 1), a1, 1, vAc);
            PG8_WAIT_V(8); PG8_WAIT_L(0); PG8_BAR; PG8_MMA(0, 0, At, B0); PG8_MMA(0, 1, At, B1); PG8_BAR; PG8_SCHED;
            PG8_LDA(At, 0, 1); PG8_STAGE(PG8_SB(0, 0), b2, voffB); PG8_STAGE(PG8_SB(0, 1), b2 + hstep, voffB); PG8_STAGE_A(PG8_SA(0, 0), a2, 0, vA2);
            PG8_WAIT_V(8); PG8_WAIT_L(0); PG8_BAR; PG8_MMA(1, 0, At, B0); PG8_MMA(1, 1, At, B1); PG8_BAR; PG8_SCHED;
            PG8_LDB(B0, 1, 0); PG8_LDB(B1, 1, 1); PG8_SCHED; PG8_LDA(At, 1, 0); PG8_STAGE_A(PG8_SA(0, 1), a2, 1, vA2);
            PG8_WAIT_V(8); PG8_WAIT_L(0); PG8_BAR; PG8_MMA(0, 0, At, B0); PG8_MMA(0, 1, At, B1); PG8_BAR; PG8_SCHED;
            PG8_LDA(At, 1, 1); PG8_STAGE(PG8_SB(1, 0), b3, voffB); PG8_STAGE(PG8_SB(1, 1), b3 + hstep, voffB); PG8_STAGE_A(PG8_SA(1, 0), a3, 0, vA2);
            PG8_WAIT_V(8); PG8_WAIT_L(0); PG8_BAR; PG8_MMA(1, 0, At, B0); PG8_MMA(1, 1, At, B1); PG8_BAR; PG8_SCHED;
            } else {
            PG8_LDB(B0, 0, 0); PG8_SCHED; PG8_LDA(At, 0, 0); PG8_STAGE(PG8_SA(1, 1), a1 + hstep, voffA);
            PG8_WAIT_L(8); PG8_BAR; PG8_WAIT_L(0); PG8_MMA(0, 0, At, B0); PG8_BAR; PG8_SCHED;
            PG8_LDB(B1, 0, 1); PG8_STAGE(PG8_SB(0, 0), b2, voffB);
            PG8_BAR; PG8_WAIT_L(0); PG8_MMA(0, 1, At, B1); PG8_BAR;
            PG8_LDA(At, 0, 1); PG8_STAGE(PG8_SA(0, 0), a2, voffA);
            PG8_BAR; PG8_WAIT_L(0); PG8_MMA(1, 0, At, B0); PG8_BAR; PG8_SCHED;
            PG8_STAGE(PG8_SB(0, 1), b2 + hstep, voffB);
            PG8_WAIT_V(6); PG8_BAR; PG8_MMA(1, 1, At, B1); PG8_BAR;
            PG8_LDB(B0, 1, 0); PG8_SCHED; PG8_LDA(At, 1, 0); PG8_STAGE(PG8_SA(0, 1), a2 + hstep, voffA);
            PG8_WAIT_L(8); PG8_BAR; PG8_WAIT_L(0); PG8_MMA(0, 0, At, B0); PG8_BAR; PG8_SCHED;
            PG8_LDB(B1, 1, 1); PG8_STAGE(PG8_SB(1, 0), b3, voffB);
            PG8_BAR; PG8_WAIT_L(0); PG8_MMA(0, 1, At, B1); PG8_BAR;
            PG8_LDA(At, 1, 1); PG8_STAGE(PG8_SA(1, 0), a3, voffA);
            PG8_BAR; PG8_WAIT_L(0); PG8_MMA(1, 0, At, B0); PG8_BAR; PG8_SCHED;
            PG8_STAGE(PG8_SB(1, 1), b3 + hstep, voffB);
            PG8_WAIT_V(6); PG8_BAR; PG8_MMA(1, 1, At, B1); PG8_BAR;
            }
        }
        if constexpr (ALIGN_EPI) { if (wr == 0) PG8_BAR; }
        if constexpr (!Epi::AFTER_DRAIN) { E(acc, cur, wr, wc, fr, fq); S.done(cur); }
        if (!has_next) break;
#pragma unroll
        for (int a = 0; a < 2; ++a)
#pragma unroll
            for (int b = 0; b < 2; ++b)
#pragma unroll
                for (int m = 0; m < 4; ++m)
#pragma unroll
                    for (int n = 0; n < 2; ++n) acc[a][b][m][n] = (f32x4){0.f, 0.f, 0.f, 0.f};
        cur = nxt; cA = nA; cB = nB; ++ui;
        if constexpr (GATHER) {
#pragma unroll
            for (int h_ = 0; h_ < 2; ++h_) { vAc[h_][0] = vAn[h_][0]; vAc[h_][1] = vAn[h_][1]; } }
        if constexpr (ALIGN_EPI) { if (wr == 1) PG8_BAR; }
    }
    PG8_WAIT_V(0);
    if constexpr (!ALIGN_EPI) { if (wr == 0) PG8_BAR; }
    PG8_BAR;
    if constexpr (Epi::AFTER_DRAIN) { E.fused(acc, cur, wr, wc, fr, fq, lds, wid, lane); S.done(cur); }
#undef PG8_SA
#undef PG8_LOADIDX
#undef PG8_STAGE_A
#undef PG8_SB
#undef PG8_STAGE
#undef PG8_LDA
#undef PG8_LDB
#undef PG8_MMA
#undef PG8_WAIT_V
#undef PG8_WAIT_L
#undef PG8_BAR
#undef PG8_SCHED
}
}

constexpr int SG_AS = 132, SG_BS = 68;
template <class FA, class FB>
__device__ __forceinline__ void sg_tile(LAS float* As, LAS float* Bs, int K, FA fa, FB fb, float (&acc)[4][4], int tid) {
    const int ty = tid >> 4, tx = tid & 15;
#pragma unroll
    for (int i = 0; i < 4; ++i)
#pragma unroll
        for (int j = 0; j < 4; ++j) acc[i][j] = 0.f;
    for (int k0 = 0; k0 < K; k0 += 16) {
#pragma unroll
        for (int i = 0; i < 4; ++i) { const int idx = tid + 512 * i, m = idx >> 4, kk = idx & 15; As[kk * SG_AS + m] = fa(m, k0 + kk); }
#pragma unroll
        for (int i = 0; i < 2; ++i) { const int idx = tid + 512 * i, n = idx >> 4, kk = idx & 15; Bs[kk * SG_BS + n] = fb(k0 + kk, n); }
        __syncthreads();
#pragma unroll
        for (int kk = 0; kk < 16; ++kk) {
            const f32x4 a = *(const LAS f32x4*)(As + kk * SG_AS + 4 * ty), b = *(const LAS f32x4*)(Bs + kk * SG_BS + 4 * tx);
#pragma unroll
            for (int i = 0; i < 4; ++i)
#pragma unroll
                for (int j = 0; j < 4; ++j) acc[i][j] += a[i] * b[j];
        }
        __syncthreads();
    }
}

template <int DQK>
__device__ __forceinline__ void sattn_unit(LAS float* sm, const bf16* Q, int ldq, const bf16* Kp, int ldk, const bf16* Vp, int ldv, bf16* O, int ldo, int nkeys, float scale, int tid) {
    constexpr int QS = DQK + 1;
    LAS float* Qs = sm; LAS float* Ks = Qs + 32 * QS; LAS float* Vs = Ks + 64 * QS; LAS float* Ss = Vs + 64 * 128;
    const int qi = tid >> 4, sub = tid & 15;
    __syncthreads();
    for (int idx = tid; idx < 32 * DQK; idx += 512) { const int r = idx / DQK, d = idx % DQK; Qs[r * QS + d] = bf2f(Q[(size_t)r * ldq + d]) * scale; }
    float m = -1e30f, l = 0.f, acc[8];
#pragma unroll
    for (int e = 0; e < 8; ++e) acc[e] = 0.f;
    for (int k0 = 0; k0 < nkeys; k0 += 64) {
        __syncthreads();
        for (int idx = tid; idx < 64 * DQK; idx += 512) { const int r = idx / DQK, d = idx % DQK; Ks[r * QS + d] = bf2f(Kp[(size_t)(k0 + r) * ldk + d]); }
        for (int idx = tid; idx < 64 * 128; idx += 512) { const int r = idx >> 7, d = idx & 127; Vs[r * 128 + d] = bf2f(Vp[(size_t)(k0 + r) * ldv + d]); }
        __syncthreads();
        float s[4];
#pragma unroll
        for (int c = 0; c < 4; ++c) { const int kj = sub + 16 * c; float a = 0.f;
            for (int d = 0; d < DQK; ++d) a += Qs[qi * QS + d] * Ks[kj * QS + d];
            s[c] = a; }
        float tmax = fmaxf(fmaxf(s[0], s[1]), fmaxf(s[2], s[3]));
#pragma unroll
        for (int o = 1; o < 16; o <<= 1) tmax = fmaxf(tmax, __shfl_xor(tmax, o));
        const float mnew = fmaxf(m, tmax), alpha = expf(m - mnew);
        float ps = 0.f;
#pragma unroll
        for (int c = 0; c < 4; ++c) { const float p = expf(s[c] - mnew); ps += p; Ss[qi * 65 + sub + 16 * c] = p; }
#pragma unroll
        for (int o = 1; o < 16; o <<= 1) ps += __shfl_xor(ps, o);
        l = l * alpha + ps; m = mnew;
        __syncthreads();
#pragma unroll
        for (int e = 0; e < 8; ++e) acc[e] *= alpha;
        for (int k = 0; k < 64; ++k) { const float p = Ss[qi * 65 + k];
#pragma unroll
            for (int e = 0; e < 8; ++e) acc[e] += p * Vs[k * 128 + sub * 8 + e]; }
    }
    const float rl = 1.f / l;
    u32x4 w; w.x = pk2(acc[0] * rl, acc[1] * rl); w.y = pk2(acc[2] * rl, acc[3] * rl); w.z = pk2(acc[4] * rl, acc[5] * rl); w.w = pk2(acc[6] * rl, acc[7] * rl);
    *(GAS u32x4*)(O + (size_t)qi * ldo + sub * 8) = w;
}

template <class RM>
__device__ __forceinline__ void transpose_item(const float* W, int K, int N, bf16* WT, int ldt, RM rowmap, LAS float* scr, int item, int lane) {
    const int nblk = N / 64, kb = item / nblk, nb = item % nblk, k0 = 64 * kb, n0 = 64 * nb;
    const int rsub = lane >> 4, c4 = (lane & 15) * 4;
    const GAS float* src = (const GAS float*)W + (size_t)(k0 + rsub) * N + n0 + c4;
    f32x4 v[16];
#pragma unroll
    for (int i = 0; i < 16; ++i) v[i] = *(const GAS f32x4*)(src + (size_t)(4 * i) * N);
#pragma unroll
    for (int i = 0; i < 16; ++i) { LAS float* d = scr + (4 * i + rsub) * 65 + c4; d[0] = v[i].x; d[1] = v[i].y; d[2] = v[i].z; d[3] = v[i].w; }
    LDS_WAIT(); asm volatile("" ::: "memory");
    const int kc = (lane & 7) * 8;
#pragma unroll
    for (int j = 0; j < 8; ++j) { const int n = (lane >> 3) + 8 * j; const LAS float* t = scr + kc * 65 + n;
        u32x4 o; o.x = pk2(t[0 * 65], t[1 * 65]); o.y = pk2(t[2 * 65], t[3 * 65]); o.z = pk2(t[4 * 65], t[5 * 65]); o.w = pk2(t[6 * 65], t[7 * 65]);
        *(GAS u32x4*)(WT + (size_t)rowmap(n0 + n) * ldt + k0 + kc) = o; }
    LDS_WAIT(); asm volatile("" ::: "memory");
}

__device__ __forceinline__ void phase_pro_a(const Frame& F_, const Args& A) { const Frame F = fresh(F_);
    const int gw = F.bid * NWAVES + F.wave, NGW = F.G * NWAVES, gt = F.bid * NTHREADS + F.tid, NGT = F.G * NTHREADS;
    {
        LAS float* sv = (LAS float*)F.lds;
        LAS float* red = sv + 3 * DM;
        for (int i = F.tid; i < 3 * DM; i += NTHREADS) { const int t = i / DM, k = i % DM; const float x = (t < 2) ? AIN(1)[t * DM + k] : AIN(3)[k]; sv[i] = silu_f(x); }
        __syncthreads();
        for (int item = F.bid; item < DEPTH * 24; item += F.G) {
            const int l = item / 24, n0 = (item % 24) * 256, kp = F.wave;
            const GAS float* w = (const GAS float*)AIN(4) + (size_t)l * DM * 6144 + (size_t)(kp * 128) * 6144 + n0 + 4 * F.lane;
            f32x4 a0 = {0.f, 0.f, 0.f, 0.f}, a1 = a0, a2 = a0;
#pragma unroll 8
            for (int k = 0; k < 128; ++k) { const f32x4 wv = *(const GAS f32x4*)(w + (size_t)k * 6144); const int kk = kp * 128 + k; a0 += wv * sv[kk]; a1 += wv * sv[DM + kk]; a2 += wv * sv[2 * DM + kk]; }
            *(LAS f32x4*)(red + (kp * 3 + 0) * 256 + 4 * F.lane) = a0; *(LAS f32x4*)(red + (kp * 3 + 1) * 256 + 4 * F.lane) = a1; *(LAS f32x4*)(red + (kp * 3 + 2) * 256 + 4 * F.lane) = a2;
            __syncthreads();
            for (int o = F.tid; o < 3 * 256; o += NTHREADS) { const int t = o >> 8, nn = o & 255; float sacc = AIN(5)[l * 6144 + n0 + nn];
                for (int q = 0; q < 8; ++q) sacc += red[(q * 3 + t) * 256 + nn];
                ((float*)(F.ws + WS_MODV))[(size_t)(l * 3 + t) * 6144 + n0 + nn] = sacc; }
            __syncthreads();
        }
    }
    for (int i = gt; i < 128 * 32 + 128 * 16; i += NGT) {
        if (i < 128 * 32) { const int p = i >> 5, f = i & 31; const float inv = powf(10000.f, -(float)(2 * f) / 64.f), ang = (float)p * inv;
            ((float*)(F.ws + WS_TABA))[2 * i] = cosf(ang); ((float*)(F.ws + WS_TABA))[2 * i + 1] = sinf(ang); }
        else { const int ii = i - 128 * 32, p = ii >> 4, f = ii & 15; const float inv = powf(10000.f, -(float)(2 * f) / 32.f), ang = (float)p * inv;
            ((float*)(F.ws + WS_TABC))[2 * ii] = cosf(ang); ((float*)(F.ws + WS_TABC))[2 * ii + 1] = sinf(ang); }
    }
    if (F.bid == 0 && F.wave < 2) { const int i = F.wave; const float a = AIN(13)[i * 64 + F.lane] * AIN(14)[i * 64 + F.lane], b = AIN(15)[i * 64 + F.lane] * AIN(16)[i * 64 + F.lane];
        const float sa = wave_sum(a), sb = wave_sum(b); const int l = 2 * i + 1; const float lam_init = 0.8f - 0.6f * expf(-0.3f * (float)l);
        if (F.lane == 0) { ((float*)(F.ws + WS_LAM))[2 * i] = expf(sa) - expf(sb) + lam_init; ((float*)(F.ws + WS_LAM))[2 * i + 1] = lam_init; } }
    {
        __syncthreads();
        LAS float* scr = (LAS float*)F.lds + F.wave * (64 * 65);
        constexpr int I_INE = (DM / 64) * (EIN / 64), I_OUT = (DM / 64) * (DM / 64), I_INO = (DM / 64) * (OIN / 64), I_G = (DM / 64) * (DEXP / 64), I_D = (DEXP / 64) * (DM / 64);
        constexpr int T_INE = 2 * I_INE, T_OUTE = 2 * I_OUT, T_INO = 2 * I_INO, T_OUTO = 2 * I_OUT, T_G = 64 * I_G, T_U = 64 * I_G, T_D = 64 * I_D;
        constexpr int NITEMS = T_INE + T_OUTE + T_INO + T_OUTO + T_G + T_U + T_D;
        for (int it = gw; it < NITEMS; it += NGW) {
            int r = it;
            if (r < T_INE) { const int i = r / I_INE; transpose_item(AIN(6) + (size_t)i * DM * EIN, DM, EIN, (bf16*)(F.ws + WS_WINE) + (size_t)i * EIN * DM, DM, [](int n) { return n; }, scr, r % I_INE, F.lane); continue; } r -= T_INE;
            if (r < T_OUTE) { const int i = r / I_OUT, item = r % I_OUT;
                if (item / (DM / 64) < 12) transpose_item(AIN(7) + (size_t)i * DM * DM, DM, DM, (bf16*)(F.ws + WS_WOUTE) + (size_t)i * DM * OAE, OAE, [](int n) { return n; }, scr, item, F.lane);
                continue; } r -= T_OUTE;
            if (r < T_INO) { const int i = r / I_INO; transpose_item(AIN(11) + (size_t)i * DM * OIN, DM, OIN, (bf16*)(F.ws + WS_WINO) + (size_t)i * OIN * DM, DM, [](int n) { return n; }, scr, r % I_INO, F.lane); continue; } r -= T_INO;
            if (r < T_OUTO) { const int i = r / I_OUT; transpose_item(AIN(12) + (size_t)i * DM * DM, DM, DM, (bf16*)(F.ws + WS_WOUTO) + (size_t)i * DM * DM, DM, [](int n) { return n; }, scr, r % I_OUT, F.lane); continue; } r -= T_OUTO;
            if (r < T_G) { const int le = r / I_G; transpose_item(AIN(22) + (size_t)le * DM * DEXP, DM, DEXP, (bf16*)(F.ws + WS_WGU) + (size_t)le * DM * DM, DM, [](int n) { return (n >> 7) * 256 + (n & 127); }, scr, r % I_G, F.lane); continue; } r -= T_G;
            if (r < T_U) { const int le = r / I_G; transpose_item(AIN(23) + (size_t)le * DM * DEXP, DM, DEXP, (bf16*)(F.ws + WS_WGU) + (size_t)le * DM * DM, DM, [](int n) { return (n >> 7) * 256 + 128 + (n & 127); }, scr, r % I_G, F.lane); continue; } r -= T_U;
            { const int le = r / I_D; transpose_item(AIN(24) + (size_t)le * DEXP * DM, DEXP, DM, (bf16*)(F.ws + WS_WD) + (size_t)le * DM * DEXP, DEXP, [](int n) { return n; }, scr, r % I_D, F.lane); }
        }
    }
    for (int o = gt; o < 2 * 2 * 256 * DM; o += NGT) {
        const int n = o & 1023, gc = (o >> 10) & 255, ri = (o >> 18) & 1, i = o >> 19, g = gc >> 6, c = gc & 63;
        const float* w = AIN(7) + (size_t)i * DM * DM + (size_t)(768 + 64 * g) * DM + n;
        float a = 0.f;
        for (int m = 0; m < 64; ++m) { const float fr = (float)((m * c) & 63) * (1.f / 64.f); const float t = ri ? __builtin_amdgcn_sinf(fr) : __builtin_amdgcn_cosf(fr); a += t * w[(size_t)m * DM]; }
        ((bf16*)(F.ws + WS_WOUTE))[(size_t)i * DM * OAE + (size_t)n * OAE + 768 + ri * 256 + gc] = (bf16)f2bf(a);
    }
}

__device__ __forceinline__ void phase_pro_b(const Frame& F_, const Args& A) { const Frame F = fresh(F_);
    const int gw = F.bid * NWAVES + F.wave, NGW = F.G * NWAVES;
    for (int r = gw; r < NTOK; r += NGW) {
        const int b = r / TPB, j = r - b * TPB, type = j < CTX ? 2 : b;
        const float* src = j < CTX ? AIN(2) + (size_t)(b * CTX + j) * DM : AIN(0) + (size_t)(b * SEQ + (j - CTX)) * DM;
        f32x4 v[4]; load_row_f32(src, F.lane, v);
        store_row_f32((float*)(F.ws + WS_X) + (size_t)r * DM, F.lane, v);
        modnorm_store(v, modv(F, 0, type, 1), modv(F, 0, type, 0), (bf16*)(F.ws + WS_HA) + (size_t)r * DM, F.lane);
    }
}

__device__ __forceinline__ void unpack8(const u32x4 w, float (&v)[8]) { v[0] = bflo(w.x); v[1] = bfhi(w.x); v[2] = bflo(w.y); v[3] = bfhi(w.y); v[4] = bflo(w.z); v[5] = bfhi(w.z); v[6] = bflo(w.w); v[7] = bfhi(w.w); }
__device__ __forceinline__ u32x4 pack8(const float (&v)[8]) { u32x4 w; w.x = pk2(v[0], v[1]); w.y = pk2(v[2], v[3]); w.z = pk2(v[4], v[5]); w.w = pk2(v[6], v[7]); return w; }

__device__ __forceinline__ void phase_qkfix_e(const Frame& F_, const Args& A, int i) { const Frame F = fresh(F_);
    const int gw = F.bid * NWAVES + F.wave, NGW = F.G * NWAVES, lane = F.lane;
    const float* qg = AIN(8) + i * 128; const float* kg = AIN(9) + i * 128; const float* bg = AIN(10) + i * 256;
    const float* tab = (const float*)(F.ws + WS_TABA);
    for (int r = gw; r < NTOK; r += NGW) {
        const int b = r / TPB, j = r - b * TPB; const bool lat = j >= CTX; const int t = j - CTX, prow = t >> 6, pcol = t & 63;
        bf16* P = (bf16*)(F.ws + WS_PBUF) + (size_t)r * EIN;
#pragma unroll
        for (int it = 0; it < 2; ++it) {
            GAS u32x4* p = (GAS u32x4*)(P + 512 * it) + lane;
            float v[8], y[8], o[8]; unpack8(*p, v);
            float ss = 0.f;
#pragma unroll
            for (int e = 0; e < 8; ++e) ss += v[e] * v[e];
            ss += swz_xor<1>(ss); ss += swz_xor<2>(ss); ss += swz_xor<4>(ss); ss += swz_xor<8>(ss);
            const float rstd = rsqrtf(ss * (1.f / 128.f) + EPS);
            const bool isk = (it == 1) && (lane >= 32);
            const int d0 = 8 * (lane & 15);
            const float* gp = (isk ? kg : qg) + d0;
#pragma unroll
            for (int e = 0; e < 8; ++e) y[e] = v[e] * rstd * gp[e];
            const int quarter = (lane & 15) >> 2, fi = 8 * (lane & 3);
            const int pos = quarter < 2 ? prow : pcol;
#pragma unroll
            for (int e = 0; e < 8; ++e) {
                const float pv = swz_xor<4>(y[e]);
                const float c = lat ? tab[2 * (pos * 32 + fi + e)] : 1.f, s = lat ? tab[2 * (pos * 32 + fi + e) + 1] : 0.f;
                o[e] = (quarter & 1) ? (pv * s + y[e] * c) : (y[e] * c - pv * s);
            }
            *p = pack8(o);
        }
        {
            GAS u32x4* p = (GAS u32x4*)(P + 1024) + lane;
            float v[8], o[8]; unpack8(*p, v);
            float ss = 0.f;
#pragma unroll
            for (int e = 0; e < 8; ++e) ss += v[e] * v[e];
            ss += swz_xor<1>(ss); ss += swz_xor<2>(ss); ss += swz_xor<4>(ss);
            const float rstd = rsqrtf(ss * (1.f / 64.f) + EPS);
            const float* gp = bg + 8 * (lane & 31);
#pragma unroll
            for (int e = 0; e < 8; ++e) o[e] = v[e] * rstd * gp[e];
            if (lane >= 32) *p = pack8(o);
        }
    }
}
__device__ __forceinline__ void phase_qkfix_o(const Frame& F_) { const Frame F = fresh(F_);
    const int gw = F.bid * NWAVES + F.wave, NGW = F.G * NWAVES, lane = F.lane;
    const float* tab = (const float*)(F.ws + WS_TABC);
    for (int r = gw; r < NTOK; r += NGW) {
        const int b = r / TPB, j = r - b * TPB; if (j < CTX) continue;
        const int t = j - CTX, prow = t >> 6, pcol = t & 63;
        bf16* P = (bf16*)(F.ws + WS_PBUF) + (size_t)r * OIN;
#pragma unroll
        for (int it = 0; it < 4; ++it) {
            GAS u32x4* p = (GAS u32x4*)(P + 512 * it) + lane;
            float y[8], o[8]; unpack8(*p, y);
            const int quarter = (lane & 7) >> 1, fi = 8 * (lane & 1);
            const int pos = quarter < 2 ? prow : pcol;
#pragma unroll
            for (int e = 0; e < 8; ++e) {
                const float pv = swz_xor<2>(y[e]);
                const float c = tab[2 * (pos * 16 + fi + e)], s = tab[2 * (pos * 16 + fi + e) + 1];
                o[e] = (quarter & 1) ? (pv * s + y[e] * c) : (y[e] * c - pv * s);
            }
            *p = pack8(o);
        }
    }
}
__device__ __forceinline__ void phase_finish_o(const Frame& F_, const Args& A, int i) { const Frame F = fresh(F_);
    const int gw = F.bid * NWAVES + F.wave, NGW = F.G * NWAVES, lane = F.lane;
    const float lam = ((const float*)(F.ws + WS_LAM))[2 * i], post = 1.f - ((const float*)(F.ws + WS_LAM))[2 * i + 1];
    const float* hg = AIN(17) + i * 128 + 8 * (lane & 15);
    for (int r = gw; r < NTOK; r += NGW) {
        const bf16* T = (const bf16*)(F.ws + WS_OT) + (size_t)r * OTW; bf16* O = (bf16*)(F.ws + WS_OA) + (size_t)r * OAO;
#pragma unroll
        for (int it = 0; it < 4; ++it) {
            float v[8], o[8]; unpack8(*((const GAS u32x4*)(T + 512 * it) + lane), v);
            float ss = 0.f;
#pragma unroll
            for (int e = 0; e < 8; ++e) { const float pv = swz_xor<16>(v[e]); o[e] = v[e] - lam * pv; ss += o[e] * o[e]; }
            ss += swz_xor<1>(ss); ss += swz_xor<2>(ss); ss += swz_xor<4>(ss); ss += swz_xor<8>(ss);
            const float rstd = rsqrtf(ss * (1.f / 128.f) + EPS) * post;
#pragma unroll
            for (int e = 0; e < 8; ++e) o[e] = o[e] * rstd * hg[e];
            if (((lane >> 4) & 1) == 0) *(GAS u32x4*)(O + (2 * it + (lane >> 5)) * 128 + 8 * (lane & 15)) = pack8(o);
        }
    }
}

__device__ __forceinline__ void phase_router(const Frame& F_, const Args& A, int l) { const Frame F = fresh(F_);
    LAS float* wc = (LAS float*)F.lds;
    LAS int* lcnt = (LAS int*)(F.lds + 81920);
    LAS int* gb = lcnt + 16;
    LAS int* rec = gb + 16;
    LAS float* recw = (LAS float*)(rec + 72 * 4);
    const int lane = F.lane;
    __syncthreads();
    for (int i = F.tid; i < DM * 20; i += NTHREADS) { const int k = i / 20, c = i % 20; wc[i] = c < 4 ? AIN(18)[(size_t)l * DM * 4 + k * 4 + c] : AIN(20)[(size_t)l * DM * 16 + k * 16 + (c - 4)]; }
    if (F.tid < 16) lcnt[F.tid] = 0;
    __syncthreads();
    const int nmine = (NTOK - F.bid + F.G - 1) / F.G;
    for (int it = F.wave; it < nmine; it += NWAVES) {
        const int r = F.bid + it * F.G, type = row_type(r);
        f32x4 v[4]; load_row_f32((const float*)(F.ws + WS_X) + (size_t)r * DM, lane, v);
        const float rstd = row_rstd(v);
        f32x4 s[4], h[4]; load_row_f32(modv(F, l, type, 4), lane, s); load_row_f32(modv(F, l, type, 3), lane, h);
#pragma unroll
        for (int j = 0; j < 4; ++j) v[j] = v[j] * rstd * (s[j] + 1.f) + h[j];
        store_row_bf16((bf16*)(F.ws + WS_HA) + (size_t)r * DM, lane, v);
        float lg[20];
#pragma unroll
        for (int c = 0; c < 20; ++c) lg[c] = 0.f;
#pragma unroll
        for (int j = 0; j < 4; ++j)
#pragma unroll
            for (int e = 0; e < 4; ++e) { const LAS float* wr = wc + (4 * lane + 256 * j + e) * 20; const float xv = v[j][e];
#pragma unroll
                for (int c = 0; c < 20; ++c) lg[c] += xv * wr[c]; }
#pragma unroll
        for (int c = 0; c < 20; ++c) lg[c] = wave_sum(lg[c]);
        if (lane == 0) {
            float gl[4]; int gi = 0;
#pragma unroll
            for (int g = 0; g < 4; ++g) gl[g] = lg[g] + AIN(19)[l * 4 + g];
#pragma unroll
            for (int g = 1; g < 4; ++g) if (gl[g] > gl[gi]) gi = g;
            float gs = 0.f;
#pragma unroll
            for (int g = 0; g < 4; ++g) gs += expf(gl[g] - gl[gi]);
            const float ggate = 1.f / gs;
            float el[4];
#pragma unroll
            for (int e = 0; e < 4; ++e) { float x = 0.f;
#pragma unroll
                for (int g = 0; g < 4; ++g) x = (g == gi) ? lg[4 + 4 * g + e] + AIN(21)[l * 16 + 4 * g + e] : x;
                el[e] = x; }
            int i0 = 0;
#pragma unroll
            for (int e = 1; e < 4; ++e) if (el[e] > el[i0]) i0 = e;
            int i1 = (i0 == 0) ? 1 : 0;
#pragma unroll
            for (int e = 0; e < 4; ++e) if (e != i0 && el[e] > el[i1]) i1 = e;
            const float p1 = expf(el[i1] - el[i0]);
            const float w0 = ggate / (1.f + p1), w1 = ggate * p1 / (1.f + p1);
            const int e0 = gi * 4 + i0, e1 = gi * 4 + i1;
            const int lp0 = __hip_atomic_fetch_add(lcnt + e0, 1, __ATOMIC_RELAXED, __HIP_MEMORY_SCOPE_WORKGROUP);
            const int lp1 = __hip_atomic_fetch_add(lcnt + e1, 1, __ATOMIC_RELAXED, __HIP_MEMORY_SCOPE_WORKGROUP);
            rec[it * 4 + 0] = e0; rec[it * 4 + 1] = lp0; rec[it * 4 + 2] = e1; rec[it * 4 + 3] = lp1; recw[it * 2] = w0; recw[it * 2 + 1] = w1;
        }
    }
    __syncthreads();
    if (F.tid < 16) gb[F.tid] = (int)__hip_atomic_fetch_add((unsigned*)(F.ws + WS_CTL) + CW_CNT + 64 * l + F.tid, (unsigned)lcnt[F.tid], __ATOMIC_RELAXED, __HIP_MEMORY_SCOPE_AGENT);
    __syncthreads();
    if (F.tid < nmine) { const int it = F.tid, r = F.bid + it * F.G; const int e0 = rec[it * 4], e1 = rec[it * 4 + 2];
        const int q0 = gb[e0] + rec[it * 4 + 1], q1 = gb[e1] + rec[it * 4 + 3];
        ((GAS i32x4*)(F.ws + WS_SELA))[r] = (i32x4){e0, q0, e1, q1};
        ((GAS int*)(F.ws + WS_ROWTOK))[(size_t)e0 * NTOK + q0] = r; ((GAS int*)(F.ws + WS_ROWTOK))[(size_t)e1 * NTOK + q1] = r;
        ((GAS f32x2*)(F.ws + WS_SELW))[r] = (f32x2){recw[it * 2], recw[it * 2 + 1]}; }
    __syncthreads();
}
__device__ __forceinline__ void moe_bases(const Frame& F, int l, int (&base)[17]) {
    const unsigned* cnt = (const unsigned*)(F.ws + WS_CTL) + CW_CNT + 64 * l;
    int acc = 0;
#pragma unroll
    for (int e = 0; e < 16; ++e) { base[e] = acc; const int c = __builtin_amdgcn_readfirstlane((int)__hip_atomic_load(cnt + e, __ATOMIC_RELAXED, __HIP_MEMORY_SCOPE_AGENT)); acc += ((c + 255) >> 8) << 8; }
    base[16] = acc;
}
__device__ __forceinline__ void phase_gather(const Frame& F_, int l) { const Frame F = fresh(F_);
    const int gw = F.bid * NWAVES + F.wave, NGW = F.G * NWAVES, lane = F.lane;
    int base[17]; moe_bases(F, l, base);
    for (int r = gw; r < NTOK; r += NGW) {
        const i32x4 s = ((const GAS i32x4*)(F.ws + WS_SELA))[r];
        int b0 = 0, b1 = 0;
#pragma unroll
        for (int e = 0; e < 16; ++e) { b0 = (s.x == e) ? base[e] : b0; b1 = (s.z == e) ? base[e] : b1; }
        const int r0 = b0 + s.y, r1 = b1 + s.w;
        const GAS u32x4* src = (const GAS u32x4*)((const bf16*)(F.ws + WS_HA) + (size_t)r * DM) + lane;
        const u32x4 a = src[0], c = src[64];
        GAS u32x4* d0 = (GAS u32x4*)((bf16*)(F.ws + WS_XS) + (size_t)r0 * DM) + lane; d0[0] = a; d0[64] = c;
        GAS u32x4* d1 = (GAS u32x4*)((bf16*)(F.ws + WS_XS) + (size_t)r1 * DM) + lane; d1[0] = a; d1[64] = c;
        if (lane == 0) ((GAS i32x2*)(F.ws + WS_RPOS))[r] = (i32x2){r0, r1};
    }
}
__device__ __forceinline__ void phase_combine(const Frame& F_, const Args& A, int l) { const Frame F = fresh(F_);
    const int gw = F.bid * NWAVES + F.wave, NGW = F.G * NWAVES, lane = F.lane;
    int base[17]; moe_bases(F, l, base);
    for (int r = gw; r < NTOK; r += NGW) {
        const int b = r / TPB, j = r - b * TPB, type = j < CTX ? 2 : b;
        if (l == DEPTH - 1 && j < CTX) continue;
        const i32x4 sel = ((const GAS i32x4*)(F.ws + WS_SELA))[r]; const f32x2 w = ((const GAS f32x2*)(F.ws + WS_SELW))[r];
        int b0_ = 0, b1_ = 0;
#pragma unroll
        for (int e = 0; e < 16; ++e) { b0_ = (sel.x == e) ? base[e] : b0_; b1_ = (sel.z == e) ? base[e] : b1_; }
        const i32x2 rp = (i32x2){b0_ + sel.y, b1_ + sel.w};
        f32x4 x[4], y0[4], y1[4], g[4];
        float* xp = (float*)(F.ws + WS_X) + (size_t)r * DM;
        load_row_f32(xp, lane, x); load_row_bf16((const bf16*)(F.ws + WS_Y2S) + (size_t)rp.x * DM, lane, y0); load_row_bf16((const bf16*)(F.ws + WS_Y2S) + (size_t)rp.y * DM, lane, y1);
        load_row_f32(modv(F, l, type, 5), lane, g);
#pragma unroll
        for (int q = 0; q < 4; ++q) x[q] = x[q] + g[q] * (y0[q] * w.x + y1[q] * w.y);
        if (l < DEPTH - 1) {
            store_row_f32(xp, lane, x);
            modnorm_store(x, modv(F, l + 1, type, 1), modv(F, l + 1, type, 0), (bf16*)(F.ws + WS_HA) + (size_t)r * DM, lane);
        } else {
            const float rstd = row_rstd(x);
            f32x4 fg[4]; load_row_f32(AIN(25), lane, fg);
#pragma unroll
            for (int q = 0; q < 4; ++q) x[q] = x[q] * rstd * fg[q];
            store_row_f32(A.out + (size_t)(b * SEQ + (j - CTX)) * DM, lane, x);
        }
    }
}

__device__ __forceinline__ void sphase_gemm_bf16(const Frame& F_, const bf16* Am, int lda, const bf16* Bt, int ldb, bf16* C, int ldc, int M, int N, int K) { const Frame F = fresh(F_);
    LAS float* As = (LAS float*)F.lds; LAS float* Bs = As + 16 * SG_AS;
    const int nm = M / 128, nn = N / 64, ty = F.tid >> 4, tx = F.tid & 15;
    for (int t = F.bid; t < nm * nn; t += F.G) {
        const int tm = t / nn, tn = t % nn; const bf16* a0 = Am + (size_t)tm * 128 * lda; const bf16* b0 = Bt + (size_t)tn * 64 * ldb;
        float acc[4][4];
        sg_tile(As, Bs, K, [&](int m, int k) { return bf2f(a0[(size_t)m * lda + k]); }, [&](int k, int n) { return bf2f(b0[(size_t)n * ldb + k]); }, acc, F.tid);
#pragma unroll
        for (int i = 0; i < 4; ++i) { u32x2 w; w.x = pk2(acc[i][0], acc[i][1]); w.y = pk2(acc[i][2], acc[i][3]);
            *(GAS u32x2*)(C + (size_t)(tm * 128 + 4 * ty + i) * ldc + tn * 64 + 4 * tx) = w; }
    }
}
__device__ __forceinline__ void sphase_outproj(const Frame& F_, const bf16* Am, int lda, const bf16* Bt, int K, int l) { const Frame F = fresh(F_);
    LAS float* As = (LAS float*)F.lds; LAS float* Bs = As + 16 * SG_AS;
    const int nm = NTOK / 128, nn = DM / 64, ty = F.tid >> 4, tx = F.tid & 15;
    for (int t = F.bid; t < nm * nn; t += F.G) {
        const int tm = t / nn, tn = t % nn; const bf16* a0 = Am + (size_t)tm * 128 * lda; const bf16* b0 = Bt + (size_t)tn * 64 * K;
        float acc[4][4];
        sg_tile(As, Bs, K, [&](int m, int k) { return bf2f(a0[(size_t)m * lda + k]); }, [&](int k, int n) { return bf2f(b0[(size_t)n * K + k]); }, acc, F.tid);
#pragma unroll
        for (int i = 0; i < 4; ++i) { const int r = tm * 128 + 4 * ty + i, c = tn * 64 + 4 * tx;
            const f32x4 g = *(const GAS f32x4*)(modv(F, l, row_type(r), 2) + c);
            GAS f32x4* xp = (GAS f32x4*)((float*)(F.ws + WS_X) + (size_t)r * DM + c); f32x4 x = *xp;
            x.x += g.x * acc[i][0]; x.y += g.y * acc[i][1]; x.z += g.z * acc[i][2]; x.w += g.w * acc[i][3]; *xp = x; }
    }
}
__device__ __forceinline__ int moe_expert_of_row(const int (&base)[17], int row) { int e = 0;
#pragma unroll
    for (int q = 1; q < 16; ++q) e = (row >= base[q]) ? q : e;
    return e; }
__device__ __forceinline__ void sphase_moe_gu(const Frame& F_, int l) { const Frame F = fresh(F_);
    LAS float* As = (LAS float*)F.lds; LAS float* Bs = As + 16 * SG_AS;
    int base[17]; moe_bases(F, l, base);
    const int nm = base[16] / 128, nn = DEXP / 64, ty = F.tid >> 4, tx = F.tid & 15;
    for (int t = F.bid; t < nm * nn; t += F.G) {
        const int tm = t / nn, tn = t % nn, e = moe_expert_of_row(base, tm * 128);
        const bf16* a0 = (const bf16*)(F.ws + WS_XS) + (size_t)tm * 128 * DM;
        const bf16* w = (const bf16*)(F.ws + WS_WGU) + (size_t)(l * 16 + e) * DM * DM;
        const int hc0 = tn * 64;
        const bf16* bg0 = w + (size_t)((hc0 >> 7) * 256 + (hc0 & 127)) * DM; const bf16* bu0 = bg0 + (size_t)128 * DM;
        float ag[4][4], au[4][4];
        sg_tile(As, Bs, DM, [&](int m, int k) { return bf2f(a0[(size_t)m * DM + k]); }, [&](int k, int n) { return bf2f(bg0[(size_t)n * DM + k]); }, ag, F.tid);
        sg_tile(As, Bs, DM, [&](int m, int k) { return bf2f(a0[(size_t)m * DM + k]); }, [&](int k, int n) { return bf2f(bu0[(size_t)n * DM + k]); }, au, F.tid);
#pragma unroll
        for (int i = 0; i < 4; ++i) { float h[4];
#pragma unroll
            for (int j = 0; j < 4; ++j) h[j] = silu_f(ag[i][j]) * au[i][j];
            u32x2 wv; wv.x = pk2(h[0], h[1]); wv.y = pk2(h[2], h[3]);
            *(GAS u32x2*)((bf16*)(F.ws + WS_HID) + (size_t)(tm * 128 + 4 * ty + i) * DEXP + hc0 + 4 * tx) = wv; }
    }
}
__device__ __forceinline__ void sphase_moe_down(const Frame& F_, int l) { const Frame F = fresh(F_);
    LAS float* As = (LAS float*)F.lds; LAS float* Bs = As + 16 * SG_AS;
    int base[17]; moe_bases(F, l, base);
    const int nm = base[16] / 128, nn = DM / 64, ty = F.tid >> 4, tx = F.tid & 15;
    for (int t = F.bid; t < nm * nn; t += F.G) {
        const int tm = t / nn, tn = t % nn, e = moe_expert_of_row(base, tm * 128);
        const bf16* a0 = (const bf16*)(F.ws + WS_HID) + (size_t)tm * 128 * DEXP;
        const bf16* b0 = (const bf16*)(F.ws + WS_WD) + (size_t)(l * 16 + e) * DM * DEXP + (size_t)tn * 64 * DEXP;
        float acc[4][4];
        sg_tile(As, Bs, DEXP, [&](int m, int k) { return bf2f(a0[(size_t)m * DEXP + k]); }, [&](int k, int n) { return bf2f(b0[(size_t)n * DEXP + k]); }, acc, F.tid);
#pragma unroll
        for (int i = 0; i < 4; ++i) { u32x2 w; w.x = pk2(acc[i][0], acc[i][1]); w.y = pk2(acc[i][2], acc[i][3]);
            *(GAS u32x2*)((bf16*)(F.ws + WS_Y2S) + (size_t)(tm * 128 + 4 * ty + i) * DM + tn * 64 + 4 * tx) = w; }
    }
}


#ifndef FAST_GEMM
#define FAST_GEMM 1
#endif
__device__ __forceinline__ void fphase_inproj(const Frame& F_, bool even, int i) { const Frame F = fresh(F_);
    if (even) {
        pg8::Gemm g{(const bf16*)(F.ws + WS_HA), (const bf16*)(F.ws + WS_WINE) + (size_t)i * EIN * DM, NTOK, EIN, DM, 0};
        pg8::StaticOrder S; S.init(NTOK, EIN, F.G, F.bid);
        pg8::EpiBf16<0> E{(bf16*)(F.ws + WS_PBUF), EIN, nullptr, 0, 0, 1.f};
        pg8::gemm_phase<pg8::EpiBf16<0>, pg8::StaticOrder, true, true>(F.lds, g, S, E, F.tid);
    } else {
        pg8::Gemm g{(const bf16*)(F.ws + WS_HA), (const bf16*)(F.ws + WS_WINO) + (size_t)i * OIN * DM, NTOK, OIN, DM, 0};
        pg8::StaticOrder S; S.init(NTOK, OIN, F.G, F.bid);
        pg8::EpiRopeO E{(bf16*)(F.ws + WS_PBUF), OIN, (const float*)(F.ws + WS_TABC), 8, (ATTN_RING3 && ATTN_NEGM) ? 4 : 0, 0.125f * 1.4426950408889634f};
        pg8::gemm_phase<pg8::EpiRopeO, pg8::StaticOrder, true, true>(F.lds, g, S, E, F.tid);
    }
}
__device__ __forceinline__ void fphase_outproj(const Frame& F_, bool even, int i, int l) { const Frame F = fresh(F_);
    const int K = even ? OAE : OAO;
    const bf16* Bt = even ? (const bf16*)(F.ws + WS_WOUTE) + (size_t)i * DM * OAE : (const bf16*)(F.ws + WS_WOUTO) + (size_t)i * DM * DM;
    pg8::Gemm g{(const bf16*)(F.ws + WS_OA), Bt, NTOK, DM, K, 0};
    pg8::StaticOrder S; S.init(NTOK, DM, F.G, F.bid);
    pg8::EpiResGate E{(float*)(F.ws + WS_X), modv(F, l, 0, 2)};
    pg8::gemm_phase<pg8::EpiResGate, pg8::StaticOrder, true, true>(F.lds, g, S, E, F.tid);
}
__device__ __forceinline__ void fphase_moe_gu(const Frame& F_, int l) { const Frame F = fresh(F_);
    int base[17]; moe_bases(F, l, base);
    LAS int* tbl = (LAS int*)(F.lds + TB_OFF);
    __syncthreads();
#pragma unroll
    for (int e = 0; e < 17; ++e) if (F.tid == e) tbl[e] = base[e] >> 8;
    __syncthreads();
    pg8::MoeOrder S; S.tb = tbl; S.nN = 4; S.nwg = (base[16] >> 8) * 4; S.G = F.G; S.c = F.bid;
    pg8::Gemm g{(const bf16*)(F.ws + WS_HA), (const bf16*)(F.ws + WS_WGU) + (size_t)l * 16 * DM * DM, base[16], DM, DM, (size_t)DM * DM * 2, (const int*)(F.ws + WS_ROWTOK), NTOK};
    pg8::EpiSwiGLU E{(bf16*)(F.ws + WS_HID)};
    pg8::gemm_phase<pg8::EpiSwiGLU, pg8::MoeOrder, true, true, true>(F.lds, g, S, E, F.tid);
}
__device__ __forceinline__ void fphase_moe_down(const Frame& F_, int l) { const Frame F = fresh(F_);
    int base[17]; moe_bases(F, l, base);
    LAS int* tbl = (LAS int*)(F.lds + TB_OFF);
    __syncthreads();
#pragma unroll
    for (int e = 0; e < 17; ++e) if (F.tid == e) tbl[e] = base[e] >> 8;
    __syncthreads();
    pg8::MoeOrder S; S.tb = tbl; S.nN = 4; S.nwg = (base[16] >> 8) * 4; S.G = F.G; S.c = F.bid;
    pg8::Gemm g{(const bf16*)(F.ws + WS_HID), (const bf16*)(F.ws + WS_WD) + (size_t)l * 16 * DM * DEXP, base[16], DM, DEXP, (size_t)DM * DEXP * 2};
    pg8::EpiBf16<0> E{(bf16*)(F.ws + WS_Y2S), DM, nullptr, 0, 0, 1.f};
    pg8::gemm_phase<pg8::EpiBf16<0>, pg8::MoeOrder, true, true>(F.lds, g, S, E, F.tid);
}

__device__ __forceinline__ void sphase_fft1(const Frame& F_) { const Frame F = fresh(F_);
    const int gt = F.bid * NTHREADS + F.tid, NGT = F.G * NTHREADS;
    for (int o = gt; o < NB * 128 * 2 * 64 * 256; o += NGT) {
        const int col = o & 255, t2 = (o >> 8) & 63, ri = (o >> 14) & 1, k1 = (o >> 15) & 127, b = o >> 22;
        const bf16* f = (const bf16*)(F.ws + WS_PBUF) + (size_t)(b * TPB + CTX + t2) * EIN + 1280 + col;
        float a = 0.f;
        for (int t1 = 0; t1 < 128; ++t1) { const int t = 64 * t1 + t2; const float fr = (float)((k1 * t) & 8191) * (1.f / 8192.f);
            const float c = ri ? -__builtin_amdgcn_sinf(fr) : __builtin_amdgcn_cosf(fr); a += c * bf2f(f[(size_t)(64 * t1) * EIN]); }
        ((bf16*)(F.ws + WS_YB))[o] = (bf16)f2bf(a);
    }
}
__device__ __forceinline__ void sphase_fft2(const Frame& F_) { const Frame F = fresh(F_);
    const int gt = F.bid * NTHREADS + F.tid, NGT = F.G * NTHREADS;
    const float norm = 1.f / sqrtf(8192.f * 64.f);
    for (int o = gt; o < NB * SEQ * 2 * 256; o += NGT) {
        const int col = o & 255, ri = (o >> 8) & 1, k = (o >> 9) & 8191, b = o >> 22, k1 = k & 127, k2 = k >> 7;
        const bf16* yr = (const bf16*)(F.ws + WS_YB) + ((size_t)((b * 128 + k1) * 2 + 0) * 64) * 256 + col; const bf16* yi = yr + 64 * 256;
        float a = 0.f;
        for (int t2 = 0; t2 < 64; ++t2) { const float fr = (float)((k2 * t2) & 63) * (1.f / 64.f), c = __builtin_amdgcn_cosf(fr), s = __builtin_amdgcn_sinf(fr);
            const float vr = bf2f(yr[t2 * 256]), vi = bf2f(yi[t2 * 256]);
            a += ri ? (c * vi - s * vr) : (c * vr + s * vi); }
        ((bf16*)(F.ws + WS_OA))[(size_t)(b * TPB + CTX + k) * OAE + 768 + ri * 256 + col] = (bf16)f2bf(a * norm);
    }
}
__device__ __forceinline__ void sphase_fftc(const Frame& F_) { const Frame F = fresh(F_);
    const int gt = F.bid * NTHREADS + F.tid, NGT = F.G * NTHREADS;
    const float norm = 1.f / sqrtf(256.f * 64.f);
    for (int o = gt; o < NB * CTX * 2 * 256; o += NGT) {
        const int col = o & 255, ri = (o >> 8) & 1, k = (o >> 9) & 255, b = o >> 17;
        const bf16* f = (const bf16*)(F.ws + WS_PBUF) + (size_t)(b * TPB) * EIN + 1280 + col;
        float a = 0.f;
        for (int t = 0; t < CTX; ++t) { const float fr = (float)((k * t) & 255) * (1.f / 256.f); const float c = ri ? -__builtin_amdgcn_sinf(fr) : __builtin_amdgcn_cosf(fr); a += c * bf2f(f[(size_t)t * EIN]); }
        ((bf16*)(F.ws + WS_OA))[(size_t)(b * TPB + k) * OAE + 768 + ri * 256 + col] = (bf16)f2bf(a * norm);
    }
}


namespace fa {
using bf16x8 = __attribute__((ext_vector_type(8))) short;
using s16x4  = __attribute__((ext_vector_type(4))) short;
using f32x16 = __attribute__((ext_vector_type(16))) float;
constexpr int NW = 8, QBLK = 32, KVBLK = 64, DV = 128;
constexpr float THR = 8.f;
constexpr int SHM_V = KVBLK * DV * 2;
template <int DQK> struct Cfg { static constexpr float SCALE = DQK == 128 ? 0.088388347648318440f : 0.125f; static constexpr int RB = DQK * 2, SHM_K = KVBLK * DQK * 2, ND0 = DQK / 16; };
#define FA_KSWZ(row, colB, RB) ((row) * (RB) + ((colB) ^ (((RB) == 256 ? ((row) & 15) : (((row) >> 1) & 7)) << 4)))
#define FA_SBAR() __builtin_amdgcn_sched_barrier(0)
__device__ __forceinline__ int crow(int r, int hi) { return (r & 3) + 8 * (r >> 2) + 4 * hi; }
__device__ __forceinline__ unsigned cvtpk(float lo, float hi) { unsigned r; asm volatile("v_cvt_pk_bf16_f32 %0, %1, %2" : "=v"(r) : "v"(lo), "v"(hi)); return r; }
template <int DQK>
__device__ __forceinline__ void partialSM(f32x16& p0, f32x16& p1, float& m_reg, float& mn, float& alpha) {
  constexpr float SCALE = Cfg<DQK>::SCALE, C = SCALE * 1.4426950408889634f;
  float pmax = p0[0];
#pragma unroll
  for (int r = 1; r < 16; ++r) pmax = fmaxf(pmax, p0[r]);
#pragma unroll
  for (int r = 0; r < 16; ++r) pmax = fmaxf(pmax, p1[r]);
  { auto rr = __builtin_amdgcn_permlane32_swap(__float_as_uint(pmax), __float_as_uint(pmax), false, false);
    pmax = fmaxf(__uint_as_float(rr[0]), __uint_as_float(rr[1])); }
  if (__builtin_expect(__all(pmax - m_reg <= THR / SCALE), 1)) { mn = m_reg; alpha = 1.f; }
  else { mn = fmaxf(m_reg, pmax); alpha = __builtin_amdgcn_exp2f((m_reg - mn) * C); m_reg = mn; }
  const float mnC = -mn * C;
#pragma unroll
  for (int r = 0; r < 16; ++r) p0[r] = fmaf(p0[r], C, mnC);
#pragma unroll
  for (int r = 0; r < 16; ++r) p1[r] = fmaf(p1[r], C, mnC);
#pragma unroll
  for (int r = 0; r < 16; ++r) p0[r] = __builtin_amdgcn_exp2f(p0[r]);
}
__device__ __forceinline__ void finishSM(f32x16& p0, f32x16& p1, float alpha, float& l_reg, bf16x8& pa0, bf16x8& pa1, bf16x8& pa2, bf16x8& pa3) {
#pragma unroll
  for (int r = 0; r < 16; ++r) p1[r] = __builtin_amdgcn_exp2f(p1[r]);
  float ps = 0;
#pragma unroll
  for (int r = 0; r < 16; ++r) ps += p0[r];
#pragma unroll
  for (int r = 0; r < 16; ++r) ps += p1[r];
  { auto rr = __builtin_amdgcn_permlane32_swap(__float_as_uint(ps), __float_as_uint(ps), false, false);
    ps = __uint_as_float(rr[0]) + __uint_as_float(rr[1]); }
  l_reg = l_reg * alpha + ps;
#define FA_PK4(P, BASE, OUT) do { unsigned a0 = cvtpk(P[BASE + 0], P[BASE + 1]), a1 = cvtpk(P[BASE + 2], P[BASE + 3]);   \
    unsigned b0 = cvtpk(P[BASE + 4], P[BASE + 5]), b1 = cvtpk(P[BASE + 6], P[BASE + 7]);                              \
    auto r0 = __builtin_amdgcn_permlane32_swap(a0, b0, false, false); auto r1 = __builtin_amdgcn_permlane32_swap(a1, b1, false, false); \
    u32x4 w = {r0[0], r1[0], r0[1], r1[1]}; OUT = *reinterpret_cast<bf16x8*>(&w); } while (0)
  FA_PK4(p0, 0, pa0); FA_PK4(p0, 8, pa1); FA_PK4(p1, 0, pa2); FA_PK4(p1, 8, pa3);
#undef FA_PK4
}
template <int DQK>
__device__ __forceinline__ void qkt(f32x16& p0, f32x16& p1, const LAS char* Ks, const bf16x8* qr, int r32, int hi) {
  constexpr int RB = Cfg<DQK>::RB;
  p0 = f32x16{}; p1 = f32x16{};
#pragma unroll
  for (int d0 = 0; d0 < Cfg<DQK>::ND0; ++d0) { const int cb = (d0 * 16 + hi * 8) * 2;
    bf16x8 b0 = *reinterpret_cast<const LAS bf16x8*>(Ks + FA_KSWZ(r32, cb, RB));
    bf16x8 b1 = *reinterpret_cast<const LAS bf16x8*>(Ks + FA_KSWZ(32 + r32, cb, RB));
    p0 = __builtin_amdgcn_mfma_f32_32x32x16_bf16(b0, qr[d0], p0, 0, 0, 0);
    p1 = __builtin_amdgcn_mfma_f32_32x32x16_bf16(b1, qr[d0], p1, 0, 0, 0); }
}
__device__ __forceinline__ int v_st(int k, int c) { const int kk = (k & ~0xC) | ((k & 4) << 1) | ((k & 8) >> 1); return ((kk >> 3) * 4 + (c >> 5)) * 512 + ((kk & 7) * 32 + (c & 31)) * 2; }
__device__ __forceinline__ int v_rd_base(int lane) { return ((lane & 3) << 3) | (((lane >> 2) & 3) << 6) | (((lane >> 4) & 1) << 5) | (((lane >> 5) & 1) << 8); }
constexpr int v_rd_off(int d0, int ks, int half) { return d0 * 512 + ks * 4096 + half * 2048; }
template <int OFF> __device__ __forceinline__ s16x4 tr_read(int vb) {
  s16x4 r; asm volatile("ds_read_b64_tr_b16 %0, %1 offset:%2" : "=&v"(r) : "v"(vb), "i"(OFF) : "memory"); return r;
}
template <int D0> __device__ __forceinline__ void pv_one(f32x16& od, int vb, bf16x8 pa0, bf16x8 pa1, bf16x8 pa2, bf16x8 pa3) {
  const s16x4 l0 = tr_read<v_rd_off(D0, 0, 0)>(vb), h0 = tr_read<v_rd_off(D0, 0, 1)>(vb), l1 = tr_read<v_rd_off(D0, 1, 0)>(vb), h1 = tr_read<v_rd_off(D0, 1, 1)>(vb);
  const s16x4 l2 = tr_read<v_rd_off(D0, 2, 0)>(vb), h2 = tr_read<v_rd_off(D0, 2, 1)>(vb), l3 = tr_read<v_rd_off(D0, 3, 0)>(vb), h3 = tr_read<v_rd_off(D0, 3, 1)>(vb);
  asm volatile("s_waitcnt lgkmcnt(0)" ::: "memory"); FA_SBAR();
#define FA_PK(L, H) (bf16x8){L[0], L[1], L[2], L[3], H[0], H[1], H[2], H[3]}
  od = __builtin_amdgcn_mfma_f32_32x32x16_bf16(pa0, FA_PK(l0, h0), od, 0, 0, 0);
  od = __builtin_amdgcn_mfma_f32_32x32x16_bf16(pa1, FA_PK(l1, h1), od, 0, 0, 0);
  od = __builtin_amdgcn_mfma_f32_32x32x16_bf16(pa2, FA_PK(l2, h2), od, 0, 0, 0);
  od = __builtin_amdgcn_mfma_f32_32x32x16_bf16(pa3, FA_PK(l3, h3), od, 0, 0, 0);
#undef FA_PK
}
__device__ __forceinline__ void pv_d0(f32x16* o, int vb, bf16x8 pa0, bf16x8 pa1, bf16x8 pa2, bf16x8 pa3) {
  pv_one<0>(o[0], vb, pa0, pa1, pa2, pa3); pv_one<1>(o[1], vb, pa0, pa1, pa2, pa3); pv_one<2>(o[2], vb, pa0, pa1, pa2, pa3); pv_one<3>(o[3], vb, pa0, pa1, pa2, pa3);
}
template <int DQK, int LDI, int SDEPTH>
__device__ __forceinline__ void attn_unit(const bf16* __restrict__ Qb, const bf16* __restrict__ Kh, const bf16* __restrict__ Vh, bf16* __restrict__ Ob, const int ldo, float* stats, int seq, LAS char* lds, int tid) {
  constexpr int ldq = LDI, ldk = LDI, ldv = LDI;
  constexpr int RB = Cfg<DQK>::RB, SHM_K = Cfg<DQK>::SHM_K, ND0 = Cfg<DQK>::ND0;
  const int wid = tid >> 6, lane = tid & 63, r32 = lane & 31, hi = lane >> 5;
  LAS char* V_lds = lds; LAS char* K_lds = lds + 2 * SHM_V;
  LAS float* ws = (LAS float*)(lds + 2 * SHM_V + 2 * SHM_K) + wid * 64; LAS float* li_l = ws; LAS float* al_l = ws + 32;
  float m_reg = -1e30f, l_reg = 0; f32x16 o[4] = {}; bf16x8 qr[ND0];
  __syncthreads();
  const GAS bf16* Qw = (const GAS bf16*)Qb + (size_t)(wid * QBLK + r32) * ldq + hi * 8;
#pragma unroll
  for (int d0 = 0; d0 < ND0; ++d0) qr[d0] = *reinterpret_cast<const GAS bf16x8*>(Qw + d0 * 16);
  const int sr = tid >> 4, sc = (tid & 15) * 8, vst0 = v_st(sr, sc), vst1 = v_st(32 + sr, sc);
  const int kr = DQK == 128 ? sr : (tid >> 3), kc = DQK == 128 ? sc : (tid & 7) * 8;
  const int vb0 = (int)(unsigned)(size_t)V_lds + v_rd_base(lane);
  struct { bf16x8 vs0, vs1, ks0, ks1; } sr_[SDEPTH];
const unsigned vo0 = (unsigned)(sr * ldv + sc), vo1 = (unsigned)((32 + sr) * ldv + sc), ko0 = (unsigned)(kr * ldk + kc), ko1 = (unsigned)((32 + kr) * ldk + kc);
#define FA_SLOAD(i, k0) do { const GAS bf16* Vt_ = (const GAS bf16*)Vh + (size_t)(k0) * ldv; const GAS bf16* Kt_ = (const GAS bf16*)Kh + (size_t)(k0) * ldk; \
    sr_[i].vs0 = *reinterpret_cast<const GAS bf16x8*>(Vt_ + vo0); sr_[i].vs1 = *reinterpret_cast<const GAS bf16x8*>(Vt_ + vo1); \
    sr_[i].ks0 = *reinterpret_cast<const GAS bf16x8*>(Kt_ + ko0); if constexpr (DQK == 128) sr_[i].ks1 = *reinterpret_cast<const GAS bf16x8*>(Kt_ + ko1); } while (0)
#define FA_SWRITE(b, i) do { *(LAS bf16x8*)(V_lds + (b) * SHM_V + vst0) = sr_[i].vs0; *(LAS bf16x8*)(V_lds + (b) * SHM_V + vst1) = sr_[i].vs1; \
    *(LAS bf16x8*)(K_lds + (b) * SHM_K + FA_KSWZ(kr, kc * 2, RB)) = sr_[i].ks0; if constexpr (DQK == 128) *(LAS bf16x8*)(K_lds + (b) * SHM_K + FA_KSWZ(32 + kr, kc * 2, RB)) = sr_[i].ks1; } while (0)
#define FA_SWAIT() do { if constexpr (SDEPTH == 1) asm volatile("s_waitcnt vmcnt(0)" ::: "memory"); else if constexpr (DQK == 128) asm volatile("s_waitcnt vmcnt(4)" ::: "memory"); else asm volatile("s_waitcnt vmcnt(3)" ::: "memory"); } while (0)
#define FA_RESC(a) do { if (__any((a) < 1.f)) { if (hi == 0) al_l[r32] = (a); asm volatile("s_waitcnt lgkmcnt(0)" ::: "memory"); \
    _Pragma("unroll") for (int d = 0; d < 4; ++d) _Pragma("unroll") for (int r = 0; r < 16; ++r) o[d][r] *= al_l[crow(r, hi)]; } } while (0)
  f32x16 pA0, pA1, pB0, pB1; float mnA, mnB, alA, alB; bf16x8 pa0, pa1, pa2, pa3; const int NT = seq / KVBLK;
  constexpr int SE = 0, SO = SDEPTH - 1;
  FA_SLOAD(SE, 0); asm volatile("s_waitcnt vmcnt(0)" ::: "memory"); FA_SWRITE(0, SE); __syncthreads();
  qkt<DQK>(pA0, pA1, K_lds, qr, r32, hi); partialSM<DQK>(pA0, pA1, m_reg, mnA, alA);
  FA_SLOAD(SO, KVBLK); if constexpr (SDEPTH == 2) { if (2 < NT) FA_SLOAD(SE, 2 * KVBLK); }
  FA_SWAIT(); FA_SWRITE(1, SO); __syncthreads();
  for (int j = 1; j + 1 < NT; j += 2) {
    FA_SBAR(); qkt<DQK>(pB0, pB1, K_lds + SHM_K, qr, r32, hi);
    finishSM(pA0, pA1, alA, l_reg, pa0, pa1, pa2, pa3); FA_SBAR();
    FA_SLOAD(SO, (j + SDEPTH) * KVBLK); FA_SBAR();
    pv_d0(o, vb0, pa0, pa1, pa2, pa3); partialSM<DQK>(pB0, pB1, m_reg, mnB, alB);
    __syncthreads(); FA_SWAIT(); FA_SWRITE(0, SE);
    FA_RESC(alB); __syncthreads();
    FA_SBAR(); qkt<DQK>(pA0, pA1, K_lds, qr, r32, hi);
    finishSM(pB0, pB1, alB, l_reg, pa0, pa1, pa2, pa3); FA_SBAR();
    if (SDEPTH == 1 || j + 3 < NT) FA_SLOAD(SE, (j + 1 + SDEPTH) * KVBLK); FA_SBAR();
    pv_d0(o, vb0 + SHM_V, pa0, pa1, pa2, pa3); partialSM<DQK>(pA0, pA1, m_reg, mnA, alA);
    __syncthreads(); FA_SWAIT(); FA_SWRITE(1, SO);
    FA_RESC(alA); __syncthreads();
  }
  FA_SBAR(); qkt<DQK>(pB0, pB1, K_lds + SHM_K, qr, r32, hi);
  finishSM(pA0, pA1, alA, l_reg, pa0, pa1, pa2, pa3); FA_SBAR();
  pv_d0(o, vb0, pa0, pa1, pa2, pa3); partialSM<DQK>(pB0, pB1, m_reg, mnB, alB);
  __syncthreads(); FA_RESC(alB);
  finishSM(pB0, pB1, alB, l_reg, pa0, pa1, pa2, pa3); FA_SBAR();
  pv_d0(o, vb0 + SHM_V, pa0, pa1, pa2, pa3);
  if (hi == 0) li_l[r32] = l_reg; asm volatile("s_waitcnt lgkmcnt(0)" ::: "memory");
  if (stats != nullptr && hi == 0) ((GAS f32x2*)stats)[wid * QBLK + r32] = (f32x2){m_reg, l_reg};
  int r32e = r32, hie = hi; asm volatile("" : "+v"(r32e), "+v"(hie));
  float rli[16];
#pragma unroll
  for (int r = 0; r < 16; ++r) rli[r] = __builtin_amdgcn_rcpf(li_l[crow(r, hie)]);
  GAS bf16* Ow = (GAS bf16*)Ob + (size_t)(wid * QBLK) * ldo;
  const unsigned oo = (unsigned)(4 * hie * ldo + r32e);
#pragma unroll
  for (int r = 0; r < 16; ++r) { const unsigned orow = (unsigned)((r & 3) + 8 * (r >> 2));
#pragma unroll
    for (int d0 = 0; d0 < 4; ++d0) Ow[oo + orow * ldo + d0 * 32] = (bf16)f2bf(o[d0][r] * rli[r]); }
#undef FA_SLOAD
#undef FA_SWRITE
#undef FA_SWAIT
#undef FA_RESC
}


constexpr float THR2 = THR * 1.4426950408889634f;
template <bool FORCE>
__device__ __forceinline__ void partialSM2(f32x16& p0, f32x16& p1, float& m_run, f32x16& negm, float& alpha) {
  float pmax = p0[0];
#pragma unroll
  for (int r = 1; r < 16; ++r) pmax = fmaxf(pmax, p0[r]);
#pragma unroll
  for (int r = 0; r < 16; ++r) pmax = fmaxf(pmax, p1[r]);
  { const f32x2 s2 = swap32(pmax); pmax = fmaxf(s2.x, s2.y); }
  if (!FORCE && __builtin_expect(__all(pmax <= THR2), 1)) { alpha = 1.f; }
  else { const float d = FORCE ? pmax : fmaxf(pmax, 0.f); alpha = FORCE ? 1.f : __builtin_amdgcn_exp2f(-d); m_run += d;
#pragma unroll
    for (int r = 0; r < 16; ++r) { p0[r] -= d; p1[r] -= d; negm[r] = -m_run; } }
#pragma unroll
  for (int r = 0; r < 16; ++r) p0[r] = __builtin_amdgcn_exp2f(p0[r]);
}
__device__ __forceinline__ void qkt64n(f32x16& p0, f32x16& p1, const LAS char* Ks, const bf16x8* qr, const f32x16& negm, int r32, int hi) {
  constexpr int RB = 128;
#pragma unroll
  for (int d0 = 0; d0 < 4; ++d0) { const int cb = (d0 * 16 + hi * 8) * 2;
    bf16x8 b0 = *reinterpret_cast<const LAS bf16x8*>(Ks + FA_KSWZ(r32, cb, RB));
    bf16x8 b1 = *reinterpret_cast<const LAS bf16x8*>(Ks + FA_KSWZ(32 + r32, cb, RB));
    if (d0 == 0) { p0 = __builtin_amdgcn_mfma_f32_32x32x16_bf16(b0, qr[0], negm, 0, 0, 0); p1 = __builtin_amdgcn_mfma_f32_32x32x16_bf16(b1, qr[0], negm, 0, 0, 0); }
    else { p0 = __builtin_amdgcn_mfma_f32_32x32x16_bf16(b0, qr[d0], p0, 0, 0, 0); p1 = __builtin_amdgcn_mfma_f32_32x32x16_bf16(b1, qr[d0], p1, 0, 0, 0); } }
}
template <int DQK, int LDI>
__device__ __forceinline__ void attn_unit3(const bf16* __restrict__ Qb, const bf16* __restrict__ Kh, const bf16* __restrict__ Vh, bf16* __restrict__ Ob, const int ldo, float* stats, int seq, LAS char* lds, int tid) {
  constexpr int ldq = LDI, ldk = LDI, ldv = LDI;
  constexpr int RB = Cfg<DQK>::RB, SHM_K = Cfg<DQK>::SHM_K, ND0 = Cfg<DQK>::ND0;
  const int wid = tid >> 6, lane = tid & 63, r32 = lane & 31, hi = lane >> 5;
  LAS char* V_lds = lds; LAS char* K_lds = lds + 3 * SHM_V;
  LAS float* ws = (LAS float*)(lds + 3 * SHM_V + 3 * SHM_K) + wid * 64; LAS float* li_l = ws; LAS float* al_l = ws + 32;
  float m_reg = -1e30f, l_reg = 0; f32x16 o[4] = {}; bf16x8 qr[ND0];
  __syncthreads();
  const GAS bf16* Qw = (const GAS bf16*)Qb + (size_t)(wid * QBLK + r32) * ldq + hi * 8;
#pragma unroll
  for (int d0 = 0; d0 < ND0; ++d0) qr[d0] = *reinterpret_cast<const GAS bf16x8*>(Qw + d0 * 16);
  const int sr = tid >> 4, sc = (tid & 15) * 8, vst0 = v_st(sr, sc), vst1 = v_st(32 + sr, sc);
  const int kr = DQK == 128 ? sr : (tid >> 3), kc = DQK == 128 ? sc : (tid & 7) * 8;
  const int kst0 = FA_KSWZ(kr, kc * 2, RB), kst1 = FA_KSWZ(32 + kr, kc * 2, RB);
  const int vb0 = (int)(unsigned)(size_t)V_lds + v_rd_base(lane);
  bf16x8 vs0, vs1, ks0, ks1;
  const unsigned vo0 = (unsigned)(sr * ldv + sc), ko0 = (unsigned)(kr * ldk + kc);
#define F3_SLOAD(k0) do { const GAS bf16* Vt_ = (const GAS bf16*)Vh + (size_t)(k0) * ldv; const GAS bf16* Kt_ = (const GAS bf16*)Kh + (size_t)(k0) * ldk; \
    vs0 = *reinterpret_cast<const GAS bf16x8*>(Vt_ + vo0); vs1 = *reinterpret_cast<const GAS bf16x8*>(Vt_ + (size_t)32 * ldv + vo0); \
    ks0 = *reinterpret_cast<const GAS bf16x8*>(Kt_ + ko0); if constexpr (DQK == 128) ks1 = *reinterpret_cast<const GAS bf16x8*>(Kt_ + (size_t)32 * ldk + ko0); } while (0)
#define F3_SWRITE(b) do { asm volatile("s_waitcnt vmcnt(0)" ::: "memory"); *(LAS bf16x8*)(V_lds + (b) * SHM_V + vst0) = vs0; *(LAS bf16x8*)(V_lds + (b) * SHM_V + vst1) = vs1; \
    *(LAS bf16x8*)(K_lds + (b) * SHM_K + kst0) = ks0; if constexpr (DQK == 128) *(LAS bf16x8*)(K_lds + (b) * SHM_K + kst1) = ks1; } while (0)
#define F3_RESC(a) do { if (__any((a) < 1.f)) { if (hi == 0) al_l[r32] = (a); asm volatile("s_waitcnt lgkmcnt(0)" ::: "memory"); \
    _Pragma("unroll") for (int d = 0; d < 4; ++d) _Pragma("unroll") for (int r = 0; r < 16; ++r) o[d][r] *= al_l[crow(r, hi)]; } } while (0)
  f32x16 pA0, pA1, pB0, pB1; float mnA, mnB, alA, alB; bf16x8 pa0, pa1, pa2, pa3; const int NT = seq / KVBLK;
  constexpr bool NEGM = (DQK == 64) && (ATTN_NEGM != 0);
  f32x16 negm = {}; if constexpr (NEGM) m_reg = 0.f;
#define F3_QKT(P0, P1, KS) do { if constexpr (NEGM) qkt64n(P0, P1, KS, qr, negm, r32, hi); else qkt<DQK>(P0, P1, KS, qr, r32, hi); } while (0)
#define F3_PSM(P0, P1, MN, AL) do { if constexpr (NEGM) partialSM2<false>(P0, P1, m_reg, negm, AL); else partialSM<DQK>(P0, P1, m_reg, MN, AL); } while (0)
  F3_SLOAD(0); F3_SWRITE(0); F3_SLOAD(KVBLK); F3_SWRITE(1); F3_SLOAD(2 * KVBLK); __syncthreads();
  F3_QKT(pA0, pA1, K_lds); if constexpr (NEGM) partialSM2<true>(pA0, pA1, m_reg, negm, alA); else F3_PSM(pA0, pA1, mnA, alA);
  int bc = 0, bn = 1, bw = 2;
  int j = 0;
  for (; j + 2 < NT; j += 2) {
    FA_SBAR(); F3_QKT(pB0, pB1, K_lds + bn * SHM_K);
    finishSM(pA0, pA1, alA, l_reg, pa0, pa1, pa2, pa3); FA_SBAR();
    F3_SWRITE(bw); F3_SLOAD((j + 3) * KVBLK); FA_SBAR();
    pv_d0(o, vb0 + bc * SHM_V, pa0, pa1, pa2, pa3); F3_PSM(pB0, pB1, mnB, alB);
    F3_RESC(alB); __syncthreads();
    { const int t = bc; bc = bn; bn = bw; bw = t; }
    FA_SBAR(); F3_QKT(pA0, pA1, K_lds + bn * SHM_K);
    finishSM(pB0, pB1, alB, l_reg, pa0, pa1, pa2, pa3); FA_SBAR();
    F3_SWRITE(bw); if (j + 4 < NT) F3_SLOAD((j + 4) * KVBLK); FA_SBAR();
    pv_d0(o, vb0 + bc * SHM_V, pa0, pa1, pa2, pa3); F3_PSM(pA0, pA1, mnA, alA);
    F3_RESC(alA); __syncthreads();
    { const int t = bc; bc = bn; bn = bw; bw = t; }
  }
  FA_SBAR(); F3_QKT(pB0, pB1, K_lds + bn * SHM_K);
  finishSM(pA0, pA1, alA, l_reg, pa0, pa1, pa2, pa3); FA_SBAR();
  pv_d0(o, vb0 + bc * SHM_V, pa0, pa1, pa2, pa3); F3_PSM(pB0, pB1, mnB, alB);
  F3_RESC(alB);
  finishSM(pB0, pB1, alB, l_reg, pa0, pa1, pa2, pa3); FA_SBAR();
  pv_d0(o, vb0 + bn * SHM_V, pa0, pa1, pa2, pa3);
  if (hi == 0) li_l[r32] = l_reg; asm volatile("s_waitcnt lgkmcnt(0)" ::: "memory");
  if (stats != nullptr && hi == 0) ((GAS f32x2*)stats)[wid * QBLK + r32] = (f32x2){m_reg, l_reg};
  int r32e = r32, hie = hi; asm volatile("" : "+v"(r32e), "+v"(hie));
  float rli[16];
#pragma unroll
  for (int r = 0; r < 16; ++r) rli[r] = __builtin_amdgcn_rcpf(li_l[crow(r, hie)]);
  GAS bf16* Ow = (GAS bf16*)Ob + (size_t)(wid * QBLK) * ldo;
  const unsigned oo = (unsigned)(4 * hie * ldo + r32e);
#pragma unroll
  for (int r = 0; r < 16; ++r) { const unsigned orow = (unsigned)((r & 3) + 8 * (r >> 2));
#pragma unroll
    for (int d0 = 0; d0 < 4; ++d0) Ow[oo + orow * ldo + d0 * 32] = (bf16)f2bf(o[d0][r] * rli[r]); }
#undef F3_SLOAD
#undef F3_QKT
#undef F3_PSM
#undef F3_SWRITE
#undef F3_RESC
}
}

#ifndef FAST_ATTN
#define FAST_ATTN 1
#endif

constexpr int AE_NL = NB * 6 * (SEQ / 256), AE_FULL = 256, AE_SPLIT = AE_NL - AE_FULL, AE_ITEMS = AE_FULL + 2 * AE_SPLIT + NB * 6;
__device__ __forceinline__ void fphase_attn_e(const Frame& F_) { const Frame F = fresh(F_);
    const bf16* P = (const bf16*)(F.ws + WS_PBUF); bf16* OA = (bf16*)(F.ws + WS_OA);
    for (int w = F.bid; w < AE_ITEMS; w += F.G) {
        int u, part = -1;
        if (w < AE_FULL) u = w; else if (w < AE_FULL + 2 * AE_SPLIT) { u = AE_FULL + ((w - AE_FULL) >> 1); part = (w - AE_FULL) & 1; } else u = AE_NL + (w - AE_FULL - 2 * AE_SPLIT);
        int b, h, q0, nk;
        if (u < AE_NL) { b = u / (6 * 32); h = (u / 32) % 6; q0 = CTX + 256 * (u % 32); nk = TPB; }
        else { const int v = u - AE_NL; b = v / 6; h = v % 6; q0 = 0; nk = CTX; }
        const size_t rq = (size_t)(b * TPB + q0); size_t rk = (size_t)b * TPB;
        bf16* ob = OA + rq * OAE + h * 128; int ldo = OAE; float* st = nullptr;
        if (part >= 0) { nk = TPB / 2; rk += (size_t)part * (TPB / 2); const int su = u - AE_FULL;
            ob = (bf16*)(F.ws + WS_OPART) + ((size_t)(part * AE_SPLIT + su) * 256) * 128; ldo = 128; st = (float*)(F.ws + WS_OSTAT) + ((size_t)(part * AE_SPLIT + su) * 256) * 2; }
        if (ATTN_RING3) fa::attn_unit3<128, EIN>(uptr(P + rq * EIN + h * 128), uptr(P + rk * EIN + 768 + (h / 3) * 128), uptr(P + rk * EIN + 1024 + (h / 3) * 128), uptr(ob), __builtin_amdgcn_readfirstlane(ldo), uptr(st), __builtin_amdgcn_readfirstlane(nk), (LAS char*)F.lds, F.tid);
        else fa::attn_unit<128, EIN, 1>(P + rq * EIN + h * 128, P + rk * EIN + 768 + (h / 3) * 128, P + rk * EIN + 1024 + (h / 3) * 128, ob, ldo, st, nk, (LAS char*)F.lds, F.tid);
    }
}
__device__ __forceinline__ void phase_attn_merge(const Frame& F_) { const Frame F = fresh(F_);
    const int gw = F.bid * NWAVES + F.wave, NGW = F.G * NWAVES, lane = F.lane;
    constexpr float C = 0.088388347648318440f * 1.4426950408889634f;
    for (int it = gw; it < AE_SPLIT * 256; it += NGW) {
        const int su = it >> 8, r = it & 255, u = AE_FULL + su, b = u / (6 * 32), h = (u / 32) % 6, q0 = CTX + 256 * (u % 32);
        const f32x2 sa = ((const GAS f32x2*)(F.ws + WS_OSTAT))[(size_t)su * 256 + r], sb = ((const GAS f32x2*)(F.ws + WS_OSTAT))[(size_t)(AE_SPLIT + su) * 256 + r];
        const float M = fmaxf(sa.x, sb.x), wa = sa.y * __builtin_amdgcn_exp2f((sa.x - M) * C), wb = sb.y * __builtin_amdgcn_exp2f((sb.x - M) * C), rw = 1.f / (wa + wb);
        const unsigned pa = ((const GAS unsigned*)((const bf16*)(F.ws + WS_OPART) + ((size_t)su * 256 + r) * 128))[lane], pb = ((const GAS unsigned*)((const bf16*)(F.ws + WS_OPART) + ((size_t)(AE_SPLIT + su) * 256 + r) * 128))[lane];
        const float o0 = (wa * bflo(pa) + wb * bflo(pb)) * rw, o1 = (wa * bfhi(pa) + wb * bfhi(pb)) * rw;
        ((GAS unsigned*)((bf16*)(F.ws + WS_OA) + (size_t)(b * TPB + q0 + r) * OAE + h * 128))[lane] = pk2(o0, o1);
    }
}
__device__ __forceinline__ void fphase_attn_o(const Frame& F_) { const Frame F = fresh(F_);
    const bf16* P = (const bf16*)(F.ws + WS_PBUF); bf16* OT = (bf16*)(F.ws + WS_OT);
    constexpr int NL = NB * 16 * (SEQ / 256), NC = NB * 16;
    for (int u = F.bid; u < NL + NC; u += F.G) {
        int b, g, q0, nk;
        if (u < NL) { b = u / (16 * 32); g = (u / 32) % 16; q0 = CTX + 256 * (u % 32); nk = TPB; }
        else { const int v = u - NL; b = v / 16; g = v % 16; q0 = 0; nk = CTX; }
        const size_t rq = (size_t)(b * TPB + q0), rk = (size_t)b * TPB;
        if (ATTN_RING3) fa::attn_unit3<64, OIN>(uptr(P + rq * OIN + g * 64), uptr(P + rk * OIN + 1024 + g * 64), uptr(P + rk * OIN + 2048 + (g / 2) * 128), uptr(OT + rq * OTW + g * 128), OTW, nullptr, __builtin_amdgcn_readfirstlane(nk), (LAS char*)F.lds, F.tid);
        else fa::attn_unit<64, OIN, 2>(P + rq * OIN + g * 64, P + rk * OIN + 1024 + g * 64, P + rk * OIN + 2048 + (g / 2) * 128, OT + rq * OTW + g * 128, OTW, nullptr, nk, (LAS char*)F.lds, F.tid);
    }
}


#ifndef FAST_FFT
#define FAST_FFT 1
#endif
template <int NTILE, class Gen, class Out>
__device__ __forceinline__ void dft_unit(LAS char* lds, const bf16* data, unsigned ldv, int nch, int rowbase, int vsel, Gen gen, GAS bf16* obase, float oscale, Out out_off, int tid) {
    const int lane = tid & 63, r32 = lane & 31, hi = lane >> 5;
    const int sr = tid >> 4, sc = (tid & 15) * 8, vst0 = fa::v_st(sr, sc), vst1 = fa::v_st(32 + sr, sc);
    const int vb = (int)(unsigned)(size_t)lds + vsel * fa::SHM_V + fa::v_rd_base(lane);
    fa::f32x16 o[4] = {};
    for (int ch = 0; ch < nch; ++ch) {
        __syncthreads();
#pragma unroll
        for (int t = 0; t < NTILE; ++t) {
            const GAS bf16* dt = (const GAS bf16*)data + (size_t)(64 * ch) * ldv + 128 * t;
            const fa::bf16x8 a = *reinterpret_cast<const GAS fa::bf16x8*>(dt + (unsigned)sr * ldv + sc), c = *reinterpret_cast<const GAS fa::bf16x8*>(dt + (unsigned)(32 + sr) * ldv + sc);
            *(LAS fa::bf16x8*)(lds + t * fa::SHM_V + vst0) = a; *(LAS fa::bf16x8*)(lds + t * fa::SHM_V + vst1) = c;
        }
        fa::bf16x8 pa[4];
#pragma unroll
        for (int ks = 0; ks < 4; ++ks) { const int k0 = 64 * ch + 16 * ks + 8 * hi; u32x4 w;
            w.x = fa::cvtpk(gen(rowbase + r32, k0 + 0), gen(rowbase + r32, k0 + 1)); w.y = fa::cvtpk(gen(rowbase + r32, k0 + 2), gen(rowbase + r32, k0 + 3));
            w.z = fa::cvtpk(gen(rowbase + r32, k0 + 4), gen(rowbase + r32, k0 + 5)); w.w = fa::cvtpk(gen(rowbase + r32, k0 + 6), gen(rowbase + r32, k0 + 7));
            pa[ks] = *reinterpret_cast<fa::bf16x8*>(&w); }
        __syncthreads();
        fa::pv_d0(o, vb, pa[0], pa[1], pa[2], pa[3]);
    }
    int r32e = r32, hie = hi; asm volatile("" : "+v"(r32e), "+v"(hie));
#pragma unroll
    for (int r = 0; r < 16; ++r)
#pragma unroll
        for (int d0 = 0; d0 < 4; ++d0) obase[out_off(rowbase + (r & 3) + 8 * (r >> 2) + 4 * hie, 32 * d0 + r32e)] = (bf16)f2bf(o[d0][r] * oscale);
}
__device__ __forceinline__ void fphase_fft1(const Frame& F_) { const Frame F = fresh(F_);
    for (int u = F.bid; u < NB * 64 * 2; u += F.G) {
        const int ch2 = u & 1, t2 = (u >> 1) & 63, b = u >> 7;
        const bf16* data = uptr((const bf16*)(F.ws + WS_PBUF) + (size_t)(b * TPB + CTX + t2) * EIN + 1280 + 128 * ch2);
        GAS bf16* yb = (GAS bf16*)uptr((bf16*)(F.ws + WS_YB) + ((size_t)b * 128 * 2 * 64 + t2) * 256 + 128 * ch2);
        dft_unit<1>((LAS char*)F.lds, data, 64u * EIN, 2, 32 * F.wave, 0,
            [&](int rho, int kap) { const int k1 = rho & 127, t = 64 * kap + t2; const float fr = (float)((k1 * t) & 8191) * (1.f / 8192.f); return (rho >> 7) ? -__builtin_amdgcn_sinf(fr) : __builtin_amdgcn_cosf(fr); },
            yb, 1.f, [&](int rho, int col) { return (unsigned)((((rho & 127) * 2 + (rho >> 7)) * 64) * 256 + col); }, F.tid);
    }
}
__device__ __forceinline__ void fphase_fft2(const Frame& F_) { const Frame F = fresh(F_);
    const float norm = 0.0013810679320049757f, normc = 0.0078125f;
    constexpr int BUSY = 0;
    const int nfree = F.G > BUSY ? F.G - BUSY : F.G, vb0 = F.G > BUSY ? F.bid - BUSY : F.bid;
    if (vb0 < 0) return;
    for (int u = vb0; u < NB * 128; u += nfree) {
        const int k1 = u & 127, b = u >> 7;
        const bf16* data = uptr((const bf16*)(F.ws + WS_YB) + (size_t)(b * 128 + k1) * 2 * 64 * 256);
        bf16* oa_ = uptr((bf16*)(F.ws + WS_OA) + (size_t)(b * TPB + CTX + k1) * OAE + 768 + 128 * (F.wave >> 2));
        dft_unit<2>((LAS char*)F.lds, data, 256u, 2, 32 * (F.wave & 3), F.wave >> 2,
            [&](int rho, int kap) { const int k2 = rho & 63, ro = rho >> 6, t2 = kap & 63, si = kap >> 6; const float fr = (float)((k2 * t2) & 63) * (1.f / 64.f);
                return (ro == si) ? __builtin_amdgcn_cosf(fr) : (ro ? -__builtin_amdgcn_sinf(fr) : __builtin_amdgcn_sinf(fr)); },
            (GAS bf16*)oa_, norm, [&](int rho, int col) { return (unsigned)((128 * (rho & 63)) * OAE + (rho >> 6) * 256 + col); }, F.tid);
    }
    for (int u = vb0; u < 8; u += nfree) {
        const int rb = u & 1, ch2 = (u >> 1) & 1, b = u >> 2;
        const bf16* data = uptr((const bf16*)(F.ws + WS_PBUF) + (size_t)(b * TPB) * EIN + 1280 + 128 * ch2);
        bf16* oa_ = uptr((bf16*)(F.ws + WS_OA) + (size_t)(b * TPB) * OAE + 768 + 128 * ch2);
        dft_unit<1>((LAS char*)F.lds, data, (unsigned)EIN, 4, 256 * rb + 32 * F.wave, 0,
            [&](int rho, int kap) { const int k = rho & 255; const float fr = (float)((k * kap) & 255) * (1.f / 256.f); return (rho >> 8) ? -__builtin_amdgcn_sinf(fr) : __builtin_amdgcn_cosf(fr); },
            (GAS bf16*)oa_, normc, [&](int rho, int col) { return (unsigned)((rho & 255) * OAE + (rho >> 8) * 256 + col); }, F.tid);
    }
}

__device__ __forceinline__ void sphase_attn_e(const Frame& F_) { const Frame F = fresh(F_);
    const bf16* P = (const bf16*)(F.ws + WS_PBUF); bf16* OA = (bf16*)(F.ws + WS_OA);
    const int NL = NB * 6 * (SEQ / 32), NC = NB * 6 * (CTX / 32);
    for (int u = F.bid; u < NL + NC; u += F.G) {
        int b, h, q0, nk;
        if (u < NL) { b = u / (6 * 256); h = (u / 256) % 6; q0 = CTX + 32 * (u % 256); nk = TPB; }
        else { const int v = u - NL; b = v / (6 * 8); h = (v / 8) % 6; q0 = 32 * (v % 8); nk = CTX; }
        const size_t rq = (size_t)(b * TPB + q0), rk = (size_t)b * TPB;
        sattn_unit<128>((LAS float*)F.lds, P + rq * EIN + h * 128, EIN, P + rk * EIN + 768 + (h / 3) * 128, EIN, P + rk * EIN + 1024 + (h / 3) * 128, EIN,
                        OA + rq * OAE + h * 128, OAE, nk, 0.08838834764831845f, F.tid);
    }
}
__device__ __forceinline__ void sphase_attn_o(const Frame& F_) { const Frame F = fresh(F_);
    const bf16* P = (const bf16*)(F.ws + WS_PBUF); bf16* OT = (bf16*)(F.ws + WS_OT);
    const int NL = NB * 16 * (SEQ / 32), NC = NB * 16 * (CTX / 32);
    for (int u = F.bid; u < NL + NC; u += F.G) {
        int b, g, q0, nk;
        if (u < NL) { b = u / (16 * 256); g = (u / 256) % 16; q0 = CTX + 32 * (u % 256); nk = TPB; }
        else { const int v = u - NL; b = v / (16 * 8); g = (v / 8) % 16; q0 = 32 * (v % 8); nk = CTX; }
        const size_t rq = (size_t)(b * TPB + q0), rk = (size_t)b * TPB;
        sattn_unit<64>((LAS float*)F.lds, P + rq * OIN + g * 64, OIN, P + rk * OIN + 1024 + g * 64, OIN, P + rk * OIN + 2048 + (g / 2) * 128, OIN,
                       OT + rq * OTW + g * 128, OTW, nk, 0.125f, F.tid);
    }
}

__global__ void __launch_bounds__(NTHREADS, 2) fwd_kernel(Args args) {
    extern __shared__ __attribute__((aligned(16))) unsigned char lds_raw[];
    Frame F;
    F.lds = (LAS unsigned char*)lds_raw; F.ws = args.ws;
    F.tid = threadIdx.x; F.lane = F.tid & 63; F.wave = __builtin_amdgcn_readfirstlane(F.tid >> 6); F.bid = blockIdx.x; F.G = gridDim.x;
    volatile LAS unsigned* MISC = (volatile LAS unsigned*)(F.lds + MISC_OFF);
    if (F.tid < 32) MISC[F.tid] = 0u;
    __syncthreads();
    const int lo = args.ph_lo, hi = args.ph_hi;
    const bool multi = (hi - lo) > 1;
    XcdBarrier bar; bar.bar = (unsigned*)(F.ws + WS_CTL) + CW_BAR; bar.x = 0; bar.st = MISC + 8;
    if (multi) bar = xcd_barrier_post((unsigned*)(F.ws + WS_CTL) + CW_BAR, MISC + 8);
#define IN(k) (lo <= (k) && (k) < hi)
#ifdef PROBE_KIND
    unsigned long long probe_acc = 0, probe_t0 = 0;
#define PROBE_BEGIN(kind) do { if ((kind) < 32 && ((PROBE_KIND >> (kind)) & 1)) probe_t0 = __builtin_amdgcn_s_memrealtime(); } while (0)
#define PROBE_END(kind) do { if ((kind) < 32 && ((PROBE_KIND >> (kind)) & 1)) probe_acc += __builtin_amdgcn_s_memrealtime() - probe_t0; } while (0)
#else
#define PROBE_BEGIN(kind) do {} while (0)
#define PROBE_END(kind) do {} while (0)
#endif
#define SEAM(k) do { if (IN(k) && IN((k) + 1)) { const Frame Fb = fresh(F); xcd_barrier(bar, Fb.tid == 0); } } while (0)
#define SEAMC(k, c) do { if ((c) && IN(k) && IN((k) + 1)) { const Frame Fb = fresh(F); xcd_barrier(bar, Fb.tid == 0); } } while (0)
    PROBE_BEGIN(16); if (IN(PH_PRO_A)) { phase_pro_a(F, args); } SEAM(PH_PRO_A); PROBE_END(16);
    PROBE_BEGIN(17); if (IN(PH_PRO_B)) { phase_pro_b(F, args); } SEAM(PH_PRO_B); PROBE_END(17);
    for (int l = 0; l < DEPTH; ++l) {
        const int p0 = PH_L0 + l * PPL, i = l >> 1; const bool even = (l & 1) == 0;
        PROBE_BEGIN(PL_INPROJ + (PROBE_PARITY < 0 ? 0 : ((l & 1) == PROBE_PARITY ? 0 : 1000))); if (IN(p0 + PL_INPROJ)) {
#if FAST_GEMM
            fphase_inproj(F, even, i);
#else
            if (even) sphase_gemm_bf16(F, (const bf16*)(F.ws + WS_HA), DM, (const bf16*)(F.ws + WS_WINE) + (size_t)i * EIN * DM, DM, (bf16*)(F.ws + WS_PBUF), EIN, NTOK, EIN, DM);
            else sphase_gemm_bf16(F, (const bf16*)(F.ws + WS_HA), DM, (const bf16*)(F.ws + WS_WINO) + (size_t)i * OIN * DM, DM, (bf16*)(F.ws + WS_PBUF), OIN, NTOK, OIN, DM);
#endif
        } SEAM(p0 + PL_INPROJ); PROBE_END(PL_INPROJ + (PROBE_PARITY < 0 ? 0 : ((l & 1) == PROBE_PARITY ? 0 : 1000)));
        PROBE_BEGIN(PL_QKFIX + (PROBE_PARITY < 0 ? 0 : ((l & 1) == PROBE_PARITY ? 0 : 1000))); if (IN(p0 + PL_QKFIX)) { if (even) phase_qkfix_e(F, args, i); else if (!FAST_GEMM) phase_qkfix_o(F); } SEAMC(p0 + PL_QKFIX, even || !FAST_GEMM); PROBE_END(PL_QKFIX + (PROBE_PARITY < 0 ? 0 : ((l & 1) == PROBE_PARITY ? 0 : 1000)));
        PROBE_BEGIN(PL_FFT1 + (PROBE_PARITY < 0 ? 0 : ((l & 1) == PROBE_PARITY ? 0 : 1000))); if (IN(p0 + PL_FFT1)) { if (even) { if (FAST_FFT) fphase_fft1(F); else sphase_fft1(F); } } SEAMC(p0 + PL_FFT1, even); PROBE_END(PL_FFT1 + (PROBE_PARITY < 0 ? 0 : ((l & 1) == PROBE_PARITY ? 0 : 1000)));
        PROBE_BEGIN(PL_ATTN + (PROBE_PARITY < 0 ? 0 : ((l & 1) == PROBE_PARITY ? 0 : 1000))); if (IN(p0 + PL_ATTN)) { if (even) { if (FAST_ATTN) fphase_attn_e(F); else sphase_attn_e(F); if (FAST_FFT) fphase_fft2(F); else { sphase_fft2(F); sphase_fftc(F); } } else { if (FAST_ATTN) fphase_attn_o(F); else sphase_attn_o(F); } } SEAM(p0 + PL_ATTN); PROBE_END(PL_ATTN + (PROBE_PARITY < 0 ? 0 : ((l & 1) == PROBE_PARITY ? 0 : 1000)));
        PROBE_BEGIN(PL_FINISH + (PROBE_PARITY < 0 ? 0 : ((l & 1) == PROBE_PARITY ? 0 : 1000))); if (IN(p0 + PL_FINISH)) { if (!even) phase_finish_o(F, args, i); else if (FAST_ATTN) phase_attn_merge(F); } SEAM(p0 + PL_FINISH); PROBE_END(PL_FINISH + (PROBE_PARITY < 0 ? 0 : ((l & 1) == PROBE_PARITY ? 0 : 1000)));
        PROBE_BEGIN(PL_OUTPROJ + (PROBE_PARITY < 0 ? 0 : ((l & 1) == PROBE_PARITY ? 0 : 1000))); if (IN(p0 + PL_OUTPROJ)) {
#if FAST_GEMM
            fphase_outproj(F, even, i, l);
#else
            if (even) sphase_outproj(F, (const bf16*)(F.ws + WS_OA), OAE, (const bf16*)(F.ws + WS_WOUTE) + (size_t)i * DM * OAE, OAE, l);
            else sphase_outproj(F, (const bf16*)(F.ws + WS_OA), OAO, (const bf16*)(F.ws + WS_WOUTO) + (size_t)i * DM * DM, DM, l);
#endif
        } SEAM(p0 + PL_OUTPROJ); PROBE_END(PL_OUTPROJ + (PROBE_PARITY < 0 ? 0 : ((l & 1) == PROBE_PARITY ? 0 : 1000)));
        PROBE_BEGIN(PL_ROUTER + (PROBE_PARITY < 0 ? 0 : ((l & 1) == PROBE_PARITY ? 0 : 1000))); if (IN(p0 + PL_ROUTER)) { phase_router(F, args, l); } SEAM(p0 + PL_ROUTER); PROBE_END(PL_ROUTER + (PROBE_PARITY < 0 ? 0 : ((l & 1) == PROBE_PARITY ? 0 : 1000)));
        PROBE_BEGIN(PL_GU + (PROBE_PARITY < 0 ? 0 : ((l & 1) == PROBE_PARITY ? 0 : 1000))); if (IN(p0 + PL_GU)) { if (FAST_GEMM) fphase_moe_gu(F, l); else sphase_moe_gu(F, l); } SEAM(p0 + PL_GU); PROBE_END(PL_GU + (PROBE_PARITY < 0 ? 0 : ((l & 1) == PROBE_PARITY ? 0 : 1000)));
        PROBE_BEGIN(PL_DOWN + (PROBE_PARITY < 0 ? 0 : ((l & 1) == PROBE_PARITY ? 0 : 1000))); if (IN(p0 + PL_DOWN)) { if (FAST_GEMM) fphase_moe_down(F, l); else sphase_moe_down(F, l); } SEAM(p0 + PL_DOWN); PROBE_END(PL_DOWN + (PROBE_PARITY < 0 ? 0 : ((l & 1) == PROBE_PARITY ? 0 : 1000)));
        PROBE_BEGIN(PL_COMBINE + (PROBE_PARITY < 0 ? 0 : ((l & 1) == PROBE_PARITY ? 0 : 1000))); if (IN(p0 + PL_COMBINE)) { phase_combine(F, args, l); } SEAM(p0 + PL_COMBINE); PROBE_END(PL_COMBINE + (PROBE_PARITY < 0 ? 0 : ((l & 1) == PROBE_PARITY ? 0 : 1000)));
    }
#undef IN
#undef SEAM
#ifdef PROBE_KIND
    if (F.bid == 0 && F.tid == 0) { const unsigned long long t1 = __builtin_amdgcn_s_memrealtime(), want = probe_acc * PROBE_MULT; while (__builtin_amdgcn_s_memrealtime() - t1 < want) __builtin_amdgcn_s_sleep(8); }
#endif
}

extern "C" void kernel_launch(void* const* d_in, const int* in_sizes, int n_in, void* d_out, int out_size, void* d_ws, size_t ws_size, hipStream_t stream) {
    static int grid = 0;
    if (grid == 0) {
        if (n_in != 26 || in_sizes[0] != NB * SEQ * DM || out_size != NB * SEQ * DM || ws_size < WS_END) {
            fprintf(stderr, "kernel_launch: shape/workspace mismatch (n_in %d, in0 %d, out %d, ws %zu, need %zu); nothing launched\n", n_in, n_in > 0 ? in_sizes[0] : -1, out_size, ws_size, (size_t)WS_END); grid = -1; return; }
        int dev = 0, cus = 0;
        if (hipGetDevice(&dev) != hipSuccess || hipDeviceGetAttribute(&cus, hipDeviceAttributeMultiprocessorCount, dev) != hipSuccess) { grid = -1; return; }
        if (hipFuncSetAttribute((const void*)fwd_kernel, hipFuncAttributeMaxDynamicSharedMemorySize, LDS_BYTES) != hipSuccess) { fprintf(stderr, "kernel_launch: hipFuncSetAttribute failed\n"); grid = -1; return; }
        int per_cu = 0;
        if (hipOccupancyMaxActiveBlocksPerMultiprocessor(&per_cu, (const void*)fwd_kernel, NTHREADS, LDS_BYTES) != hipSuccess || per_cu < 1) { fprintf(stderr, "kernel_launch: occupancy query says %d\n", per_cu); }
        (void)hipGetLastError();
        grid = cus;
    }
    if (grid < 0) return;
    (void)hipMemsetAsync((char*)d_ws + WS_CTL, 0, CTL_ZERO_BYTES, stream);
    Args a{};
    for (int i = 0; i < 26; ++i) a.in[i] = (const float*)d_in[i];
    a.out = (float*)d_out; a.ws = (unsigned char*)d_ws;
#if MK_ONE_LAUNCH
    a.ph_lo = 0; a.ph_hi = N_PHASES;
    hipLaunchKernelGGL(fwd_kernel, dim3(grid), dim3(NTHREADS), LDS_BYTES, stream, a);
#else
    for (int p = 0; p < N_PHASES; ++p) {
        if (p >= PH_L0) { const int l = (p - PH_L0) / PPL, k = (p - PH_L0) % PPL; const bool even = (l & 1) == 0;
            if ((k == PL_FFT1 && !even) || k == PL_GATHER || (k == PL_QKFIX && !even && FAST_GEMM)) continue; }
        a.ph_lo = p; a.ph_hi = p + 1;
        hipLaunchKernelGGL(fwd_kernel, dim3(grid), dim3(NTHREADS), LDS_BYTES, stream, a);
    }
#endif
}
```

```cpp
#include <hip/hip_runtime.h>
#include <cstdio>
#include <cstdint>

#ifndef PROBE_PARITY
#define PROBE_PARITY (-1)
#endif
#ifndef PROBE_MULT
#define PROBE_MULT 4
#endif
#ifndef ATTN_RING3
#define ATTN_RING3 1
#endif
#ifndef ATTN_NEGM
#define ATTN_NEGM 1
#endif
#ifndef MK_ONE_LAUNCH
#define MK_ONE_LAUNCH 1
#endif

#define GAS __attribute__((address_space(1)))
#define LAS __attribute__((address_space(3)))
typedef unsigned short bf16;
typedef float f32x4 __attribute__((ext_vector_type(4)));
typedef unsigned u32x4 __attribute__((ext_vector_type(4)));
typedef unsigned u32x2 __attribute__((ext_vector_type(2)));
typedef int i32x4 __attribute__((ext_vector_type(4)));
typedef int i32x2 __attribute__((ext_vector_type(2)));
typedef float f32x2 __attribute__((ext_vector_type(2)));

constexpr int NB = 2, SEQ = 8192, CTX = 256, TPB = SEQ + CTX, NTOK = NB * TPB, DM = 1024, DEPTH = 4;
constexpr int EIN = 1536, OIN = 3072, OAE = 1280, OAO = 1024, OTW = 2048;
constexpr int NEXP = 16, DEXP = 512;
constexpr int XS_TILES = 2 * NTOK / 256 + NEXP, XS_ROWS = XS_TILES * 256;
constexpr float EPS = 1e-6f;
constexpr int NTHREADS = 512, NWAVES = 8;

constexpr size_t MiB = 1u << 20;
constexpr size_t WS_CTL = 0, CTL_ZERO_BYTES = MiB;
constexpr size_t WS_MODV = 1 * MiB;
constexpr size_t WS_TABA = 1 * MiB + 512 * 1024;
constexpr size_t WS_TABC = WS_TABA + 32 * 1024;
constexpr size_t WS_LAM = WS_TABC + 16 * 1024;
constexpr size_t WS_SELA = 2 * MiB;
constexpr size_t WS_SELW = 2 * MiB + 512 * 1024;
constexpr size_t WS_RPOS = 2 * MiB + 768 * 1024;
constexpr size_t WS_WINE = 3 * MiB;
constexpr size_t WS_WOUTE = 9 * MiB;
constexpr size_t WS_WINO = 14 * MiB;
constexpr size_t WS_WOUTO = 26 * MiB;
constexpr size_t WS_WGU = 30 * MiB;
constexpr size_t WS_WD = 158 * MiB;
constexpr size_t WS_X = 222 * MiB;
constexpr size_t WS_HA = 288 * MiB;
constexpr size_t WS_YB = 321 * MiB;
constexpr size_t WS_PBUF = 337 * MiB;
constexpr size_t WS_OT = 436 * MiB;
constexpr size_t WS_OA = 502 * MiB;
constexpr size_t WS_OPART = 436 * MiB;
constexpr size_t WS_OSTAT = 470 * MiB;
constexpr size_t WS_ROWTOK = 321 * MiB;
constexpr size_t WS_XS = 337 * MiB;
constexpr size_t WS_HID = 411 * MiB;
constexpr size_t WS_Y2S = 448 * MiB;
constexpr size_t WS_END = 544 * MiB;
static_assert(WS_XS + (size_t)XS_ROWS * 1024 * 2 <= WS_HID && WS_HID + (size_t)XS_ROWS * 512 * 2 <= WS_Y2S && WS_Y2S + (size_t)XS_ROWS * 1024 * 2 <= WS_END, "moe overlay");
static_assert(WS_OA + (size_t)NTOK * OAE * 2 <= WS_END && WS_PBUF + (size_t)NTOK * OIN * 2 <= WS_OT && WS_OT + (size_t)NTOK * OTW * 2 <= WS_OA, "ws map");
constexpr int CW_BAR = 4096;
constexpr int CW_CNT = 16384;

constexpr int LDS_BYTES = 147456;
constexpr int MISC_OFF = 147456 - 1024;
constexpr int TB_OFF = 147456 - 512;

constexpr int PH_PRO_A = 0, PH_PRO_B = 1, PH_L0 = 2, PPL = 11;
constexpr int PL_INPROJ = 0, PL_QKFIX = 1, PL_FFT1 = 2, PL_ATTN = 3, PL_FINISH = 4, PL_OUTPROJ = 5, PL_ROUTER = 6, PL_GATHER = 7, PL_GU = 8, PL_DOWN = 9, PL_COMBINE = 10;
constexpr int N_PHASES = PH_L0 + DEPTH * PPL;

struct Args { const float* in[26]; float* out; unsigned char* ws; int ph_lo, ph_hi; };

__device__ __forceinline__ unsigned f2bf(float f) { unsigned u = __builtin_bit_cast(unsigned, f); return (u + 0x7fffu + ((u >> 16) & 1u)) >> 16; }
__device__ __forceinline__ unsigned pk2(float lo, float hi) { return f2bf(lo) | (f2bf(hi) << 16); }
__device__ __forceinline__ float bf2f(bf16 b) { return __builtin_bit_cast(float, (unsigned)b << 16); }
__device__ __forceinline__ float bflo(unsigned w) { return __builtin_bit_cast(float, w << 16); }
__device__ __forceinline__ float bfhi(unsigned w) { return __builtin_bit_cast(float, w & 0xffff0000u); }
template <int M> __device__ __forceinline__ float swz_xor(float v) { static_assert(M >= 1 && M < 32, "swz_xor mask");
    return __builtin_bit_cast(float, __builtin_amdgcn_ds_swizzle(__builtin_bit_cast(int, v), (M << 10) | 0x1f)); }
__device__ __forceinline__ f32x2 swap32(float v) {
    unsigned a = __builtin_bit_cast(unsigned, v), b = a;
    asm volatile("s_nop 1\n\tv_permlane32_swap_b32 %0, %1" : "+v"(a), "+v"(b));
    return (f32x2){__builtin_bit_cast(float, a), __builtin_bit_cast(float, b)}; }
__device__ __forceinline__ float xor32(float v, bool upper) { const f32x2 s2 = swap32(v); return upper ? s2.x : s2.y; }
__device__ __forceinline__ float wave_sum(float v) {
    v += swz_xor<1>(v); v += swz_xor<2>(v); v += swz_xor<4>(v); v += swz_xor<8>(v); v += swz_xor<16>(v);
    const f32x2 s2 = swap32(v); return s2.x + s2.y;
}
__device__ __forceinline__ float silu_f(float x) { return x / (1.f + expf(-x)); }
#define LDS_WAIT() asm volatile("s_waitcnt lgkmcnt(0)" ::: "memory")

#define XB_TMO      128
#define XB_XCNT(j)  (256  + 64 * (j))
#define XB_XSUB(j)  (1280 + 64 * (j))
#define XB_XGEN(j)  (2304 + 64 * (j))
#define XB_TOP      3328
#define XB_TOPGEN   3392
#define XCD_BAR_WORDS 3456
#define XB_SPIN_CAP (1u << 24)
__device__ __forceinline__ unsigned xb_ld(unsigned* p)              { return __hip_atomic_load(p, __ATOMIC_RELAXED, __HIP_MEMORY_SCOPE_AGENT); }
__device__ __forceinline__ unsigned xb_add(unsigned* p, unsigned v) { return __hip_atomic_fetch_add(p, v, __ATOMIC_RELAXED, __HIP_MEMORY_SCOPE_AGENT); }
__device__ __forceinline__ unsigned xb_xcc_id() { return (unsigned)__builtin_amdgcn_s_getreg((3 << 11) | 20) & 0xFu; }
#define XB_SPIN(cond, bar) do { unsigned _sp = 0; while (cond) { __builtin_amdgcn_s_sleep(1); \
    if ((++_sp & 255u) == 0u) { if (xb_ld(&(bar)[XB_TMO])) break; if (_sp > XB_SPIN_CAP) { atomicAdd(&(bar)[XB_TMO], 1u); break; } } } } while (0)
struct XcdBarrier { unsigned* bar; unsigned x; volatile LAS unsigned* st; };
__device__ __forceinline__ XcdBarrier xcd_barrier_post(unsigned* bar, volatile LAS unsigned* st) {
    XcdBarrier b; b.bar = bar; b.x = xb_xcc_id(); b.st = st;
    if (threadIdx.x == 0) (void)xb_add(&bar[XB_XCNT(b.x)], 1u);
    return b;
}
__device__ __forceinline__ void xcd_barrier_complete(unsigned* bar, unsigned x, unsigned& nloc, unsigned& nx) {
    const unsigned G = gridDim.x * gridDim.y * gridDim.z;
    unsigned sum, cnt, mine, sp = 0u;
    for (;;) {
        sum = 0u; cnt = 0u; mine = 0u;
#pragma unroll
        for (unsigned j = 0; j < 16; ++j) { const unsigned c = xb_ld(&bar[XB_XCNT(j)]); sum += c; cnt += (c > 0u) ? 1u : 0u; mine = (j == x) ? c : mine; }
        if (sum == G) break;
        __builtin_amdgcn_s_sleep(1);
        if ((++sp & 255u) == 0u) { if (xb_ld(&bar[XB_TMO])) break; if (sp > XB_SPIN_CAP) { atomicAdd(&bar[XB_TMO], 1u); break; } }
    }
    nloc = mine > 0u ? mine : 1u; nx = cnt > 0u ? cnt : 1u;
}
__device__ __forceinline__ void xcd_barrier(const XcdBarrier& b, const bool leader) {
    asm volatile("s_waitcnt vmcnt(0)" ::: "memory");
    __syncthreads();
    if (leader) {
        unsigned* bar = b.bar; unsigned bx_ = b.x; asm volatile("" : "+s"(bar), "+s"(bx_));
        __builtin_amdgcn_s_waitcnt(0);
        unsigned nloc = b.st[0], nx = b.st[1];
        if (nloc == 0u) { xcd_barrier_complete(bar, bx_, nloc, nx); b.st[0] = nloc; b.st[1] = nx; }
        const unsigned old = xb_add(&bar[XB_XSUB(bx_)], 1u);
        const unsigned gen = old / nloc;
        if (old + 1u == (gen + 1u) * nloc) {
            __builtin_amdgcn_fence(__ATOMIC_RELEASE, "agent");
            asm volatile("s_waitcnt vmcnt(0)" ::: "memory");
            const unsigned og = xb_add(&bar[XB_TOP], 1u);
            const unsigned tg = og / nx;
            if (og + 1u == (tg + 1u) * nx) xb_add(&bar[XB_TOPGEN], 1u);
            else XB_SPIN(xb_ld(&bar[XB_TOPGEN]) == tg, bar);
            __builtin_amdgcn_fence(__ATOMIC_ACQUIRE, "agent");
            xb_add(&bar[XB_XGEN(bx_)], 1u);
            asm volatile("s_waitcnt vmcnt(0)" ::: "memory");
        } else {
            XB_SPIN(xb_ld(&bar[XB_XGEN(bx_)]) == gen, bar);
            __builtin_amdgcn_fence(__ATOMIC_ACQUIRE, "agent");
            asm volatile("s_waitcnt vmcnt(0)" ::: "memory");
        }
    }
    __syncthreads();
}

struct Frame {
    LAS unsigned char* lds;
    unsigned char* ws;
    int tid, lane, wave, bid, G;
};
template <class T> __device__ __forceinline__ T* opq(T* p) { asm volatile("" : "+s"(p)); return p; }
__device__ __forceinline__ Frame fresh(const Frame& F) { Frame G = F;
    asm volatile("" : "+s"(G.ws), "+s"(G.bid), "+s"(G.wave), "+s"(G.G));
    G.lane = (int)__builtin_amdgcn_mbcnt_hi(~0u, __builtin_amdgcn_mbcnt_lo(~0u, 0u)); asm volatile("" : "+v"(G.lane));
    G.tid = G.wave * 64 + G.lane; return G; }
__device__ __forceinline__ const float* ain_ptr(int k) {
    auto kp = __builtin_amdgcn_kernarg_segment_ptr(); asm volatile("" : "+s"(kp));
    typedef const float* cfp;
    return ((const __attribute__((address_space(4))) cfp*)kp)[k]; }
#define AIN(k) ain_ptr(k)
template <class T> __device__ __forceinline__ T* uptr(T* p) {
    const unsigned long long v = (unsigned long long)p; const unsigned lo = __builtin_amdgcn_readfirstlane((unsigned)v), hi = __builtin_amdgcn_readfirstlane((unsigned)(v >> 32));
    return (T*)(((unsigned long long)hi << 32) | lo); }
__device__ __forceinline__ const float* modv(const Frame& F, int l, int type, int chunk) { return (const float*)(F.ws + WS_MODV) + ((size_t)(l * 3 + type) * 6 + chunk) * DM; }
__device__ __forceinline__ int row_type(int r) { const int b = r / TPB, j = r - b * TPB; return j < CTX ? 2 : b; }

__device__ __forceinline__ void load_row_f32(const float* p, int lane, f32x4 (&v)[4]) {
    const GAS f32x4* q = (const GAS f32x4*)p + lane;
#pragma unroll
    for (int j = 0; j < 4; ++j) v[j] = q[64 * j];
}
__device__ __forceinline__ void store_row_f32(float* p, int lane, const f32x4 (&v)[4]) {
    GAS f32x4* q = (GAS f32x4*)p + lane;
#pragma unroll
    for (int j = 0; j < 4; ++j) q[64 * j] = v[j];
}
__device__ __forceinline__ void load_row_bf16(const bf16* p, int lane, f32x4 (&v)[4]) {
    const GAS u32x2* q = (const GAS u32x2*)p + lane;
#pragma unroll
    for (int j = 0; j < 4; ++j) { const u32x2 w = q[64 * j]; v[j] = (f32x4){bflo(w.x), bfhi(w.x), bflo(w.y), bfhi(w.y)}; }
}
__device__ __forceinline__ void store_row_bf16(bf16* p, int lane, const f32x4 (&v)[4]) {
    GAS u32x2* q = (GAS u32x2*)p + lane;
#pragma unroll
    for (int j = 0; j < 4; ++j) { u32x2 w; w.x = pk2(v[j].x, v[j].y); w.y = pk2(v[j].z, v[j].w); q[64 * j] = w; }
}
__device__ __forceinline__ float row_rstd(const f32x4 (&v)[4]) {
    float s = 0.f;
#pragma unroll
    for (int j = 0; j < 4; ++j) s += (v[j].x * v[j].x + v[j].y * v[j].y) + (v[j].z * v[j].z + v[j].w * v[j].w);
    return rsqrtf(wave_sum(s) * (1.f / DM) + EPS);
}
__device__ __forceinline__ void modnorm_store(const f32x4 (&v)[4], const float* sc, const float* sh, bf16* dst, int lane) {
    const float rstd = row_rstd(v);
    f32x4 s[4], h[4], o[4]; load_row_f32(sc, lane, s); load_row_f32(sh, lane, h);
#pragma unroll
    for (int j = 0; j < 4; ++j) o[j] = v[j] * rstd * (s[j] + 1.f) + h[j];
    store_row_bf16(dst, lane, o);
}

namespace pg8 {
#define PG8_LAS __attribute__((address_space(3)))
typedef unsigned short bf16_t;
typedef short bf16x8 __attribute__((ext_vector_type(8)));
typedef float f32x4 __attribute__((ext_vector_type(4)));
typedef unsigned u32x4 __attribute__((ext_vector_type(4)));
constexpr int BM = 256, BK = 64, HALF = 128, HTB = HALF * BK * 2  , STAGE_BYTES = 8 * HTB, NXCD = 8, WGM = 8;

__host__ __device__ __forceinline__ int lds_byte(int r, int c) { const int st = (r >> 4) * 2 + (c >> 5), rr = r & 15, cc = c & 31, ob = rr * 64 + cc * 2; return st * 1024 + (ob ^ (((ob >> 9) & 1) << 5)); }
__host__ __device__ __forceinline__ void stage_rc(int b, int& R, int& C) { const int st = b / 1024, sb = b % 1024, swz = sb ^ (((sb >> 9) & 1) << 5); R = (st >> 1) * 16 + swz / 64; C = (st & 1) * 32 + (swz % 64) / 2; }
__host__ __device__ __forceinline__ int perm32(int rho) { const int n = rho >> 4, i = rho & 15; return 8 * (i >> 2) + 4 * n + (i & 3); }

struct Unit { int pm, pn, e, lt; };
struct Gemm { const bf16_t* A; const bf16_t* Bt; int M, N, K; size_t estride; const int* rowtok; int ntok; };

struct StaticOrder {
    int nM, nN, nwg, G, c;
    __host__ __device__ void init(int M, int N, int G_, int c_) { nM = M / BM; nN = N / BM; nwg = nM * nN; G = G_; c = c_; }
    __host__ __device__ bool next(int i, Unit& u) const {
        const long L = (long)i * G + c; if (L >= nwg) return false;
        int wgid = (int)L; { const int q = nwg / NXCD, r = nwg % NXCD, xcd = wgid % NXCD, off = wgid / NXCD; wgid = (xcd < r ? xcd * (q + 1) : r * (q + 1) + (xcd - r) * q) + off; }
        const int nig = WGM * nN, gid = wgid / nig, fm = gid * WGM, gsz = (nM - fm) < WGM ? (nM - fm) : WGM;
        u.pm = fm + ((wgid % nig) % gsz); u.pn = (wgid % nig) / gsz; u.e = 0; u.lt = 0; return true;
    }
    __device__ __forceinline__ void a_ready(const Unit&) const {}
    __device__ __forceinline__ void done(const Unit&) const {}
};

struct LatOrder {
    StaticOrder so;
    __host__ __device__ void init(int N, int G_, int c_) { so.init(64 * BM, N, G_, c_); }
    __host__ __device__ bool next(int i, Unit& u) const { if (!so.next(i, u)) return false; u.pm = u.pm + 1 + (u.pm >= 32 ? 1 : 0); return true; }
    __device__ __forceinline__ void a_ready(const Unit&) const {}
    __device__ __forceinline__ void done(const Unit&) const {}
};
__device__ __forceinline__ unsigned cvt_pk_bf16(float lo, float hi) { unsigned r; asm volatile("v_cvt_pk_bf16_f32 %0, %1, %2" : "=v"(r) : "v"(lo), "v"(hi)); return r; }
typedef float f32x2 __attribute__((ext_vector_type(2)));
__device__ __forceinline__ f32x2 gelu_pk(f32x2 v) {
    const f32x2 av = __builtin_elementwise_abs(v), d = av * 0.2316418882f + 1.0f;
    f32x2 t; t.x = __builtin_amdgcn_rcpf(d.x); t.y = __builtin_amdgcn_rcpf(d.y);
    f32x2 q = t * 0.5307027145f + (-0.7265760135f); q = q * t + 0.7107068705f; q = q * t + (-0.142248368f); q = q * t + 0.127414796f; q = q * t;
    const f32x2 s = (v * v) * (-0.72134752044f);
    f32x2 e; e.x = __builtin_amdgcn_exp2f(s.x); e.y = __builtin_amdgcn_exp2f(s.y);
    const f32x2 m = v * (q * e), r = v - m;
    f32x2 o; o.x = v.x < 0.f ? m.x : r.x; o.y = v.y < 0.f ? m.y : r.y; return o;
}

template <int ACT  > struct EpiBf16 {
    static constexpr bool PERM = true, AFTER_DRAIN = false; static_assert(ACT == 0 || ACT == 1, "EpiBf16: ACT is 0 (none) or 1 (gelu_pk)");
    bf16_t* O; int ldc; const float* bias; int split_cols; size_t split_stride; float scale0;
    __device__ __forceinline__ void operator()(const f32x4 (&acc)[2][2][4][2], const Unit& u, int wr, int wc, int fr, int fq) const {
        const int row0 = u.pm * BM + wr * 64 + fr; int colt = u.pn * BM; bf16_t* base = O;
        float sc = 1.f; if (split_cols) { const int t = colt / split_cols; base += (size_t)t * split_stride; colt -= t * split_cols; if (t == 0) sc = scale0; }
        const int col0 = colt + wc * 32 + 8 * fq, bcol0 = u.pn * BM + wc * 32 + 8 * fq;
        f32x4 bv[2][2];
#pragma unroll
        for (int bj = 0; bj < 2; ++bj)
#pragma unroll
            for (int n = 0; n < 2; ++n) bv[bj][n] = bias ? *(const f32x4*)(bias + bcol0 + bj * HALF + 4 * n) : (f32x4){0.f, 0.f, 0.f, 0.f};
#pragma unroll
        for (int ai = 0; ai < 2; ++ai)
#pragma unroll
            for (int m = 0; m < 4; ++m) { bf16_t* rowp = base + (size_t)(row0 + ai * HALF + m * 16) * ldc + col0;
#pragma unroll
                for (int bj = 0; bj < 2; ++bj) { f32x4 v0 = acc[ai][bj][m][0] + bv[bj][0], v1 = acc[ai][bj][m][1] + bv[bj][1];
                    if (ACT == 1) { f32x2 a = gelu_pk((f32x2){v0[0], v0[1]}), b = gelu_pk((f32x2){v0[2], v0[3]}), c = gelu_pk((f32x2){v1[0], v1[1]}), d = gelu_pk((f32x2){v1[2], v1[3]});
                        v0 = (f32x4){a.x, a.y, b.x, b.y}; v1 = (f32x4){c.x, c.y, d.x, d.y}; }
                    v0 = v0 * sc; v1 = v1 * sc; u32x4 w; w.x = cvt_pk_bf16(v0[0], v0[1]); w.y = cvt_pk_bf16(v0[2], v0[3]); w.z = cvt_pk_bf16(v1[0], v1[1]); w.w = cvt_pk_bf16(v1[2], v1[3]);
                    *(GAS u32x4*)(rowp + bj * HALF) = w; } }
    }
};

__device__ __forceinline__ float silu_fast(float x) { return x * __builtin_amdgcn_rcpf(1.f + __expf(-x)); }
struct EpiSwiGLU {
    static constexpr bool PERM = true, AFTER_DRAIN = false;
    bf16_t* O;
    __device__ __forceinline__ void operator()(const f32x4 (&acc)[2][2][4][2], const Unit& u, int wr, int wc, int fr, int fq) const {
        const int row0 = u.pm * BM + wr * 64 + fr, col0 = u.pn * HALF + wc * 32 + 8 * fq;
#pragma unroll
        for (int ai = 0; ai < 2; ++ai)
#pragma unroll
            for (int m = 0; m < 4; ++m) { bf16_t* rowp = O + (size_t)(row0 + ai * HALF + m * 16) * 512 + col0;
                const f32x4 g0 = acc[ai][0][m][0], g1 = acc[ai][0][m][1], u0 = acc[ai][1][m][0], u1 = acc[ai][1][m][1];
                u32x4 w; w.x = cvt_pk_bf16(silu_fast(g0[0]) * u0[0], silu_fast(g0[1]) * u0[1]); w.y = cvt_pk_bf16(silu_fast(g0[2]) * u0[2], silu_fast(g0[3]) * u0[3]);
                w.z = cvt_pk_bf16(silu_fast(g1[0]) * u1[0], silu_fast(g1[1]) * u1[1]); w.w = cvt_pk_bf16(silu_fast(g1[2]) * u1[2], silu_fast(g1[3]) * u1[3]);
                *(GAS u32x4*)rowp = w; }
    }
};
struct EpiResGate {
    static constexpr bool PERM = false, AFTER_DRAIN = false;
    float* X; const float* gate3;
    __device__ __forceinline__ void operator()(const f32x4 (&acc)[2][2][4][2], const Unit& u, int wr, int wc, int fr, int fq) const {
        const int type = (u.pm % 33 == 0) ? 2 : u.pm / 33;
        const int col0 = u.pn * BM + wc * 32 + 4 * fq; const float* gp = gate3 + (size_t)type * 6144 + col0;
        f32x4 gv[2][2];
#pragma unroll
        for (int bj = 0; bj < 2; ++bj)
#pragma unroll
            for (int n = 0; n < 2; ++n) gv[bj][n] = *(const GAS f32x4*)(gp + bj * HALF + n * 16);
#pragma unroll
        for (int ai = 0; ai < 2; ++ai)
#pragma unroll
            for (int m = 0; m < 4; ++m) { float* rowp = X + (size_t)(u.pm * BM + ai * HALF + wr * 64 + m * 16 + fr) * 1024 + col0;
#pragma unroll
                for (int bj = 0; bj < 2; ++bj)
#pragma unroll
                    for (int n = 0; n < 2; ++n) { GAS f32x4* xp = (GAS f32x4*)(rowp + bj * HALF + n * 16); *xp = *xp + gv[bj][n] * acc[ai][bj][m][n]; } }
    }
};

struct EpiRopeO {
    static constexpr bool PERM = true, AFTER_DRAIN = false;
    bf16_t* O; int ldc; const float* tab; int nrope_tiles;
    int nq_tiles; float qscale;
    __device__ __forceinline__ void operator()(const f32x4 (&acc)[2][2][4][2], const Unit& u, int wr, int wc, int fr, int fq) const {
        const int row0 = u.pm * BM + wr * 64 + fr, col0 = u.pn * BM + wc * 32 + 8 * fq;
        const bool rope = (u.pn < nrope_tiles) && (u.pm % 33 != 0);
        const int t0 = row0 - (u.pm / 33) * 8448 - 256;
        const bool x2 = (fq >> 1) != 0; const float qs = (u.pn < nq_tiles) ? qscale : 1.f;
#pragma unroll
        for (int ai = 0; ai < 2; ++ai)
#pragma unroll
            for (int m = 0; m < 4; ++m) { const int t = t0 + ai * HALF + m * 16; bf16_t* rowp = O + (size_t)(row0 + ai * HALF + m * 16) * ldc + col0;
                f32x4 cs[4];
                if (rope) { const int pos = (wc & 1) ? (t & 63) : (t >> 6); const float* tp = tab + (size_t)(pos * 16 + 8 * (fq & 1)) * 2;
#pragma unroll
                    for (int q = 0; q < 4; ++q) cs[q] = *(const GAS f32x4*)(tp + 4 * q); }
#pragma unroll
                for (int bj = 0; bj < 2; ++bj) { f32x4 v0 = acc[ai][bj][m][0], v1 = acc[ai][bj][m][1];
                    if (rope) { f32x4 p0, p1;
#pragma unroll
                        for (int e = 0; e < 4; ++e) { p0[e] = xor32(v0[e], x2); p1[e] = xor32(v1[e], x2); }
                        const f32x4 c0 = {cs[0][0], cs[0][2], cs[1][0], cs[1][2]}, s0 = {cs[0][1], cs[0][3], cs[1][1], cs[1][3]};
                        const f32x4 c1 = {cs[2][0], cs[2][2], cs[3][0], cs[3][2]}, s1 = {cs[2][1], cs[2][3], cs[3][1], cs[3][3]};
                        v0 = x2 ? (p0 * s0 + v0 * c0) : (v0 * c0 - p0 * s0); v1 = x2 ? (p1 * s1 + v1 * c1) : (v1 * c1 - p1 * s1); }
                    v0 = v0 * qs; v1 = v1 * qs;
                    u32x4 w; w.x = cvt_pk_bf16(v0[0], v0[1]); w.y = cvt_pk_bf16(v0[2], v0[3]); w.z = cvt_pk_bf16(v1[0], v1[1]); w.w = cvt_pk_bf16(v1[2], v1[3]);
                    *(GAS u32x4*)(rowp + bj * HALF) = w; } }
    }
};
struct MoeOrder {
    const PG8_LAS int* tb; int nN, nwg, G, c;
    __device__ __forceinline__ bool next(int i, Unit& u) const {
        const int L = i * G + c; if (L >= nwg) return false;
        u.pm = L / nN; u.pn = L - u.pm * nN; int e = 0;
        int t0 = 0;
#pragma unroll
        for (int q = 1; q < 16; ++q) { const int tq = tb[q]; const bool ge = u.pm >= tq; e = ge ? q : e; t0 = ge ? tq : t0; }
        u.e = __builtin_amdgcn_readfirstlane(e); u.lt = u.pm - __builtin_amdgcn_readfirstlane(t0); return true;
    }
    __device__ __forceinline__ void a_ready(const Unit&) const {}
    __device__ __forceinline__ void done(const Unit&) const {}
};

template <class Epi, class Sched, bool ALIGN_EPI = false, bool SP2 = false, bool GATHER = false>
__device__ __forceinline__ void gemm_phase(PG8_LAS unsigned char* lds, const Gemm g, const Sched& S, const Epi& E, const int tid_) {
    const int tid = tid_, wid = __builtin_amdgcn_readfirstlane(tid >> 6), lane = tid & 63, wr = wid >> 2, wc = wid & 3, fr = lane & 15, fq = lane >> 4;
    const int K = g.K, nt = K / BK;
    unsigned voffA[2], voffB[2];
#pragma unroll
    for (int i = 0; i < 2; ++i) { int R, C; stage_rc(tid * 16 + i * 8192, R, C); const int Rb = Epi::PERM ? ((R & ~31) + perm32(R & 31)) : R;
        voffA[i] = (unsigned)(R * K + C) * 2u; voffB[i] = (unsigned)(Rb * K + C) * 2u; }
    static_assert(!GATHER || SP2, "GATHER is implemented on the SP2 loop only");
    int gR[2], gC[2];
#pragma unroll
    for (int i = 0; i < 2; ++i) stage_rc(tid * 16 + i * 8192, gR[i], gC[i]);
    unsigned vAc[2][2], vAn[2][2];
#define PG8_LOADIDX(u, v) do { _Pragma("unroll") for (int h_ = 0; h_ < 2; ++h_) _Pragma("unroll") for (int i_ = 0; i_ < 2; ++i_) { \
        int tok_ = g.rowtok[(size_t)(u).e * g.ntok + (u).lt * 256 + h_ * HALF + gR[i_]]; tok_ = ((unsigned)tok_ < (unsigned)g.ntok) ? tok_ : 0; (v)[h_][i_] = (unsigned)(tok_ * K + gC[i_]) * 2u; } } while (0)
#define PG8_STAGE_A(bufoff, gbase, h, set) do { if constexpr (GATHER) { PG8_STAGE(bufoff, gbase, (set)[h]); } else { PG8_STAGE(bufoff, (gbase) + (h) * hstep, voffA); } } while (0)
    const size_t kstep = (size_t)(BK * 2);
    const size_t hstep = (size_t)HALF * K * 2;
    const size_t tstep = 2 * hstep;
    const unsigned ldsw = (unsigned)wid * 1024u;
    const int aoff = lds_byte(wr * 64 + fr, fq * 8), boff = lds_byte(wc * 32 + fr, fq * 8);
#define PG8_SA(b, h) (((b) * 2 + (h)) * HTB)
#define PG8_SB(b, h) ((4 + (b) * 2 + (h)) * HTB)
#define PG8_STAGE(bufoff, gbase, voff) do { _Pragma("unroll") for (int _i = 0; _i < 2; ++_i) \
        __builtin_amdgcn_global_load_lds((const unsigned*)((const char*)(gbase) + (voff)[_i]), (PG8_LAS unsigned*)(lds + (bufoff) + ldsw + _i * 8192), 16, 0, 0); } while (0)
#define PG8_LDA(dst, b, h) do { _Pragma("unroll") for (int m = 0; m < 4; ++m) _Pragma("unroll") for (int k = 0; k < 2; ++k) dst[m][k] = *(const PG8_LAS bf16x8*)(lds + PG8_SA(b, h) + aoff + m * 2048 + k * 1024); } while (0)
#define PG8_LDB(dst, b, h) do { _Pragma("unroll") for (int n = 0; n < 2; ++n) _Pragma("unroll") for (int k = 0; k < 2; ++k) dst[n][k] = *(const PG8_LAS bf16x8*)(lds + PG8_SB(b, h) + boff + n * 2048 + k * 1024); } while (0)
#define PG8_MMA(ai, bj, At, Bt) do { __builtin_amdgcn_s_setprio(1); _Pragma("unroll") for (int m = 0; m < 4; ++m) _Pragma("unroll") for (int n = 0; n < 2; ++n) _Pragma("unroll") for (int k = 0; k < 2; ++k) \
        acc[ai][bj][m][n] = __builtin_amdgcn_mfma_f32_16x16x32_bf16(Bt[n][k], At[m][k], acc[ai][bj][m][n], 0, 0, 0); __builtin_amdgcn_s_setprio(0); } while (0)
#define PG8_WAIT_V(n) asm volatile("s_waitcnt vmcnt(" #n ")" ::: "memory")
#define PG8_WAIT_L(n) asm volatile("s_waitcnt lgkmcnt(" #n ")" ::: "memory")
#define PG8_BAR __builtin_amdgcn_s_barrier()
#define PG8_SCHED __builtin_amdgcn_sched_barrier(0)
    Unit cur, nxt; int ui = 0;
    if (!S.next(0, cur)) return;
    f32x4 acc[2][2][4][2];
#pragma unroll
    for (int a = 0; a < 2; ++a)
#pragma unroll
        for (int b = 0; b < 2; ++b)
#pragma unroll
            for (int m = 0; m < 4; ++m)
#pragma unroll
                for (int n = 0; n < 2; ++n) acc[a][b][m][n] = (f32x4){0.f, 0.f, 0.f, 0.f};
    bf16x8 At[4][2], B0[2][2], B1[2][2];
    const char* cA = GATHER ? (const char*)g.A : (const char*)g.A + (size_t)cur.pm * tstep; const char* cB = (const char*)g.Bt + (size_t)cur.e * g.estride + (size_t)cur.pn * tstep;
    if constexpr (GATHER) { PG8_LOADIDX(cur, vAc); }
    S.a_ready(cur);
    if constexpr (SP2) {
        PG8_STAGE(PG8_SB(0, 0), cB, voffB); PG8_STAGE(PG8_SB(0, 1), cB + hstep, voffB); PG8_STAGE_A(PG8_SA(0, 0), cA, 0, vAc); PG8_STAGE_A(PG8_SA(0, 1), cA, 1, vAc);
        if (wr == 1) PG8_BAR;
        PG8_WAIT_V(2); PG8_BAR;
        PG8_STAGE(PG8_SB(1, 0), cB + kstep, voffB); PG8_STAGE_A(PG8_SA(1, 0), cA + kstep, 0, vAc); PG8_STAGE(PG8_SB(1, 1), cB + hstep + kstep, voffB);
        PG8_WAIT_V(6); PG8_BAR;
    } else {
        PG8_STAGE(PG8_SB(0, 0), cB, voffB); PG8_STAGE(PG8_SA(0, 0), cA, voffA); PG8_STAGE(PG8_SB(0, 1), cB + hstep, voffB); PG8_STAGE(PG8_SA(0, 1), cA + hstep, voffA);
        if (wr == 1) PG8_BAR;
        PG8_WAIT_V(4); PG8_BAR;
        PG8_STAGE(PG8_SB(1, 0), cB + kstep, voffB); PG8_STAGE(PG8_SA(1, 0), cA + kstep, voffA); PG8_STAGE(PG8_SB(1, 1), cB + hstep + kstep, voffB);
        PG8_WAIT_V(6); PG8_BAR;
    }
    for (;;) {
        const bool has_next = S.next(ui + 1, nxt);
        const char* nA = GATHER ? cA : (has_next ? (const char*)g.A + (size_t)nxt.pm * tstep : cA); const char* nB = has_next ? (const char*)g.Bt + (size_t)nxt.e * g.estride + (size_t)nxt.pn * tstep : cB;
        if constexpr (GATHER) { if (has_next) { PG8_LOADIDX(nxt, vAn); } else {
#pragma unroll
            for (int h_ = 0; h_ < 2; ++h_) { vAn[h_][0] = vAc[h_][0]; vAn[h_][1] = vAc[h_][1]; } } }
        for (int t = 0; t < nt; t += 2) {
            const bool last = (t == nt - 2);
            const char* a1 = cA + (size_t)(t + 1) * kstep;
            const char* a2 = last ? nA : cA + (size_t)(t + 2) * kstep; const char* b2 = last ? nB : cB + (size_t)(t + 2) * kstep;
            const char* a3 = a2 + kstep; const char* b3 = b2 + kstep;
            if (last && has_next) S.a_ready(nxt);
            if constexpr (SP2) {
            unsigned vA2[2][2];
#pragma unroll
            for (int h_ = 0; h_ < 2; ++h_) { vA2[h_][0] = last ? vAn[h_][0] : vAc[h_][0]; vA2[h_][1] = last ? vAn[h_][1] : vAc[h_][1]; }
            PG8_LDB(B0, 0, 0); PG8_LDB(B1, 0, 1); PG8_SCHED; PG8_LDA(At, 0, 0); PG8_STAGE_A(PG8_SA(1, 1), a1, 1, vAc);
            PG8_WAIT_V(8); PG8_WAIT_L(0); PG8_BAR; PG8_MMA(0, 0, At, B0); PG8_MMA(0, 1, At, B1); PG8_BAR; PG8_SCHED;
            PG8_LDA(At, 0, 1); PG8_STAGE(PG8_SB(0, 0), b2, voffB); PG8_STAGE(PG8_SB(0, 1), b2 + hstep, voffB); PG8_STAGE_A(PG8_SA(0, 0), a2, 0, vA2);
            PG8_WAIT_V(8); PG8_WAIT_L(0); PG8_BAR; PG8_MMA(1, 0, At, B0); PG8_MMA(1, 1, At, B1); PG8_BAR; PG8_SCHED;
            PG8_LDB(B0, 1, 0); PG8_LDB(B1, 1, 1); PG8_SCHED; PG8_LDA(At, 1, 0); PG8_STAGE_A(PG8_SA(0, 1), a2, 1, vA2);
            PG8_WAIT_V(8); PG8_WAIT_L(0); PG8_BAR; PG8_MMA(0, 0, At, B0); PG8_MMA(0, 1, At, B1); PG8_BAR; PG8_SCHED;
            PG8_LDA(At, 1, 1); PG8_STAGE(PG8_SB(1, 0), b3, voffB); PG8_STAGE(PG8_SB(1, 1), b3 + hstep, voffB); PG8_STAGE_A(PG8_SA(1, 0), a3, 0, vA2);
            PG8_WAIT_V(8); PG8_WAIT_L(0); PG8_BAR; PG8_MMA(1, 0, At, B0); PG8_MMA(1, 1, At, B1); PG8_BAR; PG8_SCHED;
            } else {
            PG8_LDB(B0, 0, 0); PG8_SCHED; PG8_LDA(At, 0, 0); PG8_STAGE(PG8_SA(1, 1), a1 + hstep, voffA);
            PG8_WAIT_L(8); PG8_BAR; PG8_WAIT_L(0); PG8_MMA(0, 0, At, B0); PG8_BAR; PG8_SCHED;
            PG8_LDB(B1, 0, 1); PG8_STAGE(PG8_SB(0, 0), b2, voffB);
            PG8_BAR; PG8_WAIT_L(0); PG8_MMA(0, 1, At, B1); PG8_BAR;
            PG8_LDA(At, 0, 1); PG8_STAGE(PG8_SA(0, 0), a2, voffA);
            PG8_BAR; PG8_WAIT_L(0); PG8_MMA(1, 0, At, B0); PG8_BAR; PG8_SCHED;
            PG8_STAGE(PG8_SB(0, 1), b2 + hstep, voffB);
            PG8_WAIT_V(6); PG8_BAR; PG8_MMA(1, 1, At, B1); PG8_BAR;
            PG8_LDB(B0, 1, 0); PG8_SCHED; PG8_LDA(At, 1, 0); PG8_STAGE(PG8_SA(0, 1), a2 + hstep, voffA);
            PG8_WAIT_L(8); PG8_BAR; PG8_WAIT_L(0); PG8_MMA(0, 0, At, B0); PG8_BAR; PG8_SCHED;
            PG8_LDB(B1, 1, 1); PG8_STAGE(PG8_SB(1, 0), b3, voffB);
            PG8_BAR; PG8_WAIT_L(0); PG8_MMA(0, 1, At, B1); PG8_BAR;
            PG8_LDA(At, 1, 1); PG8_STAGE(PG8_SA(1, 0), a3, voffA);
            PG8_BAR; PG8_WAIT_L(0); PG8_MMA(1, 0, At, B0); PG8_BAR; PG8_SCHED;
            PG8_STAGE(PG8_SB(1, 1), b3 + hstep, voffB);
            PG8_WAIT_V(6); PG8_BAR; PG8_MMA(1, 1, At, B1); PG8_BAR;
            }
        }
        if constexpr (ALIGN_EPI) { if (wr == 0) PG8_BAR; }
        if constexpr (!Epi::AFTER_DRAIN) { E(acc, cur, wr, wc, fr, fq); S.done(cur); }
        if (!has_next) break;
#pragma unroll
        for (int a = 0; a < 2; ++a)
#pragma unroll
            for (int b = 0; b < 2; ++b)
#pragma unroll
                for (int m = 0; m < 4; ++m)
#pragma unroll
                    for (int n = 0; n < 2; ++n) acc[a][b][m][n] = (f32x4){0.f, 0.f, 0.f, 0.f};
        cur = nxt; cA = nA; cB = nB; ++ui;
        if constexpr (GATHER) {
#pragma unroll
            for (int h_ = 0; h_ < 2; ++h_) { vAc[h_][0] = vAn[h_][0]; vAc[h_][1] = vAn[h_][1]; } }
        if constexpr (ALIGN_EPI) { if (wr == 1) PG8_BAR; }
    }
    PG8_WAIT_V(0);
    if constexpr (!ALIGN_EPI) { if (wr == 0) PG8_BAR; }
    PG8_BAR;
    if constexpr (Epi::AFTER_DRAIN) { E.fused(acc, cur, wr, wc, fr, fq, lds, wid, lane); S.done(cur); }
#undef PG8_SA
#undef PG8_LOADIDX
#undef PG8_STAGE_A
#undef PG8_SB
#undef PG8_STAGE
#undef PG8_LDA
#undef PG8_LDB
#undef PG8_MMA
#undef PG8_WAIT_V
#undef PG8_WAIT_L
#undef PG8_BAR
#undef PG8_SCHED
}
}

constexpr int SG_AS = 132, SG_BS = 68;
template <class FA, class FB>
__device__ __forceinline__ void sg_tile(LAS float* As, LAS float* Bs, int K, FA fa, FB fb, float (&acc)[4][4], int tid) {
    const int ty = tid >> 4, tx = tid & 15;
#pragma unroll
    for (int i = 0; i < 4; ++i)
#pragma unroll
        for (int j = 0; j < 4; ++j) acc[i][j] = 0.f;
    for (int k0 = 0; k0 < K; k0 += 16) {
#pragma unroll
        for (int i = 0; i < 4; ++i) { const int idx = tid + 512 * i, m = idx >> 4, kk = idx & 15; As[kk * SG_AS + m] = fa(m, k0 + kk); }
#pragma unroll
        for (int i = 0; i < 2; ++i) { const int idx = tid + 512 * i, n = idx >> 4, kk = idx & 15; Bs[kk * SG_BS + n] = fb(k0 + kk, n); }
        __syncthreads();
#pragma unroll
        for (int kk = 0; kk < 16; ++kk) {
            const f32x4 a = *(const LAS f32x4*)(As + kk * SG_AS + 4 * ty), b = *(const LAS f32x4*)(Bs + kk * SG_BS + 4 * tx);
#pragma unroll
            for (int i = 0; i < 4; ++i)
#pragma unroll
                for (int j = 0; j < 4; ++j) acc[i][j] += a[i] * b[j];
        }
        __syncthreads();
    }
}

template <int DQK>
__device__ __forceinline__ void sattn_unit(LAS float* sm, const bf16* Q, int ldq, const bf16* Kp, int ldk, const bf16* Vp, int ldv, bf16* O, int ldo, int nkeys, float scale, int tid) {
    constexpr int QS = DQK + 1;
    LAS float* Qs = sm; LAS float* Ks = Qs + 32 * QS; LAS float* Vs = Ks + 64 * QS; LAS float* Ss = Vs + 64 * 128;
    const int qi = tid >> 4, sub = tid & 15;
    __syncthreads();
    for (int idx = tid; idx < 32 * DQK; idx += 512) { const int r = idx / DQK, d = idx % DQK; Qs[r * QS + d] = bf2f(Q[(size_t)r * ldq + d]) * scale; }
    float m = -1e30f, l = 0.f, acc[8];
#pragma unroll
    for (int e = 0; e < 8; ++e) acc[e] = 0.f;
    for (int k0 = 0; k0 < nkeys; k0 += 64) {
        __syncthreads();
        for (int idx = tid; idx < 64 * DQK; idx += 512) { const int r = idx / DQK, d = idx % DQK; Ks[r * QS + d] = bf2f(Kp[(size_t)(k0 + r) * ldk + d]); }
        for (int idx = tid; idx < 64 * 128; idx += 512) { const int r = idx >> 7, d = idx & 127; Vs[r * 128 + d] = bf2f(Vp[(size_t)(k0 + r) * ldv + d]); }
        __syncthreads();
        float s[4];
#pragma unroll
        for (int c = 0; c < 4; ++c) { const int kj = sub + 16 * c; float a = 0.f;
            for (int d = 0; d < DQK; ++d) a += Qs[qi * QS + d] * Ks[kj * QS + d];
            s[c] = a; }
        float tmax = fmaxf(fmaxf(s[0], s[1]), fmaxf(s[2], s[3]));
#pragma unroll
        for (int o = 1; o < 16; o <<= 1) tmax = fmaxf(tmax, __shfl_xor(tmax, o));
        const float mnew = fmaxf(m, tmax), alpha = expf(m - mnew);
        float ps = 0.f;
#pragma unroll
        for (int c = 0; c < 4; ++c) { const float p = expf(s[c] - mnew); ps += p; Ss[qi * 65 + sub + 16 * c] = p; }
#pragma unroll
        for (int o = 1; o < 16; o <<= 1) ps += __shfl_xor(ps, o);
        l = l * alpha + ps; m = mnew;
        __syncthreads();
#pragma unroll
        for (int e = 0; e < 8; ++e) acc[e] *= alpha;
        for (int k = 0; k < 64; ++k) { const float p = Ss[qi * 65 + k];
#pragma unroll
            for (int e = 0; e < 8; ++e) acc[e] += p * Vs[k * 128 + sub * 8 + e]; }
    }
    const float rl = 1.f / l;
    u32x4 w; w.x = pk2(acc[0] * rl, acc[1] * rl); w.y = pk2(acc[2] * rl, acc[3] * rl); w.z = pk2(acc[4] * rl, acc[5] * rl); w.w = pk2(acc[6] * rl, acc[7] * rl);
    *(GAS u32x4*)(O + (size_t)qi * ldo + sub * 8) = w;
}

template <class RM>
__device__ __forceinline__ void transpose_item(const float* W, int K, int N, bf16* WT, int ldt, RM rowmap, LAS float* scr, int item, int lane) {
    const int nblk = N / 64, kb = item / nblk, nb = item % nblk, k0 = 64 * kb, n0 = 64 * nb;
    const int rsub = lane >> 4, c4 = (lane & 15) * 4;
    const GAS float* src = (const GAS float*)W + (size_t)(k0 + rsub) * N + n0 + c4;
    f32x4 v[16];
#pragma unroll
    for (int i = 0; i < 16; ++i) v[i] = *(const GAS f32x4*)(src + (size_t)(4 * i) * N);
#pragma unroll
    for (int i = 0; i < 16; ++i) { LAS float* d = scr + (4 * i + rsub) * 65 + c4; d[0] = v[i].x; d[1] = v[i].y; d[2] = v[i].z; d[3] = v[i].w; }
    LDS_WAIT(); asm volatile("" ::: "memory");
    const int kc = (lane & 7) * 8;
#pragma unroll
    for (int j = 0; j < 8; ++j) { const int n = (lane >> 3) + 8 * j; const LAS float* t = scr + kc * 65 + n;
        u32x4 o; o.x = pk2(t[0 * 65], t[1 * 65]); o.y = pk2(t[2 * 65], t[3 * 65]); o.z = pk2(t[4 * 65], t[5 * 65]); o.w = pk2(t[6 * 65], t[7 * 65]);
        *(GAS u32x4*)(WT + (size_t)rowmap(n0 + n) * ldt + k0 + kc) = o; }
    LDS_WAIT(); asm volatile("" ::: "memory");
}

__device__ __forceinline__ void phase_pro_a(const Frame& F_, const Args& A) { const Frame F = fresh(F_);
    const int gw = F.bid * NWAVES + F.wave, NGW = F.G * NWAVES, gt = F.bid * NTHREADS + F.tid, NGT = F.G * NTHREADS;
    {
        LAS float* sv = (LAS float*)F.lds;
        LAS float* red = sv + 3 * DM;
        for (int i = F.tid; i < 3 * DM; i += NTHREADS) { const int t = i / DM, k = i % DM; const float x = (t < 2) ? AIN(1)[t * DM + k] : AIN(3)[k]; sv[i] = silu_f(x); }
        __syncthreads();
        for (int item = F.bid; item < DEPTH * 24; item += F.G) {
            const int l = item / 24, n0 = (item % 24) * 256, kp = F.wave;
            const GAS float* w = (const GAS float*)AIN(4) + (size_t)l * DM * 6144 + (size_t)(kp * 128) * 6144 + n0 + 4 * F.lane;
            f32x4 a0 = {0.f, 0.f, 0.f, 0.f}, a1 = a0, a2 = a0;
#pragma unroll 8
            for (int k = 0; k < 128; ++k) { const f32x4 wv = *(const GAS f32x4*)(w + (size_t)k * 6144); const int kk = kp * 128 + k; a0 += wv * sv[kk]; a1 += wv * sv[DM + kk]; a2 += wv * sv[2 * DM + kk]; }
            *(LAS f32x4*)(red + (kp * 3 + 0) * 256 + 4 * F.lane) = a0; *(LAS f32x4*)(red + (kp * 3 + 1) * 256 + 4 * F.lane) = a1; *(LAS f32x4*)(red + (kp * 3 + 2) * 256 + 4 * F.lane) = a2;
            __syncthreads();
            for (int o = F.tid; o < 3 * 256; o += NTHREADS) { const int t = o >> 8, nn = o & 255; float sacc = AIN(5)[l * 6144 + n0 + nn];
                for (int q = 0; q < 8; ++q) sacc += red[(q * 3 + t) * 256 + nn];
                ((float*)(F.ws + WS_MODV))[(size_t)(l * 3 + t) * 6144 + n0 + nn] = sacc; }
            __syncthreads();
        }
    }
    for (int i = gt; i < 128 * 32 + 128 * 16; i += NGT) {
        if (i < 128 * 32) { const int p = i >> 5, f = i & 31; const float inv = powf(10000.f, -(float)(2 * f) / 64.f), ang = (float)p * inv;
            ((float*)(F.ws + WS_TABA))[2 * i] = cosf(ang); ((float*)(F.ws + WS_TABA))[2 * i + 1] = sinf(ang); }
        else { const int ii = i - 128 * 32, p = ii >> 4, f = ii & 15; const float inv = powf(10000.f, -(float)(2 * f) / 32.f), ang = (float)p * inv;
            ((float*)(F.ws + WS_TABC))[2 * ii] = cosf(ang); ((float*)(F.ws + WS_TABC))[2 * ii + 1] = sinf(ang); }
    }
    if (F.bid == 0 && F.wave < 2) { const int i = F.wave; const float a = AIN(13)[i * 64 + F.lane] * AIN(14)[i * 64 + F.lane], b = AIN(15)[i * 64 + F.lane] * AIN(16)[i * 64 + F.lane];
        const float sa = wave_sum(a), sb = wave_sum(b); const int l = 2 * i + 1; const float lam_init = 0.8f - 0.6f * expf(-0.3f * (float)l);
        if (F.lane == 0) { ((float*)(F.ws + WS_LAM))[2 * i] = expf(sa) - expf(sb) + lam_init; ((float*)(F.ws + WS_LAM))[2 * i + 1] = lam_init; } }
    {
        __syncthreads();
        LAS float* scr = (LAS float*)F.lds + F.wave * (64 * 65);
        constexpr int I_INE = (DM / 64) * (EIN / 64), I_OUT = (DM / 64) * (DM / 64), I_INO = (DM / 64) * (OIN / 64), I_G = (DM / 64) * (DEXP / 64), I_D = (DEXP / 64) * (DM / 64);
        constexpr int T_INE = 2 * I_INE, T_OUTE = 2 * I_OUT, T_INO = 2 * I_INO, T_OUTO = 2 * I_OUT, T_G = 64 * I_G, T_U = 64 * I_G, T_D = 64 * I_D;
        constexpr int NITEMS = T_INE + T_OUTE + T_INO + T_OUTO + T_G + T_U + T_D;
        for (int it = gw; it < NITEMS; it += NGW) {
            int r = it;
            if (r < T_INE) { const int i = r / I_INE; transpose_item(AIN(6) + (size_t)i * DM * EIN, DM, EIN, (bf16*)(F.ws + WS_WINE) + (size_t)i * EIN * DM, DM, [](int n) { return n; }, scr, r % I_INE, F.lane); continue; } r -= T_INE;
            if (r < T_OUTE) { const int i = r / I_OUT, item = r % I_OUT;
                if (item / (DM / 64) < 12) transpose_item(AIN(7) + (size_t)i * DM * DM, DM, DM, (bf16*)(F.ws + WS_WOUTE) + (size_t)i * DM * OAE, OAE, [](int n) { return n; }, scr, item, F.lane);
                continue; } r -= T_OUTE;
            if (r < T_INO) { const int i = r / I_INO; transpose_item(AIN(11) + (size_t)i * DM * OIN, DM, OIN, (bf16*)(F.ws + WS_WINO) + (size_t)i * OIN * DM, DM, [](int n) { return n; }, scr, r % I_INO, F.lane); continue; } r -= T_INO;
            if (r < T_OUTO) { const int i = r / I_OUT; transpose_item(AIN(12) + (size_t)i * DM * DM, DM, DM, (bf16*)(F.ws + WS_WOUTO) + (size_t)i * DM * DM, DM, [](int n) { return n; }, scr, r % I_OUT, F.lane); continue; } r -= T_OUTO;
            if (r < T_G) { const int le = r / I_G; transpose_item(AIN(22) + (size_t)le * DM * DEXP, DM, DEXP, (bf16*)(F.ws + WS_WGU) + (size_t)le * DM * DM, DM, [](int n) { return (n >> 7) * 256 + (n & 127); }, scr, r % I_G, F.lane); continue; } r -= T_G;
            if (r < T_U) { const int le = r / I_G; transpose_item(AIN(23) + (size_t)le * DM * DEXP, DM, DEXP, (bf16*)(F.ws + WS_WGU) + (size_t)le * DM * DM, DM, [](int n) { return (n >> 7) * 256 + 128 + (n & 127); }, scr, r % I_G, F.lane); continue; } r -= T_U;
            { const int le = r / I_D; transpose_item(AIN(24) + (size_t)le * DEXP * DM, DEXP, DM, (bf16*)(F.ws + WS_WD) + (size_t)le * DM * DEXP, DEXP, [](int n) { return n; }, scr, r % I_D, F.lane); }
        }
    }
    for (int o = gt; o < 2 * 2 * 256 * DM; o += NGT) {
        const int n = o & 1023, gc = (o >> 10) & 255, ri = (o >> 18) & 1, i = o >> 19, g = gc >> 6, c = gc & 63;
        const float* w = AIN(7) + (size_t)i * DM * DM + (size_t)(768 + 64 * g) * DM + n;
        float a = 0.f;
        for (int m = 0; m < 64; ++m) { const float fr = (float)((m * c) & 63) * (1.f / 64.f); const float t = ri ? __builtin_amdgcn_sinf(fr) : __builtin_amdgcn_cosf(fr); a += t * w[(size_t)m * DM]; }
        ((bf16*)(F.ws + WS_WOUTE))[(size_t)i * DM * OAE + (size_t)n * OAE + 768 + ri * 256 + gc] = (bf16)f2bf(a);
    }
}

__device__ __forceinline__ void phase_pro_b(const Frame& F_, const Args& A) { const Frame F = fresh(F_);
    const int gw = F.bid * NWAVES + F.wave, NGW = F.G * NWAVES;
    for (int r = gw; r < NTOK; r += NGW) {
        const int b = r / TPB, j = r - b * TPB, type = j < CTX ? 2 : b;
        const float* src = j < CTX ? AIN(2) + (size_t)(b * CTX + j) * DM : AIN(0) + (size_t)(b * SEQ + (j - CTX)) * DM;
        f32x4 v[4]; load_row_f32(src, F.lane, v);
        store_row_f32((float*)(F.ws + WS_X) + (size_t)r * DM, F.lane, v);
        modnorm_store(v, modv(F, 0, type, 1), modv(F, 0, type, 0), (bf16*)(F.ws + WS_HA) + (size_t)r * DM, F.lane);
    }
}

__device__ __forceinline__ void unpack8(const u32x4 w, float (&v)[8]) { v[0] = bflo(w.x); v[1] = bfhi(w.x); v[2] = bflo(w.y); v[3] = bfhi(w.y); v[4] = bflo(w.z); v[5] = bfhi(w.z); v[6] = bflo(w.w); v[7] = bfhi(w.w); }
__device__ __forceinline__ u32x4 pack8(const float (&v)[8]) { u32x4 w; w.x = pk2(v[0], v[1]); w.y = pk2(v[2], v[3]); w.z = pk2(v[4], v[5]); w.w = pk2(v[6], v[7]); return w; }

__device__ __forceinline__ void phase_qkfix_e(const Frame& F_, const Args& A, int i) { const Frame F = fresh(F_);
    const int gw = F.bid * NWAVES + F.wave, NGW = F.G * NWAVES, lane = F.lane;
    const float* qg = AIN(8) + i * 128; const float* kg = AIN(9) + i * 128; const float* bg = AIN(10) + i * 256;
    const float* tab = (const float*)(F.ws + WS_TABA);
    for (int r = gw; r < NTOK; r += NGW) {
        const int b = r / TPB, j = r - b * TPB; const bool lat = j >= CTX; const int t = j - CTX, prow = t >> 6, pcol = t & 63;
        bf16* P = (bf16*)(F.ws + WS_PBUF) + (size_t)r * EIN;
#pragma unroll
        for (int it = 0; it < 2; ++it) {
            GAS u32x4* p = (GAS u32x4*)(P + 512 * it) + lane;
            float v[8], y[8], o[8]; unpack8(*p, v);
            float ss = 0.f;
#pragma unroll
            for (int e = 0; e < 8; ++e) ss += v[e] * v[e];
            ss += swz_xor<1>(ss); ss += swz_xor<2>(ss); ss += swz_xor<4>(ss); ss += swz_xor<8>(ss);
            const float rstd = rsqrtf(ss * (1.f / 128.f) + EPS);
            const bool isk = (it == 1) && (lane >= 32);
            const int d0 = 8 * (lane & 15);
            const float* gp = (isk ? kg : qg) + d0;
#pragma unroll
            for (int e = 0; e < 8; ++e) y[e] = v[e] * rstd * gp[e];
            const int quarter = (lane & 15) >> 2, fi = 8 * (lane & 3);
            const int pos = quarter < 2 ? prow : pcol;
#pragma unroll
            for (int e = 0; e < 8; ++e) {
                const float pv = swz_xor<4>(y[e]);
                const float c = lat ? tab[2 * (pos * 32 + fi + e)] : 1.f, s = lat ? tab[2 * (pos * 32 + fi + e) + 1] : 0.f;
                o[e] = (quarter & 1) ? (pv * s + y[e] * c) : (y[e] * c - pv * s);
            }
            *p = pack8(o);
        }
        {
            GAS u32x4* p = (GAS u32x4*)(P + 1024) + lane;
            float v[8], o[8]; unpack8(*p, v);
            float ss = 0.f;
#pragma unroll
            for (int e = 0; e < 8; ++e) ss += v[e] * v[e];
            ss += swz_xor<1>(ss); ss += swz_xor<2>(ss); ss += swz_xor<4>(ss);
            const float rstd = rsqrtf(ss * (1.f / 64.f) + EPS);
            const float* gp = bg + 8 * (lane & 31);
#pragma unroll
            for (int e = 0; e < 8; ++e) o[e] = v[e] * rstd * gp[e];
            if (lane >= 32) *p = pack8(o);
        }
    }
}
__device__ __forceinline__ void phase_qkfix_o(const Frame& F_) { const Frame F = fresh(F_);
    const int gw = F.bid * NWAVES + F.wave, NGW = F.G * NWAVES, lane = F.lane;
    const float* tab = (const float*)(F.ws + WS_TABC);
    for (int r = gw; r < NTOK; r += NGW) {
        const int b = r / TPB, j = r - b * TPB; if (j < CTX) continue;
        const int t = j - CTX, prow = t >> 6, pcol = t & 63;
        bf16* P = (bf16*)(F.ws + WS_PBUF) + (size_t)r * OIN;
#pragma unroll
        for (int it = 0; it < 4; ++it) {
            GAS u32x4* p = (GAS u32x4*)(P + 512 * it) + lane;
            float y[8], o[8]; unpack8(*p, y);
            const int quarter = (lane & 7) >> 1, fi = 8 * (lane & 1);
            const int pos = quarter < 2 ? prow : pcol;
#pragma unroll
            for (int e = 0; e < 8; ++e) {
                const float pv = swz_xor<2>(y[e]);
                const float c = tab[2 * (pos * 16 + fi + e)], s = tab[2 * (pos * 16 + fi + e) + 1];
                o[e] = (quarter & 1) ? (pv * s + y[e] * c) : (y[e] * c - pv * s);
            }
            *p = pack8(o);
        }
    }
}
__device__ __forceinline__ void phase_finish_o(const Frame& F_, const Args& A, int i) { const Frame F = fresh(F_);
    const int gw = F.bid * NWAVES + F.wave, NGW = F.G * NWAVES, lane = F.lane;
    const float lam = ((const float*)(F.ws + WS_LAM))[2 * i], post = 1.f - ((const float*)(F.ws + WS_LAM))[2 * i + 1];
    const float* hg = AIN(17) + i * 128 + 8 * (lane & 15);
    for (int r = gw; r < NTOK; r += NGW) {
        const bf16* T = (const bf16*)(F.ws + WS_OT) + (size_t)r * OTW; bf16* O = (bf16*)(F.ws + WS_OA) + (size_t)r * OAO;
#pragma unroll
        for (int it = 0; it < 4; ++it) {
            float v[8], o[8]; unpack8(*((const GAS u32x4*)(T + 512 * it) + lane), v);
            float ss = 0.f;
#pragma unroll
            for (int e = 0; e < 8; ++e) { const float pv = swz_xor<16>(v[e]); o[e] = v[e] - lam * pv; ss += o[e] * o[e]; }
            ss += swz_xor<1>(ss); ss += swz_xor<2>(ss); ss += swz_xor<4>(ss); ss += swz_xor<8>(ss);
            const float rstd = rsqrtf(ss * (1.f / 128.f) + EPS) * post;
#pragma unroll
            for (int e = 0; e < 8; ++e) o[e] = o[e] * rstd * hg[e];
            if (((lane >> 4) & 1) == 0) *(GAS u32x4*)(O + (2 * it + (lane >> 5)) * 128 + 8 * (lane & 15)) = pack8(o);
        }
    }
}

__device__ __forceinline__ void phase_router(const Frame& F_, const Args& A, int l) { const Frame F = fresh(F_);
    LAS float* wc = (LAS float*)F.lds;
    LAS int* lcnt = (LAS int*)(F.lds + 81920);
    LAS int* gb = lcnt + 16;
    LAS int* rec = gb + 16;
    LAS float* recw = (LAS float*)(rec + 72 * 4);
    LAS float* bias = recw + 72 * 2;
    LAS float* lgt = bias + 32;
    const int lane = F.lane;
    __syncthreads();
    {
        const GAS f32x4* wg4 = (const GAS f32x4*)(AIN(18) + (size_t)l * DM * 4); const GAS f32x4* wr4 = (const GAS f32x4*)(AIN(20) + (size_t)l * DM * 16);
        f32x4 g[2], r[8];
#pragma unroll
        for (int i = 0; i < 2; ++i) g[i] = wg4[F.tid + 512 * i];
#pragma unroll
        for (int i = 0; i < 8; ++i) r[i] = wr4[F.tid + 512 * i];
#pragma unroll
        for (int i = 0; i < 2; ++i) { const int k = F.tid + 512 * i; wc[0 * DM + k] = g[i].x; wc[1 * DM + k] = g[i].y; wc[2 * DM + k] = g[i].z; wc[3 * DM + k] = g[i].w; }
#pragma unroll
        for (int i = 0; i < 8; ++i) { const int idx = F.tid + 512 * i, k = idx >> 2, q = idx & 3; wc[(4 + 4 * q + 0) * DM + k] = r[i].x; wc[(4 + 4 * q + 1) * DM + k] = r[i].y; wc[(4 + 4 * q + 2) * DM + k] = r[i].z; wc[(4 + 4 * q + 3) * DM + k] = r[i].w; }
    }
    if (F.tid < 16) lcnt[F.tid] = 0;
    if (F.tid < 20) bias[F.tid] = F.tid < 4 ? AIN(19)[l * 4 + F.tid] : AIN(21)[l * 16 + (F.tid - 4)];
    __syncthreads();
    const int nmine = (NTOK - F.bid + F.G - 1) / F.G;
    f32x4 vn[4];
    if (F.wave < nmine) load_row_f32((const float*)(F.ws + WS_X) + (size_t)(F.bid + F.wave * F.G) * DM, lane, vn);
    const bool lastl = (l == DEPTH - 1);
    for (int it = F.wave; it < nmine; it += NWAVES) {
        const int r = F.bid + it * F.G, type = row_type(r);
        f32x4 v[4];
#pragma unroll
        for (int j = 0; j < 4; ++j) v[j] = vn[j];
        if (it + NWAVES < nmine) load_row_f32((const float*)(F.ws + WS_X) + (size_t)(F.bid + (it + NWAVES) * F.G) * DM, lane, vn);
        if (lastl && type == 2) continue;
        f32x4 s[4], h[4]; load_row_f32(modv(F, l, type, 4), lane, s); load_row_f32(modv(F, l, type, 3), lane, h);
        const float rstd = row_rstd(v);
#pragma unroll
        for (int j = 0; j < 4; ++j) v[j] = v[j] * rstd * (s[j] + 1.f) + h[j];
        store_row_bf16((bf16*)(F.ws + WS_HA) + (size_t)r * DM, lane, v);
        float gl[4];
#pragma unroll
        for (int c = 0; c < 4; ++c) { float a = 0.f;
#pragma unroll
            for (int j = 0; j < 4; ++j) { const f32x4 w = *(const LAS f32x4*)(wc + c * DM + 4 * lane + 256 * j); a += (v[j].x * w.x + v[j].y * w.y) + (v[j].z * w.z + v[j].w * w.w); }
            gl[c] = a; }
        { float t[4];
#define RT_STEP(M) _Pragma("unroll") for (int c = 0; c < 4; ++c) t[c] = swz_xor<M>(gl[c]); _Pragma("unroll") for (int c = 0; c < 4; ++c) gl[c] += t[c];
          RT_STEP(1) RT_STEP(2) RT_STEP(4) RT_STEP(8) RT_STEP(16)
#pragma unroll
          for (int c = 0; c < 4; ++c) { const f32x2 s2 = swap32(gl[c]); gl[c] = s2.x + s2.y + bias[c]; } }
        int gi = 0;
#pragma unroll
        for (int g = 1; g < 4; ++g) if (gl[g] > gl[gi]) gi = g;
        gi = __builtin_amdgcn_readfirstlane(gi);
        float el[4];
#pragma unroll
        for (int e = 0; e < 4; ++e) { float a = 0.f; const LAS float* wrow = wc + (4 + 4 * gi + e) * DM + 4 * lane;
#pragma unroll
            for (int j = 0; j < 4; ++j) { const f32x4 w = *(const LAS f32x4*)(wrow + 256 * j); a += (v[j].x * w.x + v[j].y * w.y) + (v[j].z * w.z + v[j].w * w.w); }
            el[e] = a; }
        { float t[4];
#define RT_STEP2(M) _Pragma("unroll") for (int c = 0; c < 4; ++c) t[c] = swz_xor<M>(el[c]); _Pragma("unroll") for (int c = 0; c < 4; ++c) el[c] += t[c];
          RT_STEP2(1) RT_STEP2(2) RT_STEP2(4) RT_STEP2(8) RT_STEP2(16)
#undef RT_STEP
#undef RT_STEP2
#pragma unroll
          for (int c = 0; c < 4; ++c) { const f32x2 s2 = swap32(el[c]); el[c] = s2.x + s2.y + bias[4 + 4 * gi + c]; } }
        if (lane < 9) { float o = (lane < 4) ? gl[0] : el[0];
#pragma unroll
            for (int c = 1; c < 4; ++c) { o = (lane == c) ? gl[c] : o; o = (lane == 4 + c) ? el[c] : o; }
            if (lane == 8) o = __builtin_bit_cast(float, gi);
            lgt[it * 12 + lane] = o; }
    }
    __syncthreads();
    if (F.tid < nmine && !(lastl && row_type(F.bid + F.tid * F.G) == 2)) { const int it = F.tid;
        float gl[4], el[4];
#pragma unroll
        for (int c = 0; c < 4; ++c) { gl[c] = lgt[it * 12 + c]; el[c] = lgt[it * 12 + 4 + c]; }
        const int gi = __builtin_bit_cast(int, lgt[it * 12 + 8]);
        float gmax = gl[0];
#pragma unroll
        for (int g = 1; g < 4; ++g) gmax = fmaxf(gmax, gl[g]);
        float gs = 0.f;
#pragma unroll
        for (int g = 0; g < 4; ++g) gs += expf(gl[g] - gmax);
        const float ggate = 1.f / gs;
        int i0 = 0;
#pragma unroll
        for (int e = 1; e < 4; ++e) if (el[e] > el[i0]) i0 = e;
        int i1 = (i0 == 0) ? 1 : 0;
#pragma unroll
        for (int e = 0; e < 4; ++e) if (e != i0 && el[e] > el[i1]) i1 = e;
        float e0v = el[0], e1v = el[0];
#pragma unroll
        for (int e = 1; e < 4; ++e) { e0v = (i0 == e) ? el[e] : e0v; e1v = (i1 == e) ? el[e] : e1v; }
        const float p1 = expf(e1v - e0v);
        const float w0 = ggate / (1.f + p1), w1 = ggate * p1 / (1.f + p1);
        const int e0 = gi * 4 + i0, e1 = gi * 4 + i1;
        const int lp0 = __hip_atomic_fetch_add(lcnt + e0, 1, __ATOMIC_RELAXED, __HIP_MEMORY_SCOPE_WORKGROUP);
        const int lp1 = __hip_atomic_fetch_add(lcnt + e1, 1, __ATOMIC_RELAXED, __HIP_MEMORY_SCOPE_WORKGROUP);
        rec[it * 4 + 0] = e0; rec[it * 4 + 1] = lp0; rec[it * 4 + 2] = e1; rec[it * 4 + 3] = lp1; recw[it * 2] = w0; recw[it * 2 + 1] = w1;
    }
    __syncthreads();
    if (F.tid < 16) gb[F.tid] = (int)__hip_atomic_fetch_add((unsigned*)(F.ws + WS_CTL) + CW_CNT + 64 * (16 * l + F.tid), (unsigned)lcnt[F.tid], __ATOMIC_RELAXED, __HIP_MEMORY_SCOPE_AGENT);
    __syncthreads();
    if (F.tid < nmine && !(lastl && row_type(F.bid + F.tid * F.G) == 2)) { const int it = F.tid, r = F.bid + it * F.G; const int e0 = rec[it * 4], e1 = rec[it * 4 + 2];
        const int q0 = gb[e0] + rec[it * 4 + 1], q1 = gb[e1] + rec[it * 4 + 3];
        ((GAS i32x4*)(F.ws + WS_SELA))[r] = (i32x4){e0, q0, e1, q1};
        ((GAS int*)(F.ws + WS_ROWTOK))[(size_t)e0 * NTOK + q0] = r; ((GAS int*)(F.ws + WS_ROWTOK))[(size_t)e1 * NTOK + q1] = r;
        ((GAS f32x2*)(F.ws + WS_SELW))[r] = (f32x2){recw[it * 2], recw[it * 2 + 1]}; }
    __syncthreads();
}
__device__ __forceinline__ void moe_bases(const Frame& F, int l, int (&base)[17]) {
    const unsigned* cnt = (const unsigned*)(F.ws + WS_CTL) + CW_CNT + 64 * 16 * l;
    int acc = 0;
#pragma unroll
    for (int e = 0; e < 16; ++e) { base[e] = acc; const int c = __builtin_amdgcn_readfirstlane((int)__hip_atomic_load(cnt + 64 * e, __ATOMIC_RELAXED, __HIP_MEMORY_SCOPE_AGENT)); acc += ((c + 255) >> 8) << 8; }
    base[16] = acc;
}
__device__ __forceinline__ void phase_gather(const Frame& F_, int l) { const Frame F = fresh(F_);
    const int gw = F.bid * NWAVES + F.wave, NGW = F.G * NWAVES, lane = F.lane;
    int base[17]; moe_bases(F, l, base);
    for (int r = gw; r < NTOK; r += NGW) {
        const i32x4 s = ((const GAS i32x4*)(F.ws + WS_SELA))[r];
        int b0 = 0, b1 = 0;
#pragma unroll
        for (int e = 0; e < 16; ++e) { b0 = (s.x == e) ? base[e] : b0; b1 = (s.z == e) ? base[e] : b1; }
        const int r0 = b0 + s.y, r1 = b1 + s.w;
        const GAS u32x4* src = (const GAS u32x4*)((const bf16*)(F.ws + WS_HA) + (size_t)r * DM) + lane;
        const u32x4 a = src[0], c = src[64];
        GAS u32x4* d0 = (GAS u32x4*)((bf16*)(F.ws + WS_XS) + (size_t)r0 * DM) + lane; d0[0] = a; d0[64] = c;
        GAS u32x4* d1 = (GAS u32x4*)((bf16*)(F.ws + WS_XS) + (size_t)r1 * DM) + lane; d1[0] = a; d1[64] = c;
        if (lane == 0) ((GAS i32x2*)(F.ws + WS_RPOS))[r] = (i32x2){r0, r1};
    }
}
__device__ __forceinline__ void phase_combine(const Frame& F_, const Args& A, int l) { const Frame F = fresh(F_);
    const int gw = F.bid * NWAVES + F.wave, NGW = F.G * NWAVES, lane = F.lane;
    int base[17]; moe_bases(F, l, base);
    const GAS i32x4* SELA = (const GAS i32x4*)(F.ws + WS_SELA); const GAS f32x2* SELW = (const GAS f32x2*)(F.ws + WS_SELW);
    const bf16* Y = (const bf16*)(F.ws + WS_Y2S); float* X = (float*)(F.ws + WS_X);
    const int nk = (NTOK - gw + NGW - 1) / NGW;
    if (nk <= 0) return;
#define CB_ROWS(sel, ra, rb) do { int b0_ = 0, b1_ = 0; _Pragma("unroll") for (int e = 0; e < 16; ++e) { b0_ = ((sel).x == e) ? base[e] : b0_; b1_ = ((sel).z == e) ? base[e] : b1_; } ra = b0_ + (sel).y; rb = b1_ + (sel).w; } while (0)
#define CB_LOADY(dst, row) do { const GAS u32x2* q_ = (const GAS u32x2*)(Y + (size_t)(row) * DM) + lane; _Pragma("unroll") for (int j = 0; j < 4; ++j) dst[j] = q_[64 * j]; } while (0)
    i32x4 selB = SELA[gw]; f32x2 wA = SELW[gw], wB = wA; i32x4 selC = selB;
    f32x4 xA[4], xB[4]; u32x2 yA0[4], yA1[4], yB0[4], yB1[4];
    { int ra, rb; CB_ROWS(selB, ra, rb); load_row_f32(X + (size_t)gw * DM, lane, xA); CB_LOADY(yA0, ra); CB_LOADY(yA1, rb); }
    if (nk > 1) selB = SELA[gw + NGW];
    for (int k = 0; k < nk; ++k) {
        const int r = gw + k * NGW, b = r / TPB, j = r - b * TPB, type = j < CTX ? 2 : b;
        if (k + 1 < nk) { const int rn = r + NGW; int ra, rb; CB_ROWS(selB, ra, rb); load_row_f32(X + (size_t)rn * DM, lane, xB); CB_LOADY(yB0, ra); CB_LOADY(yB1, rb); wB = SELW[rn]; }
        if (k + 2 < nk) selC = SELA[r + 2 * NGW];
        if (!(l == DEPTH - 1 && j < CTX)) {
            f32x4 x[4], g[4];
            load_row_f32(modv(F, l, type, 5), lane, g);
#pragma unroll
            for (int q = 0; q < 4; ++q) { const f32x4 y0 = {bflo(yA0[q].x), bfhi(yA0[q].x), bflo(yA0[q].y), bfhi(yA0[q].y)}, y1 = {bflo(yA1[q].x), bfhi(yA1[q].x), bflo(yA1[q].y), bfhi(yA1[q].y)};
                x[q] = xA[q] + g[q] * (y0 * wA.x + y1 * wA.y); }
            if (l < DEPTH - 1) {
                store_row_f32(X + (size_t)r * DM, lane, x);
                modnorm_store(x, modv(F, l + 1, type, 1), modv(F, l + 1, type, 0), (bf16*)(F.ws + WS_HA) + (size_t)r * DM, lane);
            } else {
                const float rstd = row_rstd(x);
                f32x4 fg[4]; load_row_f32(AIN(25), lane, fg);
#pragma unroll
                for (int q = 0; q < 4; ++q) x[q] = x[q] * rstd * fg[q];
                store_row_f32(A.out + (size_t)(b * SEQ + (j - CTX)) * DM, lane, x);
            }
        }
#pragma unroll
        for (int q = 0; q < 4; ++q) { xA[q] = xB[q]; yA0[q] = yB0[q]; yA1[q] = yB1[q]; }
        wA = wB; selB = selC;
    }
#undef CB_ROWS
#undef CB_LOADY
}

__device__ __forceinline__ void sphase_gemm_bf16(const Frame& F_, const bf16* Am, int lda, const bf16* Bt, int ldb, bf16* C, int ldc, int M, int N, int K) { const Frame F = fresh(F_);
    LAS float* As = (LAS float*)F.lds; LAS float* Bs = As + 16 * SG_AS;
    const int nm = M / 128, nn = N / 64, ty = F.tid >> 4, tx = F.tid & 15;
    for (int t = F.bid; t < nm * nn; t += F.G) {
        const int tm = t / nn, tn = t % nn; const bf16* a0 = Am + (size_t)tm * 128 * lda; const bf16* b0 = Bt + (size_t)tn * 64 * ldb;
        float acc[4][4];
        sg_tile(As, Bs, K, [&](int m, int k) { return bf2f(a0[(size_t)m * lda + k]); }, [&](int k, int n) { return bf2f(b0[(size_t)n * ldb + k]); }, acc, F.tid);
#pragma unroll
        for (int i = 0; i < 4; ++i) { u32x2 w; w.x = pk2(acc[i][0], acc[i][1]); w.y = pk2(acc[i][2], acc[i][3]);
            *(GAS u32x2*)(C + (size_t)(tm * 128 + 4 * ty + i) * ldc + tn * 64 + 4 * tx) = w; }
    }
}
__device__ __forceinline__ void sphase_outproj(const Frame& F_, const bf16* Am, int lda, const bf16* Bt, int K, int l) { const Frame F = fresh(F_);
    LAS float* As = (LAS float*)F.lds; LAS float* Bs = As + 16 * SG_AS;
    const int nm = NTOK / 128, nn = DM / 64, ty = F.tid >> 4, tx = F.tid & 15;
    for (int t = F.bid; t < nm * nn; t += F.G) {
        const int tm = t / nn, tn = t % nn; const bf16* a0 = Am + (size_t)tm * 128 * lda; const bf16* b0 = Bt + (size_t)tn * 64 * K;
        float acc[4][4];
        sg_tile(As, Bs, K, [&](int m, int k) { return bf2f(a0[(size_t)m * lda + k]); }, [&](int k, int n) { return bf2f(b0[(size_t)n * K + k]); }, acc, F.tid);
#pragma unroll
        for (int i = 0; i < 4; ++i) { const int r = tm * 128 + 4 * ty + i, c = tn * 64 + 4 * tx;
            const f32x4 g = *(const GAS f32x4*)(modv(F, l, row_type(r), 2) + c);
            GAS f32x4* xp = (GAS f32x4*)((float*)(F.ws + WS_X) + (size_t)r * DM + c); f32x4 x = *xp;
            x.x += g.x * acc[i][0]; x.y += g.y * acc[i][1]; x.z += g.z * acc[i][2]; x.w += g.w * acc[i][3]; *xp = x; }
    }
}
__device__ __forceinline__ int moe_expert_of_row(const int (&base)[17], int row) { int e = 0;
#pragma unroll
    for (int q = 1; q < 16; ++q) e = (row >= base[q]) ? q : e;
    return e; }
__device__ __forceinline__ void sphase_moe_gu(const Frame& F_, int l) { const Frame F = fresh(F_);
    LAS float* As = (LAS float*)F.lds; LAS float* Bs = As + 16 * SG_AS;
    int base[17]; moe_bases(F, l, base);
    const int nm = base[16] / 128, nn = DEXP / 64, ty = F.tid >> 4, tx = F.tid & 15;
    for (int t = F.bid; t < nm * nn; t += F.G) {
        const int tm = t / nn, tn = t % nn, e = moe_expert_of_row(base, tm * 128);
        const bf16* a0 = (const bf16*)(F.ws + WS_XS) + (size_t)tm * 128 * DM;
        const bf16* w = (const bf16*)(F.ws + WS_WGU) + (size_t)(l * 16 + e) * DM * DM;
        const int hc0 = tn * 64;
        const bf16* bg0 = w + (size_t)((hc0 >> 7) * 256 + (hc0 & 127)) * DM; const bf16* bu0 = bg0 + (size_t)128 * DM;
        float ag[4][4], au[4][4];
        sg_tile(As, Bs, DM, [&](int m, int k) { return bf2f(a0[(size_t)m * DM + k]); }, [&](int k, int n) { return bf2f(bg0[(size_t)n * DM + k]); }, ag, F.tid);
        sg_tile(As, Bs, DM, [&](int m, int k) { return bf2f(a0[(size_t)m * DM + k]); }, [&](int k, int n) { return bf2f(bu0[(size_t)n * DM + k]); }, au, F.tid);
#pragma unroll
        for (int i = 0; i < 4; ++i) { float h[4];
#pragma unroll
            for (int j = 0; j < 4; ++j) h[j] = silu_f(ag[i][j]) * au[i][j];
            u32x2 wv; wv.x = pk2(h[0], h[1]); wv.y = pk2(h[2], h[3]);
            *(GAS u32x2*)((bf16*)(F.ws + WS_HID) + (size_t)(tm * 128 + 4 * ty + i) * DEXP + hc0 + 4 * tx) = wv; }
    }
}
__device__ __forceinline__ void sphase_moe_down(const Frame& F_, int l) { const Frame F = fresh(F_);
    LAS float* As = (LAS float*)F.lds; LAS float* Bs = As + 16 * SG_AS;
    int base[17]; moe_bases(F, l, base);
    const int nm = base[16] / 128, nn = DM / 64, ty = F.tid >> 4, tx = F.tid & 15;
    for (int t = F.bid; t < nm * nn; t += F.G) {
        const int tm = t / nn, tn = t % nn, e = moe_expert_of_row(base, tm * 128);
        const bf16* a0 = (const bf16*)(F.ws + WS_HID) + (size_t)tm * 128 * DEXP;
        const bf16* b0 = (const bf16*)(F.ws + WS_WD) + (size_t)(l * 16 + e) * DM * DEXP + (size_t)tn * 64 * DEXP;
        float acc[4][4];
        sg_tile(As, Bs, DEXP, [&](int m, int k) { return bf2f(a0[(size_t)m * DEXP + k]); }, [&](int k, int n) { return bf2f(b0[(size_t)n * DEXP + k]); }, acc, F.tid);
#pragma unroll
        for (int i = 0; i < 4; ++i) { u32x2 w; w.x = pk2(acc[i][0], acc[i][1]); w.y = pk2(acc[i][2], acc[i][3]);
            *(GAS u32x2*)((bf16*)(F.ws + WS_Y2S) + (size_t)(tm * 128 + 4 * ty + i) * DM + tn * 64 + 4 * tx) = w; }
    }
}


#ifndef FAST_GEMM
#define FAST_GEMM 1
#endif
__device__ __forceinline__ void fphase_inproj(const Frame& F_, bool even, int i) { const Frame F = fresh(F_);
    if (even) {
        pg8::Gemm g{(const bf16*)(F.ws + WS_HA), (const bf16*)(F.ws + WS_WINE) + (size_t)i * EIN * DM, NTOK, EIN, DM, 0};
        pg8::StaticOrder S; S.init(NTOK, EIN, F.G, F.bid);
        pg8::EpiBf16<0> E{(bf16*)(F.ws + WS_PBUF), EIN, nullptr, 0, 0, 1.f};
        pg8::gemm_phase<pg8::EpiBf16<0>, pg8::StaticOrder, true, true>(F.lds, g, S, E, F.tid);
    } else {
        pg8::Gemm g{(const bf16*)(F.ws + WS_HA), (const bf16*)(F.ws + WS_WINO) + (size_t)i * OIN * DM, NTOK, OIN, DM, 0};
        pg8::StaticOrder S; S.init(NTOK, OIN, F.G, F.bid);
        pg8::EpiRopeO E{(bf16*)(F.ws + WS_PBUF), OIN, (const float*)(F.ws + WS_TABC), 8, (ATTN_RING3 && ATTN_NEGM) ? 4 : 0, 0.125f * 1.4426950408889634f};
        pg8::gemm_phase<pg8::EpiRopeO, pg8::StaticOrder, true, true>(F.lds, g, S, E, F.tid);
    }
}
__device__ __forceinline__ void fphase_outproj(const Frame& F_, bool even, int i, int l) { const Frame F = fresh(F_);
    const int K = even ? OAE : OAO;
    const bf16* Bt = even ? (const bf16*)(F.ws + WS_WOUTE) + (size_t)i * DM * OAE : (const bf16*)(F.ws + WS_WOUTO) + (size_t)i * DM * DM;
    pg8::Gemm g{(const bf16*)(F.ws + WS_OA), Bt, NTOK, DM, K, 0};
    pg8::EpiResGate E{(float*)(F.ws + WS_X), modv(F, l, 0, 2)};
    if (l == DEPTH - 1) {
        pg8::LatOrder S; S.init(DM, F.G, F.bid);
        pg8::gemm_phase<pg8::EpiResGate, pg8::LatOrder, true, true>(F.lds, g, S, E, F.tid);
    } else {
        pg8::StaticOrder S; S.init(NTOK, DM, F.G, F.bid);
        pg8::gemm_phase<pg8::EpiResGate, pg8::StaticOrder, true, true>(F.lds, g, S, E, F.tid);
    }
}
__device__ __forceinline__ void fphase_moe_gu(const Frame& F_, int l) { const Frame F = fresh(F_);
    int base[17]; moe_bases(F, l, base);
    LAS int* tbl = (LAS int*)(F.lds + TB_OFF);
    __syncthreads();
#pragma unroll
    for (int e = 0; e < 17; ++e) if (F.tid == e) tbl[e] = base[e] >> 8;
    __syncthreads();
    pg8::MoeOrder S; S.tb = tbl; S.nN = 4; S.nwg = (base[16] >> 8) * 4; S.G = F.G; S.c = F.bid;
    pg8::Gemm g{(const bf16*)(F.ws + WS_HA), (const bf16*)(F.ws + WS_WGU) + (size_t)l * 16 * DM * DM, base[16], DM, DM, (size_t)DM * DM * 2, (const int*)(F.ws + WS_ROWTOK), NTOK};
    pg8::EpiSwiGLU E{(bf16*)(F.ws + WS_HID)};
    pg8::gemm_phase<pg8::EpiSwiGLU, pg8::MoeOrder, true, true, true>(F.lds, g, S, E, F.tid);
}
__device__ __forceinline__ void fphase_moe_down(const Frame& F_, int l) { const Frame F = fresh(F_);
    int base[17]; moe_bases(F, l, base);
    LAS int* tbl = (LAS int*)(F.lds + TB_OFF);
    __syncthreads();
#pragma unroll
    for (int e = 0; e < 17; ++e) if (F.tid == e) tbl[e] = base[e] >> 8;
    __syncthreads();
    pg8::MoeOrder S; S.tb = tbl; S.nN = 4; S.nwg = (base[16] >> 8) * 4; S.G = F.G; S.c = F.bid;
    pg8::Gemm g{(const bf16*)(F.ws + WS_HID), (const bf16*)(F.ws + WS_WD) + (size_t)l * 16 * DM * DEXP, base[16], DM, DEXP, (size_t)DM * DEXP * 2};
    pg8::EpiBf16<0> E{(bf16*)(F.ws + WS_Y2S), DM, nullptr, 0, 0, 1.f};
    pg8::gemm_phase<pg8::EpiBf16<0>, pg8::MoeOrder, true, true>(F.lds, g, S, E, F.tid);
}

__device__ __forceinline__ void sphase_fft1(const Frame& F_) { const Frame F = fresh(F_);
    const int gt = F.bid * NTHREADS + F.tid, NGT = F.G * NTHREADS;
    for (int o = gt; o < NB * 128 * 2 * 64 * 256; o += NGT) {
        const int col = o & 255, t2 = (o >> 8) & 63, ri = (o >> 14) & 1, k1 = (o >> 15) & 127, b = o >> 22;
        const bf16* f = (const bf16*)(F.ws + WS_PBUF) + (size_t)(b * TPB + CTX + t2) * EIN + 1280 + col;
        float a = 0.f;
        for (int t1 = 0; t1 < 128; ++t1) { const int t = 64 * t1 + t2; const float fr = (float)((k1 * t) & 8191) * (1.f / 8192.f);
            const float c = ri ? -__builtin_amdgcn_sinf(fr) : __builtin_amdgcn_cosf(fr); a += c * bf2f(f[(size_t)(64 * t1) * EIN]); }
        ((bf16*)(F.ws + WS_YB))[o] = (bf16)f2bf(a);
    }
}
__device__ __forceinline__ void sphase_fft2(const Frame& F_) { const Frame F = fresh(F_);
    const int gt = F.bid * NTHREADS + F.tid, NGT = F.G * NTHREADS;
    const float norm = 1.f / sqrtf(8192.f * 64.f);
    for (int o = gt; o < NB * SEQ * 2 * 256; o += NGT) {
        const int col = o & 255, ri = (o >> 8) & 1, k = (o >> 9) & 8191, b = o >> 22, k1 = k & 127, k2 = k >> 7;
        const bf16* yr = (const bf16*)(F.ws + WS_YB) + ((size_t)((b * 128 + k1) * 2 + 0) * 64) * 256 + col; const bf16* yi = yr + 64 * 256;
        float a = 0.f;
        for (int t2 = 0; t2 < 64; ++t2) { const float fr = (float)((k2 * t2) & 63) * (1.f / 64.f), c = __builtin_amdgcn_cosf(fr), s = __builtin_amdgcn_sinf(fr);
            const float vr = bf2f(yr[t2 * 256]), vi = bf2f(yi[t2 * 256]);
            a += ri ? (c * vi - s * vr) : (c * vr + s * vi); }
        ((bf16*)(F.ws + WS_OA))[(size_t)(b * TPB + CTX + k) * OAE + 768 + ri * 256 + col] = (bf16)f2bf(a * norm);
    }
}
__device__ __forceinline__ void sphase_fftc(const Frame& F_) { const Frame F = fresh(F_);
    const int gt = F.bid * NTHREADS + F.tid, NGT = F.G * NTHREADS;
    const float norm = 1.f / sqrtf(256.f * 64.f);
    for (int o = gt; o < NB * CTX * 2 * 256; o += NGT) {
        const int col = o & 255, ri = (o >> 8) & 1, k = (o >> 9) & 255, b = o >> 17;
        const bf16* f = (const bf16*)(F.ws + WS_PBUF) + (size_t)(b * TPB) * EIN + 1280 + col;
        float a = 0.f;
        for (int t = 0; t < CTX; ++t) { const float fr = (float)((k * t) & 255) * (1.f / 256.f); const float c = ri ? -__builtin_amdgcn_sinf(fr) : __builtin_amdgcn_cosf(fr); a += c * bf2f(f[(size_t)t * EIN]); }
        ((bf16*)(F.ws + WS_OA))[(size_t)(b * TPB + k) * OAE + 768 + ri * 256 + col] = (bf16)f2bf(a * norm);
    }
}


namespace fa {
using bf16x8 = __attribute__((ext_vector_type(8))) short;
using s16x4  = __attribute__((ext_vector_type(4))) short;
using f32x16 = __attribute__((ext_vector_type(16))) float;
constexpr int NW = 8, QBLK = 32, KVBLK = 64, DV = 128;
constexpr float THR = 8.f;
constexpr int SHM_V = KVBLK * DV * 2;
template <int DQK> struct Cfg { static constexpr float SCALE = DQK == 128 ? 0.088388347648318440f : 0.125f; static constexpr int RB = DQK * 2, SHM_K = KVBLK * DQK * 2, ND0 = DQK / 16; };
#define FA_KSWZ(row, colB, RB) ((row) * (RB) + ((colB) ^ (((RB) == 256 ? ((row) & 15) : (((row) >> 1) & 7)) << 4)))
#define FA_SBAR() __builtin_amdgcn_sched_barrier(0)
__device__ __forceinline__ int crow(int r, int hi) { return (r & 3) + 8 * (r >> 2) + 4 * hi; }
__device__ __forceinline__ unsigned cvtpk(float lo, float hi) { unsigned r; asm volatile("v_cvt_pk_bf16_f32 %0, %1, %2" : "=v"(r) : "v"(lo), "v"(hi)); return r; }
template <int DQK>
__device__ __forceinline__ void partialSM(f32x16& p0, f32x16& p1, float& m_reg, float& mn, float& alpha) {
  constexpr float SCALE = Cfg<DQK>::SCALE, C = SCALE * 1.4426950408889634f;
  float pmax = p0[0];
#pragma unroll
  for (int r = 1; r < 16; ++r) pmax = fmaxf(pmax, p0[r]);
#pragma unroll
  for (int r = 0; r < 16; ++r) pmax = fmaxf(pmax, p1[r]);
  { auto rr = __builtin_amdgcn_permlane32_swap(__float_as_uint(pmax), __float_as_uint(pmax), false, false);
    pmax = fmaxf(__uint_as_float(rr[0]), __uint_as_float(rr[1])); }
  if (__builtin_expect(__all(pmax - m_reg <= THR / SCALE), 1)) { mn = m_reg; alpha = 1.f; }
  else { mn = fmaxf(m_reg, pmax); alpha = __builtin_amdgcn_exp2f((m_reg - mn) * C); m_reg = mn; }
  const float mnC = -mn * C;
#pragma unroll
  for (int r = 0; r < 16; ++r) p0[r] = fmaf(p0[r], C, mnC);
#pragma unroll
  for (int r = 0; r < 16; ++r) p1[r] = fmaf(p1[r], C, mnC);
#pragma unroll
  for (int r = 0; r < 16; ++r) p0[r] = __builtin_amdgcn_exp2f(p0[r]);
}
__device__ __forceinline__ void finishSM(f32x16& p0, f32x16& p1, float alpha, float& l_reg, bf16x8& pa0, bf16x8& pa1, bf16x8& pa2, bf16x8& pa3) {
#pragma unroll
  for (int r = 0; r < 16; ++r) p1[r] = __builtin_amdgcn_exp2f(p1[r]);
  float ps = 0;
#pragma unroll
  for (int r = 0; r < 16; ++r) ps += p0[r];
#pragma unroll
  for (int r = 0; r < 16; ++r) ps += p1[r];
  { auto rr = __builtin_amdgcn_permlane32_swap(__float_as_uint(ps), __float_as_uint(ps), false, false);
    ps = __uint_as_float(rr[0]) + __uint_as_float(rr[1]); }
  l_reg = l_reg * alpha + ps;
#define FA_PK4(P, BASE, OUT) do { unsigned a0 = cvtpk(P[BASE + 0], P[BASE + 1]), a1 = cvtpk(P[BASE + 2], P[BASE + 3]);   \
    unsigned b0 = cvtpk(P[BASE + 4], P[BASE + 5]), b1 = cvtpk(P[BASE + 6], P[BASE + 7]);                              \
    auto r0 = __builtin_amdgcn_permlane32_swap(a0, b0, false, false); auto r1 = __builtin_amdgcn_permlane32_swap(a1, b1, false, false); \
    u32x4 w = {r0[0], r1[0], r0[1], r1[1]}; OUT = *reinterpret_cast<bf16x8*>(&w); } while (0)
  FA_PK4(p0, 0, pa0); FA_PK4(p0, 8, pa1); FA_PK4(p1, 0, pa2); FA_PK4(p1, 8, pa3);
#undef FA_PK4
}
template <int DQK>
__device__ __forceinline__ void qkt(f32x16& p0, f32x16& p1, const LAS char* Ks, const bf16x8* qr, int r32, int hi) {
  constexpr int RB = Cfg<DQK>::RB;
  p0 = f32x16{}; p1 = f32x16{};
#pragma unroll
  for (int d0 = 0; d0 < Cfg<DQK>::ND0; ++d0) { const int cb = (d0 * 16 + hi * 8) * 2;
    bf16x8 b0 = *reinterpret_cast<const LAS bf16x8*>(Ks + FA_KSWZ(r32, cb, RB));
    bf16x8 b1 = *reinterpret_cast<const LAS bf16x8*>(Ks + FA_KSWZ(32 + r32, cb, RB));
    p0 = __builtin_amdgcn_mfma_f32_32x32x16_bf16(b0, qr[d0], p0, 0, 0, 0);
    p1 = __builtin_amdgcn_mfma_f32_32x32x16_bf16(b1, qr[d0], p1, 0, 0, 0); }
}
__device__ __forceinline__ int v_st(int k, int c) { const int kk = (k & ~0xC) | ((k & 4) << 1) | ((k & 8) >> 1); return ((kk >> 3) * 4 + (c >> 5)) * 512 + ((kk & 7) * 32 + (c & 31)) * 2; }
__device__ __forceinline__ int v_rd_base(int lane) { return ((lane & 3) << 3) | (((lane >> 2) & 3) << 6) | (((lane >> 4) & 1) << 5) | (((lane >> 5) & 1) << 8); }
constexpr int v_rd_off(int d0, int ks, int half) { return d0 * 512 + ks * 4096 + half * 2048; }
template <int OFF> __device__ __forceinline__ s16x4 tr_read(int vb) {
  s16x4 r; asm volatile("ds_read_b64_tr_b16 %0, %1 offset:%2" : "=&v"(r) : "v"(vb), "i"(OFF) : "memory"); return r;
}
template <int D0> __device__ __forceinline__ void pv_one(f32x16& od, int vb, bf16x8 pa0, bf16x8 pa1, bf16x8 pa2, bf16x8 pa3) {
  const s16x4 l0 = tr_read<v_rd_off(D0, 0, 0)>(vb), h0 = tr_read<v_rd_off(D0, 0, 1)>(vb), l1 = tr_read<v_rd_off(D0, 1, 0)>(vb), h1 = tr_read<v_rd_off(D0, 1, 1)>(vb);
  const s16x4 l2 = tr_read<v_rd_off(D0, 2, 0)>(vb), h2 = tr_read<v_rd_off(D0, 2, 1)>(vb), l3 = tr_read<v_rd_off(D0, 3, 0)>(vb), h3 = tr_read<v_rd_off(D0, 3, 1)>(vb);
  asm volatile("s_waitcnt lgkmcnt(0)" ::: "memory"); FA_SBAR();
#define FA_PK(L, H) (bf16x8){L[0], L[1], L[2], L[3], H[0], H[1], H[2], H[3]}
  od = __builtin_amdgcn_mfma_f32_32x32x16_bf16(pa0, FA_PK(l0, h0), od, 0, 0, 0);
  od = __builtin_amdgcn_mfma_f32_32x32x16_bf16(pa1, FA_PK(l1, h1), od, 0, 0, 0);
  od = __builtin_amdgcn_mfma_f32_32x32x16_bf16(pa2, FA_PK(l2, h2), od, 0, 0, 0);
  od = __builtin_amdgcn_mfma_f32_32x32x16_bf16(pa3, FA_PK(l3, h3), od, 0, 0, 0);
#undef FA_PK
}
__device__ __forceinline__ void pv_d0(f32x16* o, int vb, bf16x8 pa0, bf16x8 pa1, bf16x8 pa2, bf16x8 pa3) {
  pv_one<0>(o[0], vb, pa0, pa1, pa2, pa3); pv_one<1>(o[1], vb, pa0, pa1, pa2, pa3); pv_one<2>(o[2], vb, pa0, pa1, pa2, pa3); pv_one<3>(o[3], vb, pa0, pa1, pa2, pa3);
}
template <int DQK, int LDI, int SDEPTH>
__device__ __forceinline__ void attn_unit(const bf16* __restrict__ Qb, const bf16* __restrict__ Kh, const bf16* __restrict__ Vh, bf16* __restrict__ Ob, const int ldo, float* stats, int seq, LAS char* lds, int tid) {
  constexpr int ldq = LDI, ldk = LDI, ldv = LDI;
  constexpr int RB = Cfg<DQK>::RB, SHM_K = Cfg<DQK>::SHM_K, ND0 = Cfg<DQK>::ND0;
  const int wid = tid >> 6, lane = tid & 63, r32 = lane & 31, hi = lane >> 5;
  LAS char* V_lds = lds; LAS char* K_lds = lds + 2 * SHM_V;
  LAS float* ws = (LAS float*)(lds + 2 * SHM_V + 2 * SHM_K) + wid * 64; LAS float* li_l = ws; LAS float* al_l = ws + 32;
  float m_reg = -1e30f, l_reg = 0; f32x16 o[4] = {}; bf16x8 qr[ND0];
  __syncthreads();
  const GAS bf16* Qw = (const GAS bf16*)Qb + (size_t)(wid * QBLK + r32) * ldq + hi * 8;
#pragma unroll
  for (int d0 = 0; d0 < ND0; ++d0) qr[d0] = *reinterpret_cast<const GAS bf16x8*>(Qw + d0 * 16);
  const int sr = tid >> 4, sc = (tid & 15) * 8, vst0 = v_st(sr, sc), vst1 = v_st(32 + sr, sc);
  const int kr = DQK == 128 ? sr : (tid >> 3), kc = DQK == 128 ? sc : (tid & 7) * 8;
  const int vb0 = (int)(unsigned)(size_t)V_lds + v_rd_base(lane);
  struct { bf16x8 vs0, vs1, ks0, ks1; } sr_[SDEPTH];
const unsigned vo0 = (unsigned)(sr * ldv + sc), vo1 = (unsigned)((32 + sr) * ldv + sc), ko0 = (unsigned)(kr * ldk + kc), ko1 = (unsigned)((32 + kr) * ldk + kc);
#define FA_SLOAD(i, k0) do { const GAS bf16* Vt_ = (const GAS bf16*)Vh + (size_t)(k0) * ldv; const GAS bf16* Kt_ = (const GAS bf16*)Kh + (size_t)(k0) * ldk; \
    sr_[i].vs0 = *reinterpret_cast<const GAS bf16x8*>(Vt_ + vo0); sr_[i].vs1 = *reinterpret_cast<const GAS bf16x8*>(Vt_ + vo1); \
    sr_[i].ks0 = *reinterpret_cast<const GAS bf16x8*>(Kt_ + ko0); if constexpr (DQK == 128) sr_[i].ks1 = *reinterpret_cast<const GAS bf16x8*>(Kt_ + ko1); } while (0)
#define FA_SWRITE(b, i) do { *(LAS bf16x8*)(V_lds + (b) * SHM_V + vst0) = sr_[i].vs0; *(LAS bf16x8*)(V_lds + (b) * SHM_V + vst1) = sr_[i].vs1; \
    *(LAS bf16x8*)(K_lds + (b) * SHM_K + FA_KSWZ(kr, kc * 2, RB)) = sr_[i].ks0; if constexpr (DQK == 128) *(LAS bf16x8*)(K_lds + (b) * SHM_K + FA_KSWZ(32 + kr, kc * 2, RB)) = sr_[i].ks1; } while (0)
#define FA_SWAIT() do { if constexpr (SDEPTH == 1) asm volatile("s_waitcnt vmcnt(0)" ::: "memory"); else if constexpr (DQK == 128) asm volatile("s_waitcnt vmcnt(4)" ::: "memory"); else asm volatile("s_waitcnt vmcnt(3)" ::: "memory"); } while (0)
#define FA_RESC(a) do { if (__any((a) < 1.f)) { if (hi == 0) al_l[r32] = (a); asm volatile("s_waitcnt lgkmcnt(0)" ::: "memory"); \
    _Pragma("unroll") for (int d = 0; d < 4; ++d) _Pragma("unroll") for (int r = 0; r < 16; ++r) o[d][r] *= al_l[crow(r, hi)]; } } while (0)
  f32x16 pA0, pA1, pB0, pB1; float mnA, mnB, alA, alB; bf16x8 pa0, pa1, pa2, pa3; const int NT = seq / KVBLK;
  constexpr int SE = 0, SO = SDEPTH - 1;
  FA_SLOAD(SE, 0); asm volatile("s_waitcnt vmcnt(0)" ::: "memory"); FA_SWRITE(0, SE); __syncthreads();
  qkt<DQK>(pA0, pA1, K_lds, qr, r32, hi); partialSM<DQK>(pA0, pA1, m_reg, mnA, alA);
  FA_SLOAD(SO, KVBLK); if constexpr (SDEPTH == 2) { if (2 < NT) FA_SLOAD(SE, 2 * KVBLK); }
  FA_SWAIT(); FA_SWRITE(1, SO); __syncthreads();
  for (int j = 1; j + 1 < NT; j += 2) {
    FA_SBAR(); qkt<DQK>(pB0, pB1, K_lds + SHM_K, qr, r32, hi);
    finishSM(pA0, pA1, alA, l_reg, pa0, pa1, pa2, pa3); FA_SBAR();
    FA_SLOAD(SO, (j + SDEPTH) * KVBLK); FA_SBAR();
    pv_d0(o, vb0, pa0, pa1, pa2, pa3); partialSM<DQK>(pB0, pB1, m_reg, mnB, alB);
    __syncthreads(); FA_SWAIT(); FA_SWRITE(0, SE);
    FA_RESC(alB); __syncthreads();
    FA_SBAR(); qkt<DQK>(pA0, pA1, K_lds, qr, r32, hi);
    finishSM(pB0, pB1, alB, l_reg, pa0, pa1, pa2, pa3); FA_SBAR();
    if (SDEPTH == 1 || j + 3 < NT) FA_SLOAD(SE, (j + 1 + SDEPTH) * KVBLK); FA_SBAR();
    pv_d0(o, vb0 + SHM_V, pa0, pa1, pa2, pa3); partialSM<DQK>(pA0, pA1, m_reg, mnA, alA);
    __syncthreads(); FA_SWAIT(); FA_SWRITE(1, SO);
    FA_RESC(alA); __syncthreads();
  }
  FA_SBAR(); qkt<DQK>(pB0, pB1, K_lds + SHM_K, qr, r32, hi);
  finishSM(pA0, pA1, alA, l_reg, pa0, pa1, pa2, pa3); FA_SBAR();
  pv_d0(o, vb0, pa0, pa1, pa2, pa3); partialSM<DQK>(pB0, pB1, m_reg, mnB, alB);
  __syncthreads(); FA_RESC(alB);
  finishSM(pB0, pB1, alB, l_reg, pa0, pa1, pa2, pa3); FA_SBAR();
  pv_d0(o, vb0 + SHM_V, pa0, pa1, pa2, pa3);
  if (hi == 0) li_l[r32] = l_reg; asm volatile("s_waitcnt lgkmcnt(0)" ::: "memory");
  if (stats != nullptr && hi == 0) ((GAS f32x2*)stats)[wid * QBLK + r32] = (f32x2){m_reg, l_reg};
  int r32e = r32, hie = hi; asm volatile("" : "+v"(r32e), "+v"(hie));
  float rli[16];
#pragma unroll
  for (int r = 0; r < 16; ++r) rli[r] = __builtin_amdgcn_rcpf(li_l[crow(r, hie)]);
  GAS bf16* Ow = (GAS bf16*)Ob + (size_t)(wid * QBLK) * ldo;
  const unsigned oo = (unsigned)(4 * hie * ldo + r32e);
#pragma unroll
  for (int r = 0; r < 16; ++r) { const unsigned orow = (unsigned)((r & 3) + 8 * (r >> 2));
#pragma unroll
    for (int d0 = 0; d0 < 4; ++d0) Ow[oo + orow * ldo + d0 * 32] = (bf16)f2bf(o[d0][r] * rli[r]); }
#undef FA_SLOAD
#undef FA_SWRITE
#undef FA_SWAIT
#undef FA_RESC
}


constexpr float THR2 = THR * 1.4426950408889634f;
template <bool FORCE>
__device__ __forceinline__ void partialSM2(f32x16& p0, f32x16& p1, float& m_run, f32x16& negm, float& alpha) {
  float pmax = p0[0];
#pragma unroll
  for (int r = 1; r < 16; ++r) pmax = fmaxf(pmax, p0[r]);
#pragma unroll
  for (int r = 0; r < 16; ++r) pmax = fmaxf(pmax, p1[r]);
  { const f32x2 s2 = swap32(pmax); pmax = fmaxf(s2.x, s2.y); }
  if (!FORCE && __builtin_expect(__all(pmax <= THR2), 1)) { alpha = 1.f; }
  else { const float d = FORCE ? pmax : fmaxf(pmax, 0.f); alpha = FORCE ? 1.f : __builtin_amdgcn_exp2f(-d); m_run += d;
#pragma unroll
    for (int r = 0; r < 16; ++r) { p0[r] -= d; p1[r] -= d; negm[r] = -m_run; } }
#pragma unroll
  for (int r = 0; r < 16; ++r) p0[r] = __builtin_amdgcn_exp2f(p0[r]);
}
__device__ __forceinline__ void qkt64n(f32x16& p0, f32x16& p1, const LAS char* Ks, const bf16x8* qr, const f32x16& negm, int r32, int hi) {
  constexpr int RB = 128;
#pragma unroll
  for (int d0 = 0; d0 < 4; ++d0) { const int cb = (d0 * 16 + hi * 8) * 2;
    bf16x8 b0 = *reinterpret_cast<const LAS bf16x8*>(Ks + FA_KSWZ(r32, cb, RB));
    bf16x8 b1 = *reinterpret_cast<const LAS bf16x8*>(Ks + FA_KSWZ(32 + r32, cb, RB));
    if (d0 == 0) { p0 = __builtin_amdgcn_mfma_f32_32x32x16_bf16(b0, qr[0], negm, 0, 0, 0); p1 = __builtin_amdgcn_mfma_f32_32x32x16_bf16(b1, qr[0], negm, 0, 0, 0); }
    else { p0 = __builtin_amdgcn_mfma_f32_32x32x16_bf16(b0, qr[d0], p0, 0, 0, 0); p1 = __builtin_amdgcn_mfma_f32_32x32x16_bf16(b1, qr[d0], p1, 0, 0, 0); } }
}
template <int DQK, int LDI>
__device__ __forceinline__ void attn_unit3(const bf16* __restrict__ Qb, const bf16* __restrict__ Kh, const bf16* __restrict__ Vh, bf16* __restrict__ Ob, const int ldo, float* stats, int seq, LAS char* lds, int tid) {
  constexpr int ldq = LDI, ldk = LDI, ldv = LDI;
  constexpr int RB = Cfg<DQK>::RB, SHM_K = Cfg<DQK>::SHM_K, ND0 = Cfg<DQK>::ND0;
  const int wid = tid >> 6, lane = tid & 63, r32 = lane & 31, hi = lane >> 5;
  LAS char* V_lds = lds; LAS char* K_lds = lds + 3 * SHM_V;
  LAS float* ws = (LAS float*)(lds + 3 * SHM_V + 3 * SHM_K) + wid * 64; LAS float* li_l = ws; LAS float* al_l = ws + 32;
  float m_reg = -1e30f, l_reg = 0; f32x16 o[4] = {}; bf16x8 qr[ND0];
  __syncthreads();
  const GAS bf16* Qw = (const GAS bf16*)Qb + (size_t)(wid * QBLK + r32) * ldq + hi * 8;
#pragma unroll
  for (int d0 = 0; d0 < ND0; ++d0) qr[d0] = *reinterpret_cast<const GAS bf16x8*>(Qw + d0 * 16);
  const int sr = tid >> 4, sc = (tid & 15) * 8, vst0 = v_st(sr, sc), vst1 = v_st(32 + sr, sc);
  const int kr = DQK == 128 ? sr : (tid >> 3), kc = DQK == 128 ? sc : (tid & 7) * 8;
  const int kst0 = FA_KSWZ(kr, kc * 2, RB), kst1 = FA_KSWZ(32 + kr, kc * 2, RB);
  const int vb0 = (int)(unsigned)(size_t)V_lds + v_rd_base(lane);
  bf16x8 vs0, vs1, ks0, ks1;
  const unsigned vo0 = (unsigned)(sr * ldv + sc), ko0 = (unsigned)(kr * ldk + kc);
#define F3_SLOAD(k0) do { const GAS bf16* Vt_ = (const GAS bf16*)Vh + (size_t)(k0) * ldv; const GAS bf16* Kt_ = (const GAS bf16*)Kh + (size_t)(k0) * ldk; \
    vs0 = *reinterpret_cast<const GAS bf16x8*>(Vt_ + vo0); vs1 = *reinterpret_cast<const GAS bf16x8*>(Vt_ + (size_t)32 * ldv + vo0); \
    ks0 = *reinterpret_cast<const GAS bf16x8*>(Kt_ + ko0); if constexpr (DQK == 128) ks1 = *reinterpret_cast<const GAS bf16x8*>(Kt_ + (size_t)32 * ldk + ko0); } while (0)
#define F3_SWRITE(b) do { asm volatile("s_waitcnt vmcnt(0)" ::: "memory"); *(LAS bf16x8*)(V_lds + (b) * SHM_V + vst0) = vs0; *(LAS bf16x8*)(V_lds + (b) * SHM_V + vst1) = vs1; \
    *(LAS bf16x8*)(K_lds + (b) * SHM_K + kst0) = ks0; if constexpr (DQK == 128) *(LAS bf16x8*)(K_lds + (b) * SHM_K + kst1) = ks1; } while (0)
#define F3_RESC(a) do { if (__any((a) < 1.f)) { if (hi == 0) al_l[r32] = (a); asm volatile("s_waitcnt lgkmcnt(0)" ::: "memory"); \
    _Pragma("unroll") for (int d = 0; d < 4; ++d) _Pragma("unroll") for (int r = 0; r < 16; ++r) o[d][r] *= al_l[crow(r, hi)]; } } while (0)
  f32x16 pA0, pA1, pB0, pB1; float mnA, mnB, alA, alB; bf16x8 pa0, pa1, pa2, pa3; const int NT = seq / KVBLK;
  constexpr bool NEGM = (DQK == 64) && (ATTN_NEGM != 0);
  f32x16 negm = {}; if constexpr (NEGM) m_reg = 0.f;
#define F3_QKT(P0, P1, KS) do { if constexpr (NEGM) qkt64n(P0, P1, KS, qr, negm, r32, hi); else qkt<DQK>(P0, P1, KS, qr, r32, hi); } while (0)
#define F3_PSM(P0, P1, MN, AL) do { if constexpr (NEGM) partialSM2<false>(P0, P1, m_reg, negm, AL); else partialSM<DQK>(P0, P1, m_reg, MN, AL); } while (0)
  F3_SLOAD(0); F3_SWRITE(0); F3_SLOAD(KVBLK); F3_SWRITE(1); F3_SLOAD(2 * KVBLK); __syncthreads();
  F3_QKT(pA0, pA1, K_lds); if constexpr (NEGM) partialSM2<true>(pA0, pA1, m_reg, negm, alA); else F3_PSM(pA0, pA1, mnA, alA);
  int bc = 0, bn = 1, bw = 2;
  int j = 0;
  for (; j + 2 < NT; j += 2) {
    FA_SBAR(); F3_QKT(pB0, pB1, K_lds + bn * SHM_K);
    finishSM(pA0, pA1, alA, l_reg, pa0, pa1, pa2, pa3); FA_SBAR();
    F3_SWRITE(bw); F3_SLOAD((j + 3) * KVBLK); FA_SBAR();
    pv_d0(o, vb0 + bc * SHM_V, pa0, pa1, pa2, pa3); F3_PSM(pB0, pB1, mnB, alB);
    F3_RESC(alB); __syncthreads();
    { const int t = bc; bc = bn; bn = bw; bw = t; }
    FA_SBAR(); F3_QKT(pA0, pA1, K_lds + bn * SHM_K);
    finishSM(pB0, pB1, alB, l_reg, pa0, pa1, pa2, pa3); FA_SBAR();
    F3_SWRITE(bw); if (j + 4 < NT) F3_SLOAD((j + 4) * KVBLK); FA_SBAR();
    pv_d0(o, vb0 + bc * SHM_V, pa0, pa1, pa2, pa3); F3_PSM(pA0, pA1, mnA, alA);
    F3_RESC(alA); __syncthreads();
    { const int t = bc; bc = bn; bn = bw; bw = t; }
  }
  FA_SBAR(); F3_QKT(pB0, pB1, K_lds + bn * SHM_K);
  finishSM(pA0, pA1, alA, l_reg, pa0, pa1, pa2, pa3); FA_SBAR();
  pv_d0(o, vb0 + bc * SHM_V, pa0, pa1, pa2, pa3); F3_PSM(pB0, pB1, mnB, alB);
  F3_RESC(alB);
  finishSM(pB0, pB1, alB, l_reg, pa0, pa1, pa2, pa3); FA_SBAR();
  pv_d0(o, vb0 + bn * SHM_V, pa0, pa1, pa2, pa3);
  if (hi == 0) li_l[r32] = l_reg; asm volatile("s_waitcnt lgkmcnt(0)" ::: "memory");
  if (stats != nullptr && hi == 0) ((GAS f32x2*)stats)[wid * QBLK + r32] = (f32x2){m_reg, l_reg};
  int r32e = r32, hie = hi; asm volatile("" : "+v"(r32e), "+v"(hie));
  float rli[16];
#pragma unroll
  for (int r = 0; r < 16; ++r) rli[r] = __builtin_amdgcn_rcpf(li_l[crow(r, hie)]);
  GAS bf16* Ow = (GAS bf16*)Ob + (size_t)(wid * QBLK) * ldo;
  const unsigned oo = (unsigned)(4 * hie * ldo + r32e);
#pragma unroll
  for (int r = 0; r < 16; ++r) { const unsigned orow = (unsigned)((r & 3) + 8 * (r >> 2));
#pragma unroll
    for (int d0 = 0; d0 < 4; ++d0) Ow[oo + orow * ldo + d0 * 32] = (bf16)f2bf(o[d0][r] * rli[r]); }
#undef F3_SLOAD
#undef F3_QKT
#undef F3_PSM
#undef F3_SWRITE
#undef F3_RESC
}
}

#ifndef FAST_ATTN
#define FAST_ATTN 1
#endif

constexpr int AE_NL = NB * 6 * (SEQ / 256), AE_FULL = 256, AE_SPLIT = AE_NL - AE_FULL, AE_ITEMS = AE_FULL + 2 * AE_SPLIT + NB * 6;
__device__ __forceinline__ void fphase_attn_e(const Frame& F_) { const Frame F = fresh(F_);
    const bf16* P = (const bf16*)(F.ws + WS_PBUF); bf16* OA = (bf16*)(F.ws + WS_OA);
    for (int w = F.bid; w < AE_ITEMS; w += F.G) {
        int u, part = -1;
        if (w < AE_FULL) u = w; else if (w < AE_FULL + 2 * AE_SPLIT) { u = AE_FULL + ((w - AE_FULL) >> 1); part = (w - AE_FULL) & 1; } else u = AE_NL + (w - AE_FULL - 2 * AE_SPLIT);
        int b, h, q0, nk;
        if (u < AE_NL) { b = u / (6 * 32); h = (u / 32) % 6; q0 = CTX + 256 * (u % 32); nk = TPB; }
        else { const int v = u - AE_NL; b = v / 6; h = v % 6; q0 = 0; nk = CTX; }
        const size_t rq = (size_t)(b * TPB + q0); size_t rk = (size_t)b * TPB;
        bf16* ob = OA + rq * OAE + h * 128; int ldo = OAE; float* st = nullptr;
        if (part >= 0) { nk = TPB / 2; rk += (size_t)part * (TPB / 2); const int su = u - AE_FULL;
            ob = (bf16*)(F.ws + WS_OPART) + ((size_t)(part * AE_SPLIT + su) * 256) * 128; ldo = 128; st = (float*)(F.ws + WS_OSTAT) + ((size_t)(part * AE_SPLIT + su) * 256) * 2; }
        if (ATTN_RING3) fa::attn_unit3<128, EIN>(uptr(P + rq * EIN + h * 128), uptr(P + rk * EIN + 768 + (h / 3) * 128), uptr(P + rk * EIN + 1024 + (h / 3) * 128), uptr(ob), __builtin_amdgcn_readfirstlane(ldo), uptr(st), __builtin_amdgcn_readfirstlane(nk), (LAS char*)F.lds, F.tid);
        else fa::attn_unit<128, EIN, 1>(P + rq * EIN + h * 128, P + rk * EIN + 768 + (h / 3) * 128, P + rk * EIN + 1024 + (h / 3) * 128, ob, ldo, st, nk, (LAS char*)F.lds, F.tid);
    }
}
__device__ __forceinline__ void phase_attn_merge(const Frame& F_) { const Frame F = fresh(F_);
    const int gw = F.bid * NWAVES + F.wave, NGW = F.G * NWAVES, lane = F.lane;
    constexpr float C = 0.088388347648318440f * 1.4426950408889634f;
    for (int it = gw; it < AE_SPLIT * 256; it += NGW) {
        const int su = it >> 8, r = it & 255, u = AE_FULL + su, b = u / (6 * 32), h = (u / 32) % 6, q0 = CTX + 256 * (u % 32);
        const f32x2 sa = ((const GAS f32x2*)(F.ws + WS_OSTAT))[(size_t)su * 256 + r], sb = ((const GAS f32x2*)(F.ws + WS_OSTAT))[(size_t)(AE_SPLIT + su) * 256 + r];
        const float M = fmaxf(sa.x, sb.x), wa = sa.y * __builtin_amdgcn_exp2f((sa.x - M) * C), wb = sb.y * __builtin_amdgcn_exp2f((sb.x - M) * C), rw = 1.f / (wa + wb);
        const unsigned pa = ((const GAS unsigned*)((const bf16*)(F.ws + WS_OPART) + ((size_t)su * 256 + r) * 128))[lane], pb = ((const GAS unsigned*)((const bf16*)(F.ws + WS_OPART) + ((size_t)(AE_SPLIT + su) * 256 + r) * 128))[lane];
        const float o0 = (wa * bflo(pa) + wb * bflo(pb)) * rw, o1 = (wa * bfhi(pa) + wb * bfhi(pb)) * rw;
        ((GAS unsigned*)((bf16*)(F.ws + WS_OA) + (size_t)(b * TPB + q0 + r) * OAE + h * 128))[lane] = pk2(o0, o1);
    }
}
__device__ __forceinline__ void fphase_attn_o(const Frame& F_) { const Frame F = fresh(F_);
    const bf16* P = (const bf16*)(F.ws + WS_PBUF); bf16* OT = (bf16*)(F.ws + WS_OT);
    constexpr int NL = NB * 16 * (SEQ / 256), NC = NB * 16;
    for (int u = F.bid; u < NL + NC; u += F.G) {
        int b, g, q0, nk;
        if (u < NL) { b = u / (16 * 32); g = (u / 32) % 16; q0 = CTX + 256 * (u % 32); nk = TPB; }
        else { const int v = u - NL; b = v / 16; g = v % 16; q0 = 0; nk = CTX; }
        const size_t rq = (size_t)(b * TPB + q0), rk = (size_t)b * TPB;
        if (ATTN_RING3) fa::attn_unit3<64, OIN>(uptr(P + rq * OIN + g * 64), uptr(P + rk * OIN + 1024 + g * 64), uptr(P + rk * OIN + 2048 + (g / 2) * 128), uptr(OT + rq * OTW + g * 128), OTW, nullptr, __builtin_amdgcn_readfirstlane(nk), (LAS char*)F.lds, F.tid);
        else fa::attn_unit<64, OIN, 2>(P + rq * OIN + g * 64, P + rk * OIN + 1024 + g * 64, P + rk * OIN + 2048 + (g / 2) * 128, OT + rq * OTW + g * 128, OTW, nullptr, nk, (LAS char*)F.lds, F.tid);
    }
}


#ifndef FAST_FFT
#define FAST_FFT 1
#endif
template <int NTILE, class Gen, class Out>
__device__ __forceinline__ void dft_unit(LAS char* lds, const bf16* data, unsigned ldv, int nch, int rowbase, int vsel, Gen gen, GAS bf16* obase, float oscale, Out out_off, int tid) {
    const int lane = tid & 63, r32 = lane & 31, hi = lane >> 5;
    const int sr = tid >> 4, sc = (tid & 15) * 8, vst0 = fa::v_st(sr, sc), vst1 = fa::v_st(32 + sr, sc);
    const int vb = (int)(unsigned)(size_t)lds + vsel * fa::SHM_V + fa::v_rd_base(lane);
    fa::f32x16 o[4] = {};
    for (int ch = 0; ch < nch; ++ch) {
        __syncthreads();
#pragma unroll
        for (int t = 0; t < NTILE; ++t) {
            const GAS bf16* dt = (const GAS bf16*)data + (size_t)(64 * ch) * ldv + 128 * t;
            const fa::bf16x8 a = *reinterpret_cast<const GAS fa::bf16x8*>(dt + (unsigned)sr * ldv + sc), c = *reinterpret_cast<const GAS fa::bf16x8*>(dt + (unsigned)(32 + sr) * ldv + sc);
            *(LAS fa::bf16x8*)(lds + t * fa::SHM_V + vst0) = a; *(LAS fa::bf16x8*)(lds + t * fa::SHM_V + vst1) = c;
        }
        fa::bf16x8 pa[4];
#pragma unroll
        for (int ks = 0; ks < 4; ++ks) { const int k0 = 64 * ch + 16 * ks + 8 * hi; u32x4 w;
            w.x = fa::cvtpk(gen(rowbase + r32, k0 + 0), gen(rowbase + r32, k0 + 1)); w.y = fa::cvtpk(gen(rowbase + r32, k0 + 2), gen(rowbase + r32, k0 + 3));
            w.z = fa::cvtpk(gen(rowbase + r32, k0 + 4), gen(rowbase + r32, k0 + 5)); w.w = fa::cvtpk(gen(rowbase + r32, k0 + 6), gen(rowbase + r32, k0 + 7));
            pa[ks] = *reinterpret_cast<fa::bf16x8*>(&w); }
        __syncthreads();
        fa::pv_d0(o, vb, pa[0], pa[1], pa[2], pa[3]);
    }
    int r32e = r32, hie = hi; asm volatile("" : "+v"(r32e), "+v"(hie));
#pragma unroll
    for (int r = 0; r < 16; ++r)
#pragma unroll
        for (int d0 = 0; d0 < 4; ++d0) obase[out_off(rowbase + (r & 3) + 8 * (r >> 2) + 4 * hie, 32 * d0 + r32e)] = (bf16)f2bf(o[d0][r] * oscale);
}
__device__ __forceinline__ void fphase_fft1(const Frame& F_) { const Frame F = fresh(F_);
    for (int u = F.bid; u < NB * 64 * 2; u += F.G) {
        const int ch2 = u & 1, t2 = (u >> 1) & 63, b = u >> 7;
        const bf16* data = uptr((const bf16*)(F.ws + WS_PBUF) + (size_t)(b * TPB + CTX + t2) * EIN + 1280 + 128 * ch2);
        GAS bf16* yb = (GAS bf16*)uptr((bf16*)(F.ws + WS_YB) + ((size_t)b * 128 * 2 * 64 + t2) * 256 + 128 * ch2);
        dft_unit<1>((LAS char*)F.lds, data, 64u * EIN, 2, 32 * F.wave, 0,
            [&](int rho, int kap) { const int k1 = rho & 127, t = 64 * kap + t2; const float fr = (float)((k1 * t) & 8191) * (1.f / 8192.f); return (rho >> 7) ? -__builtin_amdgcn_sinf(fr) : __builtin_amdgcn_cosf(fr); },
            yb, 1.f, [&](int rho, int col) { return (unsigned)((((rho & 127) * 2 + (rho >> 7)) * 64) * 256 + col); }, F.tid);
    }
}
__device__ __forceinline__ void fphase_fft2(const Frame& F_) { const Frame F = fresh(F_);
    const float norm = 0.0013810679320049757f, normc = 0.0078125f;
    constexpr int BUSY = 0;
    const int nfree = F.G > BUSY ? F.G - BUSY : F.G, vb0 = F.G > BUSY ? F.bid - BUSY : F.bid;
    if (vb0 < 0) return;
    for (int u = vb0; u < NB * 128; u += nfree) {
        const int k1 = u & 127, b = u >> 7;
        const bf16* data = uptr((const bf16*)(F.ws + WS_YB) + (size_t)(b * 128 + k1) * 2 * 64 * 256);
        bf16* oa_ = uptr((bf16*)(F.ws + WS_OA) + (size_t)(b * TPB + CTX + k1) * OAE + 768 + 128 * (F.wave >> 2));
        dft_unit<2>((LAS char*)F.lds, data, 256u, 2, 32 * (F.wave & 3), F.wave >> 2,
            [&](int rho, int kap) { const int k2 = rho & 63, ro = rho >> 6, t2 = kap & 63, si = kap >> 6; const float fr = (float)((k2 * t2) & 63) * (1.f / 64.f);
                return (ro == si) ? __builtin_amdgcn_cosf(fr) : (ro ? -__builtin_amdgcn_sinf(fr) : __builtin_amdgcn_sinf(fr)); },
            (GAS bf16*)oa_, norm, [&](int rho, int col) { return (unsigned)((128 * (rho & 63)) * OAE + (rho >> 6) * 256 + col); }, F.tid);
    }
    for (int u = vb0; u < 8; u += nfree) {
        const int rb = u & 1, ch2 = (u >> 1) & 1, b = u >> 2;
        const bf16* data = uptr((const bf16*)(F.ws + WS_PBUF) + (size_t)(b * TPB) * EIN + 1280 + 128 * ch2);
        bf16* oa_ = uptr((bf16*)(F.ws + WS_OA) + (size_t)(b * TPB) * OAE + 768 + 128 * ch2);
        dft_unit<1>((LAS char*)F.lds, data, (unsigned)EIN, 4, 256 * rb + 32 * F.wave, 0,
            [&](int rho, int kap) { const int k = rho & 255; const float fr = (float)((k * kap) & 255) * (1.f / 256.f); return (rho >> 8) ? -__builtin_amdgcn_sinf(fr) : __builtin_amdgcn_cosf(fr); },
            (GAS bf16*)oa_, normc, [&](int rho, int col) { return (unsigned)((rho & 255) * OAE + (rho >> 8) * 256 + col); }, F.tid);
    }
}

__device__ __forceinline__ void sphase_attn_e(const Frame& F_) { const Frame F = fresh(F_);
    const bf16* P = (const bf16*)(F.ws + WS_PBUF); bf16* OA = (bf16*)(F.ws + WS_OA);
    const int NL = NB * 6 * (SEQ / 32), NC = NB * 6 * (CTX / 32);
    for (int u = F.bid; u < NL + NC; u += F.G) {
        int b, h, q0, nk;
        if (u < NL) { b = u / (6 * 256); h = (u / 256) % 6; q0 = CTX + 32 * (u % 256); nk = TPB; }
        else { const int v = u - NL; b = v / (6 * 8); h = (v / 8) % 6; q0 = 32 * (v % 8); nk = CTX; }
        const size_t rq = (size_t)(b * TPB + q0), rk = (size_t)b * TPB;
        sattn_unit<128>((LAS float*)F.lds, P + rq * EIN + h * 128, EIN, P + rk * EIN + 768 + (h / 3) * 128, EIN, P + rk * EIN + 1024 + (h / 3) * 128, EIN,
                        OA + rq * OAE + h * 128, OAE, nk, 0.08838834764831845f, F.tid);
    }
}
__device__ __forceinline__ void sphase_attn_o(const Frame& F_) { const Frame F = fresh(F_);
    const bf16* P = (const bf16*)(F.ws + WS_PBUF); bf16* OT = (bf16*)(F.ws + WS_OT);
    const int NL = NB * 16 * (SEQ / 32), NC = NB * 16 * (CTX / 32);
    for (int u = F.bid; u < NL + NC; u += F.G) {
        int b, g, q0, nk;
        if (u < NL) { b = u / (16 * 256); g = (u / 256) % 16; q0 = CTX + 32 * (u % 256); nk = TPB; }
        else { const int v = u - NL; b = v / (16 * 8); g = (v / 8) % 16; q0 = 32 * (v % 8); nk = CTX; }
        const size_t rq = (size_t)(b * TPB + q0), rk = (size_t)b * TPB;
        sattn_unit<64>((LAS float*)F.lds, P + rq * OIN + g * 64, OIN, P + rk * OIN + 1024 + g * 64, OIN, P + rk * OIN + 2048 + (g / 2) * 128, OIN,
                       OT + rq * OTW + g * 128, OTW, nk, 0.125f, F.tid);
    }
}

__global__ void __launch_bounds__(NTHREADS, 2) fwd_kernel(Args args) {
    extern __shared__ __attribute__((aligned(16))) unsigned char lds_raw[];
    Frame F;
    F.lds = (LAS unsigned char*)lds_raw; F.ws = args.ws;
    F.tid = threadIdx.x; F.lane = F.tid & 63; F.wave = __builtin_amdgcn_readfirstlane(F.tid >> 6); F.bid = blockIdx.x; F.G = gridDim.x;
    volatile LAS unsigned* MISC = (volatile LAS unsigned*)(F.lds + MISC_OFF);
    if (F.tid < 32) MISC[F.tid] = 0u;
    __syncthreads();
    const int lo = args.ph_lo, hi = args.ph_hi;
    const bool multi = (hi - lo) > 1;
    XcdBarrier bar; bar.bar = (unsigned*)(F.ws + WS_CTL) + CW_BAR; bar.x = 0; bar.st = MISC + 8;
    if (multi) bar = xcd_barrier_post((unsigned*)(F.ws + WS_CTL) + CW_BAR, MISC + 8);
#define IN(k) (lo <= (k) && (k) < hi)
#ifdef PROBE_KIND
    volatile LAS unsigned long long* PRB = (volatile LAS unsigned long long*)(MISC + 16);
#define PROBE_BEGIN(kind) do { if ((kind) < 32 && ((PROBE_KIND >> (kind)) & 1)) { const Frame Fp = fresh(F); if (Fp.tid == 0) PRB[0] = __builtin_amdgcn_s_memrealtime(); } } while (0)
#define PROBE_END(kind) do { if ((kind) < 32 && ((PROBE_KIND >> (kind)) & 1)) { const Frame Fp = fresh(F); if (Fp.tid == 0) PRB[1] = PRB[1] + (__builtin_amdgcn_s_memrealtime() - PRB[0]); } } while (0)
#else
#define PROBE_BEGIN(kind) do {} while (0)
#define PROBE_END(kind) do {} while (0)
#endif
#define SEAM(k) do { if (IN(k) && IN((k) + 1)) { const Frame Fb = fresh(F); xcd_barrier(bar, Fb.tid == 0); } } while (0)
#define SEAMC(k, c) do { if ((c) && IN(k) && IN((k) + 1)) { const Frame Fb = fresh(F); xcd_barrier(bar, Fb.tid == 0); } } while (0)
    PROBE_BEGIN(16); if (IN(PH_PRO_A)) { phase_pro_a(F, args); } SEAM(PH_PRO_A); PROBE_END(16);
    PROBE_BEGIN(17); if (IN(PH_PRO_B)) { phase_pro_b(F, args); } SEAM(PH_PRO_B); PROBE_END(17);
    for (int l = 0; l < DEPTH; ++l) {
        const int p0 = PH_L0 + l * PPL, i = l >> 1; const bool even = (l & 1) == 0;
        PROBE_BEGIN(PL_INPROJ + (PROBE_PARITY < 0 ? 0 : ((l & 1) == PROBE_PARITY ? 0 : 1000))); if (IN(p0 + PL_INPROJ)) {
#if FAST_GEMM
            fphase_inproj(F, even, i);
#else
            if (even) sphase_gemm_bf16(F, (const bf16*)(F.ws + WS_HA), DM, (const bf16*)(F.ws + WS_WINE) + (size_t)i * EIN * DM, DM, (bf16*)(F.ws + WS_PBUF), EIN, NTOK, EIN, DM);
            else sphase_gemm_bf16(F, (const bf16*)(F.ws + WS_HA), DM, (const bf16*)(F.ws + WS_WINO) + (size_t)i * OIN * DM, DM, (bf16*)(F.ws + WS_PBUF), OIN, NTOK, OIN, DM);
#endif
        } SEAM(p0 + PL_INPROJ); PROBE_END(PL_INPROJ + (PROBE_PARITY < 0 ? 0 : ((l & 1) == PROBE_PARITY ? 0 : 1000)));
        PROBE_BEGIN(PL_QKFIX + (PROBE_PARITY < 0 ? 0 : ((l & 1) == PROBE_PARITY ? 0 : 1000))); if (IN(p0 + PL_QKFIX)) { if (even) phase_qkfix_e(F, args, i); else if (!FAST_GEMM) phase_qkfix_o(F); } SEAMC(p0 + PL_QKFIX, even || !FAST_GEMM); PROBE_END(PL_QKFIX + (PROBE_PARITY < 0 ? 0 : ((l & 1) == PROBE_PARITY ? 0 : 1000)));
        PROBE_BEGIN(PL_FFT1 + (PROBE_PARITY < 0 ? 0 : ((l & 1) == PROBE_PARITY ? 0 : 1000))); if (IN(p0 + PL_FFT1)) { if (even) { if (FAST_FFT) fphase_fft1(F); else sphase_fft1(F); } } SEAMC(p0 + PL_FFT1, even); PROBE_END(PL_FFT1 + (PROBE_PARITY < 0 ? 0 : ((l & 1) == PROBE_PARITY ? 0 : 1000)));
        PROBE_BEGIN(PL_ATTN + (PROBE_PARITY < 0 ? 0 : ((l & 1) == PROBE_PARITY ? 0 : 1000))); if (IN(p0 + PL_ATTN)) { if (even) { if (FAST_ATTN) fphase_attn_e(F); else sphase_attn_e(F); if (FAST_FFT) fphase_fft2(F); else { sphase_fft2(F); sphase_fftc(F); } } else { if (FAST_ATTN) fphase_attn_o(F); else sphase_attn_o(F); } } SEAM(p0 + PL_ATTN); PROBE_END(PL_ATTN + (PROBE_PARITY < 0 ? 0 : ((l & 1) == PROBE_PARITY ? 0 : 1000)));
        PROBE_BEGIN(PL_FINISH + (PROBE_PARITY < 0 ? 0 : ((l & 1) == PROBE_PARITY ? 0 : 1000))); if (IN(p0 + PL_FINISH)) { if (!even) phase_finish_o(F, args, i); else if (FAST_ATTN) phase_attn_merge(F); } SEAM(p0 + PL_FINISH); PROBE_END(PL_FINISH + (PROBE_PARITY < 0 ? 0 : ((l & 1) == PROBE_PARITY ? 0 : 1000)));
        PROBE_BEGIN(PL_OUTPROJ + (PROBE_PARITY < 0 ? 0 : ((l & 1) == PROBE_PARITY ? 0 : 1000))); if (IN(p0 + PL_OUTPROJ)) {
#if FAST_GEMM
            fphase_outproj(F, even, i, l);
#else
            if (even) sphase_outproj(F, (const bf16*)(F.ws + WS_OA), OAE, (const bf16*)(F.ws + WS_WOUTE) + (size_t)i * DM * OAE, OAE, l);
            else sphase_outproj(F, (const bf16*)(F.ws + WS_OA), OAO, (const bf16*)(F.ws + WS_WOUTO) + (size_t)i * DM * DM, DM, l);
#endif
        } SEAM(p0 + PL_OUTPROJ); PROBE_END(PL_OUTPROJ + (PROBE_PARITY < 0 ? 0 : ((l & 1) == PROBE_PARITY ? 0 : 1000)));
        PROBE_BEGIN(PL_ROUTER + (PROBE_PARITY < 0 ? 0 : ((l & 1) == PROBE_PARITY ? 0 : 1000))); if (IN(p0 + PL_ROUTER)) { phase_router(F, args, l); } SEAM(p0 + PL_ROUTER); PROBE_END(PL_ROUTER + (PROBE_PARITY < 0 ? 0 : ((l & 1) == PROBE_PARITY ? 0 : 1000)));
        PROBE_BEGIN(PL_GU + (PROBE_PARITY < 0 ? 0 : ((l & 1) == PROBE_PARITY ? 0 : 1000))); if (IN(p0 + PL_GU)) { if (FAST_GEMM) fphase_moe_gu(F, l); else sphase_moe_gu(F, l); } SEAM(p0 + PL_GU); PROBE_END(PL_GU + (PROBE_PARITY < 0 ? 0 : ((l & 1) == PROBE_PARITY ? 0 : 1000)));
        PROBE_BEGIN(PL_DOWN + (PROBE_PARITY < 0 ? 0 : ((l & 1) == PROBE_PARITY ? 0 : 1000))); if (IN(p0 + PL_DOWN)) { if (FAST_GEMM) fphase_moe_down(F, l); else sphase_moe_down(F, l); } SEAM(p0 + PL_DOWN); PROBE_END(PL_DOWN + (PROBE_PARITY < 0 ? 0 : ((l & 1) == PROBE_PARITY ? 0 : 1000)));
        PROBE_BEGIN(PL_COMBINE + (PROBE_PARITY < 0 ? 0 : ((l & 1) == PROBE_PARITY ? 0 : 1000))); if (IN(p0 + PL_COMBINE)) { phase_combine(F, args, l); } SEAM(p0 + PL_COMBINE); PROBE_END(PL_COMBINE + (PROBE_PARITY < 0 ? 0 : ((l & 1) == PROBE_PARITY ? 0 : 1000)));
    }
#undef IN
#undef SEAM
#ifdef PROBE_KIND
    { const Frame Fp = fresh(F); if (Fp.bid == 0 && Fp.tid == 0) { const unsigned long long t1 = __builtin_amdgcn_s_memrealtime(), want = PRB[1] * PROBE_MULT; while (__builtin_amdgcn_s_memrealtime() - t1 < want) __builtin_amdgcn_s_sleep(8); } }
#endif
}

extern "C" void kernel_launch(void* const* d_in, const int* in_sizes, int n_in, void* d_out, int out_size, void* d_ws, size_t ws_size, hipStream_t stream) {
    static int grid = 0;
    if (grid == 0) {
        if (n_in != 26 || in_sizes[0] != NB * SEQ * DM || out_size != NB * SEQ * DM || ws_size < WS_END) {
            fprintf(stderr, "kernel_launch: shape/workspace mismatch (n_in %d, in0 %d, out %d, ws %zu, need %zu); nothing launched\n", n_in, n_in > 0 ? in_sizes[0] : -1, out_size, ws_size, (size_t)WS_END); grid = -1; return; }
        int dev = 0, cus = 0;
        if (hipGetDevice(&dev) != hipSuccess || hipDeviceGetAttribute(&cus, hipDeviceAttributeMultiprocessorCount, dev) != hipSuccess) { grid = -1; return; }
        if (hipFuncSetAttribute((const void*)fwd_kernel, hipFuncAttributeMaxDynamicSharedMemorySize, LDS_BYTES) != hipSuccess) { fprintf(stderr, "kernel_launch: hipFuncSetAttribute failed\n"); grid = -1; return; }
        int per_cu = 0;
        if (hipOccupancyMaxActiveBlocksPerMultiprocessor(&per_cu, (const void*)fwd_kernel, NTHREADS, LDS_BYTES) != hipSuccess || per_cu < 1) { fprintf(stderr, "kernel_launch: occupancy query says %d\n", per_cu); }
        (void)hipGetLastError();
        grid = cus;
    }
    if (grid < 0) return;
    (void)hipMemsetAsync((char*)d_ws + WS_CTL, 0, CTL_ZERO_BYTES, stream);
    Args a{};
    for (int i = 0; i < 26; ++i) a.in[i] = (const float*)d_in[i];
    a.out = (float*)d_out; a.ws = (unsigned char*)d_ws;
#if MK_ONE_LAUNCH
    a.ph_lo = 0; a.ph_hi = N_PHASES;
    hipLaunchKernelGGL(fwd_kernel, dim3(grid), dim3(NTHREADS), LDS_BYTES, stream, a);
#else
    for (int p = 0; p < N_PHASES; ++p) {
        if (p >= PH_L0) { const int l = (p - PH_L0) / PPL, k = (p - PH_L0) % PPL; const bool even = (l & 1) == 0;
            if ((k == PL_FFT1 && !even) || k == PL_GATHER || (k == PL_QKFIX && !even && FAST_GEMM)) continue; }
        a.ph_lo = p; a.ph_hi = p + 1;
        hipLaunchKernelGGL(fwd_kernel, dim3(grid), dim3(NTHREADS), LDS_BYTES, stream, a);
    }
#endif
}
```

```cpp
#include <hip/hip_runtime.h>
#include <cstdio>
#include <cstdint>

#ifndef PROBE_PARITY
#define PROBE_PARITY (-1)
#endif
#ifndef PROBE_MULT
#define PROBE_MULT 4
#endif
#ifndef ATTN_RING3
#define ATTN_RING3 1
#endif
#ifndef EPI_NORM_E
#define EPI_NORM_E 1
#endif
#ifndef ATTN_NEGM
#define ATTN_NEGM 1
#endif
#ifndef MK_ONE_LAUNCH
#define MK_ONE_LAUNCH 1
#endif

#define GAS __attribute__((address_space(1)))
#define LAS __attribute__((address_space(3)))
typedef unsigned short bf16;
typedef float f32x4 __attribute__((ext_vector_type(4)));
typedef unsigned u32x4 __attribute__((ext_vector_type(4)));
typedef unsigned u32x2 __attribute__((ext_vector_type(2)));
typedef int i32x4 __attribute__((ext_vector_type(4)));
typedef int i32x2 __attribute__((ext_vector_type(2)));
typedef float f32x2 __attribute__((ext_vector_type(2)));

constexpr int NB = 2, SEQ = 8192, CTX = 256, TPB = SEQ + CTX, NTOK = NB * TPB, DM = 1024, DEPTH = 4;
constexpr int EIN = 1536, OIN = 3072, OAE = 1280, OAO = 1024, OTW = 2048;
constexpr int NEXP = 16, DEXP = 512;
constexpr int XS_TILES = 2 * NTOK / 256 + NEXP, XS_ROWS = XS_TILES * 256;
constexpr float EPS = 1e-6f;
constexpr int NTHREADS = 512, NWAVES = 8;

constexpr size_t MiB = 1u << 20;
constexpr size_t WS_CTL = 0, CTL_ZERO_BYTES = MiB;
constexpr size_t WS_MODV = 1 * MiB;
constexpr size_t WS_TABA = 1 * MiB + 512 * 1024;
constexpr size_t WS_TABC = WS_TABA + 32 * 1024;
constexpr size_t WS_LAM = WS_TABC + 16 * 1024;
constexpr size_t WS_SELA = 2 * MiB;
constexpr size_t WS_SELW = 2 * MiB + 512 * 1024;
constexpr size_t WS_RPOS = 2 * MiB + 768 * 1024;
constexpr size_t WS_WINE = 3 * MiB;
constexpr size_t WS_WOUTE = 9 * MiB;
constexpr size_t WS_WINO = 14 * MiB;
constexpr size_t WS_WOUTO = 26 * MiB;
constexpr size_t WS_WGU = 30 * MiB;
constexpr size_t WS_WD = 158 * MiB;
constexpr size_t WS_X = 222 * MiB;
constexpr size_t WS_HA = 288 * MiB;
constexpr size_t WS_YB = 321 * MiB;
constexpr size_t WS_PBUF = 337 * MiB;
constexpr size_t WS_OT = 436 * MiB;
constexpr size_t WS_OA = 502 * MiB;
constexpr size_t WS_OPART = 436 * MiB;
constexpr size_t WS_OSTAT = 470 * MiB;
constexpr size_t WS_ROWTOK = 321 * MiB;
constexpr size_t WS_XS = 337 * MiB;
constexpr size_t WS_HID = 411 * MiB;
constexpr size_t WS_Y2S = 448 * MiB;
constexpr size_t WS_END = 544 * MiB;
static_assert(WS_XS + (size_t)XS_ROWS * 1024 * 2 <= WS_HID && WS_HID + (size_t)XS_ROWS * 512 * 2 <= WS_Y2S && WS_Y2S + (size_t)XS_ROWS * 1024 * 2 <= WS_END, "moe overlay");
static_assert(WS_OA + (size_t)NTOK * OAE * 2 <= WS_END && WS_PBUF + (size_t)NTOK * OIN * 2 <= WS_OT && WS_OT + (size_t)NTOK * OTW * 2 <= WS_OA, "ws map");
constexpr int CW_BAR = 4096;
constexpr int CW_CNT = 16384;

constexpr int LDS_BYTES = 147456;
constexpr int MISC_OFF = 147456 - 1024;
constexpr int TB_OFF = 147456 - 512;

constexpr int PH_PRO_A = 0, PH_PRO_B = 1, PH_L0 = 2, PPL = 11;
constexpr int PL_INPROJ = 0, PL_QKFIX = 1, PL_FFT1 = 2, PL_ATTN = 3, PL_FINISH = 4, PL_OUTPROJ = 5, PL_ROUTER = 6, PL_GATHER = 7, PL_GU = 8, PL_DOWN = 9, PL_COMBINE = 10;
constexpr int N_PHASES = PH_L0 + DEPTH * PPL;

struct Args { const float* in[26]; float* out; unsigned char* ws; int ph_lo, ph_hi; };

__device__ __forceinline__ unsigned f2bf(float f) { unsigned u = __builtin_bit_cast(unsigned, f); return (u + 0x7fffu + ((u >> 16) & 1u)) >> 16; }
__device__ __forceinline__ unsigned pk2(float lo, float hi) { return f2bf(lo) | (f2bf(hi) << 16); }
__device__ __forceinline__ float bf2f(bf16 b) { return __builtin_bit_cast(float, (unsigned)b << 16); }
__device__ __forceinline__ float bflo(unsigned w) { return __builtin_bit_cast(float, w << 16); }
__device__ __forceinline__ float bfhi(unsigned w) { return __builtin_bit_cast(float, w & 0xffff0000u); }
template <int M> __device__ __forceinline__ float swz_xor(float v) { static_assert(M >= 1 && M < 32, "swz_xor mask");
    return __builtin_bit_cast(float, __builtin_amdgcn_ds_swizzle(__builtin_bit_cast(int, v), (M << 10) | 0x1f)); }
__device__ __forceinline__ f32x2 swap32(float v) {
    unsigned a = __builtin_bit_cast(unsigned, v), b = a;
    asm volatile("s_nop 1\n\tv_permlane32_swap_b32 %0, %1" : "+v"(a), "+v"(b));
    return (f32x2){__builtin_bit_cast(float, a), __builtin_bit_cast(float, b)}; }
__device__ __forceinline__ float xor32(float v, bool upper) { const f32x2 s2 = swap32(v); return upper ? s2.x : s2.y; }
__device__ __forceinline__ float wave_sum(float v) {
    v += swz_xor<1>(v); v += swz_xor<2>(v); v += swz_xor<4>(v); v += swz_xor<8>(v); v += swz_xor<16>(v);
    const f32x2 s2 = swap32(v); return s2.x + s2.y;
}
__device__ __forceinline__ float silu_f(float x) { return x / (1.f + expf(-x)); }
#define LDS_WAIT() asm volatile("s_waitcnt lgkmcnt(0)" ::: "memory")

#define XB_TMO      128
#define XB_XCNT(j)  (256  + 64 * (j))
#define XB_XSUB(j)  (1280 + 64 * (j))
#define XB_XGEN(j)  (2304 + 64 * (j))
#define XB_TOP      3328
#define XB_TOPGEN   3392
#define XCD_BAR_WORDS 3456
#define XB_SPIN_CAP (1u << 24)
__device__ __forceinline__ unsigned xb_ld(unsigned* p)              { return __hip_atomic_load(p, __ATOMIC_RELAXED, __HIP_MEMORY_SCOPE_AGENT); }
__device__ __forceinline__ unsigned xb_add(unsigned* p, unsigned v) { return __hip_atomic_fetch_add(p, v, __ATOMIC_RELAXED, __HIP_MEMORY_SCOPE_AGENT); }
__device__ __forceinline__ unsigned xb_xcc_id() { return (unsigned)__builtin_amdgcn_s_getreg((3 << 11) | 20) & 0xFu; }
#define XB_SPIN(cond, bar) do { unsigned _sp = 0; while (cond) { __builtin_amdgcn_s_sleep(1); \
    if ((++_sp & 255u) == 0u) { if (xb_ld(&(bar)[XB_TMO])) break; if (_sp > XB_SPIN_CAP) { atomicAdd(&(bar)[XB_TMO], 1u); break; } } } } while (0)
struct XcdBarrier { unsigned* bar; unsigned x; volatile LAS unsigned* st; };
__device__ __forceinline__ XcdBarrier xcd_barrier_post(unsigned* bar, volatile LAS unsigned* st) {
    XcdBarrier b; b.bar = bar; b.x = xb_xcc_id(); b.st = st;
    if (threadIdx.x == 0) (void)xb_add(&bar[XB_XCNT(b.x)], 1u);
    return b;
}
__device__ __forceinline__ void xcd_barrier_complete(unsigned* bar, unsigned x, unsigned& nloc, unsigned& nx) {
    const unsigned G = gridDim.x * gridDim.y * gridDim.z;
    unsigned sum, cnt, mine, sp = 0u;
    for (;;) {
        sum = 0u; cnt = 0u; mine = 0u;
#pragma unroll
        for (unsigned j = 0; j < 16; ++j) { const unsigned c = xb_ld(&bar[XB_XCNT(j)]); sum += c; cnt += (c > 0u) ? 1u : 0u; mine = (j == x) ? c : mine; }
        if (sum == G) break;
        __builtin_amdgcn_s_sleep(1);
        if ((++sp & 255u) == 0u) { if (xb_ld(&bar[XB_TMO])) break; if (sp > XB_SPIN_CAP) { atomicAdd(&bar[XB_TMO], 1u); break; } }
    }
    nloc = mine > 0u ? mine : 1u; nx = cnt > 0u ? cnt : 1u;
}
__device__ __forceinline__ void xcd_barrier(const XcdBarrier& b, const bool leader) {
    asm volatile("s_waitcnt vmcnt(0)" ::: "memory");
    __syncthreads();
    if (leader) {
        unsigned* bar = b.bar; unsigned bx_ = b.x; asm volatile("" : "+s"(bar), "+s"(bx_));
        __builtin_amdgcn_s_waitcnt(0);
        unsigned nloc = b.st[0], nx = b.st[1];
        if (nloc == 0u) { xcd_barrier_complete(bar, bx_, nloc, nx); b.st[0] = nloc; b.st[1] = nx; }
        const unsigned old = xb_add(&bar[XB_XSUB(bx_)], 1u);
        const unsigned gen = old / nloc;
        if (old + 1u == (gen + 1u) * nloc) {
            __builtin_amdgcn_fence(__ATOMIC_RELEASE, "agent");
            asm volatile("s_waitcnt vmcnt(0)" ::: "memory");
            const unsigned og = xb_add(&bar[XB_TOP], 1u);
            const unsigned tg = og / nx;
            if (og + 1u == (tg + 1u) * nx) xb_add(&bar[XB_TOPGEN], 1u);
            else XB_SPIN(xb_ld(&bar[XB_TOPGEN]) == tg, bar);
            __builtin_amdgcn_fence(__ATOMIC_ACQUIRE, "agent");
            xb_add(&bar[XB_XGEN(bx_)], 1u);
            asm volatile("s_waitcnt vmcnt(0)" ::: "memory");
        } else {
            XB_SPIN(xb_ld(&bar[XB_XGEN(bx_)]) == gen, bar);
            __builtin_amdgcn_fence(__ATOMIC_ACQUIRE, "agent");
            asm volatile("s_waitcnt vmcnt(0)" ::: "memory");
        }
    }
    __syncthreads();
}

struct Frame {
    LAS unsigned char* lds;
    unsigned char* ws;
    int tid, lane, wave, bid, G;
};
template <class T> __device__ __forceinline__ T* opq(T* p) { asm volatile("" : "+s"(p)); return p; }
__device__ __forceinline__ Frame fresh(const Frame& F) { Frame G = F;
    asm volatile("" : "+s"(G.ws), "+s"(G.bid), "+s"(G.wave), "+s"(G.G));
    unsigned z_ = 0u; asm volatile("" : "+v"(z_));
    G.lane = (int)__builtin_amdgcn_mbcnt_hi(~0u, __builtin_amdgcn_mbcnt_lo(~0u, z_));
    G.tid = G.wave * 64 + G.lane; return G; }
__device__ __forceinline__ const float* ain_ptr(int k) {
    auto kp = __builtin_amdgcn_kernarg_segment_ptr(); asm volatile("" : "+s"(kp));
    typedef const float* cfp;
    return ((const __attribute__((address_space(4))) cfp*)kp)[k]; }
#define AIN(k) ain_ptr(k)
template <class T> __device__ __forceinline__ T* uptr(T* p) {
    const unsigned long long v = (unsigned long long)p; const unsigned lo = __builtin_amdgcn_readfirstlane((unsigned)v), hi = __builtin_amdgcn_readfirstlane((unsigned)(v >> 32));
    return (T*)(((unsigned long long)hi << 32) | lo); }
__device__ __forceinline__ const float* modv(const Frame& F, int l, int type, int chunk) { return (const float*)(F.ws + WS_MODV) + ((size_t)(l * 3 + type) * 6 + chunk) * DM; }
__device__ __forceinline__ int row_type(int r) { const int b = r / TPB, j = r - b * TPB; return j < CTX ? 2 : b; }

__device__ __forceinline__ void load_row_f32(const float* p, int lane, f32x4 (&v)[4]) {
    const GAS f32x4* q = (const GAS f32x4*)p + lane;
#pragma unroll
    for (int j = 0; j < 4; ++j) v[j] = q[64 * j];
}
__device__ __forceinline__ void store_row_f32(float* p, int lane, const f32x4 (&v)[4]) {
    GAS f32x4* q = (GAS f32x4*)p + lane;
#pragma unroll
    for (int j = 0; j < 4; ++j) q[64 * j] = v[j];
}
__device__ __forceinline__ void load_row_bf16(const bf16* p, int lane, f32x4 (&v)[4]) {
    const GAS u32x2* q = (const GAS u32x2*)p + lane;
#pragma unroll
    for (int j = 0; j < 4; ++j) { const u32x2 w = q[64 * j]; v[j] = (f32x4){bflo(w.x), bfhi(w.x), bflo(w.y), bfhi(w.y)}; }
}
__device__ __forceinline__ void store_row_bf16(bf16* p, int lane, const f32x4 (&v)[4]) {
    GAS u32x2* q = (GAS u32x2*)p + lane;
#pragma unroll
    for (int j = 0; j < 4; ++j) { u32x2 w; w.x = pk2(v[j].x, v[j].y); w.y = pk2(v[j].z, v[j].w); q[64 * j] = w; }
}
__device__ __forceinline__ float row_rstd(const f32x4 (&v)[4]) {
    float s = 0.f;
#pragma unroll
    for (int j = 0; j < 4; ++j) s += (v[j].x * v[j].x + v[j].y * v[j].y) + (v[j].z * v[j].z + v[j].w * v[j].w);
    return rsqrtf(wave_sum(s) * (1.f / DM) + EPS);
}
__device__ __forceinline__ void modnorm_store(const f32x4 (&v)[4], const float* sc, const float* sh, bf16* dst, int lane) {
    const float rstd = row_rstd(v);
    f32x4 s[4], h[4], o[4]; load_row_f32(sc, lane, s); load_row_f32(sh, lane, h);
#pragma unroll
    for (int j = 0; j < 4; ++j) o[j] = v[j] * rstd * (s[j] + 1.f) + h[j];
    store_row_bf16(dst, lane, o);
}

namespace pg8 {
#define PG8_LAS __attribute__((address_space(3)))
typedef unsigned short bf16_t;
typedef short bf16x8 __attribute__((ext_vector_type(8)));
typedef float f32x4 __attribute__((ext_vector_type(4)));
typedef unsigned u32x4 __attribute__((ext_vector_type(4)));
constexpr int BM = 256, BK = 64, HALF = 128, HTB = HALF * BK * 2  , STAGE_BYTES = 8 * HTB, NXCD = 8, WGM = 8;

__host__ __device__ __forceinline__ int lds_byte(int r, int c) { const int st = (r >> 4) * 2 + (c >> 5), rr = r & 15, cc = c & 31, ob = rr * 64 + cc * 2; return st * 1024 + (ob ^ (((ob >> 9) & 1) << 5)); }
__host__ __device__ __forceinline__ void stage_rc(int b, int& R, int& C) { const int st = b / 1024, sb = b % 1024, swz = sb ^ (((sb >> 9) & 1) << 5); R = (st >> 1) * 16 + swz / 64; C = (st & 1) * 32 + (swz % 64) / 2; }
__host__ __device__ __forceinline__ int perm32(int rho) { const int n = rho >> 4, i = rho & 15; return 8 * (i >> 2) + 4 * n + (i & 3); }

struct Unit { int pm, pn, e, lt; };
struct Gemm { const bf16_t* A; const bf16_t* Bt; int M, N, K; size_t estride; const int* rowtok; int ntok; };

struct StaticOrder {
    int nM, nN, nwg, G, c;
    __host__ __device__ void init(int M, int N, int G_, int c_) { nM = M / BM; nN = N / BM; nwg = nM * nN; G = G_; c = c_; }
    __host__ __device__ bool next(int i, Unit& u) const {
        const long L = (long)i * G + c; if (L >= nwg) return false;
        int wgid = (int)L; { const int q = nwg / NXCD, r = nwg % NXCD, xcd = wgid % NXCD, off = wgid / NXCD; wgid = (xcd < r ? xcd * (q + 1) : r * (q + 1) + (xcd - r) * q) + off; }
        const int nig = WGM * nN, gid = wgid / nig, fm = gid * WGM, gsz = (nM - fm) < WGM ? (nM - fm) : WGM;
        u.pm = fm + ((wgid % nig) % gsz); u.pn = (wgid % nig) / gsz; u.e = 0; u.lt = 0; return true;
    }
    __device__ __forceinline__ void a_ready(const Unit&) const {}
    __device__ __forceinline__ void done(const Unit&) const {}
};

struct LatOrder {
    StaticOrder so;
    __host__ __device__ void init(int N, int G_, int c_) { so.init(64 * BM, N, G_, c_); }
    __host__ __device__ bool next(int i, Unit& u) const { if (!so.next(i, u)) return false; u.pm = u.pm + 1 + (u.pm >= 32 ? 1 : 0); return true; }
    __device__ __forceinline__ void a_ready(const Unit&) const {}
    __device__ __forceinline__ void done(const Unit&) const {}
};
__device__ __forceinline__ unsigned cvt_pk_bf16(float lo, float hi) { unsigned r; asm volatile("v_cvt_pk_bf16_f32 %0, %1, %2" : "=v"(r) : "v"(lo), "v"(hi)); return r; }
typedef float f32x2 __attribute__((ext_vector_type(2)));
__device__ __forceinline__ f32x2 gelu_pk(f32x2 v) {
    const f32x2 av = __builtin_elementwise_abs(v), d = av * 0.2316418882f + 1.0f;
    f32x2 t; t.x = __builtin_amdgcn_rcpf(d.x); t.y = __builtin_amdgcn_rcpf(d.y);
    f32x2 q = t * 0.5307027145f + (-0.7265760135f); q = q * t + 0.7107068705f; q = q * t + (-0.142248368f); q = q * t + 0.127414796f; q = q * t;
    const f32x2 s = (v * v) * (-0.72134752044f);
    f32x2 e; e.x = __builtin_amdgcn_exp2f(s.x); e.y = __builtin_amdgcn_exp2f(s.y);
    const f32x2 m = v * (q * e), r = v - m;
    f32x2 o; o.x = v.x < 0.f ? m.x : r.x; o.y = v.y < 0.f ? m.y : r.y; return o;
}

template <int ACT  > struct EpiBf16 {
    static constexpr bool PERM = true, AFTER_DRAIN = false; static_assert(ACT == 0 || ACT == 1, "EpiBf16: ACT is 0 (none) or 1 (gelu_pk)");
    bf16_t* O; int ldc; const float* bias; int split_cols; size_t split_stride; float scale0;
    __device__ __forceinline__ void operator()(const f32x4 (&acc)[2][2][4][2], const Unit& u, int wr, int wc, int fr, int fq) const {
        const int row0 = u.pm * BM + wr * 64 + fr; int colt = u.pn * BM; bf16_t* base = O;
        float sc = 1.f; if (split_cols) { const int t = colt / split_cols; base += (size_t)t * split_stride; colt -= t * split_cols; if (t == 0) sc = scale0; }
        const int col0 = colt + wc * 32 + 8 * fq, bcol0 = u.pn * BM + wc * 32 + 8 * fq;
        f32x4 bv[2][2];
#pragma unroll
        for (int bj = 0; bj < 2; ++bj)
#pragma unroll
            for (int n = 0; n < 2; ++n) bv[bj][n] = bias ? *(const f32x4*)(bias + bcol0 + bj * HALF + 4 * n) : (f32x4){0.f, 0.f, 0.f, 0.f};
#pragma unroll
        for (int ai = 0; ai < 2; ++ai)
#pragma unroll
            for (int m = 0; m < 4; ++m) { bf16_t* rowp = base + (size_t)(row0 + ai * HALF + m * 16) * ldc + col0;
#pragma unroll
                for (int bj = 0; bj < 2; ++bj) { f32x4 v0 = acc[ai][bj][m][0] + bv[bj][0], v1 = acc[ai][bj][m][1] + bv[bj][1];
                    if (ACT == 1) { f32x2 a = gelu_pk((f32x2){v0[0], v0[1]}), b = gelu_pk((f32x2){v0[2], v0[3]}), c = gelu_pk((f32x2){v1[0], v1[1]}), d = gelu_pk((f32x2){v1[2], v1[3]});
                        v0 = (f32x4){a.x, a.y, b.x, b.y}; v1 = (f32x4){c.x, c.y, d.x, d.y}; }
                    v0 = v0 * sc; v1 = v1 * sc; u32x4 w; w.x = cvt_pk_bf16(v0[0], v0[1]); w.y = cvt_pk_bf16(v0[2], v0[3]); w.z = cvt_pk_bf16(v1[0], v1[1]); w.w = cvt_pk_bf16(v1[2], v1[3]);
                    *(GAS u32x4*)(rowp + bj * HALF) = w; } }
    }
};

__device__ __forceinline__ float silu_fast(float x) { return x * __builtin_amdgcn_rcpf(1.f + __expf(-x)); }
struct EpiSwiGLU {
    static constexpr bool PERM = true, AFTER_DRAIN = false;
    bf16_t* O;
    __device__ __forceinline__ void operator()(const f32x4 (&acc)[2][2][4][2], const Unit& u, int wr, int wc, int fr, int fq) const {
        const int row0 = u.pm * BM + wr * 64 + fr, col0 = u.pn * HALF + wc * 32 + 8 * fq;
#pragma unroll
        for (int ai = 0; ai < 2; ++ai)
#pragma unroll
            for (int m = 0; m < 4; ++m) { bf16_t* rowp = O + (size_t)(row0 + ai * HALF + m * 16) * 512 + col0;
                const f32x4 g0 = acc[ai][0][m][0], g1 = acc[ai][0][m][1], u0 = acc[ai][1][m][0], u1 = acc[ai][1][m][1];
                u32x4 w; w.x = cvt_pk_bf16(silu_fast(g0[0]) * u0[0], silu_fast(g0[1]) * u0[1]); w.y = cvt_pk_bf16(silu_fast(g0[2]) * u0[2], silu_fast(g0[3]) * u0[3]);
                w.z = cvt_pk_bf16(silu_fast(g1[0]) * u1[0], silu_fast(g1[1]) * u1[1]); w.w = cvt_pk_bf16(silu_fast(g1[2]) * u1[2], silu_fast(g1[3]) * u1[3]);
                *(GAS u32x4*)rowp = w; }
    }
};
struct EpiResGate {
    static constexpr bool PERM = false, AFTER_DRAIN = false;
    float* X; const float* gate3;
    __device__ __forceinline__ void operator()(const f32x4 (&acc)[2][2][4][2], const Unit& u, int wr, int wc, int fr, int fq) const {
        const int type = (u.pm % 33 == 0) ? 2 : u.pm / 33;
        const int col0 = u.pn * BM + wc * 32 + 4 * fq; const float* gp = gate3 + (size_t)type * 6144 + col0;
        f32x4 gv[2][2];
#pragma unroll
        for (int bj = 0; bj < 2; ++bj)
#pragma unroll
            for (int n = 0; n < 2; ++n) gv[bj][n] = *(const GAS f32x4*)(gp + bj * HALF + n * 16);
#pragma unroll
        for (int ai = 0; ai < 2; ++ai)
#pragma unroll
            for (int m = 0; m < 4; ++m) { float* rowp = X + (size_t)(u.pm * BM + ai * HALF + wr * 64 + m * 16 + fr) * 1024 + col0;
#pragma unroll
                for (int bj = 0; bj < 2; ++bj)
#pragma unroll
                    for (int n = 0; n < 2; ++n) { GAS f32x4* xp = (GAS f32x4*)(rowp + bj * HALF + n * 16); *xp = *xp + gv[bj][n] * acc[ai][bj][m][n]; } }
    }
};

struct EpiRopeO {
    static constexpr bool PERM = true, AFTER_DRAIN = false;
    bf16_t* O; int ldc; const float* tab; int nrope_tiles;
    int nq_tiles; float qscale;
    __device__ __forceinline__ void operator()(const f32x4 (&acc)[2][2][4][2], const Unit& u, int wr, int wc, int fr, int fq) const {
        const int row0 = u.pm * BM + wr * 64 + fr, col0 = u.pn * BM + wc * 32 + 8 * fq;
        const bool rope = (u.pn < nrope_tiles) && (u.pm % 33 != 0);
        const int t0 = row0 - (u.pm / 33) * 8448 - 256;
        const bool x2 = (fq >> 1) != 0; const float qs = (u.pn < nq_tiles) ? qscale : 1.f;
#pragma unroll
        for (int ai = 0; ai < 2; ++ai)
#pragma unroll
            for (int m = 0; m < 4; ++m) { const int t = t0 + ai * HALF + m * 16; bf16_t* rowp = O + (size_t)(row0 + ai * HALF + m * 16) * ldc + col0;
                f32x4 cs[4];
                if (rope) { const int pos = (wc & 1) ? (t & 63) : (t >> 6); const float* tp = tab + (size_t)(pos * 16 + 8 * (fq & 1)) * 2;
#pragma unroll
                    for (int q = 0; q < 4; ++q) cs[q] = *(const GAS f32x4*)(tp + 4 * q); }
#pragma unroll
                for (int bj = 0; bj < 2; ++bj) { f32x4 v0 = acc[ai][bj][m][0], v1 = acc[ai][bj][m][1];
                    if (rope) { f32x4 p0, p1;
#pragma unroll
                        for (int e = 0; e < 4; ++e) { p0[e] = xor32(v0[e], x2); p1[e] = xor32(v1[e], x2); }
                        const f32x4 c0 = {cs[0][0], cs[0][2], cs[1][0], cs[1][2]}, s0 = {cs[0][1], cs[0][3], cs[1][1], cs[1][3]};
                        const f32x4 c1 = {cs[2][0], cs[2][2], cs[3][0], cs[3][2]}, s1 = {cs[2][1], cs[2][3], cs[3][1], cs[3][3]};
                        v0 = x2 ? (p0 * s0 + v0 * c0) : (v0 * c0 - p0 * s0); v1 = x2 ? (p1 * s1 + v1 * c1) : (v1 * c1 - p1 * s1); }
                    v0 = v0 * qs; v1 = v1 * qs;
                    u32x4 w; w.x = cvt_pk_bf16(v0[0], v0[1]); w.y = cvt_pk_bf16(v0[2], v0[3]); w.z = cvt_pk_bf16(v1[0], v1[1]); w.w = cvt_pk_bf16(v1[2], v1[3]);
                    *(GAS u32x4*)(rowp + bj * HALF) = w; } }
    }
};

struct EpiNormRopeE {
    static constexpr bool PERM = true, AFTER_DRAIN = false;
    bf16_t* O; const float* qg; const float* kg; const float* bg; const float* tab; PG8_LAS float* xch;
    __device__ __forceinline__ void operator()(const f32x4 (&acc)[2][2][4][2], const Unit& u, int wr, int wc, int fr, int fq) const {
        const int kind = u.pn < 3 ? 0 : (u.pn == 3 ? 1 : (u.pn == 4 ? 2 : 3));
        const bool x2 = (fq >> 1) != 0;
#pragma unroll
        for (int ai = 0; ai < 2; ++ai)
#pragma unroll
            for (int m = 0; m < 4; ++m)
#pragma unroll
                for (int bj = 0; bj < 2; ++bj) { const f32x4 a = acc[ai][bj][m][0], b = acc[ai][bj][m][1];
                    float sq = (a[0] * a[0] + a[1] * a[1]) + (a[2] * a[2] + a[3] * a[3]) + (b[0] * b[0] + b[1] * b[1]) + (b[2] * b[2] + b[3] * b[3]);
                    sq += swz_xor<16>(sq); { const f32x2 s2 = swap32(sq); sq = s2.x + s2.y; }
                    if (fq == 0) xch[((ai * HALF + wr * 64 + m * 16 + fr) * 2 + bj) * 4 + wc] = sq; }
        asm volatile("s_waitcnt lgkmcnt(0)" ::: "memory"); __builtin_amdgcn_s_barrier(); asm volatile("" ::: "memory");
        const int row0 = u.pm * BM + wr * 64 + fr, col0 = u.pn * BM + wc * 32 + 8 * fq;
        const bool lat = (u.pm % 33 != 0);
        const int t0 = row0 - (u.pm / 33) * 8448 - 256;
#pragma unroll
        for (int ai = 0; ai < 2; ++ai)
#pragma unroll
            for (int m = 0; m < 4; ++m) { const int t = t0 + ai * HALF + m * 16; bf16_t* rowp = O + (size_t)(row0 + ai * HALF + m * 16) * 1536 + col0;
                f32x4 cs[4];
                if (kind < 2 && lat) { const int pos = (wc >> 1) ? (t & 63) : (t >> 6); const float* tp = tab + (size_t)(pos * 32 + 16 * (wc & 1) + 8 * (fq & 1)) * 2;
#pragma unroll
                    for (int q = 0; q < 4; ++q) cs[q] = *(const GAS f32x4*)(tp + 4 * q); }
#pragma unroll
                for (int bj = 0; bj < 2; ++bj) { f32x4 v0 = acc[ai][bj][m][0], v1 = acc[ai][bj][m][1];
                    if (kind != 2) {
                        const f32x4 pq = *(const PG8_LAS f32x4*)(xch + ((ai * HALF + wr * 64 + m * 16 + fr) * 2 + bj) * 4);
                        float ssum, inv;
                        if (kind == 3) { ssum = (wc & 2) ? (pq[2] + pq[3]) : (pq[0] + pq[1]); inv = 1.f / 64.f; } else { ssum = (pq[0] + pq[1]) + (pq[2] + pq[3]); inv = 1.f / 128.f; }
                        const float rstd = rsqrtf(ssum * inv + 1e-6f);
                        const float* gp = kind == 3 ? bg + (2 * bj + (wc >> 1)) * 64 + 32 * (wc & 1) + 8 * fq
                                                    : (kind == 0 ? qg : kg) + 64 * (wc >> 1) + 32 * (fq >> 1) + 16 * (wc & 1) + 8 * (fq & 1);
                        const f32x4 g0 = *(const GAS f32x4*)gp, g1 = *(const GAS f32x4*)(gp + 4);
                        v0 = v0 * rstd * g0; v1 = v1 * rstd * g1;
                        if (kind < 2 && lat) { f32x4 p0, p1;
#pragma unroll
                            for (int e = 0; e < 4; ++e) { p0[e] = xor32(v0[e], x2); p1[e] = xor32(v1[e], x2); }
                            const f32x4 c0 = {cs[0][0], cs[0][2], cs[1][0], cs[1][2]}, s0 = {cs[0][1], cs[0][3], cs[1][1], cs[1][3]};
                            const f32x4 c1 = {cs[2][0], cs[2][2], cs[3][0], cs[3][2]}, s1 = {cs[2][1], cs[2][3], cs[3][1], cs[3][3]};
                            v0 = x2 ? (p0 * s0 + v0 * c0) : (v0 * c0 - p0 * s0); v1 = x2 ? (p1 * s1 + v1 * c1) : (v1 * c1 - p1 * s1); } }
                    u32x4 w; w.x = cvt_pk_bf16(v0[0], v0[1]); w.y = cvt_pk_bf16(v0[2], v0[3]); w.z = cvt_pk_bf16(v1[0], v1[1]); w.w = cvt_pk_bf16(v1[2], v1[3]);
                    *(GAS u32x4*)(rowp + bj * HALF) = w; } }
    }
};
struct MoeOrder {
    const PG8_LAS int* tb; int nN, nwg, G, c;
    __device__ __forceinline__ bool next(int i, Unit& u) const {
        const int L = i * G + c; if (L >= nwg) return false;
        u.pm = L / nN; u.pn = L - u.pm * nN; int e = 0;
        int t0 = 0;
#pragma unroll
        for (int q = 1; q < 16; ++q) { const int tq = tb[q]; const bool ge = u.pm >= tq; e = ge ? q : e; t0 = ge ? tq : t0; }
        u.e = __builtin_amdgcn_readfirstlane(e); u.lt = u.pm - __builtin_amdgcn_readfirstlane(t0); return true;
    }
    __device__ __forceinline__ void a_ready(const Unit&) const {}
    __device__ __forceinline__ void done(const Unit&) const {}
};

template <class Epi, class Sched, bool ALIGN_EPI = false, bool SP2 = false, bool GATHER = false>
__device__ __forceinline__ void gemm_phase(PG8_LAS unsigned char* lds, const Gemm g, const Sched& S, const Epi& E, const int tid_) {
    const int tid = tid_, wid = __builtin_amdgcn_readfirstlane(tid >> 6), lane = tid & 63, wr = wid >> 2, wc = wid & 3, fr = lane & 15, fq = lane >> 4;
    const int K = g.K, nt = K / BK;
    unsigned voffA[2], voffB[2];
#pragma unroll
    for (int i = 0; i < 2; ++i) { int R, C; stage_rc(tid * 16 + i * 8192, R, C); const int Rb = Epi::PERM ? ((R & ~31) + perm32(R & 31)) : R;
        voffA[i] = (unsigned)(R * K + C) * 2u; voffB[i] = (unsigned)(Rb * K + C) * 2u; }
    static_assert(!GATHER || SP2, "GATHER is implemented on the SP2 loop only");
    int gR[2], gC[2];
#pragma unroll
    for (int i = 0; i < 2; ++i) stage_rc(tid * 16 + i * 8192, gR[i], gC[i]);
    unsigned vAc[2][2], vAn[2][2];
#define PG8_LOADIDX(u, v) do { _Pragma("unroll") for (int h_ = 0; h_ < 2; ++h_) _Pragma("unroll") for (int i_ = 0; i_ < 2; ++i_) { \
        int tok_ = g.rowtok[(size_t)(u).e * g.ntok + (u).lt * 256 + h_ * HALF + gR[i_]]; tok_ = ((unsigned)tok_ < (unsigned)g.ntok) ? tok_ : 0; (v)[h_][i_] = (unsigned)(tok_ * K + gC[i_]) * 2u; } } while (0)
#define PG8_STAGE_A(bufoff, gbase, h, set) do { if constexpr (GATHER) { PG8_STAGE(bufoff, gbase, (set)[h]); } else { PG8_STAGE(bufoff, (gbase) + (h) * hstep, voffA); } } while (0)
    const size_t kstep = (size_t)(BK * 2);
    const size_t hstep = (size_t)HALF * K * 2;
    const size_t tstep = 2 * hstep;
    const unsigned ldsw = (unsigned)wid * 1024u;
    const int aoff = lds_byte(wr * 64 + fr, fq * 8), boff = lds_byte(wc * 32 + fr, fq * 8);
#define PG8_SA(b, h) (((b) * 2 + (h)) * HTB)
#define PG8_SB(b, h) ((4 + (b) * 2 + (h)) * HTB)
#define PG8_STAGE(bufoff, gbase, voff) do { _Pragma("unroll") for (int _i = 0; _i < 2; ++_i) \
        __builtin_amdgcn_global_load_lds((const unsigned*)((const char*)(gbase) + (voff)[_i]), (PG8_LAS unsigned*)(lds + (bufoff) + ldsw + _i * 8192), 16, 0, 0); } while (0)
#define PG8_LDA(dst, b, h) do { _Pragma("unroll") for (int m = 0; m < 4; ++m) _Pragma("unroll") for (int k = 0; k < 2; ++k) dst[m][k] = *(const PG8_LAS bf16x8*)(lds + PG8_SA(b, h) + aoff + m * 2048 + k * 1024); } while (0)
#define PG8_LDB(dst, b, h) do { _Pragma("unroll") for (int n = 0; n < 2; ++n) _Pragma("unroll") for (int k = 0; k < 2; ++k) dst[n][k] = *(const PG8_LAS bf16x8*)(lds + PG8_SB(b, h) + boff + n * 2048 + k * 1024); } while (0)
#define PG8_MMA(ai, bj, At, Bt) do { __builtin_amdgcn_s_setprio(1); _Pragma("unroll") for (int m = 0; m < 4; ++m) _Pragma("unroll") for (int n = 0; n < 2; ++n) _Pragma("unroll") for (int k = 0; k < 2; ++k) \
        acc[ai][bj][m][n] = __builtin_amdgcn_mfma_f32_16x16x32_bf16(Bt[n][k], At[m][k], acc[ai][bj][m][n], 0, 0, 0); __builtin_amdgcn_s_setprio(0); } while (0)
#define PG8_WAIT_V(n) asm volatile("s_waitcnt vmcnt(" #n ")" ::: "memory")
#define PG8_WAIT_L(n) asm volatile("s_waitcnt lgkmcnt(" #n ")" ::: "memory")
#define PG8_BAR __builtin_amdgcn_s_barrier()
#define PG8_SCHED __builtin_amdgcn_sched_barrier(0)
    Unit cur, nxt; int ui = 0;
    if (!S.next(0, cur)) return;
    f32x4 acc[2][2][4][2];
#pragma unroll
    for (int a = 0; a < 2; ++a)
#pragma unroll
        for (int b = 0; b < 2; ++b)
#pragma unroll
            for (int m = 0; m < 4; ++m)
#pragma unroll
                for (int n = 0; n < 2; ++n) acc[a][b][m][n] = (f32x4){0.f, 0.f, 0.f, 0.f};
    bf16x8 At[4][2], B0[2][2], B1[2][2];
    const char* cA = GATHER ? (const char*)g.A : (const char*)g.A + (size_t)cur.pm * tstep; const char* cB = (const char*)g.Bt + (size_t)cur.e * g.estride + (size_t)cur.pn * tstep;
    if constexpr (GATHER) { PG8_LOADIDX(cur, vAc); }
    S.a_ready(cur);
    if constexpr (SP2) {
        PG8_STAGE(PG8_SB(0, 0), cB, voffB); PG8_STAGE(PG8_SB(0, 1), cB + hstep, voffB); PG8_STAGE_A(PG8_SA(0, 0), cA, 0, vAc); PG8_STAGE_A(PG8_SA(0, 1), cA, 1, vAc);
        if (wr == 1) PG8_BAR;
        PG8_WAIT_V(2); PG8_BAR;
        PG8_STAGE(PG8_SB(1, 0), cB + kstep, voffB); PG8_STAGE_A(PG8_SA(1, 0), cA + kstep, 0, vAc); PG8_STAGE(PG8_SB(1, 1), cB + hstep + kstep, voffB);
        PG8_WAIT_V(6); PG8_BAR;
    } else {
        PG8_STAGE(PG8_SB(0, 0), cB, voffB); PG8_STAGE(PG8_SA(0, 0), cA, voffA); PG8_STAGE(PG8_SB(0, 1), cB + hstep, voffB); PG8_STAGE(PG8_SA(0, 1), cA + hstep, voffA);
        if (wr == 1) PG8_BAR;
        PG8_WAIT_V(4); PG8_BAR;
        PG8_STAGE(PG8_SB(1, 0), cB + kstep, voffB); PG8_STAGE(PG8_SA(1, 0), cA + kstep, voffA); PG8_STAGE(PG8_SB(1, 1), cB + hstep + kstep, voffB);
        PG8_WAIT_V(6); PG8_BAR;
    }
    for (;;) {
        const bool has_next = S.next(ui + 1, nxt);
        const char* nA = GATHER ? cA : (has_next ? (const char*)g.A + (size_t)nxt.pm * tstep : cA); const char* nB = has_next ? (const char*)g.Bt + (size_t)nxt.e * g.estride + (size_t)nxt.pn * tstep : cB;
        if constexpr (GATHER) { if (has_next) { PG8_LOADIDX(nxt, vAn); } else {
#pragma unroll
            for (int h_ = 0; h_ < 2; ++h_) { vAn[h_][0] = vAc[h_][0]; vAn[h_][1] = vAc[h_][1]; } } }
        for (int t = 0; t < nt; t += 2) {
            const bool last = (t == nt - 2);
            const char* a1 = cA + (size_t)(t + 1) * kstep;
            const char* a2 = last ? nA : cA + (size_t)(t + 2) * kstep; const char* b2 = last ? nB : cB + (size_t)(t + 2) * kstep;
            const char* a3 = a2 + kstep; const char* b3 = b2 + kstep;
            if (last && has_next) S.a_ready(nxt);
            if constexpr (SP2) {
            unsigned vA2[2][2];
#pragma unroll
            for (int h_ = 0; h_ < 2; ++h_) { vA2[h_][0] = last ? vAn[h_][0] : vAc[h_][0]; vA2[h_][1] = last ? vAn[h_][1] : vAc[h_][1]; }
            PG8_LDB(B0, 0, 0); PG8_LDB(B1, 0, 1); PG8_SCHED; PG8_LDA(At, 0, 0); PG8_STAGE_A(PG8_SA(1, 1), a1, 1, vAc);
            PG8_WAIT_V(8); PG8_WAIT_L(0); PG8_BAR; PG8_MMA(0, 0, At, B0); PG8_MMA(0, 1, At, B1); PG8_BAR; PG8_SCHED;
            PG8_LDA(At, 0, 1); PG8_STAGE(PG8_SB(0, 0), b2, voffB); PG8_STAGE(PG8_SB(0, 1), b2 + hstep, voffB); PG8_STAGE_A(PG8_SA(0, 0), a2, 0, vA2);
            PG8_WAIT_V(8); PG8_WAIT_L(0); PG8_BAR; PG8_MMA(1, 0, At, B0); PG8_MMA(1, 1, At, B1); PG8_BAR; PG8_SCHED;
            PG8_LDB(B0, 1, 0); PG8_LDB(B1, 1, 1); PG8_SCHED; PG8_LDA(At, 1, 0); PG8_STAGE_A(PG8_SA(0, 1), a2, 1, vA2);
            PG8_WAIT_V(8); PG8_WAIT_L(0); PG8_BAR; PG8_MMA(0, 0, At, B0); PG8_MMA(0, 1, At, B1); PG8_BAR; PG8_SCHED;
            PG8_LDA(At, 1, 1); PG8_STAGE(PG8_SB(1, 0), b3, voffB); PG8_STAGE(PG8_SB(1, 1), b3 + hstep, voffB); PG8_STAGE_A(PG8_SA(1, 0), a3, 0, vA2);
            PG8_WAIT_V(8); PG8_WAIT_L(0); PG8_BAR; PG8_MMA(1, 0, At, B0); PG8_MMA(1, 1, At, B1); PG8_BAR; PG8_SCHED;
            } else {
            PG8_LDB(B0, 0, 0); PG8_SCHED; PG8_LDA(At, 0, 0); PG8_STAGE(PG8_SA(1, 1), a1 + hstep, voffA);
            PG8_WAIT_L(8); PG8_BAR; PG8_WAIT_L(0); PG8_MMA(0, 0, At, B0); PG8_BAR; PG8_SCHED;
            PG8_LDB(B1, 0, 1); PG8_STAGE(PG8_SB(0, 0), b2, voffB);
            PG8_BAR; PG8_WAIT_L(0); PG8_MMA(0, 1, At, B1); PG8_BAR;
            PG8_LDA(At, 0, 1); PG8_STAGE(PG8_SA(0, 0), a2, voffA);
            PG8_BAR; PG8_WAIT_L(0); PG8_MMA(1, 0, At, B0); PG8_BAR; PG8_SCHED;
            PG8_STAGE(PG8_SB(0, 1), b2 + hstep, voffB);
            PG8_WAIT_V(6); PG8_BAR; PG8_MMA(1, 1, At, B1); PG8_BAR;
            PG8_LDB(B0, 1, 0); PG8_SCHED; PG8_LDA(At, 1, 0); PG8_STAGE(PG8_SA(0, 1), a2 + hstep, voffA);
            PG8_WAIT_L(8); PG8_BAR; PG8_WAIT_L(0); PG8_MMA(0, 0, At, B0); PG8_BAR; PG8_SCHED;
            PG8_LDB(B1, 1, 1); PG8_STAGE(PG8_SB(1, 0), b3, voffB);
            PG8_BAR; PG8_WAIT_L(0); PG8_MMA(0, 1, At, B1); PG8_BAR;
            PG8_LDA(At, 1, 1); PG8_STAGE(PG8_SA(1, 0), a3, voffA);
            PG8_BAR; PG8_WAIT_L(0); PG8_MMA(1, 0, At, B0); PG8_BAR; PG8_SCHED;
            PG8_STAGE(PG8_SB(1, 1), b3 + hstep, voffB);
            PG8_WAIT_V(6); PG8_BAR; PG8_MMA(1, 1, At, B1); PG8_BAR;
            }
        }
        if constexpr (ALIGN_EPI) { if (wr == 0) PG8_BAR; }
        if constexpr (!Epi::AFTER_DRAIN) { E(acc, cur, wr, wc, fr, fq); S.done(cur); }
        if (!has_next) break;
#pragma unroll
        for (int a = 0; a < 2; ++a)
#pragma unroll
            for (int b = 0; b < 2; ++b)
#pragma unroll
                for (int m = 0; m < 4; ++m)
#pragma unroll
                    for (int n = 0; n < 2; ++n) acc[a][b][m][n] = (f32x4){0.f, 0.f, 0.f, 0.f};
        cur = nxt; cA = nA; cB = nB; ++ui;
        if constexpr (GATHER) {
#pragma unroll
            for (int h_ = 0; h_ < 2; ++h_) { vAc[h_][0] = vAn[h_][0]; vAc[h_][1] = vAn[h_][1]; } }
        if constexpr (ALIGN_EPI) { if (wr == 1) PG8_BAR; }
    }
    PG8_WAIT_V(0);
    if constexpr (!ALIGN_EPI) { if (wr == 0) PG8_BAR; }
    PG8_BAR;
    if constexpr (Epi::AFTER_DRAIN) { E.fused(acc, cur, wr, wc, fr, fq, lds, wid, lane); S.done(cur); }
#undef PG8_SA
#undef PG8_LOADIDX
#undef PG8_STAGE_A
#undef PG8_SB
#undef PG8_STAGE
#undef PG8_LDA
#undef PG8_LDB
#undef PG8_MMA
#undef PG8_WAIT_V
#undef PG8_WAIT_L
#undef PG8_BAR
#undef PG8_SCHED
}
}

constexpr int SG_AS = 132, SG_BS = 68;
template <class FA, class FB>
__device__ __forceinline__ void sg_tile(LAS float* As, LAS float* Bs, int K, FA fa, FB fb, float (&acc)[4][4], int tid) {
    const int ty = tid >> 4, tx = tid & 15;
#pragma unroll
    for (int i = 0; i < 4; ++i)
#pragma unroll
        for (int j = 0; j < 4; ++j) acc[i][j] = 0.f;
    for (int k0 = 0; k0 < K; k0 += 16) {
#pragma unroll
        for (int i = 0; i < 4; ++i) { const int idx = tid + 512 * i, m = idx >> 4, kk = idx & 15; As[kk * SG_AS + m] = fa(m, k0 + kk); }
#pragma unroll
        for (int i = 0; i < 2; ++i) { const int idx = tid + 512 * i, n = idx >> 4, kk = idx & 15; Bs[kk * SG_BS + n] = fb(k0 + kk, n); }
        __syncthreads();
#pragma unroll
        for (int kk = 0; kk < 16; ++kk) {
            const f32x4 a = *(const LAS f32x4*)(As + kk * SG_AS + 4 * ty), b = *(const LAS f32x4*)(Bs + kk * SG_BS + 4 * tx);
#pragma unroll
            for (int i = 0; i < 4; ++i)
#pragma unroll
                for (int j = 0; j < 4; ++j) acc[i][j] += a[i] * b[j];
        }
        __syncthreads();
    }
}

template <int DQK>
__device__ __forceinline__ void sattn_unit(LAS float* sm, const bf16* Q, int ldq, const bf16* Kp, int ldk, const bf16* Vp, int ldv, bf16* O, int ldo, int nkeys, float scale, int tid) {
    constexpr int QS = DQK + 1;
    LAS float* Qs = sm; LAS float* Ks = Qs + 32 * QS; LAS float* Vs = Ks + 64 * QS; LAS float* Ss = Vs + 64 * 128;
    const int qi = tid >> 4, sub = tid & 15;
    __syncthreads();
    for (int idx = tid; idx < 32 * DQK; idx += 512) { const int r = idx / DQK, d = idx % DQK; Qs[r * QS + d] = bf2f(Q[(size_t)r * ldq + d]) * scale; }
    float m = -1e30f, l = 0.f, acc[8];
#pragma unroll
    for (int e = 0; e < 8; ++e) acc[e] = 0.f;
    for (int k0 = 0; k0 < nkeys; k0 += 64) {
        __syncthreads();
        for (int idx = tid; idx < 64 * DQK; idx += 512) { const int r = idx / DQK, d = idx % DQK; Ks[r * QS + d] = bf2f(Kp[(size_t)(k0 + r) * ldk + d]); }
        for (int idx = tid; idx < 64 * 128; idx += 512) { const int r = idx >> 7, d = idx & 127; Vs[r * 128 + d] = bf2f(Vp[(size_t)(k0 + r) * ldv + d]); }
        __syncthreads();
        float s[4];
#pragma unroll
        for (int c = 0; c < 4; ++c) { const int kj = sub + 16 * c; float a = 0.f;
            for (int d = 0; d < DQK; ++d) a += Qs[qi * QS + d] * Ks[kj * QS + d];
            s[c] = a; }
        float tmax = fmaxf(fmaxf(s[0], s[1]), fmaxf(s[2], s[3]));
#pragma unroll
        for (int o = 1; o < 16; o <<= 1) tmax = fmaxf(tmax, __shfl_xor(tmax, o));
        const float mnew = fmaxf(m, tmax), alpha = expf(m - mnew);
        float ps = 0.f;
#pragma unroll
        for (int c = 0; c < 4; ++c) { const float p = expf(s[c] - mnew); ps += p; Ss[qi * 65 + sub + 16 * c] = p; }
#pragma unroll
        for (int o = 1; o < 16; o <<= 1) ps += __shfl_xor(ps, o);
        l = l * alpha + ps; m = mnew;
        __syncthreads();
#pragma unroll
        for (int e = 0; e < 8; ++e) acc[e] *= alpha;
        for (int k = 0; k < 64; ++k) { const float p = Ss[qi * 65 + k];
#pragma unroll
            for (int e = 0; e < 8; ++e) acc[e] += p * Vs[k * 128 + sub * 8 + e]; }
    }
    const float rl = 1.f / l;
    u32x4 w; w.x = pk2(acc[0] * rl, acc[1] * rl); w.y = pk2(acc[2] * rl, acc[3] * rl); w.z = pk2(acc[4] * rl, acc[5] * rl); w.w = pk2(acc[6] * rl, acc[7] * rl);
    *(GAS u32x4*)(O + (size_t)qi * ldo + sub * 8) = w;
}

template <class RM>
__device__ __forceinline__ void transpose_item(const float* W, int K, int N, bf16* WT, int ldt, RM rowmap, LAS float* scr, int item, int lane) {
    const int nblk = N / 64, kb = item / nblk, nb = item % nblk, k0 = 64 * kb, n0 = 64 * nb;
    const int rsub = lane >> 4, c4 = (lane & 15) * 4;
    const GAS float* src = (const GAS float*)W + (size_t)(k0 + rsub) * N + n0 + c4;
    f32x4 v[16];
#pragma unroll
    for (int i = 0; i < 16; ++i) v[i] = *(const GAS f32x4*)(src + (size_t)(4 * i) * N);
#pragma unroll
    for (int i = 0; i < 16; ++i) { LAS float* d = scr + (4 * i + rsub) * 65 + c4; d[0] = v[i].x; d[1] = v[i].y; d[2] = v[i].z; d[3] = v[i].w; }
    LDS_WAIT(); asm volatile("" ::: "memory");
    const int kc = (lane & 7) * 8;
#pragma unroll
    for (int j = 0; j < 8; ++j) { const int n = (lane >> 3) + 8 * j; const LAS float* t = scr + kc * 65 + n;
        u32x4 o; o.x = pk2(t[0 * 65], t[1 * 65]); o.y = pk2(t[2 * 65], t[3 * 65]); o.z = pk2(t[4 * 65], t[5 * 65]); o.w = pk2(t[6 * 65], t[7 * 65]);
        *(GAS u32x4*)(WT + (size_t)rowmap(n0 + n) * ldt + k0 + kc) = o; }
    LDS_WAIT(); asm volatile("" ::: "memory");
}

__device__ __forceinline__ void phase_pro_a(const Frame& F_, const Args& A) { const Frame F = fresh(F_);
    const int gw = F.bid * NWAVES + F.wave, NGW = F.G * NWAVES, gt = F.bid * NTHREADS + F.tid, NGT = F.G * NTHREADS;
    {
        LAS float* sv = (LAS float*)F.lds;
        LAS float* red = sv + 3 * DM;
        for (int i = F.tid; i < 3 * DM; i += NTHREADS) { const int t = i / DM, k = i % DM; const float x = (t < 2) ? AIN(1)[t * DM + k] : AIN(3)[k]; sv[i] = silu_f(x); }
        __syncthreads();
        for (int item = F.bid; item < 256; item += F.G) {
            const int l = item >> 6, n0 = (item & 63) * 96, krow = F.lane / 24, c4 = (F.lane % 24) * 4, kp = F.wave; const bool act = F.lane < 48;
            const GAS float* w = (const GAS float*)AIN(4) + (size_t)l * DM * 6144 + (size_t)(kp * 128 + (act ? krow : 0)) * 6144 + n0 + c4;
            f32x4 a0 = {0.f, 0.f, 0.f, 0.f}, a1 = a0, a2 = a0;
            for (int kb = 0; kb < 64; kb += 16) {
                f32x4 wv[16];
#pragma unroll
                for (int k = 0; k < 16; ++k) wv[k] = *(const GAS f32x4*)(w + (size_t)(2 * (kb + k)) * 6144);
#pragma unroll
                for (int k = 0; k < 16; ++k) { const int kk = kp * 128 + 2 * (kb + k) + (act ? krow : 0); a0 += wv[k] * sv[kk]; a1 += wv[k] * sv[DM + kk]; a2 += wv[k] * sv[2 * DM + kk]; } }
            if (act) { const int pr = kp * 2 + krow; *(LAS f32x4*)(red + (pr * 3 + 0) * 96 + c4) = a0; *(LAS f32x4*)(red + (pr * 3 + 1) * 96 + c4) = a1; *(LAS f32x4*)(red + (pr * 3 + 2) * 96 + c4) = a2; }
            __syncthreads();
            for (int o = F.tid; o < 3 * 96; o += NTHREADS) { const int t = o / 96, nn = o % 96; float sacc = AIN(5)[l * 6144 + n0 + nn];
                for (int q = 0; q < 16; ++q) sacc += red[(q * 3 + t) * 96 + nn];
                ((float*)(F.ws + WS_MODV))[(size_t)(l * 3 + t) * 6144 + n0 + nn] = sacc; }
            __syncthreads();
        }
    }
    for (int i = gt; i < 128 * 32 + 128 * 16; i += NGT) {
        if (i < 128 * 32) { const int p = i >> 5, f = i & 31; const float inv = powf(10000.f, -(float)(2 * f) / 64.f), ang = (float)p * inv;
            ((float*)(F.ws + WS_TABA))[2 * i] = cosf(ang); ((float*)(F.ws + WS_TABA))[2 * i + 1] = sinf(ang); }
        else { const int ii = i - 128 * 32, p = ii >> 4, f = ii & 15; const float inv = powf(10000.f, -(float)(2 * f) / 32.f), ang = (float)p * inv;
            ((float*)(F.ws + WS_TABC))[2 * ii] = cosf(ang); ((float*)(F.ws + WS_TABC))[2 * ii + 1] = sinf(ang); }
    }
    if (F.bid == 0 && F.wave < 2) { const int i = F.wave; const float a = AIN(13)[i * 64 + F.lane] * AIN(14)[i * 64 + F.lane], b = AIN(15)[i * 64 + F.lane] * AIN(16)[i * 64 + F.lane];
        const float sa = wave_sum(a), sb = wave_sum(b); const int l = 2 * i + 1; const float lam_init = 0.8f - 0.6f * expf(-0.3f * (float)l);
        if (F.lane == 0) { ((float*)(F.ws + WS_LAM))[2 * i] = expf(sa) - expf(sb) + lam_init; ((float*)(F.ws + WS_LAM))[2 * i + 1] = lam_init; } }
    {
        __syncthreads();
        LAS float* scr = (LAS float*)F.lds + F.wave * (64 * 65);
        constexpr int I_INE = (DM / 64) * (EIN / 64), I_OUT = (DM / 64) * (DM / 64), I_INO = (DM / 64) * (OIN / 64), I_G = (DM / 64) * (DEXP / 64), I_D = (DEXP / 64) * (DM / 64);
        constexpr int T_INE = 2 * I_INE, T_OUTE = 2 * I_OUT, T_INO = 2 * I_INO, T_OUTO = 2 * I_OUT, T_G = 64 * I_G, T_U = 64 * I_G, T_D = 64 * I_D;
        constexpr int NITEMS = T_INE + T_OUTE + T_INO + T_OUTO + T_G + T_U + T_D;
        for (int it = gw; it < NITEMS; it += NGW) {
            int r = it;
            if (r < T_INE) { const int i = r / I_INE; transpose_item(AIN(6) + (size_t)i * DM * EIN, DM, EIN, (bf16*)(F.ws + WS_WINE) + (size_t)i * EIN * DM, DM,
                [](int n) { if (!EPI_NORM_E || n >= 1024) return n; const int d = n & 127, w = 2 * (d >> 6) + ((d >> 4) & 1), sx = (d >> 5) & 1; return (n & ~127) + 32 * w + 16 * sx + (d & 15); },
                scr, r % I_INE, F.lane); continue; } r -= T_INE;
            if (r < T_OUTE) { const int i = r / I_OUT, item = r % I_OUT;
                if (item / (DM / 64) < 12) transpose_item(AIN(7) + (size_t)i * DM * DM, DM, DM, (bf16*)(F.ws + WS_WOUTE) + (size_t)i * DM * OAE, OAE, [](int n) { return n; }, scr, item, F.lane);
                continue; } r -= T_OUTE;
            if (r < T_INO) { const int i = r / I_INO; transpose_item(AIN(11) + (size_t)i * DM * OIN, DM, OIN, (bf16*)(F.ws + WS_WINO) + (size_t)i * OIN * DM, DM, [](int n) { return n; }, scr, r % I_INO, F.lane); continue; } r -= T_INO;
            if (r < T_OUTO) { const int i = r / I_OUT; transpose_item(AIN(12) + (size_t)i * DM * DM, DM, DM, (bf16*)(F.ws + WS_WOUTO) + (size_t)i * DM * DM, DM, [](int n) { return n; }, scr, r % I_OUT, F.lane); continue; } r -= T_OUTO;
            if (r < T_G) { const int le = r / I_G; transpose_item(AIN(22) + (size_t)le * DM * DEXP, DM, DEXP, (bf16*)(F.ws + WS_WGU) + (size_t)le * DM * DM, DM, [](int n) { return (n >> 7) * 256 + (n & 127); }, scr, r % I_G, F.lane); continue; } r -= T_G;
            if (r < T_U) { const int le = r / I_G; transpose_item(AIN(23) + (size_t)le * DM * DEXP, DM, DEXP, (bf16*)(F.ws + WS_WGU) + (size_t)le * DM * DM, DM, [](int n) { return (n >> 7) * 256 + 128 + (n & 127); }, scr, r % I_G, F.lane); continue; } r -= T_U;
            { const int le = r / I_D; transpose_item(AIN(24) + (size_t)le * DEXP * DM, DEXP, DM, (bf16*)(F.ws + WS_WD) + (size_t)le * DM * DEXP, DEXP, [](int n) { return n; }, scr, r % I_D, F.lane); }
        }
    }
    for (int o = gt; o < 2 * 2 * 256 * DM; o += NGT) {
        const int n = o & 1023, gc = (o >> 10) & 255, ri = (o >> 18) & 1, i = o >> 19, g = gc >> 6, c = gc & 63;
        const float* w = AIN(7) + (size_t)i * DM * DM + (size_t)(768 + 64 * g) * DM + n;
        float a = 0.f;
#pragma unroll
        for (int mb = 0; mb < 64; mb += 32) { float wv[32];
#pragma unroll
            for (int m = 0; m < 32; ++m) wv[m] = ((const GAS float*)w)[(size_t)(mb + m) * DM];
#pragma unroll
            for (int m = 0; m < 32; ++m) { const float fr = (float)(((mb + m) * c) & 63) * (1.f / 64.f); const float t = ri ? __builtin_amdgcn_sinf(fr) : __builtin_amdgcn_cosf(fr); a += t * wv[m]; } }
        ((bf16*)(F.ws + WS_WOUTE))[(size_t)i * DM * OAE + (size_t)n * OAE + 768 + ri * 256 + gc] = (bf16)f2bf(a);
    }
}

__device__ __forceinline__ void phase_pro_b(const Frame& F_, const Args& A) { const Frame F = fresh(F_);
    const int gw = F.bid * NWAVES + F.wave, NGW = F.G * NWAVES;
    for (int r = gw; r < NTOK; r += NGW) {
        const int b = r / TPB, j = r - b * TPB, type = j < CTX ? 2 : b;
        const float* src = j < CTX ? AIN(2) + (size_t)(b * CTX + j) * DM : AIN(0) + (size_t)(b * SEQ + (j - CTX)) * DM;
        f32x4 v[4]; load_row_f32(src, F.lane, v);
        store_row_f32((float*)(F.ws + WS_X) + (size_t)r * DM, F.lane, v);
        modnorm_store(v, modv(F, 0, type, 1), modv(F, 0, type, 0), (bf16*)(F.ws + WS_HA) + (size_t)r * DM, F.lane);
    }
}

__device__ __forceinline__ void unpack8(const u32x4 w, float (&v)[8]) { v[0] = bflo(w.x); v[1] = bfhi(w.x); v[2] = bflo(w.y); v[3] = bfhi(w.y); v[4] = bflo(w.z); v[5] = bfhi(w.z); v[6] = bflo(w.w); v[7] = bfhi(w.w); }
__device__ __forceinline__ u32x4 pack8(const float (&v)[8]) { u32x4 w; w.x = pk2(v[0], v[1]); w.y = pk2(v[2], v[3]); w.z = pk2(v[4], v[5]); w.w = pk2(v[6], v[7]); return w; }

__device__ __forceinline__ void phase_qkfix_e(const Frame& F_, const Args& A, int i) { const Frame F = fresh(F_);
    const int gw = F.bid * NWAVES + F.wave, NGW = F.G * NWAVES, lane = F.lane;
    const float* qg = AIN(8) + i * 128; const float* kg = AIN(9) + i * 128; const float* bg = AIN(10) + i * 256;
    const float* tab = (const float*)(F.ws + WS_TABA);
    for (int r = gw; r < NTOK; r += NGW) {
        const int b = r / TPB, j = r - b * TPB; const bool lat = j >= CTX; const int t = j - CTX, prow = t >> 6, pcol = t & 63;
        bf16* P = (bf16*)(F.ws + WS_PBUF) + (size_t)r * EIN;
#pragma unroll
        for (int it = 0; it < 2; ++it) {
            GAS u32x4* p = (GAS u32x4*)(P + 512 * it) + lane;
            float v[8], y[8], o[8]; unpack8(*p, v);
            float ss = 0.f;
#pragma unroll
            for (int e = 0; e < 8; ++e) ss += v[e] * v[e];
            ss += swz_xor<1>(ss); ss += swz_xor<2>(ss); ss += swz_xor<4>(ss); ss += swz_xor<8>(ss);
            const float rstd = rsqrtf(ss * (1.f / 128.f) + EPS);
            const bool isk = (it == 1) && (lane >= 32);
            const int d0 = 8 * (lane & 15);
            const float* gp = (isk ? kg : qg) + d0;
#pragma unroll
            for (int e = 0; e < 8; ++e) y[e] = v[e] * rstd * gp[e];
            const int quarter = (lane & 15) >> 2, fi = 8 * (lane & 3);
            const int pos = quarter < 2 ? prow : pcol;
#pragma unroll
            for (int e = 0; e < 8; ++e) {
                const float pv = swz_xor<4>(y[e]);
                const float c = lat ? tab[2 * (pos * 32 + fi + e)] : 1.f, s = lat ? tab[2 * (pos * 32 + fi + e) + 1] : 0.f;
                o[e] = (quarter & 1) ? (pv * s + y[e] * c) : (y[e] * c - pv * s);
            }
            *p = pack8(o);
        }
        {
            GAS u32x4* p = (GAS u32x4*)(P + 1024) + lane;
            float v[8], o[8]; unpack8(*p, v);
            float ss = 0.f;
#pragma unroll
            for (int e = 0; e < 8; ++e) ss += v[e] * v[e];
            ss += swz_xor<1>(ss); ss += swz_xor<2>(ss); ss += swz_xor<4>(ss);
            const float rstd = rsqrtf(ss * (1.f / 64.f) + EPS);
            const float* gp = bg + 8 * (lane & 31);
#pragma unroll
            for (int e = 0; e < 8; ++e) o[e] = v[e] * rstd * gp[e];
            if (lane >= 32) *p = pack8(o);
        }
    }
}
__device__ __forceinline__ void phase_qkfix_o(const Frame& F_) { const Frame F = fresh(F_);
    const int gw = F.bid * NWAVES + F.wave, NGW = F.G * NWAVES, lane = F.lane;
    const float* tab = (const float*)(F.ws + WS_TABC);
    for (int r = gw; r < NTOK; r += NGW) {
        const int b = r / TPB, j = r - b * TPB; if (j < CTX) continue;
        const int t = j - CTX, prow = t >> 6, pcol = t & 63;
        bf16* P = (bf16*)(F.ws + WS_PBUF) + (size_t)r * OIN;
#pragma unroll
        for (int it = 0; it < 4; ++it) {
            GAS u32x4* p = (GAS u32x4*)(P + 512 * it) + lane;
            float y[8], o[8]; unpack8(*p, y);
            const int quarter = (lane & 7) >> 1, fi = 8 * (lane & 1);
            const int pos = quarter < 2 ? prow : pcol;
#pragma unroll
            for (int e = 0; e < 8; ++e) {
                const float pv = swz_xor<2>(y[e]);
                const float c = tab[2 * (pos * 16 + fi + e)], s = tab[2 * (pos * 16 + fi + e) + 1];
                o[e] = (quarter & 1) ? (pv * s + y[e] * c) : (y[e] * c - pv * s);
            }
            *p = pack8(o);
        }
    }
}
__device__ __forceinline__ void phase_finish_o(const Frame& F_, const Args& A, int i) { const Frame F = fresh(F_);
    const int gw = F.bid * NWAVES + F.wave, NGW = F.G * NWAVES, lane = F.lane;
    const float lam = ((const float*)(F.ws + WS_LAM))[2 * i], post = 1.f - ((const float*)(F.ws + WS_LAM))[2 * i + 1];
    const float* hg = AIN(17) + i * 128 + 8 * (lane & 15);
    for (int r = gw; r < NTOK; r += NGW) {
        const bf16* T = (const bf16*)(F.ws + WS_OT) + (size_t)r * OTW; bf16* O = (bf16*)(F.ws + WS_OA) + (size_t)r * OAO;
#pragma unroll
        for (int it = 0; it < 4; ++it) {
            float v[8], o[8]; unpack8(*((const GAS u32x4*)(T + 512 * it) + lane), v);
            float ss = 0.f;
#pragma unroll
            for (int e = 0; e < 8; ++e) { const float pv = swz_xor<16>(v[e]); o[e] = v[e] - lam * pv; ss += o[e] * o[e]; }
            ss += swz_xor<1>(ss); ss += swz_xor<2>(ss); ss += swz_xor<4>(ss); ss += swz_xor<8>(ss);
            const float rstd = rsqrtf(ss * (1.f / 128.f) + EPS) * post;
#pragma unroll
            for (int e = 0; e < 8; ++e) o[e] = o[e] * rstd * hg[e];
            if (((lane >> 4) & 1) == 0) *(GAS u32x4*)(O + (2 * it + (lane >> 5)) * 128 + 8 * (lane & 15)) = pack8(o);
        }
    }
}

__device__ __forceinline__ void phase_router(const Frame& F_, const Args& A, int l) { const Frame F = fresh(F_);
    LAS float* wc = (LAS float*)F.lds;
    LAS int* lcnt = (LAS int*)(F.lds + 81920);
    LAS int* gb = lcnt + 16;
    LAS int* rec = gb + 16;
    LAS float* recw = (LAS float*)(rec + 72 * 4);
    LAS float* bias = recw + 72 * 2;
    LAS float* lgt = bias + 32;
    const int lane = F.lane;
    __syncthreads();
    {
        const GAS f32x4* wg4 = (const GAS f32x4*)(AIN(18) + (size_t)l * DM * 4); const GAS f32x4* wr4 = (const GAS f32x4*)(AIN(20) + (size_t)l * DM * 16);
        f32x4 g[2], r[8];
#pragma unroll
        for (int i = 0; i < 2; ++i) g[i] = wg4[F.tid + 512 * i];
#pragma unroll
        for (int i = 0; i < 8; ++i) r[i] = wr4[F.tid + 512 * i];
#pragma unroll
        for (int i = 0; i < 2; ++i) { const int k = F.tid + 512 * i; wc[0 * DM + k] = g[i].x; wc[1 * DM + k] = g[i].y; wc[2 * DM + k] = g[i].z; wc[3 * DM + k] = g[i].w; }
#pragma unroll
        for (int i = 0; i < 8; ++i) { const int idx = F.tid + 512 * i, k = idx >> 2, q = idx & 3; wc[(4 + 4 * q + 0) * DM + k] = r[i].x; wc[(4 + 4 * q + 1) * DM + k] = r[i].y; wc[(4 + 4 * q + 2) * DM + k] = r[i].z; wc[(4 + 4 * q + 3) * DM + k] = r[i].w; }
    }
    if (F.tid < 16) lcnt[F.tid] = 0;
    if (F.tid < 20) bias[F.tid] = F.tid < 4 ? AIN(19)[l * 4 + F.tid] : AIN(21)[l * 16 + (F.tid - 4)];
    __syncthreads();
    const int nmine = (NTOK - F.bid + F.G - 1) / F.G;
    f32x4 vn[4];
    if (F.wave < nmine) load_row_f32((const float*)(F.ws + WS_X) + (size_t)(F.bid + F.wave * F.G) * DM, lane, vn);
    const bool lastl = (l == DEPTH - 1);
    for (int it = F.wave; it < nmine; it += NWAVES) {
        const int r = F.bid + it * F.G, type = row_type(r);
        f32x4 v[4];
#pragma unroll
        for (int j = 0; j < 4; ++j) v[j] = vn[j];
        if (it + NWAVES < nmine) load_row_f32((const float*)(F.ws + WS_X) + (size_t)(F.bid + (it + NWAVES) * F.G) * DM, lane, vn);
        if (lastl && type == 2) continue;
        f32x4 s[4], h[4]; load_row_f32(modv(F, l, type, 4), lane, s); load_row_f32(modv(F, l, type, 3), lane, h);
        const float rstd = row_rstd(v);
#pragma unroll
        for (int j = 0; j < 4; ++j) v[j] = v[j] * rstd * (s[j] + 1.f) + h[j];
        store_row_bf16((bf16*)(F.ws + WS_HA) + (size_t)r * DM, lane, v);
        float gl[4];
#pragma unroll
        for (int c = 0; c < 4; ++c) { float a = 0.f;
#pragma unroll
            for (int j = 0; j < 4; ++j) { const f32x4 w = *(const LAS f32x4*)(wc + c * DM + 4 * lane + 256 * j); a += (v[j].x * w.x + v[j].y * w.y) + (v[j].z * w.z + v[j].w * w.w); }
            gl[c] = a; }
        { float t[4];
#define RT_STEP(M) _Pragma("unroll") for (int c = 0; c < 4; ++c) t[c] = swz_xor<M>(gl[c]); _Pragma("unroll") for (int c = 0; c < 4; ++c) gl[c] += t[c];
          RT_STEP(1) RT_STEP(2) RT_STEP(4) RT_STEP(8) RT_STEP(16)
#pragma unroll
          for (int c = 0; c < 4; ++c) { const f32x2 s2 = swap32(gl[c]); gl[c] = s2.x + s2.y + bias[c]; } }
        int gi = 0;
#pragma unroll
        for (int g = 1; g < 4; ++g) if (gl[g] > gl[gi]) gi = g;
        gi = __builtin_amdgcn_readfirstlane(gi);
        float el[4];
#pragma unroll
        for (int e = 0; e < 4; ++e) { float a = 0.f; const LAS float* wrow = wc + (4 + 4 * gi + e) * DM + 4 * lane;
#pragma unroll
            for (int j = 0; j < 4; ++j) { const f32x4 w = *(const LAS f32x4*)(wrow + 256 * j); a += (v[j].x * w.x + v[j].y * w.y) + (v[j].z * w.z + v[j].w * w.w); }
            el[e] = a; }
        { float t[4];
#define RT_STEP2(M) _Pragma("unroll") for (int c = 0; c < 4; ++c) t[c] = swz_xor<M>(el[c]); _Pragma("unroll") for (int c = 0; c < 4; ++c) el[c] += t[c];
          RT_STEP2(1) RT_STEP2(2) RT_STEP2(4) RT_STEP2(8) RT_STEP2(16)
#undef RT_STEP
#undef RT_STEP2
#pragma unroll
          for (int c = 0; c < 4; ++c) { const f32x2 s2 = swap32(el[c]); el[c] = s2.x + s2.y + bias[4 + 4 * gi + c]; } }
        if (lane < 9) { float o = (lane < 4) ? gl[0] : el[0];
#pragma unroll
            for (int c = 1; c < 4; ++c) { o = (lane == c) ? gl[c] : o; o = (lane == 4 + c) ? el[c] : o; }
            if (lane == 8) o = __builtin_bit_cast(float, gi);
            lgt[it * 12 + lane] = o; }
    }
    __syncthreads();
    if (F.tid < nmine && !(lastl && row_type(F.bid + F.tid * F.G) == 2)) { const int it = F.tid;
        float gl[4], el[4];
#pragma unroll
        for (int c = 0; c < 4; ++c) { gl[c] = lgt[it * 12 + c]; el[c] = lgt[it * 12 + 4 + c]; }
        const int gi = __builtin_bit_cast(int, lgt[it * 12 + 8]);
        float gmax = gl[0];
#pragma unroll
        for (int g = 1; g < 4; ++g) gmax = fmaxf(gmax, gl[g]);
        float gs = 0.f;
#pragma unroll
        for (int g = 0; g < 4; ++g) gs += expf(gl[g] - gmax);
        const float ggate = 1.f / gs;
        int i0 = 0;
#pragma unroll
        for (int e = 1; e < 4; ++e) if (el[e] > el[i0]) i0 = e;
        int i1 = (i0 == 0) ? 1 : 0;
#pragma unroll
        for (int e = 0; e < 4; ++e) if (e != i0 && el[e] > el[i1]) i1 = e;
        float e0v = el[0], e1v = el[0];
#pragma unroll
        for (int e = 1; e < 4; ++e) { e0v = (i0 == e) ? el[e] : e0v; e1v = (i1 == e) ? el[e] : e1v; }
        const float p1 = expf(e1v - e0v);
        const float w0 = ggate / (1.f + p1), w1 = ggate * p1 / (1.f + p1);
        const int e0 = gi * 4 + i0, e1 = gi * 4 + i1;
        const int lp0 = __hip_atomic_fetch_add(lcnt + e0, 1, __ATOMIC_RELAXED, __HIP_MEMORY_SCOPE_WORKGROUP);
        const int lp1 = __hip_atomic_fetch_add(lcnt + e1, 1, __ATOMIC_RELAXED, __HIP_MEMORY_SCOPE_WORKGROUP);
        rec[it * 4 + 0] = e0; rec[it * 4 + 1] = lp0; rec[it * 4 + 2] = e1; rec[it * 4 + 3] = lp1; recw[it * 2] = w0; recw[it * 2 + 1] = w1;
    }
    __syncthreads();
    if (F.tid < 16) gb[F.tid] = (int)__hip_atomic_fetch_add((unsigned*)(F.ws + WS_CTL) + CW_CNT + 64 * (16 * l + F.tid), (unsigned)lcnt[F.tid], __ATOMIC_RELAXED, __HIP_MEMORY_SCOPE_AGENT);
    __syncthreads();
    if (F.tid < nmine && !(lastl && row_type(F.bid + F.tid * F.G) == 2)) { const int it = F.tid, r = F.bid + it * F.G; const int e0 = rec[it * 4], e1 = rec[it * 4 + 2];
        const int q0 = gb[e0] + rec[it * 4 + 1], q1 = gb[e1] + rec[it * 4 + 3];
        ((GAS i32x4*)(F.ws + WS_SELA))[r] = (i32x4){e0, q0, e1, q1};
        ((GAS int*)(F.ws + WS_ROWTOK))[(size_t)e0 * NTOK + q0] = r; ((GAS int*)(F.ws + WS_ROWTOK))[(size_t)e1 * NTOK + q1] = r;
        ((GAS f32x2*)(F.ws + WS_SELW))[r] = (f32x2){recw[it * 2], recw[it * 2 + 1]}; }
    __syncthreads();
}
__device__ __forceinline__ void moe_bases(const Frame& F, int l, int (&base)[17]) {
    const unsigned* cnt = (const unsigned*)(F.ws + WS_CTL) + CW_CNT + 64 * 16 * l;
    int acc = 0;
#pragma unroll
    for (int e = 0; e < 16; ++e) { base[e] = acc; const int c = __builtin_amdgcn_readfirstlane((int)__hip_atomic_load(cnt + 64 * e, __ATOMIC_RELAXED, __HIP_MEMORY_SCOPE_AGENT)); acc += ((c + 255) >> 8) << 8; }
    base[16] = acc;
}
__device__ __forceinline__ void phase_gather(const Frame& F_, int l) { const Frame F = fresh(F_);
    const int gw = F.bid * NWAVES + F.wave, NGW = F.G * NWAVES, lane = F.lane;
    int base[17]; moe_bases(F, l, base);
    for (int r = gw; r < NTOK; r += NGW) {
        const i32x4 s = ((const GAS i32x4*)(F.ws + WS_SELA))[r];
        int b0 = 0, b1 = 0;
#pragma unroll
        for (int e = 0; e < 16; ++e) { b0 = (s.x == e) ? base[e] : b0; b1 = (s.z == e) ? base[e] : b1; }
        const int r0 = b0 + s.y, r1 = b1 + s.w;
        const GAS u32x4* src = (const GAS u32x4*)((const bf16*)(F.ws + WS_HA) + (size_t)r * DM) + lane;
        const u32x4 a = src[0], c = src[64];
        GAS u32x4* d0 = (GAS u32x4*)((bf16*)(F.ws + WS_XS) + (size_t)r0 * DM) + lane; d0[0] = a; d0[64] = c;
        GAS u32x4* d1 = (GAS u32x4*)((bf16*)(F.ws + WS_XS) + (size_t)r1 * DM) + lane; d1[0] = a; d1[64] = c;
        if (lane == 0) ((GAS i32x2*)(F.ws + WS_RPOS))[r] = (i32x2){r0, r1};
    }
}
__device__ __forceinline__ void phase_combine(const Frame& F_, const Args& A, int l) { const Frame F = fresh(F_);
    const int gw = F.bid * NWAVES + F.wave, NGW = F.G * NWAVES, lane = F.lane;
    int base[17]; moe_bases(F, l, base);
    const GAS i32x4* SELA = (const GAS i32x4*)(F.ws + WS_SELA); const GAS f32x2* SELW = (const GAS f32x2*)(F.ws + WS_SELW);
    const bf16* Y = (const bf16*)(F.ws + WS_Y2S); float* X = (float*)(F.ws + WS_X);
    const int nk = (NTOK - gw + NGW - 1) / NGW;
    if (nk <= 0) return;
#define CB_ROWS(sel, ra, rb) do { int b0_ = 0, b1_ = 0; _Pragma("unroll") for (int e = 0; e < 16; ++e) { b0_ = ((sel).x == e) ? base[e] : b0_; b1_ = ((sel).z == e) ? base[e] : b1_; } ra = b0_ + (sel).y; rb = b1_ + (sel).w; } while (0)
#define CB_LOADY(dst, row) do { const GAS u32x2* q_ = (const GAS u32x2*)(Y + (size_t)(row) * DM) + lane; _Pragma("unroll") for (int j = 0; j < 4; ++j) dst[j] = q_[64 * j]; } while (0)
    i32x4 selB = SELA[gw]; f32x2 wA = SELW[gw], wB = wA; i32x4 selC = selB;
    f32x4 xA[4], xB[4]; u32x2 yA0[4], yA1[4], yB0[4], yB1[4];
    { int ra, rb; CB_ROWS(selB, ra, rb); load_row_f32(X + (size_t)gw * DM, lane, xA); CB_LOADY(yA0, ra); CB_LOADY(yA1, rb); }
    if (nk > 1) selB = SELA[gw + NGW];
    for (int k = 0; k < nk; ++k) {
        const int r = gw + k * NGW, b = r / TPB, j = r - b * TPB, type = j < CTX ? 2 : b;
        if (k + 1 < nk) { const int rn = r + NGW; int ra, rb; CB_ROWS(selB, ra, rb); load_row_f32(X + (size_t)rn * DM, lane, xB); CB_LOADY(yB0, ra); CB_LOADY(yB1, rb); wB = SELW[rn]; }
        if (k + 2 < nk) selC = SELA[r + 2 * NGW];
        if (!(l == DEPTH - 1 && j < CTX)) {
            f32x4 x[4], g[4];
            load_row_f32(modv(F, l, type, 5), lane, g);
#pragma unroll
            for (int q = 0; q < 4; ++q) { const f32x4 y0 = {bflo(yA0[q].x), bfhi(yA0[q].x), bflo(yA0[q].y), bfhi(yA0[q].y)}, y1 = {bflo(yA1[q].x), bfhi(yA1[q].x), bflo(yA1[q].y), bfhi(yA1[q].y)};
                x[q] = xA[q] + g[q] * (y0 * wA.x + y1 * wA.y); }
            if (l < DEPTH - 1) {
                store_row_f32(X + (size_t)r * DM, lane, x);
                modnorm_store(x, modv(F, l + 1, type, 1), modv(F, l + 1, type, 0), (bf16*)(F.ws + WS_HA) + (size_t)r * DM, lane);
            } else {
                const float rstd = row_rstd(x);
                f32x4 fg[4]; load_row_f32(AIN(25), lane, fg);
#pragma unroll
                for (int q = 0; q < 4; ++q) x[q] = x[q] * rstd * fg[q];
                store_row_f32(A.out + (size_t)(b * SEQ + (j - CTX)) * DM, lane, x);
            }
        }
#pragma unroll
        for (int q = 0; q < 4; ++q) { xA[q] = xB[q]; yA0[q] = yB0[q]; yA1[q] = yB1[q]; }
        wA = wB; selB = selC;
    }
#undef CB_ROWS
#undef CB_LOADY
}

__device__ __forceinline__ void sphase_gemm_bf16(const Frame& F_, const bf16* Am, int lda, const bf16* Bt, int ldb, bf16* C, int ldc, int M, int N, int K) { const Frame F = fresh(F_);
    LAS float* As = (LAS float*)F.lds; LAS float* Bs = As + 16 * SG_AS;
    const int nm = M / 128, nn = N / 64, ty = F.tid >> 4, tx = F.tid & 15;
    for (int t = F.bid; t < nm * nn; t += F.G) {
        const int tm = t / nn, tn = t % nn; const bf16* a0 = Am + (size_t)tm * 128 * lda; const bf16* b0 = Bt + (size_t)tn * 64 * ldb;
        float acc[4][4];
        sg_tile(As, Bs, K, [&](int m, int k) { return bf2f(a0[(size_t)m * lda + k]); }, [&](int k, int n) { return bf2f(b0[(size_t)n * ldb + k]); }, acc, F.tid);
#pragma unroll
        for (int i = 0; i < 4; ++i) { u32x2 w; w.x = pk2(acc[i][0], acc[i][1]); w.y = pk2(acc[i][2], acc[i][3]);
            *(GAS u32x2*)(C + (size_t)(tm * 128 + 4 * ty + i) * ldc + tn * 64 + 4 * tx) = w; }
    }
}
__device__ __forceinline__ void sphase_outproj(const Frame& F_, const bf16* Am, int lda, const bf16* Bt, int K, int l) { const Frame F = fresh(F_);
    LAS float* As = (LAS float*)F.lds; LAS float* Bs = As + 16 * SG_AS;
    const int nm = NTOK / 128, nn = DM / 64, ty = F.tid >> 4, tx = F.tid & 15;
    for (int t = F.bid; t < nm * nn; t += F.G) {
        const int tm = t / nn, tn = t % nn; const bf16* a0 = Am + (size_t)tm * 128 * lda; const bf16* b0 = Bt + (size_t)tn * 64 * K;
        float acc[4][4];
        sg_tile(As, Bs, K, [&](int m, int k) { return bf2f(a0[(size_t)m * lda + k]); }, [&](int k, int n) { return bf2f(b0[(size_t)n * K + k]); }, acc, F.tid);
#pragma unroll
        for (int i = 0; i < 4; ++i) { const int r = tm * 128 + 4 * ty + i, c = tn * 64 + 4 * tx;
            const f32x4 g = *(const GAS f32x4*)(modv(F, l, row_type(r), 2) + c);
            GAS f32x4* xp = (GAS f32x4*)((float*)(F.ws + WS_X) + (size_t)r * DM + c); f32x4 x = *xp;
            x.x += g.x * acc[i][0]; x.y += g.y * acc[i][1]; x.z += g.z * acc[i][2]; x.w += g.w * acc[i][3]; *xp = x; }
    }
}
__device__ __forceinline__ int moe_expert_of_row(const int (&base)[17], int row) { int e = 0;
#pragma unroll
    for (int q = 1; q < 16; ++q) e = (row >= base[q]) ? q : e;
    return e; }
__device__ __forceinline__ void sphase_moe_gu(const Frame& F_, int l) { const Frame F = fresh(F_);
    LAS float* As = (LAS float*)F.lds; LAS float* Bs = As + 16 * SG_AS;
    int base[17]; moe_bases(F, l, base);
    const int nm = base[16] / 128, nn = DEXP / 64, ty = F.tid >> 4, tx = F.tid & 15;
    for (int t = F.bid; t < nm * nn; t += F.G) {
        const int tm = t / nn, tn = t % nn, e = moe_expert_of_row(base, tm * 128);
        const bf16* a0 = (const bf16*)(F.ws + WS_XS) + (size_t)tm * 128 * DM;
        const bf16* w = (const bf16*)(F.ws + WS_WGU) + (size_t)(l * 16 + e) * DM * DM;
        const int hc0 = tn * 64;
        const bf16* bg0 = w + (size_t)((hc0 >> 7) * 256 + (hc0 & 127)) * DM; const bf16* bu0 = bg0 + (size_t)128 * DM;
        float ag[4][4], au[4][4];
        sg_tile(As, Bs, DM, [&](int m, int k) { return bf2f(a0[(size_t)m * DM + k]); }, [&](int k, int n) { return bf2f(bg0[(size_t)n * DM + k]); }, ag, F.tid);
        sg_tile(As, Bs, DM, [&](int m, int k) { return bf2f(a0[(size_t)m * DM + k]); }, [&](int k, int n) { return bf2f(bu0[(size_t)n * DM + k]); }, au, F.tid);
#pragma unroll
        for (int i = 0; i < 4; ++i) { float h[4];
#pragma unroll
            for (int j = 0; j < 4; ++j) h[j] = silu_f(ag[i][j]) * au[i][j];
            u32x2 wv; wv.x = pk2(h[0], h[1]); wv.y = pk2(h[2], h[3]);
            *(GAS u32x2*)((bf16*)(F.ws + WS_HID) + (size_t)(tm * 128 + 4 * ty + i) * DEXP + hc0 + 4 * tx) = wv; }
    }
}
__device__ __forceinline__ void sphase_moe_down(const Frame& F_, int l) { const Frame F = fresh(F_);
    LAS float* As = (LAS float*)F.lds; LAS float* Bs = As + 16 * SG_AS;
    int base[17]; moe_bases(F, l, base);
    const int nm = base[16] / 128, nn = DM / 64, ty = F.tid >> 4, tx = F.tid & 15;
    for (int t = F.bid; t < nm * nn; t += F.G) {
        const int tm = t / nn, tn = t % nn, e = moe_expert_of_row(base, tm * 128);
        const bf16* a0 = (const bf16*)(F.ws + WS_HID) + (size_t)tm * 128 * DEXP;
        const bf16* b0 = (const bf16*)(F.ws + WS_WD) + (size_t)(l * 16 + e) * DM * DEXP + (size_t)tn * 64 * DEXP;
        float acc[4][4];
        sg_tile(As, Bs, DEXP, [&](int m, int k) { return bf2f(a0[(size_t)m * DEXP + k]); }, [&](int k, int n) { return bf2f(b0[(size_t)n * DEXP + k]); }, acc, F.tid);
#pragma unroll
        for (int i = 0; i < 4; ++i) { u32x2 w; w.x = pk2(acc[i][0], acc[i][1]); w.y = pk2(acc[i][2], acc[i][3]);
            *(GAS u32x2*)((bf16*)(F.ws + WS_Y2S) + (size_t)(tm * 128 + 4 * ty + i) * DM + tn * 64 + 4 * tx) = w; }
    }
}


#ifndef FAST_GEMM
#define FAST_GEMM 1
#endif
__device__ __forceinline__ void fphase_inproj(const Frame& F_, bool even, int i) { const Frame F = fresh(F_);
    if (even) {
        pg8::Gemm g{(const bf16*)(F.ws + WS_HA), (const bf16*)(F.ws + WS_WINE) + (size_t)i * EIN * DM, NTOK, EIN, DM, 0};
        pg8::StaticOrder S; S.init(NTOK, EIN, F.G, F.bid);
        if (EPI_NORM_E) {
            pg8::EpiNormRopeE E{(bf16*)(F.ws + WS_PBUF), AIN(8) + i * 128, AIN(9) + i * 128, AIN(10) + i * 256, (const float*)(F.ws + WS_TABA), (LAS float*)(F.lds + 133120)};
            pg8::gemm_phase<pg8::EpiNormRopeE, pg8::StaticOrder, true, true>(F.lds, g, S, E, F.tid);
        } else {
            pg8::EpiBf16<0> E{(bf16*)(F.ws + WS_PBUF), EIN, nullptr, 0, 0, 1.f};
            pg8::gemm_phase<pg8::EpiBf16<0>, pg8::StaticOrder, true, true>(F.lds, g, S, E, F.tid);
        }
    } else {
        pg8::Gemm g{(const bf16*)(F.ws + WS_HA), (const bf16*)(F.ws + WS_WINO) + (size_t)i * OIN * DM, NTOK, OIN, DM, 0};
        pg8::StaticOrder S; S.init(NTOK, OIN, F.G, F.bid);
        pg8::EpiRopeO E{(bf16*)(F.ws + WS_PBUF), OIN, (const float*)(F.ws + WS_TABC), 8, (ATTN_RING3 && ATTN_NEGM) ? 4 : 0, 0.125f * 1.4426950408889634f};
        pg8::gemm_phase<pg8::EpiRopeO, pg8::StaticOrder, true, true>(F.lds, g, S, E, F.tid);
    }
}
__device__ __forceinline__ void fphase_outproj(const Frame& F_, bool even, int i, int l) { const Frame F = fresh(F_);
    const int K = even ? OAE : OAO;
    const bf16* Bt = even ? (const bf16*)(F.ws + WS_WOUTE) + (size_t)i * DM * OAE : (const bf16*)(F.ws + WS_WOUTO) + (size_t)i * DM * DM;
    pg8::Gemm g{(const bf16*)(F.ws + WS_OA), Bt, NTOK, DM, K, 0};
    pg8::EpiResGate E{(float*)(F.ws + WS_X), modv(F, l, 0, 2)};
    if (l == DEPTH - 1) {
        pg8::LatOrder S; S.init(DM, F.G, F.bid);
        pg8::gemm_phase<pg8::EpiResGate, pg8::LatOrder, true, true>(F.lds, g, S, E, F.tid);
    } else {
        pg8::StaticOrder S; S.init(NTOK, DM, F.G, F.bid);
        pg8::gemm_phase<pg8::EpiResGate, pg8::StaticOrder, true, true>(F.lds, g, S, E, F.tid);
    }
}
__device__ __forceinline__ void fphase_moe_gu(const Frame& F_, int l) { const Frame F = fresh(F_);
    int base[17]; moe_bases(F, l, base);
    LAS int* tbl = (LAS int*)(F.lds + TB_OFF);
    __syncthreads();
#pragma unroll
    for (int e = 0; e < 17; ++e) if (F.tid == e) tbl[e] = base[e] >> 8;
    __syncthreads();
    pg8::MoeOrder S; S.tb = tbl; S.nN = 4; S.nwg = (base[16] >> 8) * 4; S.G = F.G; S.c = F.bid;
    pg8::Gemm g{(const bf16*)(F.ws + WS_HA), (const bf16*)(F.ws + WS_WGU) + (size_t)l * 16 * DM * DM, base[16], DM, DM, (size_t)DM * DM * 2, (const int*)(F.ws + WS_ROWTOK), NTOK};
    pg8::EpiSwiGLU E{(bf16*)(F.ws + WS_HID)};
    pg8::gemm_phase<pg8::EpiSwiGLU, pg8::MoeOrder, true, true, true>(F.lds, g, S, E, F.tid);
}
__device__ __forceinline__ void fphase_moe_down(const Frame& F_, int l) { const Frame F = fresh(F_);
    int base[17]; moe_bases(F, l, base);
    LAS int* tbl = (LAS int*)(F.lds + TB_OFF);
    __syncthreads();
#pragma unroll
    for (int e = 0; e < 17; ++e) if (F.tid == e) tbl[e] = base[e] >> 8;
    __syncthreads();
    pg8::MoeOrder S; S.tb = tbl; S.nN = 4; S.nwg = (base[16] >> 8) * 4; S.G = F.G; S.c = F.bid;
    pg8::Gemm g{(const bf16*)(F.ws + WS_HID), (const bf16*)(F.ws + WS_WD) + (size_t)l * 16 * DM * DEXP, base[16], DM, DEXP, (size_t)DM * DEXP * 2};
    pg8::EpiBf16<0> E{(bf16*)(F.ws + WS_Y2S), DM, nullptr, 0, 0, 1.f};
    pg8::gemm_phase<pg8::EpiBf16<0>, pg8::MoeOrder, true, true>(F.lds, g, S, E, F.tid);
}

__device__ __forceinline__ void sphase_fft1(const Frame& F_) { const Frame F = fresh(F_);
    const int gt = F.bid * NTHREADS + F.tid, NGT = F.G * NTHREADS;
    for (int o = gt; o < NB * 128 * 2 * 64 * 256; o += NGT) {
        const int col = o & 255, t2 = (o >> 8) & 63, ri = (o >> 14) & 1, k1 = (o >> 15) & 127, b = o >> 22;
        const bf16* f = (const bf16*)(F.ws + WS_PBUF) + (size_t)(b * TPB + CTX + t2) * EIN + 1280 + col;
        float a = 0.f;
        for (int t1 = 0; t1 < 128; ++t1) { const int t = 64 * t1 + t2; const float fr = (float)((k1 * t) & 8191) * (1.f / 8192.f);
            const float c = ri ? -__builtin_amdgcn_sinf(fr) : __builtin_amdgcn_cosf(fr); a += c * bf2f(f[(size_t)(64 * t1) * EIN]); }
        ((bf16*)(F.ws + WS_YB))[o] = (bf16)f2bf(a);
    }
}
__device__ __forceinline__ void sphase_fft2(const Frame& F_) { const Frame F = fresh(F_);
    const int gt = F.bid * NTHREADS + F.tid, NGT = F.G * NTHREADS;
    const float norm = 1.f / sqrtf(8192.f * 64.f);
    for (int o = gt; o < NB * SEQ * 2 * 256; o += NGT) {
        const int col = o & 255, ri = (o >> 8) & 1, k = (o >> 9) & 8191, b = o >> 22, k1 = k & 127, k2 = k >> 7;
        const bf16* yr = (const bf16*)(F.ws + WS_YB) + ((size_t)((b * 128 + k1) * 2 + 0) * 64) * 256 + col; const bf16* yi = yr + 64 * 256;
        float a = 0.f;
        for (int t2 = 0; t2 < 64; ++t2) { const float fr = (float)((k2 * t2) & 63) * (1.f / 64.f), c = __builtin_amdgcn_cosf(fr), s = __builtin_amdgcn_sinf(fr);
            const float vr = bf2f(yr[t2 * 256]), vi = bf2f(yi[t2 * 256]);
            a += ri ? (c * vi - s * vr) : (c * vr + s * vi); }
        ((bf16*)(F.ws + WS_OA))[(size_t)(b * TPB + CTX + k) * OAE + 768 + ri * 256 + col] = (bf16)f2bf(a * norm);
    }
}
__device__ __forceinline__ void sphase_fftc(const Frame& F_) { const Frame F = fresh(F_);
    const int gt = F.bid * NTHREADS + F.tid, NGT = F.G * NTHREADS;
    const float norm = 1.f / sqrtf(256.f * 64.f);
    for (int o = gt; o < NB * CTX * 2 * 256; o += NGT) {
        const int col = o & 255, ri = (o >> 8) & 1, k = (o >> 9) & 255, b = o >> 17;
        const bf16* f = (const bf16*)(F.ws + WS_PBUF) + (size_t)(b * TPB) * EIN + 1280 + col;
        float a = 0.f;
        for (int t = 0; t < CTX; ++t) { const float fr = (float)((k * t) & 255) * (1.f / 256.f); const float c = ri ? -__builtin_amdgcn_sinf(fr) : __builtin_amdgcn_cosf(fr); a += c * bf2f(f[(size_t)t * EIN]); }
        ((bf16*)(F.ws + WS_OA))[(size_t)(b * TPB + k) * OAE + 768 + ri * 256 + col] = (bf16)f2bf(a * norm);
    }
}


namespace fa {
using bf16x8 = __attribute__((ext_vector_type(8))) short;
using s16x4  = __attribute__((ext_vector_type(4))) short;
using f32x16 = __attribute__((ext_vector_type(16))) float;
constexpr int NW = 8, QBLK = 32, KVBLK = 64, DV = 128;
constexpr float THR = 8.f;
constexpr int SHM_V = KVBLK * DV * 2;
template <int DQK> struct Cfg { static constexpr float SCALE = DQK == 128 ? 0.088388347648318440f : 0.125f; static constexpr int RB = DQK * 2, SHM_K = KVBLK * DQK * 2, ND0 = DQK / 16; };
#define FA_KSWZ(row, colB, RB) ((row) * (RB) + ((colB) ^ (((RB) == 256 ? ((row) & 15) : (((row) >> 1) & 7)) << 4)))
#define FA_SBAR() __builtin_amdgcn_sched_barrier(0)
__device__ __forceinline__ int crow(int r, int hi) { return (r & 3) + 8 * (r >> 2) + 4 * hi; }
__device__ __forceinline__ unsigned cvtpk(float lo, float hi) { unsigned r; asm volatile("v_cvt_pk_bf16_f32 %0, %1, %2" : "=v"(r) : "v"(lo), "v"(hi)); return r; }
template <int DQK>
__device__ __forceinline__ void partialSM(f32x16& p0, f32x16& p1, float& m_reg, float& mn, float& alpha) {
  constexpr float SCALE = Cfg<DQK>::SCALE, C = SCALE * 1.4426950408889634f;
  float pmax = p0[0];
#pragma unroll
  for (int r = 1; r < 16; ++r) pmax = fmaxf(pmax, p0[r]);
#pragma unroll
  for (int r = 0; r < 16; ++r) pmax = fmaxf(pmax, p1[r]);
  { auto rr = __builtin_amdgcn_permlane32_swap(__float_as_uint(pmax), __float_as_uint(pmax), false, false);
    pmax = fmaxf(__uint_as_float(rr[0]), __uint_as_float(rr[1])); }
  if (__builtin_expect(__all(pmax - m_reg <= THR / SCALE), 1)) { mn = m_reg; alpha = 1.f; }
  else { mn = fmaxf(m_reg, pmax); alpha = __builtin_amdgcn_exp2f((m_reg - mn) * C); m_reg = mn; }
  const float mnC = -mn * C;
#pragma unroll
  for (int r = 0; r < 16; ++r) p0[r] = fmaf(p0[r], C, mnC);
#pragma unroll
  for (int r = 0; r < 16; ++r) p1[r] = fmaf(p1[r], C, mnC);
#pragma unroll
  for (int r = 0; r < 16; ++r) p0[r] = __builtin_amdgcn_exp2f(p0[r]);
}
__device__ __forceinline__ void finishSM(f32x16& p0, f32x16& p1, float alpha, float& l_reg, bf16x8& pa0, bf16x8& pa1, bf16x8& pa2, bf16x8& pa3) {
#pragma unroll
  for (int r = 0; r < 16; ++r) p1[r] = __builtin_amdgcn_exp2f(p1[r]);
  float ps = 0;
#pragma unroll
  for (int r = 0; r < 16; ++r) ps += p0[r];
#pragma unroll
  for (int r = 0; r < 16; ++r) ps += p1[r];
  { auto rr = __builtin_amdgcn_permlane32_swap(__float_as_uint(ps), __float_as_uint(ps), false, false);
    ps = __uint_as_float(rr[0]) + __uint_as_float(rr[1]); }
  l_reg = l_reg * alpha + ps;
#define FA_PK4(P, BASE, OUT) do { unsigned a0 = cvtpk(P[BASE + 0], P[BASE + 1]), a1 = cvtpk(P[BASE + 2], P[BASE + 3]);   \
    unsigned b0 = cvtpk(P[BASE + 4], P[BASE + 5]), b1 = cvtpk(P[BASE + 6], P[BASE + 7]);                              \
    auto r0 = __builtin_amdgcn_permlane32_swap(a0, b0, false, false); auto r1 = __builtin_amdgcn_permlane32_swap(a1, b1, false, false); \
    u32x4 w = {r0[0], r1[0], r0[1], r1[1]}; OUT = *reinterpret_cast<bf16x8*>(&w); } while (0)
  FA_PK4(p0, 0, pa0); FA_PK4(p0, 8, pa1); FA_PK4(p1, 0, pa2); FA_PK4(p1, 8, pa3);
#undef FA_PK4
}
template <int DQK>
__device__ __forceinline__ void qkt(f32x16& p0, f32x16& p1, const LAS char* Ks, const bf16x8* qr, int r32, int hi) {
  constexpr int RB = Cfg<DQK>::RB;
  p0 = f32x16{}; p1 = f32x16{};
#pragma unroll
  for (int d0 = 0; d0 < Cfg<DQK>::ND0; ++d0) { const int cb = (d0 * 16 + hi * 8) * 2;
    bf16x8 b0 = *reinterpret_cast<const LAS bf16x8*>(Ks + FA_KSWZ(r32, cb, RB));
    bf16x8 b1 = *reinterpret_cast<const LAS bf16x8*>(Ks + FA_KSWZ(32 + r32, cb, RB));
    p0 = __builtin_amdgcn_mfma_f32_32x32x16_bf16(b0, qr[d0], p0, 0, 0, 0);
    p1 = __builtin_amdgcn_mfma_f32_32x32x16_bf16(b1, qr[d0], p1, 0, 0, 0); }
}
__device__ __forceinline__ int v_st(int k, int c) { const int kk = (k & ~0xC) | ((k & 4) << 1) | ((k & 8) >> 1); return ((kk >> 3) * 4 + (c >> 5)) * 512 + ((kk & 7) * 32 + (c & 31)) * 2; }
__device__ __forceinline__ int v_rd_base(int lane) { return ((lane & 3) << 3) | (((lane >> 2) & 3) << 6) | (((lane >> 4) & 1) << 5) | (((lane >> 5) & 1) << 8); }
constexpr int v_rd_off(int d0, int ks, int half) { return d0 * 512 + ks * 4096 + half * 2048; }
template <int OFF> __device__ __forceinline__ s16x4 tr_read(int vb) {
  s16x4 r; asm volatile("ds_read_b64_tr_b16 %0, %1 offset:%2" : "=&v"(r) : "v"(vb), "i"(OFF) : "memory"); return r;
}
template <int D0> __device__ __forceinline__ void pv_one(f32x16& od, int vb, bf16x8 pa0, bf16x8 pa1, bf16x8 pa2, bf16x8 pa3) {
  const s16x4 l0 = tr_read<v_rd_off(D0, 0, 0)>(vb), h0 = tr_read<v_rd_off(D0, 0, 1)>(vb), l1 = tr_read<v_rd_off(D0, 1, 0)>(vb), h1 = tr_read<v_rd_off(D0, 1, 1)>(vb);
  const s16x4 l2 = tr_read<v_rd_off(D0, 2, 0)>(vb), h2 = tr_read<v_rd_off(D0, 2, 1)>(vb), l3 = tr_read<v_rd_off(D0, 3, 0)>(vb), h3 = tr_read<v_rd_off(D0, 3, 1)>(vb);
  asm volatile("s_waitcnt lgkmcnt(0)" ::: "memory"); FA_SBAR();
#define FA_PK(L, H) (bf16x8){L[0], L[1], L[2], L[3], H[0], H[1], H[2], H[3]}
  od = __builtin_amdgcn_mfma_f32_32x32x16_bf16(pa0, FA_PK(l0, h0), od, 0, 0, 0);
  od = __builtin_amdgcn_mfma_f32_32x32x16_bf16(pa1, FA_PK(l1, h1), od, 0, 0, 0);
  od = __builtin_amdgcn_mfma_f32_32x32x16_bf16(pa2, FA_PK(l2, h2), od, 0, 0, 0);
  od = __builtin_amdgcn_mfma_f32_32x32x16_bf16(pa3, FA_PK(l3, h3), od, 0, 0, 0);
#undef FA_PK
}
__device__ __forceinline__ void pv_d0(f32x16* o, int vb, bf16x8 pa0, bf16x8 pa1, bf16x8 pa2, bf16x8 pa3) {
  pv_one<0>(o[0], vb, pa0, pa1, pa2, pa3); pv_one<1>(o[1], vb, pa0, pa1, pa2, pa3); pv_one<2>(o[2], vb, pa0, pa1, pa2, pa3); pv_one<3>(o[3], vb, pa0, pa1, pa2, pa3);
}
template <int DQK, int LDI, int SDEPTH>
__device__ __forceinline__ void attn_unit(const bf16* __restrict__ Qb, const bf16* __restrict__ Kh, const bf16* __restrict__ Vh, bf16* __restrict__ Ob, const int ldo, float* stats, int seq, LAS char* lds, int tid) {
  constexpr int ldq = LDI, ldk = LDI, ldv = LDI;
  constexpr int RB = Cfg<DQK>::RB, SHM_K = Cfg<DQK>::SHM_K, ND0 = Cfg<DQK>::ND0;
  const int wid = tid >> 6, lane = tid & 63, r32 = lane & 31, hi = lane >> 5;
  LAS char* V_lds = lds; LAS char* K_lds = lds + 2 * SHM_V;
  LAS float* ws = (LAS float*)(lds + 2 * SHM_V + 2 * SHM_K) + wid * 64; LAS float* li_l = ws; LAS float* al_l = ws + 32;
  float m_reg = -1e30f, l_reg = 0; f32x16 o[4] = {}; bf16x8 qr[ND0];
  __syncthreads();
  const GAS bf16* Qw = (const GAS bf16*)Qb + (size_t)(wid * QBLK + r32) * ldq + hi * 8;
#pragma unroll
  for (int d0 = 0; d0 < ND0; ++d0) qr[d0] = *reinterpret_cast<const GAS bf16x8*>(Qw + d0 * 16);
  const int sr = tid >> 4, sc = (tid & 15) * 8, vst0 = v_st(sr, sc), vst1 = v_st(32 + sr, sc);
  const int kr = DQK == 128 ? sr : (tid >> 3), kc = DQK == 128 ? sc : (tid & 7) * 8;
  const int vb0 = (int)(unsigned)(size_t)V_lds + v_rd_base(lane);
  struct { bf16x8 vs0, vs1, ks0, ks1; } sr_[SDEPTH];
const unsigned vo0 = (unsigned)(sr * ldv + sc), vo1 = (unsigned)((32 + sr) * ldv + sc), ko0 = (unsigned)(kr * ldk + kc), ko1 = (unsigned)((32 + kr) * ldk + kc);
#define FA_SLOAD(i, k0) do { const GAS bf16* Vt_ = (const GAS bf16*)Vh + (size_t)(k0) * ldv; const GAS bf16* Kt_ = (const GAS bf16*)Kh + (size_t)(k0) * ldk; \
    sr_[i].vs0 = *reinterpret_cast<const GAS bf16x8*>(Vt_ + vo0); sr_[i].vs1 = *reinterpret_cast<const GAS bf16x8*>(Vt_ + vo1); \
    sr_[i].ks0 = *reinterpret_cast<const GAS bf16x8*>(Kt_ + ko0); if constexpr (DQK == 128) sr_[i].ks1 = *reinterpret_cast<const GAS bf16x8*>(Kt_ + ko1); } while (0)
#define FA_SWRITE(b, i) do { *(LAS bf16x8*)(V_lds + (b) * SHM_V + vst0) = sr_[i].vs0; *(LAS bf16x8*)(V_lds + (b) * SHM_V + vst1) = sr_[i].vs1; \
    *(LAS bf16x8*)(K_lds + (b) * SHM_K + FA_KSWZ(kr, kc * 2, RB)) = sr_[i].ks0; if constexpr (DQK == 128) *(LAS bf16x8*)(K_lds + (b) * SHM_K + FA_KSWZ(32 + kr, kc * 2, RB)) = sr_[i].ks1; } while (0)
#define FA_SWAIT() do { if constexpr (SDEPTH == 1) asm volatile("s_waitcnt vmcnt(0)" ::: "memory"); else if constexpr (DQK == 128) asm volatile("s_waitcnt vmcnt(4)" ::: "memory"); else asm volatile("s_waitcnt vmcnt(3)" ::: "memory"); } while (0)
#define FA_RESC(a) do { if (__any((a) < 1.f)) { if (hi == 0) al_l[r32] = (a); asm volatile("s_waitcnt lgkmcnt(0)" ::: "memory"); \
    _Pragma("unroll") for (int d = 0; d < 4; ++d) _Pragma("unroll") for (int r = 0; r < 16; ++r) o[d][r] *= al_l[crow(r, hi)]; } } while (0)
  f32x16 pA0, pA1, pB0, pB1; float mnA, mnB, alA, alB; bf16x8 pa0, pa1, pa2, pa3; const int NT = seq / KVBLK;
  constexpr int SE = 0, SO = SDEPTH - 1;
  FA_SLOAD(SE, 0); asm volatile("s_waitcnt vmcnt(0)" ::: "memory"); FA_SWRITE(0, SE); __syncthreads();
  qkt<DQK>(pA0, pA1, K_lds, qr, r32, hi); partialSM<DQK>(pA0, pA1, m_reg, mnA, alA);
  FA_SLOAD(SO, KVBLK); if constexpr (SDEPTH == 2) { if (2 < NT) FA_SLOAD(SE, 2 * KVBLK); }
  FA_SWAIT(); FA_SWRITE(1, SO); __syncthreads();
  for (int j = 1; j + 1 < NT; j += 2) {
    FA_SBAR(); qkt<DQK>(pB0, pB1, K_lds + SHM_K, qr, r32, hi);
    finishSM(pA0, pA1, alA, l_reg, pa0, pa1, pa2, pa3); FA_SBAR();
    FA_SLOAD(SO, (j + SDEPTH) * KVBLK); FA_SBAR();
    pv_d0(o, vb0, pa0, pa1, pa2, pa3); partialSM<DQK>(pB0, pB1, m_reg, mnB, alB);
    __syncthreads(); FA_SWAIT(); FA_SWRITE(0, SE);
    FA_RESC(alB); __syncthreads();
    FA_SBAR(); qkt<DQK>(pA0, pA1, K_lds, qr, r32, hi);
    finishSM(pB0, pB1, alB, l_reg, pa0, pa1, pa2, pa3); FA_SBAR();
    if (SDEPTH == 1 || j + 3 < NT) FA_SLOAD(SE, (j + 1 + SDEPTH) * KVBLK); FA_SBAR();
    pv_d0(o, vb0 + SHM_V, pa0, pa1, pa2, pa3); partialSM<DQK>(pA0, pA1, m_reg, mnA, alA);
    __syncthreads(); FA_SWAIT(); FA_SWRITE(1, SO);
    FA_RESC(alA); __syncthreads();
  }
  FA_SBAR(); qkt<DQK>(pB0, pB1, K_lds + SHM_K, qr, r32, hi);
  finishSM(pA0, pA1, alA, l_reg, pa0, pa1, pa2, pa3); FA_SBAR();
  pv_d0(o, vb0, pa0, pa1, pa2, pa3); partialSM<DQK>(pB0, pB1, m_reg, mnB, alB);
  __syncthreads(); FA_RESC(alB);
  finishSM(pB0, pB1, alB, l_reg, pa0, pa1, pa2, pa3); FA_SBAR();
  pv_d0(o, vb0 + SHM_V, pa0, pa1, pa2, pa3);
  if (hi == 0) li_l[r32] = l_reg; asm volatile("s_waitcnt lgkmcnt(0)" ::: "memory");
  if (stats != nullptr && hi == 0) ((GAS f32x2*)stats)[wid * QBLK + r32] = (f32x2){m_reg, l_reg};
  int r32e = r32, hie = hi; asm volatile("" : "+v"(r32e), "+v"(hie));
  float rli[16];
#pragma unroll
  for (int r = 0; r < 16; ++r) rli[r] = __builtin_amdgcn_rcpf(li_l[crow(r, hie)]);
  GAS bf16* Ow = (GAS bf16*)Ob + (size_t)(wid * QBLK) * ldo;
  const unsigned oo = (unsigned)(4 * hie * ldo + r32e);
#pragma unroll
  for (int r = 0; r < 16; ++r) { const unsigned orow = (unsigned)((r & 3) + 8 * (r >> 2));
#pragma unroll
    for (int d0 = 0; d0 < 4; ++d0) Ow[oo + orow * ldo + d0 * 32] = (bf16)f2bf(o[d0][r] * rli[r]); }
#undef FA_SLOAD
#undef FA_SWRITE
#undef FA_SWAIT
#undef FA_RESC
}


constexpr float THR2 = THR * 1.4426950408889634f;
template <bool FORCE>
__device__ __forceinline__ void partialSM2(f32x16& p0, f32x16& p1, float& m_run, f32x16& negm, float& alpha) {
  float pmax = p0[0];
#pragma unroll
  for (int r = 1; r < 16; ++r) pmax = fmaxf(pmax, p0[r]);
#pragma unroll
  for (int r = 0; r < 16; ++r) pmax = fmaxf(pmax, p1[r]);
  { const f32x2 s2 = swap32(pmax); pmax = fmaxf(s2.x, s2.y); }
  if (!FORCE && __builtin_expect(__all(pmax <= THR2), 1)) { alpha = 1.f; }
  else { const float d = FORCE ? pmax : fmaxf(pmax, 0.f); alpha = FORCE ? 1.f : __builtin_amdgcn_exp2f(-d); m_run += d;
#pragma unroll
    for (int r = 0; r < 16; ++r) { p0[r] -= d; p1[r] -= d; negm[r] = -m_run; } }
#pragma unroll
  for (int r = 0; r < 16; ++r) p0[r] = __builtin_amdgcn_exp2f(p0[r]);
}
__device__ __forceinline__ void qkt64n(f32x16& p0, f32x16& p1, const LAS char* Ks, const bf16x8* qr, const f32x16& negm, int r32, int hi) {
  constexpr int RB = 128;
#pragma unroll
  for (int d0 = 0; d0 < 4; ++d0) { const int cb = (d0 * 16 + hi * 8) * 2;
    bf16x8 b0 = *reinterpret_cast<const LAS bf16x8*>(Ks + FA_KSWZ(r32, cb, RB));
    bf16x8 b1 = *reinterpret_cast<const LAS bf16x8*>(Ks + FA_KSWZ(32 + r32, cb, RB));
    if (d0 == 0) { p0 = __builtin_amdgcn_mfma_f32_32x32x16_bf16(b0, qr[0], negm, 0, 0, 0); p1 = __builtin_amdgcn_mfma_f32_32x32x16_bf16(b1, qr[0], negm, 0, 0, 0); }
    else { p0 = __builtin_amdgcn_mfma_f32_32x32x16_bf16(b0, qr[d0], p0, 0, 0, 0); p1 = __builtin_amdgcn_mfma_f32_32x32x16_bf16(b1, qr[d0], p1, 0, 0, 0); } }
}
struct DiffFuse { int mode; float lam, post; const float* hg; };
template <int DQK, int LDI>
__device__ __forceinline__ void attn_unit3(const bf16* __restrict__ Qb, const bf16* __restrict__ Kh, const bf16* __restrict__ Vh, bf16* __restrict__ Ob, const int ldo, float* stats, int seq, LAS char* lds, int tid, const DiffFuse fz = DiffFuse{0, 0.f, 0.f, nullptr}) {
  constexpr int ldq = LDI, ldk = LDI, ldv = LDI;
  constexpr int RB = Cfg<DQK>::RB, SHM_K = Cfg<DQK>::SHM_K, ND0 = Cfg<DQK>::ND0;
  const int wid = tid >> 6, lane = tid & 63, r32 = lane & 31, hi = lane >> 5;
  LAS char* V_lds = lds; LAS char* K_lds = lds + 3 * SHM_V;
  LAS float* ws = (LAS float*)(lds + 3 * SHM_V + 3 * SHM_K) + wid * 64; LAS float* li_l = ws; LAS float* al_l = ws + 32;
  float m_reg = -1e30f, l_reg = 0; f32x16 o[4] = {}; bf16x8 qr[ND0];
  __syncthreads();
  const GAS bf16* Qw = (const GAS bf16*)Qb + (size_t)(wid * QBLK + r32) * ldq + hi * 8;
#pragma unroll
  for (int d0 = 0; d0 < ND0; ++d0) qr[d0] = *reinterpret_cast<const GAS bf16x8*>(Qw + d0 * 16);
  const int sr = tid >> 4, sc = (tid & 15) * 8, vst0 = v_st(sr, sc), vst1 = v_st(32 + sr, sc);
  const int kr = DQK == 128 ? sr : (tid >> 3), kc = DQK == 128 ? sc : (tid & 7) * 8;
  const int kst0 = FA_KSWZ(kr, kc * 2, RB), kst1 = FA_KSWZ(32 + kr, kc * 2, RB);
  const int vb0 = (int)(unsigned)(size_t)V_lds + v_rd_base(lane);
  bf16x8 vs0, vs1, ks0, ks1;
  const unsigned vo0 = (unsigned)(sr * ldv + sc), ko0 = (unsigned)(kr * ldk + kc);
#define F3_SLOAD(k0) do { const GAS bf16* Vt_ = (const GAS bf16*)Vh + (size_t)(k0) * ldv; const GAS bf16* Kt_ = (const GAS bf16*)Kh + (size_t)(k0) * ldk; \
    vs0 = *reinterpret_cast<const GAS bf16x8*>(Vt_ + vo0); vs1 = *reinterpret_cast<const GAS bf16x8*>(Vt_ + (size_t)32 * ldv + vo0); \
    ks0 = *reinterpret_cast<const GAS bf16x8*>(Kt_ + ko0); if constexpr (DQK == 128) ks1 = *reinterpret_cast<const GAS bf16x8*>(Kt_ + (size_t)32 * ldk + ko0); } while (0)
#define F3_SWRITE(b) do { asm volatile("s_waitcnt vmcnt(0)" ::: "memory"); *(LAS bf16x8*)(V_lds + (b) * SHM_V + vst0) = vs0; *(LAS bf16x8*)(V_lds + (b) * SHM_V + vst1) = vs1; \
    *(LAS bf16x8*)(K_lds + (b) * SHM_K + kst0) = ks0; if constexpr (DQK == 128) *(LAS bf16x8*)(K_lds + (b) * SHM_K + kst1) = ks1; } while (0)
#define F3_RESC(a) do { if (__any((a) < 1.f)) { if (hi == 0) al_l[r32] = (a); asm volatile("s_waitcnt lgkmcnt(0)" ::: "memory"); \
    _Pragma("unroll") for (int d = 0; d < 4; ++d) _Pragma("unroll") for (int r = 0; r < 16; ++r) o[d][r] *= al_l[crow(r, hi)]; } } while (0)
  f32x16 pA0, pA1, pB0, pB1; float mnA, mnB, alA, alB; bf16x8 pa0, pa1, pa2, pa3; const int NT = seq / KVBLK;
  constexpr bool NEGM = (DQK == 64) && (ATTN_NEGM != 0);
  f32x16 negm = {}; if constexpr (NEGM) m_reg = 0.f;
#define F3_QKT(P0, P1, KS) do { if constexpr (NEGM) qkt64n(P0, P1, KS, qr, negm, r32, hi); else qkt<DQK>(P0, P1, KS, qr, r32, hi); } while (0)
#define F3_PSM(P0, P1, MN, AL) do { if constexpr (NEGM) partialSM2<false>(P0, P1, m_reg, negm, AL); else partialSM<DQK>(P0, P1, m_reg, MN, AL); } while (0)
  F3_SLOAD(0); F3_SWRITE(0); F3_SLOAD(KVBLK); F3_SWRITE(1); F3_SLOAD(2 * KVBLK); __syncthreads();
  F3_QKT(pA0, pA1, K_lds); if constexpr (NEGM) partialSM2<true>(pA0, pA1, m_reg, negm, alA); else F3_PSM(pA0, pA1, mnA, alA);
  int bc = 0, bn = 1, bw = 2;
  int j = 0;
  for (; j + 2 < NT; j += 2) {
    FA_SBAR(); F3_QKT(pB0, pB1, K_lds + bn * SHM_K);
    finishSM(pA0, pA1, alA, l_reg, pa0, pa1, pa2, pa3); FA_SBAR();
    F3_SWRITE(bw); F3_SLOAD((j + 3) * KVBLK); FA_SBAR();
    pv_d0(o, vb0 + bc * SHM_V, pa0, pa1, pa2, pa3); F3_PSM(pB0, pB1, mnB, alB);
    F3_RESC(alB); __syncthreads();
    { const int t = bc; bc = bn; bn = bw; bw = t; }
    FA_SBAR(); F3_QKT(pA0, pA1, K_lds + bn * SHM_K);
    finishSM(pB0, pB1, alB, l_reg, pa0, pa1, pa2, pa3); FA_SBAR();
    F3_SWRITE(bw); if (j + 4 < NT) F3_SLOAD((j + 4) * KVBLK); FA_SBAR();
    pv_d0(o, vb0 + bc * SHM_V, pa0, pa1, pa2, pa3); F3_PSM(pA0, pA1, mnA, alA);
    F3_RESC(alA); __syncthreads();
    { const int t = bc; bc = bn; bn = bw; bw = t; }
  }
  FA_SBAR(); F3_QKT(pB0, pB1, K_lds + bn * SHM_K);
  finishSM(pA0, pA1, alA, l_reg, pa0, pa1, pa2, pa3); FA_SBAR();
  pv_d0(o, vb0 + bc * SHM_V, pa0, pa1, pa2, pa3); F3_PSM(pB0, pB1, mnB, alB);
  F3_RESC(alB);
  finishSM(pB0, pB1, alB, l_reg, pa0, pa1, pa2, pa3); FA_SBAR();
  pv_d0(o, vb0 + bn * SHM_V, pa0, pa1, pa2, pa3);
  if (hi == 0) li_l[r32] = l_reg; asm volatile("s_waitcnt lgkmcnt(0)" ::: "memory");
  if (stats != nullptr && hi == 0) ((GAS f32x2*)stats)[wid * QBLK + r32] = (f32x2){m_reg, l_reg};
  int r32e = r32, hie = hi, wide = wid; float poste = fz.post; asm volatile("" : "+v"(r32e), "+v"(hie), "+v"(wide), "+s"(poste));
  float rli[16];
#pragma unroll
  for (int r = 0; r < 16; ++r) rli[r] = __builtin_amdgcn_rcpf(li_l[crow(r, hie)]);
  LAS bf16* stash = (LAS bf16*)(lds + 3 * SHM_V + 3 * SHM_K + 2048) + (size_t)(wide * QBLK) * DV;
  const unsigned so = (unsigned)(4 * hie * DV + r32e);
  if (fz.mode == 1) {
#pragma unroll
    for (int r = 0; r < 16; ++r) { const unsigned orow = (unsigned)((r & 3) + 8 * (r >> 2));
#pragma unroll
      for (int d0 = 0; d0 < 4; ++d0) stash[so + orow * DV + d0 * 32] = (bf16)f2bf(o[d0][r] * rli[r]); }
    asm volatile("s_waitcnt lgkmcnt(0)" ::: "memory");
  } else {
    GAS bf16* Ow = (GAS bf16*)Ob;
    const unsigned oo = (unsigned)((wide * QBLK + 4 * hie) * ldo + r32e);
    if (fz.mode == 2) {
      float hgv[4];
#pragma unroll
      for (int d0 = 0; d0 < 4; ++d0) hgv[d0] = ((const GAS float*)fz.hg)[d0 * 32 + r32e] * (1.f - poste);
      float ss[16];
#pragma unroll
      for (int r = 0; r < 16; ++r) { const unsigned orow = (unsigned)((r & 3) + 8 * (r >> 2)); float a = 0.f;
#pragma unroll
        for (int d0 = 0; d0 < 4; ++d0) { const float v = bf2f(stash[so + orow * DV + d0 * 32]) - fz.lam * (o[d0][r] * rli[r]); o[d0][r] = v; a += v * v; }
        ss[r] = a; }
      { float t[16];
#define F3_RS(M) _Pragma("unroll") for (int r = 0; r < 16; ++r) t[r] = swz_xor<M>(ss[r]); _Pragma("unroll") for (int r = 0; r < 16; ++r) ss[r] += t[r];
        F3_RS(1) F3_RS(2) F3_RS(4) F3_RS(8) F3_RS(16)
#undef F3_RS
      }
#pragma unroll
      for (int r = 0; r < 16; ++r) { const unsigned orow = (unsigned)((r & 3) + 8 * (r >> 2)); const float rs = rsqrtf(ss[r] * (1.f / 128.f) + EPS);
#pragma unroll
        for (int d0 = 0; d0 < 4; ++d0) Ow[oo + orow * ldo + d0 * 32] = (bf16)f2bf(o[d0][r] * rs * hgv[d0]); }
    } else {
#pragma unroll
      for (int r = 0; r < 16; ++r) { const unsigned orow = (unsigned)((r & 3) + 8 * (r >> 2));
#pragma unroll
        for (int d0 = 0; d0 < 4; ++d0) Ow[oo + orow * ldo + d0 * 32] = (bf16)f2bf(o[d0][r] * rli[r]); }
    }
  }
#undef F3_SLOAD
#undef F3_QKT
#undef F3_PSM
#undef F3_SWRITE
#undef F3_RESC
}
}

#ifndef FAST_ATTN
#define FAST_ATTN 1
#endif

constexpr int AE_NL = NB * 6 * (SEQ / 256), AE_FULL = 256, AE_SPLIT = AE_NL - AE_FULL, AE_ITEMS = AE_FULL + 2 * AE_SPLIT + NB * 6;
__device__ __forceinline__ void fphase_attn_e(const Frame& F_) { const Frame F = fresh(F_);
    const bf16* P = (const bf16*)(F.ws + WS_PBUF); bf16* OA = (bf16*)(F.ws + WS_OA);
    for (int w = F.bid; w < AE_ITEMS; w += F.G) {
        int u, part = -1;
        if (w < AE_FULL) u = w; else if (w < AE_FULL + 2 * AE_SPLIT) { u = AE_FULL + ((w - AE_FULL) >> 1); part = (w - AE_FULL) & 1; } else u = AE_NL + (w - AE_FULL - 2 * AE_SPLIT);
        int b, h, q0, nk;
        if (u < AE_NL) { b = u / (6 * 32); h = (u / 32) % 6; q0 = CTX + 256 * (u % 32); nk = TPB; }
        else { const int v = u - AE_NL; b = v / 6; h = v % 6; q0 = 0; nk = CTX; }
        const size_t rq = (size_t)(b * TPB + q0); size_t rk = (size_t)b * TPB;
        bf16* ob = OA + rq * OAE + h * 128; int ldo = OAE; float* st = nullptr;
        if (part >= 0) { nk = TPB / 2; rk += (size_t)part * (TPB / 2); const int su = u - AE_FULL;
            ob = (bf16*)(F.ws + WS_OPART) + ((size_t)(part * AE_SPLIT + su) * 256) * 128; ldo = 128; st = (float*)(F.ws + WS_OSTAT) + ((size_t)(part * AE_SPLIT + su) * 256) * 2; }
        if (ATTN_RING3) fa::attn_unit3<128, EIN>(uptr(P + rq * EIN + h * 128), uptr(P + rk * EIN + 768 + (h / 3) * 128), uptr(P + rk * EIN + 1024 + (h / 3) * 128), uptr(ob), __builtin_amdgcn_readfirstlane(ldo), uptr(st), __builtin_amdgcn_readfirstlane(nk), (LAS char*)F.lds, F.tid);
        else fa::attn_unit<128, EIN, 1>(P + rq * EIN + h * 128, P + rk * EIN + 768 + (h / 3) * 128, P + rk * EIN + 1024 + (h / 3) * 128, ob, ldo, st, nk, (LAS char*)F.lds, F.tid);
    }
}
__device__ __forceinline__ void phase_attn_merge(const Frame& F_) { const Frame F = fresh(F_);
    const int gw = F.bid * NWAVES + F.wave, NGW = F.G * NWAVES, lane = F.lane;
    constexpr float C = 0.088388347648318440f * 1.4426950408889634f;
    for (int it = gw; it < AE_SPLIT * 256; it += NGW) {
        const int su = it >> 8, r = it & 255, u = AE_FULL + su, b = u / (6 * 32), h = (u / 32) % 6, q0 = CTX + 256 * (u % 32);
        const f32x2 sa = ((const GAS f32x2*)(F.ws + WS_OSTAT))[(size_t)su * 256 + r], sb = ((const GAS f32x2*)(F.ws + WS_OSTAT))[(size_t)(AE_SPLIT + su) * 256 + r];
        const float M = fmaxf(sa.x, sb.x), wa = sa.y * __builtin_amdgcn_exp2f((sa.x - M) * C), wb = sb.y * __builtin_amdgcn_exp2f((sb.x - M) * C), rw = 1.f / (wa + wb);
        const unsigned pa = ((const GAS unsigned*)((const bf16*)(F.ws + WS_OPART) + ((size_t)su * 256 + r) * 128))[lane], pb = ((const GAS unsigned*)((const bf16*)(F.ws + WS_OPART) + ((size_t)(AE_SPLIT + su) * 256 + r) * 128))[lane];
        const float o0 = (wa * bflo(pa) + wb * bflo(pb)) * rw, o1 = (wa * bfhi(pa) + wb * bfhi(pb)) * rw;
        ((GAS unsigned*)((bf16*)(F.ws + WS_OA) + (size_t)(b * TPB + q0 + r) * OAE + h * 128))[lane] = pk2(o0, o1);
    }
}
#ifndef ATTN_FUSE_O
#define ATTN_FUSE_O 1
#endif
__device__ __forceinline__ void fphase_attn_o(const Frame& F_, const Args& A, int i) { const Frame F = fresh(F_);
    const bf16* P = (const bf16*)(F.ws + WS_PBUF);
    if (ATTN_RING3 && ATTN_FUSE_O) {
        bf16* OA = (bf16*)(F.ws + WS_OA);
        const float lam = __builtin_bit_cast(float, __builtin_amdgcn_readfirstlane(__builtin_bit_cast(int, ((const float*)(F.ws + WS_LAM))[2 * i])));
        const float post = __builtin_bit_cast(float, __builtin_amdgcn_readfirstlane(__builtin_bit_cast(int, ((const float*)(F.ws + WS_LAM))[2 * i + 1])));
        const float* hg = uptr(AIN(17) + i * 128);
        constexpr int NL = NB * 8 * (SEQ / 256), NC = NB * 8;
        for (int u = F.bid; u < NL + NC; u += F.G) {
            int b, h, q0, nk;
            if (u < NL) { b = u / (8 * 32); h = (u / 32) % 8; q0 = CTX + 256 * (u % 32); nk = TPB; }
            else { const int v = u - NL; b = v / 8; h = v % 8; q0 = 0; nk = CTX; }
            const size_t rq = (size_t)(b * TPB + q0), rk = (size_t)b * TPB;
            for (int m = 0; m < 2; ++m) { const int g = 2 * h + m;
                fa::attn_unit3<64, OIN>(uptr(P + rq * OIN + g * 64), uptr(P + rk * OIN + 1024 + g * 64), uptr(P + rk * OIN + 2048 + h * 128), uptr(OA + rq * OAO + h * 128), OAO, nullptr,
                                        __builtin_amdgcn_readfirstlane(nk), (LAS char*)F.lds, F.tid, fa::DiffFuse{1 + m, lam, post, hg}); }
        }
        return;
    }
    bf16* OT = (bf16*)(F.ws + WS_OT);
    constexpr int NL = NB * 16 * (SEQ / 256), NC = NB * 16;
    for (int u = F.bid; u < NL + NC; u += F.G) {
        int b, g, q0, nk;
        if (u < NL) { b = u / (16 * 32); g = (u / 32) % 16; q0 = CTX + 256 * (u % 32); nk = TPB; }
        else { const int v = u - NL; b = v / 16; g = v % 16; q0 = 0; nk = CTX; }
        const size_t rq = (size_t)(b * TPB + q0), rk = (size_t)b * TPB;
        fa::attn_unit<64, OIN, 2>(P + rq * OIN + g * 64, P + rk * OIN + 1024 + g * 64, P + rk * OIN + 2048 + (g / 2) * 128, OT + rq * OTW + g * 128, OTW, nullptr, nk, (LAS char*)F.lds, F.tid);
    }
}

#ifndef FAST_FFT
#define FAST_FFT 1
#endif
template <int NTILE, class Gen, class Out>
__device__ __forceinline__ void dft_unit(LAS char* lds, const bf16* data, unsigned ldv, int nch, int rowbase, int vsel, Gen gen, GAS bf16* obase, float oscale, Out out_off, int tid) {
    const int lane = tid & 63, r32 = lane & 31, hi = lane >> 5;
    const int sr = tid >> 4, sc = (tid & 15) * 8, vst0 = fa::v_st(sr, sc), vst1 = fa::v_st(32 + sr, sc);
    const int vb = (int)(unsigned)(size_t)lds + vsel * fa::SHM_V + fa::v_rd_base(lane);
    fa::f32x16 o[4] = {};
    for (int ch = 0; ch < nch; ++ch) {
        __syncthreads();
#pragma unroll
        for (int t = 0; t < NTILE; ++t) {
            const GAS bf16* dt = (const GAS bf16*)data + (size_t)(64 * ch) * ldv + 128 * t;
            const fa::bf16x8 a = *reinterpret_cast<const GAS fa::bf16x8*>(dt + (unsigned)sr * ldv + sc), c = *reinterpret_cast<const GAS fa::bf16x8*>(dt + (unsigned)(32 + sr) * ldv + sc);
            *(LAS fa::bf16x8*)(lds + t * fa::SHM_V + vst0) = a; *(LAS fa::bf16x8*)(lds + t * fa::SHM_V + vst1) = c;
        }
        fa::bf16x8 pa[4];
#pragma unroll
        for (int ks = 0; ks < 4; ++ks) { const int k0 = 64 * ch + 16 * ks + 8 * hi; u32x4 w;
            w.x = fa::cvtpk(gen(rowbase + r32, k0 + 0), gen(rowbase + r32, k0 + 1)); w.y = fa::cvtpk(gen(rowbase + r32, k0 + 2), gen(rowbase + r32, k0 + 3));
            w.z = fa::cvtpk(gen(rowbase + r32, k0 + 4), gen(rowbase + r32, k0 + 5)); w.w = fa::cvtpk(gen(rowbase + r32, k0 + 6), gen(rowbase + r32, k0 + 7));
            pa[ks] = *reinterpret_cast<fa::bf16x8*>(&w); }
        __syncthreads();
        fa::pv_d0(o, vb, pa[0], pa[1], pa[2], pa[3]);
    }
    int r32e = r32, hie = hi; asm volatile("" : "+v"(r32e), "+v"(hie));
#pragma unroll
    for (int r = 0; r < 16; ++r)
#pragma unroll
        for (int d0 = 0; d0 < 4; ++d0) obase[out_off(rowbase + (r & 3) + 8 * (r >> 2) + 4 * hie, 32 * d0 + r32e)] = (bf16)f2bf(o[d0][r] * oscale);
}
__device__ __forceinline__ void fphase_fft1(const Frame& F_) { const Frame F = fresh(F_);
    for (int u = F.bid; u < NB * 64 * 2; u += F.G) {
        const int ch2 = u & 1, t2 = (u >> 1) & 63, b = u >> 7;
        const bf16* data = uptr((const bf16*)(F.ws + WS_PBUF) + (size_t)(b * TPB + CTX + t2) * EIN + 1280 + 128 * ch2);
        GAS bf16* yb = (GAS bf16*)uptr((bf16*)(F.ws + WS_YB) + ((size_t)b * 128 * 2 * 64 + t2) * 256 + 128 * ch2);
        dft_unit<1>((LAS char*)F.lds, data, 64u * EIN, 2, 32 * F.wave, 0,
            [&](int rho, int kap) { const int k1 = rho & 127, t = 64 * kap + t2; const float fr = (float)((k1 * t) & 8191) * (1.f / 8192.f); return (rho >> 7) ? -__builtin_amdgcn_sinf(fr) : __builtin_amdgcn_cosf(fr); },
            yb, 1.f, [&](int rho, int col) { return (unsigned)((((rho & 127) * 2 + (rho >> 7)) * 64) * 256 + col); }, F.tid);
    }
}
__device__ __forceinline__ void fphase_fft2(const Frame& F_) { const Frame F = fresh(F_);
    const float norm = 0.0013810679320049757f, normc = 0.0078125f;
    constexpr int BUSY = 0;
    const int nfree = F.G > BUSY ? F.G - BUSY : F.G, vb0 = F.G > BUSY ? F.bid - BUSY : F.bid;
    if (vb0 < 0) return;
    for (int u = vb0; u < NB * 128; u += nfree) {
        const int k1 = u & 127, b = u >> 7;
        const bf16* data = uptr((const bf16*)(F.ws + WS_YB) + (size_t)(b * 128 + k1) * 2 * 64 * 256);
        bf16* oa_ = uptr((bf16*)(F.ws + WS_OA) + (size_t)(b * TPB + CTX + k1) * OAE + 768 + 128 * (F.wave >> 2));
        dft_unit<2>((LAS char*)F.lds, data, 256u, 2, 32 * (F.wave & 3), F.wave >> 2,
            [&](int rho, int kap) { const int k2 = rho & 63, ro = rho >> 6, t2 = kap & 63, si = kap >> 6; const float fr = (float)((k2 * t2) & 63) * (1.f / 64.f);
                return (ro == si) ? __builtin_amdgcn_cosf(fr) : (ro ? -__builtin_amdgcn_sinf(fr) : __builtin_amdgcn_sinf(fr)); },
            (GAS bf16*)oa_, norm, [&](int rho, int col) { return (unsigned)((128 * (rho & 63)) * OAE + (rho >> 6) * 256 + col); }, F.tid);
    }
    for (int u = vb0; u < 8; u += nfree) {
        const int rb = u & 1, ch2 = (u >> 1) & 1, b = u >> 2;
        const bf16* data = uptr((const bf16*)(F.ws + WS_PBUF) + (size_t)(b * TPB) * EIN + 1280 + 128 * ch2);
        bf16* oa_ = uptr((bf16*)(F.ws + WS_OA) + (size_t)(b * TPB) * OAE + 768 + 128 * ch2);
        dft_unit<1>((LAS char*)F.lds, data, (unsigned)EIN, 4, 256 * rb + 32 * F.wave, 0,
            [&](int rho, int kap) { const int k = rho & 255; const float fr = (float)((k * kap) & 255) * (1.f / 256.f); return (rho >> 8) ? -__builtin_amdgcn_sinf(fr) : __builtin_amdgcn_cosf(fr); },
            (GAS bf16*)oa_, normc, [&](int rho, int col) { return (unsigned)((rho & 255) * OAE + (rho >> 8) * 256 + col); }, F.tid);
    }
}

__device__ __forceinline__ void sphase_attn_e(const Frame& F_) { const Frame F = fresh(F_);
    const bf16* P = (const bf16*)(F.ws + WS_PBUF); bf16* OA = (bf16*)(F.ws + WS_OA);
    const int NL = NB * 6 * (SEQ / 32), NC = NB * 6 * (CTX / 32);
    for (int u = F.bid; u < NL + NC; u += F.G) {
        int b, h, q0, nk;
        if (u < NL) { b = u / (6 * 256); h = (u / 256) % 6; q0 = CTX + 32 * (u % 256); nk = TPB; }
        else { const int v = u - NL; b = v / (6 * 8); h = (v / 8) % 6; q0 = 32 * (v % 8); nk = CTX; }
        const size_t rq = (size_t)(b * TPB + q0), rk = (size_t)b * TPB;
        sattn_unit<128>((LAS float*)F.lds, P + rq * EIN + h * 128, EIN, P + rk * EIN + 768 + (h / 3) * 128, EIN, P + rk * EIN + 1024 + (h / 3) * 128, EIN,
                        OA + rq * OAE + h * 128, OAE, nk, 0.08838834764831845f, F.tid);
    }
}
__device__ __forceinline__ void sphase_attn_o(const Frame& F_) { const Frame F = fresh(F_);
    const bf16* P = (const bf16*)(F.ws + WS_PBUF); bf16* OT = (bf16*)(F.ws + WS_OT);
    const int NL = NB * 16 * (SEQ / 32), NC = NB * 16 * (CTX / 32);
    for (int u = F.bid; u < NL + NC; u += F.G) {
        int b, g, q0, nk;
        if (u < NL) { b = u / (16 * 256); g = (u / 256) % 16; q0 = CTX + 32 * (u % 256); nk = TPB; }
        else { const int v = u - NL; b = v / (16 * 8); g = (v / 8) % 16; q0 = 32 * (v % 8); nk = CTX; }
        const size_t rq = (size_t)(b * TPB + q0), rk = (size_t)b * TPB;
        sattn_unit<64>((LAS float*)F.lds, P + rq * OIN + g * 64, OIN, P + rk * OIN + 1024 + g * 64, OIN, P + rk * OIN + 2048 + (g / 2) * 128, OIN,
                       OT + rq * OTW + g * 128, OTW, nk, 0.125f, F.tid);
    }
}

__global__ void __launch_bounds__(NTHREADS, 2) fwd_kernel(Args args) {
    extern __shared__ __attribute__((aligned(16))) unsigned char lds_raw[];
    Frame F;
    F.lds = (LAS unsigned char*)lds_raw; F.ws = args.ws;
    F.tid = threadIdx.x; F.lane = F.tid & 63; F.wave = __builtin_amdgcn_readfirstlane(F.tid >> 6); F.bid = blockIdx.x; F.G = gridDim.x;
    volatile LAS unsigned* MISC = (volatile LAS unsigned*)(F.lds + MISC_OFF);
    if (F.tid < 32) MISC[F.tid] = 0u;
    __syncthreads();
    const int lo = args.ph_lo, hi = args.ph_hi;
    const bool multi = (hi - lo) > 1;
    XcdBarrier bar; bar.bar = (unsigned*)(F.ws + WS_CTL) + CW_BAR; bar.x = 0; bar.st = MISC + 8;
    if (multi) bar = xcd_barrier_post((unsigned*)(F.ws + WS_CTL) + CW_BAR, MISC + 8);
#define IN(k) (lo <= (k) && (k) < hi)
#ifdef PROBE_KIND
    volatile LAS unsigned long long* PRB = (volatile LAS unsigned long long*)(MISC + 16);
#define PROBE_BEGIN(kind) do { if ((kind) < 32 && ((PROBE_KIND >> (kind)) & 1)) { const Frame Fp = fresh(F); if (Fp.tid == 0) PRB[0] = __builtin_amdgcn_s_memrealtime(); } } while (0)
#define PROBE_END(kind) do { if ((kind) < 32 && ((PROBE_KIND >> (kind)) & 1)) { const Frame Fp = fresh(F); if (Fp.tid == 0) PRB[1] = PRB[1] + (__builtin_amdgcn_s_memrealtime() - PRB[0]); } } while (0)
#else
#define PROBE_BEGIN(kind) do {} while (0)
#define PROBE_END(kind) do {} while (0)
#endif
#define SEAM(k) do { if (IN(k) && IN((k) + 1)) { const Frame Fb = fresh(F); xcd_barrier(bar, Fb.tid == 0); } } while (0)
#define SEAMC(k, c) do { if ((c) && IN(k) && IN((k) + 1)) { const Frame Fb = fresh(F); xcd_barrier(bar, Fb.tid == 0); } } while (0)
    PROBE_BEGIN(16); if (IN(PH_PRO_A)) { phase_pro_a(F, args); } SEAM(PH_PRO_A); PROBE_END(16);
    PROBE_BEGIN(17); if (IN(PH_PRO_B)) { phase_pro_b(F, args); } SEAM(PH_PRO_B); PROBE_END(17);
    for (int l = 0; l < DEPTH; ++l) {
        const int p0 = PH_L0 + l * PPL, i = l >> 1; const bool even = (l & 1) == 0;
        PROBE_BEGIN(PL_INPROJ + (PROBE_PARITY < 0 ? 0 : ((l & 1) == PROBE_PARITY ? 0 : 1000))); if (IN(p0 + PL_INPROJ)) {
#if FAST_GEMM
            fphase_inproj(F, even, i);
#else
            if (even) sphase_gemm_bf16(F, (const bf16*)(F.ws + WS_HA), DM, (const bf16*)(F.ws + WS_WINE) + (size_t)i * EIN * DM, DM, (bf16*)(F.ws + WS_PBUF), EIN, NTOK, EIN, DM);
            else sphase_gemm_bf16(F, (const bf16*)(F.ws + WS_HA), DM, (const bf16*)(F.ws + WS_WINO) + (size_t)i * OIN * DM, DM, (bf16*)(F.ws + WS_PBUF), OIN, NTOK, OIN, DM);
#endif
        } SEAM(p0 + PL_INPROJ); PROBE_END(PL_INPROJ + (PROBE_PARITY < 0 ? 0 : ((l & 1) == PROBE_PARITY ? 0 : 1000)));
        PROBE_BEGIN(PL_QKFIX + (PROBE_PARITY < 0 ? 0 : ((l & 1) == PROBE_PARITY ? 0 : 1000))); if (IN(p0 + PL_QKFIX)) { if (even) { if (!(FAST_GEMM && EPI_NORM_E)) phase_qkfix_e(F, args, i); } else if (!FAST_GEMM) phase_qkfix_o(F); } SEAMC(p0 + PL_QKFIX, !FAST_GEMM || (even && !EPI_NORM_E)); PROBE_END(PL_QKFIX + (PROBE_PARITY < 0 ? 0 : ((l & 1) == PROBE_PARITY ? 0 : 1000)));
        PROBE_BEGIN(PL_FFT1 + (PROBE_PARITY < 0 ? 0 : ((l & 1) == PROBE_PARITY ? 0 : 1000))); if (IN(p0 + PL_FFT1)) { if (even) { if (FAST_FFT) fphase_fft1(F); else sphase_fft1(F); } } SEAMC(p0 + PL_FFT1, even); PROBE_END(PL_FFT1 + (PROBE_PARITY < 0 ? 0 : ((l & 1) == PROBE_PARITY ? 0 : 1000)));
        PROBE_BEGIN(PL_ATTN + (PROBE_PARITY < 0 ? 0 : ((l & 1) == PROBE_PARITY ? 0 : 1000))); if (IN(p0 + PL_ATTN)) { if (even) { if (FAST_ATTN) fphase_attn_e(F); else sphase_attn_e(F); if (FAST_FFT) fphase_fft2(F); else { sphase_fft2(F); sphase_fftc(F); } } else { if (FAST_ATTN) fphase_attn_o(F, args, i); else sphase_attn_o(F); } } SEAM(p0 + PL_ATTN); PROBE_END(PL_ATTN + (PROBE_PARITY < 0 ? 0 : ((l & 1) == PROBE_PARITY ? 0 : 1000)));
        PROBE_BEGIN(PL_FINISH + (PROBE_PARITY < 0 ? 0 : ((l & 1) == PROBE_PARITY ? 0 : 1000))); if (IN(p0 + PL_FINISH)) { if (!even) { if (!(FAST_ATTN && ATTN_RING3 && ATTN_FUSE_O)) phase_finish_o(F, args, i); } else if (FAST_ATTN) phase_attn_merge(F); } SEAMC(p0 + PL_FINISH, even || !(FAST_ATTN && ATTN_RING3 && ATTN_FUSE_O)); PROBE_END(PL_FINISH + (PROBE_PARITY < 0 ? 0 : ((l & 1) == PROBE_PARITY ? 0 : 1000)));
        PROBE_BEGIN(PL_OUTPROJ + (PROBE_PARITY < 0 ? 0 : ((l & 1) == PROBE_PARITY ? 0 : 1000))); if (IN(p0 + PL_OUTPROJ)) {
#if FAST_GEMM
            fphase_outproj(F, even, i, l);
#else
            if (even) sphase_outproj(F, (const bf16*)(F.ws + WS_OA), OAE, (const bf16*)(F.ws + WS_WOUTE) + (size_t)i * DM * OAE, OAE, l);
            else sphase_outproj(F, (const bf16*)(F.ws + WS_OA), OAO, (const bf16*)(F.ws + WS_WOUTO) + (size_t)i * DM * DM, DM, l);
#endif
        } SEAM(p0 + PL_OUTPROJ); PROBE_END(PL_OUTPROJ + (PROBE_PARITY < 0 ? 0 : ((l & 1) == PROBE_PARITY ? 0 : 1000)));
        PROBE_BEGIN(PL_ROUTER + (PROBE_PARITY < 0 ? 0 : ((l & 1) == PROBE_PARITY ? 0 : 1000))); if (IN(p0 + PL_ROUTER)) { phase_router(F, args, l); } SEAM(p0 + PL_ROUTER); PROBE_END(PL_ROUTER + (PROBE_PARITY < 0 ? 0 : ((l & 1) == PROBE_PARITY ? 0 : 1000)));
        PROBE_BEGIN(PL_GU + (PROBE_PARITY < 0 ? 0 : ((l & 1) == PROBE_PARITY ? 0 : 1000))); if (IN(p0 + PL_GU)) { if (FAST_GEMM) fphase_moe_gu(F, l); else sphase_moe_gu(F, l); } SEAM(p0 + PL_GU); PROBE_END(PL_GU + (PROBE_PARITY < 0 ? 0 : ((l & 1) == PROBE_PARITY ? 0 : 1000)));
        PROBE_BEGIN(PL_DOWN + (PROBE_PARITY < 0 ? 0 : ((l & 1) == PROBE_PARITY ? 0 : 1000))); if (IN(p0 + PL_DOWN)) { if (FAST_GEMM) fphase_moe_down(F, l); else sphase_moe_down(F, l); } SEAM(p0 + PL_DOWN); PROBE_END(PL_DOWN + (PROBE_PARITY < 0 ? 0 : ((l & 1) == PROBE_PARITY ? 0 : 1000)));
        PROBE_BEGIN(PL_COMBINE + (PROBE_PARITY < 0 ? 0 : ((l & 1) == PROBE_PARITY ? 0 : 1000))); if (IN(p0 + PL_COMBINE)) { phase_combine(F, args, l); } SEAM(p0 + PL_COMBINE); PROBE_END(PL_COMBINE + (PROBE_PARITY < 0 ? 0 : ((l & 1) == PROBE_PARITY ? 0 : 1000)));
    }
#undef IN
#undef SEAM
#ifdef PROBE_KIND
    { const Frame Fp = fresh(F); if (Fp.bid == 0 && Fp.tid == 0) { const unsigned long long t1 = __builtin_amdgcn_s_memrealtime(), want = PRB[1] * PROBE_MULT; while (__builtin_amdgcn_s_memrealtime() - t1 < want) __builtin_amdgcn_s_sleep(8); } }
#endif
}

extern "C" void kernel_launch(void* const* d_in, const int* in_sizes, int n_in, void* d_out, int out_size, void* d_ws, size_t ws_size, hipStream_t stream) {
    static int grid = 0;
    if (grid == 0) {
        if (n_in != 26 || in_sizes[0] != NB * SEQ * DM || out_size != NB * SEQ * DM || ws_size < WS_END) {
            fprintf(stderr, "kernel_launch: shape/workspace mismatch (n_in %d, in0 %d, out %d, ws %zu, need %zu); nothing launched\n", n_in, n_in > 0 ? in_sizes[0] : -1, out_size, ws_size, (size_t)WS_END); grid = -1; return; }
        int dev = 0, cus = 0;
        if (hipGetDevice(&dev) != hipSuccess || hipDeviceGetAttribute(&cus, hipDeviceAttributeMultiprocessorCount, dev) != hipSuccess) { grid = -1; return; }
        if (hipFuncSetAttribute((const void*)fwd_kernel, hipFuncAttributeMaxDynamicSharedMemorySize, LDS_BYTES) != hipSuccess) { fprintf(stderr, "kernel_launch: hipFuncSetAttribute failed\n"); grid = -1; return; }
        int per_cu = 0;
        if (hipOccupancyMaxActiveBlocksPerMultiprocessor(&per_cu, (const void*)fwd_kernel, NTHREADS, LDS_BYTES) != hipSuccess || per_cu < 1) { fprintf(stderr, "kernel_launch: occupancy query says %d\n", per_cu); }
        (void)hipGetLastError();
        grid = cus;
    }
    if (grid < 0) return;
    (void)hipMemsetAsync((char*)d_ws + WS_CTL, 0, CTL_ZERO_BYTES, stream);
    Args a{};
    for (int i = 0; i < 26; ++i) a.in[i] = (const float*)d_in[i];
    a.out = (float*)d_out; a.ws = (unsigned char*)d_ws;
#if MK_ONE_LAUNCH
    a.ph_lo = 0; a.ph_hi = N_PHASES;
    hipLaunchKernelGGL(fwd_kernel, dim3(grid), dim3(NTHREADS), LDS_BYTES, stream, a);
#else
    for (int p = 0; p < N_PHASES; ++p) {
        if (p >= PH_L0) { const int l = (p - PH_L0) / PPL, k = (p - PH_L0) % PPL; const bool even = (l & 1) == 0;
            if ((k == PL_FFT1 && !even) || k == PL_GATHER || (k == PL_QKFIX && FAST_GEMM && (!even || EPI_NORM_E)) || (k == PL_FINISH && !even && FAST_ATTN && ATTN_RING3 && ATTN_FUSE_O)) continue; }
        a.ph_lo = p; a.ph_hi = p + 1;
        hipLaunchKernelGGL(fwd_kernel, dim3(grid), dim3(NTHREADS), LDS_BYTES, stream, a);
    }
#endif
}
```
